# Optimizing an MI355X kernel written in HIP

```python
import math
import jax
import jax.numpy as jnp
from jax import lax
import numpy as np

D_MODEL = 1024
BATCH = 4
SEQ = 4096
DEPTH = 4

GRID_W = 64
CTX_LEN = 256
N_MIXERS = 3
N_S5_LAYERS = (DEPTH + 2) // 3
N_SSD_LAYERS = (DEPTH + 1) // 3
N_MLA_LAYERS = DEPTH // 3
DEEPNORM_ALPHA = (2.0 * DEPTH) ** 0.25
DEEPNORM_BETA = (8.0 * DEPTH) ** -0.25
LN_EPS = 1e-5
RMS_EPS = 1e-6
ROPE_BASE = 10000.0

S5_GROUP = 16
S5_GROUPS = D_MODEL // S5_GROUP
S5_STATE = 64
S5_DT_MIN = 1e-3
S5_DT_MAX = 1e-1

SSD_D_INNER = 2 * D_MODEL
SSD_HEADDIM = 64
SSD_HEADS = SSD_D_INNER // SSD_HEADDIM
SSD_GROUPS = 4
SSD_STATE = 128
SSD_CONV = 3
SSD_CHUNK = 128
SSD_CONV_DIM = SSD_D_INNER + 2 * SSD_GROUPS * SSD_STATE
SSD_IN_DIM = SSD_D_INNER + SSD_CONV_DIM + 2 * SSD_HEADS

MLA_HEADS = 16
MLA_Q_RANK = 256
MLA_KV_RANK = 128
MLA_NOPE = 64
MLA_ROPE = 32
MLA_V = 64
MLA_BLOCK = 128

PEER_HEADS = 8
PEER_KEYS = 128
PEER_EXPERTS = PEER_KEYS * PEER_KEYS
PEER_QDIM = 256
PEER_TOPK = 16
PEER_BLOCK = 128

kernel_name = 'hybrid_s5_ssd_mla_peer_dit'


def layer_norm(x, g, b):
    xf = x.astype(jnp.float32)
    mu = jnp.mean(xf, axis=-1, keepdims=True)
    var = jnp.mean(jnp.square(xf - mu), axis=-1, keepdims=True)
    return ((xf - mu) * lax.rsqrt(var + LN_EPS)).astype(x.dtype) * g + b


def rms_norm(x, g):
    xf = x.astype(jnp.float32)
    return (xf * lax.rsqrt(jnp.mean(jnp.square(xf), axis=-1, keepdims=True) + RMS_EPS)).astype(x.dtype) * g


def modulate(x, shift, scale):
    return x * (1.0 + scale) + shift


def grid_positions(rows):
    row = jnp.repeat(jnp.arange(rows, dtype=jnp.float32), GRID_W)
    col = jnp.tile(jnp.arange(GRID_W, dtype=jnp.float32), rows)
    return row, col


def rope_axial(x, row, col):
    half = x.shape[-1] // 2
    quarter = half // 2
    freqs = ROPE_BASE ** (-jnp.arange(quarter, dtype=jnp.float32) / quarter)

    def rot(xp, pos):
        ang = pos[:, None] * freqs
        cos = jnp.cos(ang)[None, :, None, :].astype(x.dtype)
        sin = jnp.sin(ang)[None, :, None, :].astype(x.dtype)
        x1, x2 = xp[..., :quarter], xp[..., quarter:]
        return jnp.concatenate([x1 * cos - x2 * sin, x2 * cos + x1 * sin], axis=-1)

    return jnp.concatenate([rot(x[..., :half], row), rot(x[..., half:], col)], axis=-1)


def _lin_rec(left, right):
    a1, b1 = left
    a2, b2 = right
    return a1 * a2, a2 * b1 + b2


def s5_scan(u, a_bar, b_bar, c_mat, init, reverse):
    bu = jnp.einsum('lgc,gpc->lgp', u.astype(jnp.float32), b_bar)
    a = jnp.broadcast_to(a_bar, bu.shape)
    a_cum, s = lax.associative_scan(_lin_rec, (a, bu), reverse=reverse, axis=0)
    s = s + a_cum * init
    y = jnp.einsum('lgp,gcp->lgc', s, c_mat).real
    final = s[0] if reverse else s[-1]
    return y, final


def s5_direction(u_ctx, u_lat, a_re, a_im, log_dt, b_re, b_im, c_re, c_im, reverse):
    lam = lax.complex(a_re.astype(jnp.float32), a_im.astype(jnp.float32))
    a_bar = jnp.exp(lam * jnp.exp(log_dt.astype(jnp.float32))[:, None])
    b_mat = lax.complex(b_re.astype(jnp.float32), b_im.astype(jnp.float32))
    b_bar = ((a_bar - 1.0) / lam)[..., None] * b_mat
    c_mat = lax.complex(c_re.astype(jnp.float32), c_im.astype(jnp.float32))

    def per_sample(args):
        uc, ul = args
        yc, sc = s5_scan(uc, a_bar, b_bar, c_mat, jnp.zeros_like(a_bar), reverse)
        yl, _ = s5_scan(ul, a_bar, b_bar, c_mat, sc, reverse)
        return yc, yl

    return lax.map(per_sample, (u_ctx, u_lat))


def s5_mixer(h, hc, a_re, a_im, log_dt, b_re, b_im, c_re, c_im, d, w_gate, w_val):
    bsz, seq_len, _ = h.shape
    ctx_len = hc.shape[1]
    u = h.reshape(bsz, seq_len, S5_GROUPS, S5_GROUP)
    uc = hc.reshape(bsz, ctx_len, S5_GROUPS, S5_GROUP)
    y_l = d * h
    y_c = d * hc
    for direction in range(2):
        yc, yl = s5_direction(uc, u, a_re[direction], a_im[direction], log_dt[direction],
                              b_re[direction], b_im[direction], c_re[direction], c_im[direction],
                              direction == 1)
        y_l = y_l + yl.reshape(bsz, seq_len, D_MODEL).astype(h.dtype)
        y_c = y_c + yc.reshape(bsz, ctx_len, D_MODEL).astype(h.dtype)

    def glu(y):
        g = jax.nn.gelu(y)
        return (g @ w_val) * jax.nn.sigmoid(g @ w_gate)

    return glu(y_l), glu(y_c)


def depthwise_conv_centred(x, w, b):
    k_w = w.shape[0]
    pad = k_w // 2
    seq_len = x.shape[1]
    xp = jnp.pad(x, ((0, 0), (pad, pad), (0, 0)))
    out = b
    for k in range(k_w):
        out = out + xp[:, k:k + seq_len] * w[k]
    return out


def ssd_scan(x, dt, a, bm, cm, init):
    bsz, seq_len, n_heads, p_dim = x.shape
    n_grp, n_st = bm.shape[2], bm.shape[3]
    hg = n_heads // n_grp
    q_len = SSD_CHUNK
    nc = seq_len // q_len
    xc = x.reshape(bsz, nc, q_len, n_grp, hg, p_dim)
    dtc = dt.reshape(bsz, nc, q_len, n_grp, hg).astype(jnp.float32)
    bc = bm.reshape(bsz, nc, q_len, n_grp, n_st)
    cc = cm.reshape(bsz, nc, q_len, n_grp, n_st)
    a_cum = jnp.cumsum(dtc * a.reshape(n_grp, hg), axis=2)
    xdt = xc * dtc[..., None].astype(x.dtype)
    tri = jnp.tril(jnp.ones((q_len, q_len), dtype=bool))
    seg = a_cum[:, :, :, None] - a_cum[:, :, None]
    decay = jnp.exp(jnp.where(tri[:, :, None, None], seg, -jnp.inf)).astype(x.dtype)
    cb = jnp.einsum('bcqgn,bcsgn->bcgqs', cc, bc)
    y_diag = jnp.einsum('bcgqs,bcqsgh,bcsghp->bcqghp', cb, decay, xdt)
    decay_states = jnp.exp(a_cum[:, :, -1:] - a_cum).astype(x.dtype)
    states = jnp.einsum('bcsgn,bcsgh,bcsghp->bcghpn', bc, decay_states, xdt)
    chunk_decay = jnp.exp(a_cum[:, :, -1]).astype(x.dtype)

    def step(carry, inp):
        dec, st = inp
        return carry * dec[..., None, None] + st, carry

    final, prev = lax.scan(step, init, (jnp.moveaxis(chunk_decay, 1, 0), jnp.moveaxis(states, 1, 0)))
    y_off = jnp.einsum('bcqgn,cbghpn,bcqgh->bcqghp', cc, prev, jnp.exp(a_cum).astype(x.dtype))
    return (y_diag + y_off).reshape(bsz, seq_len, n_heads, p_dim), final


def ssd_mixer(h, hc, w_in, conv_w, conv_b, dt_bias, a_log, d, norm_w, w_out):
    a = -jnp.exp(a_log.astype(jnp.float32))

    def flip(t):
        return jnp.flip(t, axis=1)

    def bidir(t, inits):
        bsz, seq_len = t.shape[0], t.shape[1]
        z, xbc, dt = jnp.split(t @ w_in, [SSD_D_INNER, SSD_D_INNER + SSD_CONV_DIM], axis=-1)
        xbc = jax.nn.silu(depthwise_conv_centred(xbc, conv_w, conv_b))
        xs, bm, cm = jnp.split(xbc, [SSD_D_INNER, SSD_D_INNER + SSD_GROUPS * SSD_STATE], axis=-1)
        xs = xs.reshape(bsz, seq_len, SSD_HEADS, SSD_HEADDIM)
        bm = bm.reshape(bsz, seq_len, SSD_GROUPS, SSD_STATE)
        cm = cm.reshape(bsz, seq_len, SSD_GROUPS, SSD_STATE)
        dt = jax.nn.softplus(dt.reshape(bsz, seq_len, 2, SSD_HEADS) + dt_bias)
        y_f, s_f = ssd_scan(xs, dt[:, :, 0], a[0], bm, cm, inits[0])
        y_b, s_b = ssd_scan(flip(xs), flip(dt[:, :, 1]), a[1], flip(bm), flip(cm), inits[1])
        y = y_f + flip(y_b) + d[:, None] * xs
        y = rms_norm(y.reshape(z.shape) * jax.nn.silu(z), norm_w)
        return y @ w_out, (s_f, s_b)

    zero = jnp.zeros((h.shape[0], SSD_GROUPS, SSD_HEADS // SSD_GROUPS, SSD_HEADDIM, SSD_STATE), h.dtype)
    out_c, states_c = bidir(hc, (zero, zero))
    out_l, _ = bidir(h, states_c)
    return out_l, out_c


def mla_project(t, w_down, q_norm, kv_norm, w_uq, w_uk, w_uv, pos):
    cq, ckv, kr = jnp.split(t @ w_down, [MLA_Q_RANK, MLA_Q_RANK + MLA_KV_RANK], axis=-1)
    q = jnp.einsum('btr,rhd->bthd', rms_norm(cq, q_norm), w_uq)
    ckv = rms_norm(ckv, kv_norm)
    k_nope = jnp.einsum('btr,rhd->bthd', ckv, w_uk)
    v = jnp.einsum('btr,rhd->bthd', ckv, w_uv)
    q_nope, q_rope = q[..., :MLA_NOPE], q[..., MLA_NOPE:]
    kr = kr[:, :, None, :]
    if pos is not None:
        q_rope = rope_axial(q_rope, pos[0], pos[1])
        kr = rope_axial(kr, pos[0], pos[1])
    k = jnp.concatenate([k_nope, jnp.broadcast_to(kr, k_nope.shape[:3] + (MLA_ROPE,))], axis=-1)
    q = jnp.concatenate([q_nope, q_rope], axis=-1)
    return q, k, v


def attend(q, k, v):
    s = jnp.einsum('bqhd,bkhd->bhqk', q, k).astype(jnp.float32) * (MLA_NOPE + MLA_ROPE) ** -0.5
    p = jax.nn.softmax(s, axis=-1).astype(v.dtype)
    return jnp.einsum('bhqk,bkhd->bqhd', p, v)


def mla_mixer(h, hc, pos, w_down, q_norm, kv_norm, w_uq, w_uk, w_uv, w_o):
    bsz, seq_len, _ = h.shape
    qc, kc, vc = mla_project(hc, w_down, q_norm, kv_norm, w_uq, w_uk, w_uv, None)
    ql, kl, vl = mla_project(h, w_down, q_norm, kv_norm, w_uq, w_uk, w_uv, pos)
    out_c = attend(qc, kc, vc).reshape(bsz, hc.shape[1], MLA_HEADS * MLA_V)
    k_all = jnp.concatenate([kc, kl], axis=1)
    v_all = jnp.concatenate([vc, vl], axis=1)
    nb = seq_len // MLA_BLOCK
    qb = jnp.moveaxis(ql.reshape(bsz, nb, MLA_BLOCK, MLA_HEADS, MLA_NOPE + MLA_ROPE), 1, 0)
    out_l = lax.map(lambda qblk: attend(qblk, k_all, v_all), qb)
    out_l = jnp.moveaxis(out_l, 0, 1).reshape(bsz, seq_len, MLA_HEADS * MLA_V)
    return out_l @ w_o, out_c @ w_o


def peer_ffn(h, w_q, subkeys, u_tab, v_tab):
    bsz, seq_len, dm = h.shape
    half = PEER_QDIM // 2
    q = jnp.einsum('btd,dhk->bthk', h, w_q)
    s1 = jnp.einsum('bthk,hnk->bthn', q[..., :half], subkeys[:, 0])
    s2 = jnp.einsum('bthk,hnk->bthn', q[..., half:], subkeys[:, 1])
    v1, i1 = lax.top_k(s1, PEER_TOPK)
    v2, i2 = lax.top_k(s2, PEER_TOPK)
    n_cand = PEER_TOPK * PEER_TOPK
    cand = (v1[..., :, None] + v2[..., None, :]).reshape(bsz, seq_len, PEER_HEADS, n_cand)
    cidx = (i1[..., :, None] * PEER_KEYS + i2[..., None, :]).reshape(bsz, seq_len, PEER_HEADS, n_cand)
    best, sel = lax.top_k(cand, PEER_TOPK)
    eidx = jnp.take_along_axis(cidx, sel, axis=-1)
    gate = jax.nn.softmax(best.astype(jnp.float32), axis=-1).astype(h.dtype)
    n_blk = (bsz * seq_len) // PEER_BLOCK
    n_sel = PEER_HEADS * PEER_TOPK
    hb = h.reshape(n_blk, PEER_BLOCK, dm)
    ib = eidx.reshape(n_blk, PEER_BLOCK, n_sel)
    gb = gate.reshape(n_blk, PEER_BLOCK, n_sel)

    def block(args):
        hk, ik, gk = args
        u = jnp.take(u_tab, ik, axis=0)
        act = jax.nn.gelu(jnp.einsum('td,ted->te', hk, u))
        v = jnp.take(v_tab, ik, axis=0)
        return jnp.einsum('te,ted->td', gk * act, v)

    return lax.map(block, (hb, ib, gb)).reshape(bsz, seq_len, dm)


def setup_inputs(seed: int = 0) -> dict:
    key = jax.random.key(seed)
    ks = iter(jax.random.split(key, 48))
    f32 = jnp.float32
    dm = D_MODEL
    na, nb, nc = N_S5_LAYERS, N_SSD_LAYERS, N_MLA_LAYERS

    def nrm(shape, scale):
        return jax.random.normal(next(ks), shape, f32) * scale

    def unif(shape, lo, hi):
        return jax.random.uniform(next(ks), shape, f32, lo, hi)

    x = nrm((BATCH, SEQ, dm), 1.0)
    c = nrm((BATCH, dm), 1.0)
    ctx = nrm((BATCH, CTX_LEN, dm), 1.0)
    c_ctx = nrm((dm,), 1.0)
    mod_w = nrm((DEPTH, dm, 6 * dm), dm ** -0.5)
    mod_b = nrm((DEPTH, 6 * dm), 0.02)
    ln_g = 1.0 + nrm((DEPTH, 2, dm), 0.02)
    ln_b = nrm((DEPTH, 2, dm), 0.02)

    s5_a_re = -0.5 + nrm((na, 2, S5_GROUPS, S5_STATE), 0.01)
    s5_a_im = jnp.pi * jnp.arange(S5_STATE, dtype=f32) + nrm((na, 2, S5_GROUPS, S5_STATE), 0.01)
    s5_log_dt = unif((na, 2, S5_GROUPS), math.log(S5_DT_MIN), math.log(S5_DT_MAX))
    s5_b_re = nrm((na, 2, S5_GROUPS, S5_STATE, S5_GROUP), (2 * S5_GROUP) ** -0.5)
    s5_b_im = nrm((na, 2, S5_GROUPS, S5_STATE, S5_GROUP), (2 * S5_GROUP) ** -0.5)
    s5_c_re = nrm((na, 2, S5_GROUPS, S5_GROUP, S5_STATE), S5_STATE ** -0.5)
    s5_c_im = nrm((na, 2, S5_GROUPS, S5_GROUP, S5_STATE), S5_STATE ** -0.5)
    s5_d = nrm((na, dm), 1.0)
    s5_w_gate = nrm((na, dm, dm), dm ** -0.5)
    s5_w_val = nrm((na, dm, dm), dm ** -0.5 * DEEPNORM_BETA)

    ssd_w_in = nrm((nb, dm, SSD_IN_DIM), dm ** -0.5)
    ssd_conv_w = nrm((nb, SSD_CONV, SSD_CONV_DIM), SSD_CONV ** -0.5)
    ssd_conv_b = nrm((nb, SSD_CONV_DIM), 0.02)
    dt0 = jnp.exp(unif((nb, 2, SSD_HEADS), math.log(1e-3), math.log(1e-1)))
    ssd_dt_bias = dt0 + jnp.log(-jnp.expm1(-dt0))
    ssd_a_log = jnp.log(unif((nb, 2, SSD_HEADS), 1.0, 16.0))
    ssd_d = 1.0 + nrm((nb, SSD_HEADS), 0.1)
    ssd_norm_w = 1.0 + nrm((nb, SSD_D_INNER), 0.02)
    ssd_w_out = nrm((nb, SSD_D_INNER, dm), SSD_D_INNER ** -0.5 * DEEPNORM_BETA)

    mla_w_down = nrm((nc, dm, MLA_Q_RANK + MLA_KV_RANK + MLA_ROPE), dm ** -0.5)
    mla_q_norm = 1.0 + nrm((nc, MLA_Q_RANK), 0.02)
    mla_kv_norm = 1.0 + nrm((nc, MLA_KV_RANK), 0.02)
    mla_w_uq = nrm((nc, MLA_Q_RANK, MLA_HEADS, MLA_NOPE + MLA_ROPE), MLA_Q_RANK ** -0.5)
    mla_w_uk = nrm((nc, MLA_KV_RANK, MLA_HEADS, MLA_NOPE), MLA_KV_RANK ** -0.5)
    mla_w_uv = nrm((nc, MLA_KV_RANK, MLA_HEADS, MLA_V), MLA_KV_RANK ** -0.5)
    mla_w_o = nrm((nc, MLA_HEADS * MLA_V, dm), (MLA_HEADS * MLA_V) ** -0.5 * DEEPNORM_BETA)

    peer_w_q = nrm((DEPTH, dm, PEER_HEADS, PEER_QDIM), dm ** -0.5)
    peer_subkeys = nrm((DEPTH, PEER_HEADS, 2, PEER_KEYS, PEER_QDIM // 2), (PEER_QDIM // 2) ** -0.5)
    peer_u = nrm((DEPTH, PEER_EXPERTS, dm), dm ** -0.5)
    peer_v = nrm((DEPTH, PEER_EXPERTS, dm), DEEPNORM_BETA)

    return {'x': x, 'c': c, 'ctx': ctx, 'c_ctx': c_ctx,
            'mod_w': mod_w, 'mod_b': mod_b, 'ln_g': ln_g, 'ln_b': ln_b,
            's5_a_re': s5_a_re, 's5_a_im': s5_a_im, 's5_log_dt': s5_log_dt,
            's5_b_re': s5_b_re, 's5_b_im': s5_b_im, 's5_c_re': s5_c_re, 's5_c_im': s5_c_im,
            's5_d': s5_d, 's5_w_gate': s5_w_gate, 's5_w_val': s5_w_val,
            'ssd_w_in': ssd_w_in, 'ssd_conv_w': ssd_conv_w, 'ssd_conv_b': ssd_conv_b,
            'ssd_dt_bias': ssd_dt_bias, 'ssd_a_log': ssd_a_log, 'ssd_d': ssd_d,
            'ssd_norm_w': ssd_norm_w, 'ssd_w_out': ssd_w_out,
            'mla_w_down': mla_w_down, 'mla_q_norm': mla_q_norm, 'mla_kv_norm': mla_kv_norm,
            'mla_w_uq': mla_w_uq, 'mla_w_uk': mla_w_uk, 'mla_w_uv': mla_w_uv, 'mla_w_o': mla_w_o,
            'peer_w_q': peer_w_q, 'peer_subkeys': peer_subkeys, 'peer_u': peer_u, 'peer_v': peer_v}


def reference(x, c, ctx, c_ctx, mod_w, mod_b, ln_g, ln_b,
              s5_a_re, s5_a_im, s5_log_dt, s5_b_re, s5_b_im, s5_c_re, s5_c_im, s5_d, s5_w_gate, s5_w_val,
              ssd_w_in, ssd_conv_w, ssd_conv_b, ssd_dt_bias, ssd_a_log, ssd_d, ssd_norm_w, ssd_w_out,
              mla_w_down, mla_q_norm, mla_kv_norm, mla_w_uq, mla_w_uk, mla_w_uv, mla_w_o,
              peer_w_q, peer_subkeys, peer_u, peer_v):
    ROWS = x.shape[1] // GRID_W
    pos = grid_positions(ROWS)
    ctx_len = ctx.shape[1]
    c_act = jax.nn.silu(c)
    c_ctx_act = jax.nn.silu(c_ctx)
    for i in range(DEPTH):
        mod_l = jnp.split((c_act @ mod_w[i] + mod_b[i])[:, None, :], 6, axis=-1)
        mod_c = jnp.split(c_ctx_act @ mod_w[i] + mod_b[i], 6, axis=-1)
        h = modulate(x, mod_l[0], mod_l[1])
        hc = modulate(ctx, mod_c[0], mod_c[1])
        kind, j = i % N_MIXERS, i // N_MIXERS
        if kind == 0:
            out_l, out_c = s5_mixer(h, hc, s5_a_re[j], s5_a_im[j], s5_log_dt[j], s5_b_re[j], s5_b_im[j],
                                    s5_c_re[j], s5_c_im[j], s5_d[j], s5_w_gate[j], s5_w_val[j])
        elif kind == 1:
            out_l, out_c = ssd_mixer(h, hc, ssd_w_in[j], ssd_conv_w[j], ssd_conv_b[j], ssd_dt_bias[j],
                                     ssd_a_log[j], ssd_d[j], ssd_norm_w[j], ssd_w_out[j])
        else:
            out_l, out_c = mla_mixer(h, hc, pos, mla_w_down[j], mla_q_norm[j], mla_kv_norm[j],
                                     mla_w_uq[j], mla_w_uk[j], mla_w_uv[j], mla_w_o[j])
        x = layer_norm(DEEPNORM_ALPHA * x + mod_l[2] * out_l, ln_g[i, 0], ln_b[i, 0])
        h = modulate(x, mod_l[3], mod_l[4])
        if i == DEPTH - 1:
            ffn = peer_ffn(h, peer_w_q[i], peer_subkeys[i], peer_u[i], peer_v[i])
            x = layer_norm(DEEPNORM_ALPHA * x + mod_l[5] * ffn, ln_g[i, 1], ln_b[i, 1])
        else:
            ctx = layer_norm(DEEPNORM_ALPHA * ctx + mod_c[2] * out_c, ln_g[i, 0], ln_b[i, 0])
            hc = modulate(ctx, mod_c[3], mod_c[4])
            ffn = peer_ffn(jnp.concatenate([hc, h], axis=1), peer_w_q[i], peer_subkeys[i], peer_u[i], peer_v[i])
            ctx = layer_norm(DEEPNORM_ALPHA * ctx + mod_c[5] * ffn[:, :ctx_len], ln_g[i, 1], ln_b[i, 1])
            x = layer_norm(DEEPNORM_ALPHA * x + mod_l[5] * ffn[:, ctx_len:], ln_g[i, 1], ln_b[i, 1])
    return x
```

```cpp
#ifndef CPU_EMU
#include <hip/hip_runtime.h>
#include <hip/hip_cooperative_groups.h>
#include <cstdio>
#include <cstdint>
#include <cmath>
namespace cg = cooperative_groups;
#endif

#ifndef BATCH
#define BATCH 4
#endif
#ifndef SEQ
#define SEQ 4096
#endif
#ifndef CTXL
#define CTXL 256
#endif
constexpr int DM = 1024, LTOK = CTXL + SEQ, NTOK = BATCH * LTOK, NR = BATCH + 1;
constexpr int NTHR = 512, NWAVES = 8;
static_assert(NTOK % 256 == 0 && SEQ % 256 == 0 && CTXL % 256 == 0 && LTOK % 32 == 0, "shape");
constexpr float DN_ALPHA = 1.6817928305074290f;
constexpr int SSD_IN = 5184, SSD_IN_PAD = 5376;

typedef unsigned short bf16_t;
typedef short bf16x8 __attribute__((ext_vector_type(8)));
typedef float f32x2 __attribute__((ext_vector_type(2)));
typedef float f32x4 __attribute__((ext_vector_type(4)));
typedef float f32x16 __attribute__((ext_vector_type(16)));
typedef unsigned u32x2 __attribute__((ext_vector_type(2)));
typedef unsigned u32x4 __attribute__((ext_vector_type(4)));

constexpr size_t MiB = 1u << 20;
constexpr size_t WS_CTL = 0, CTL_ZERO_BYTES = 64 * 1024;
constexpr size_t WS_MOD = 1 * MiB;
constexpr size_t WS_ROPE = WS_MOD + 768 * 1024;
constexpr size_t WS_S5C = 2 * MiB;
constexpr size_t S5C_ITEM = 12800;
constexpr size_t WS_WGLU = 6 * MiB;
constexpr size_t WS_WIN = 14 * MiB;
constexpr size_t WS_WOUT = 25 * MiB;
constexpr size_t WS_WDOWN = 29 * MiB;
constexpr size_t WS_WUP = 30 * MiB;
constexpr size_t WS_WO = 33 * MiB;
constexpr size_t WS_WSC = 35 * MiB;
constexpr size_t WS_UT = 52 * MiB;
constexpr size_t WS_VT = 180 * MiB;
constexpr size_t WS_X = 308 * MiB;
constexpr size_t WS_H = 376 * MiB;
constexpr size_t WS_H2 = 410 * MiB;
constexpr size_t WS_OUT = 444 * MiB;
constexpr size_t WS_R = 512 * MiB;
constexpr size_t WS_SC = WS_R;
constexpr size_t WS_YF = WS_R, WS_YB = WS_R + 34 * MiB, WS_G = WS_R + 68 * MiB;
constexpr size_t WS_Z = WS_R, WS_XBC = WS_R + 68 * MiB, WS_XBCC = WS_R + 170 * MiB, WS_DT = WS_R + 272 * MiB, WS_DTS = WS_R + 277 * MiB,
                 WS_YF2 = WS_R + 282 * MiB, WS_YB2 = WS_R + 350 * MiB, WS_G2 = WS_XBC;
constexpr size_t WS_CQKV = WS_R, WS_RS = WS_R + 17 * MiB, WS_Q = WS_R + 18 * MiB, WS_K = WS_R + 86 * MiB, WS_V = WS_R + 154 * MiB, WS_O = WS_R + 188 * MiB;
constexpr size_t WS_END = 1024 * MiB;

__device__ __forceinline__ unsigned f2bf(float f) { unsigned u = __float_as_uint(f); return (u + 0x7fffu + ((u >> 16) & 1u)) >> 16; }
__device__ __forceinline__ unsigned pk2(float lo, float hi) { return f2bf(lo) | (f2bf(hi) << 16); }
__device__ __forceinline__ float bflo(unsigned w) { return __uint_as_float(w << 16); }
__device__ __forceinline__ float bfhi(unsigned w) { return __uint_as_float(w & 0xffff0000u); }
__device__ __forceinline__ float bf2f(bf16_t s) { return __uint_as_float(((unsigned)s) << 16); }
__device__ __forceinline__ float gelu_tanh(float x) { const float u = 0.7978845608028654f * (x + 0.044715f * x * x * x); const float e = __expf(2.f * u); const float t = 1.f - 2.f / (e + 1.f); return 0.5f * x * (1.f + t); }
__device__ __forceinline__ float sigmoidf_(float x) { return 1.f / (1.f + __expf(-x)); }
__device__ __forceinline__ float siluf_(float x) { return x / (1.f + __expf(-x)); }
__device__ __forceinline__ float wave_sum(float v) {
#pragma unroll
    for (int o = 1; o < 64; o <<= 1) v += __shfl_xor(v, o);
    return v;
}
__device__ __forceinline__ unsigned wave_umax(unsigned v) {
#pragma unroll
    for (int o = 1; o < 64; o <<= 1) { const unsigned t = __shfl_xor(v, o); v = t > v ? t : v; }
    return v;
}
#ifdef CPU_EMU
__device__ __forceinline__ void wave_sync() { emu::wave_barrier(); }
__device__ __forceinline__ f32x16 mfma32(bf16x8 a, bf16x8 b, f32x16 c) { return emu_mfma_32x32x16_bf16(a, b, c); }
__device__ __forceinline__ int rfl(int x) { return x; }
#else
__device__ __forceinline__ void wave_sync() { asm volatile("s_waitcnt lgkmcnt(0)" ::: "memory"); }
__device__ __forceinline__ f32x16 mfma32(bf16x8 a, bf16x8 b, f32x16 c) { return __builtin_amdgcn_mfma_f32_32x32x16_bf16(a, b, c, 0, 0, 0); }
__device__ __forceinline__ int rfl(int x) { return __builtin_amdgcn_readfirstlane(x); }
#endif
__device__ __forceinline__ int crow(int r, int hi) { return (r & 3) + 8 * (r >> 2) + 4 * hi; }
__device__ __forceinline__ int seqpos(int dir, int s) { return dir == 0 ? s : (s < CTXL ? CTXL - 1 - s : LTOK + CTXL - 1 - s); }

struct Args { const float* in[37]; float* out; unsigned char* ws; int ph_lo, ph_hi; };
struct Frame { unsigned char* lds; int tid, lane, wave, G, bid; };

namespace pg8 {
constexpr int BM = 256, BK = 64, HALF = 128, HTB = HALF * BK * 2, STAGE_BYTES = 8 * HTB, NXCD = 8, WGM = 8;
__host__ __device__ __forceinline__ int lds_byte(int r, int c) { const int st = (r >> 4) * 2 + (c >> 5), rr = r & 15, cc = c & 31, ob = rr * 64 + cc * 2; return st * 1024 + (ob ^ (((ob >> 9) & 1) << 5)); }
__host__ __device__ __forceinline__ void stage_rc(int b, int& R, int& C) { const int st = b / 1024, sb = b % 1024, swz = sb ^ (((sb >> 9) & 1) << 5); R = (st >> 1) * 16 + swz / 64; C = (st & 1) * 32 + (swz % 64) / 2; }
__host__ __device__ __forceinline__ int perm32(int rho) { const int n = rho >> 4, i = rho & 15; return 8 * (i >> 2) + 4 * n + (i & 3); }
struct Unit { int pm, pn; };
struct Gemm { const bf16_t* A; const bf16_t* Bt; int M, N, K, lda, ldb; };
struct StaticOrder {
    int nM, nN, nwg, G, c;
    __host__ __device__ void init(int M, int N, int G_, int c_) { nM = M / BM; nN = N / BM; nwg = nM * nN; G = G_; c = c_; }
    __host__ __device__ bool next(int i, Unit& u) const {
        const long L = (long)i * G + c; if (L >= nwg) return false;
        int wgid = (int)L; { const int q = nwg / NXCD, r = nwg % NXCD, xcd = wgid % NXCD, off = wgid / NXCD; wgid = (xcd < r ? xcd * (q + 1) : r * (q + 1) + (xcd - r) * q) + off; }
        const int nig = WGM * nN, gid = wgid / nig, fm = gid * WGM, gsz = (nM - fm) < WGM ? (nM - fm) : WGM;
        u.pm = fm + ((wgid % nig) % gsz); u.pn = (wgid % nig) / gsz; return true;
    }
};
#ifdef CPU_EMU
template <class Epi, class Sched, bool ALIGN_EPI = false, bool SP2 = false>
__device__ __forceinline__ void gemm_phase(unsigned char* lds, const Gemm g, const Sched& S, const Epi& E) {
    const int tid = threadIdx.x, wid = tid >> 6, lane = tid & 63, wr = wid >> 2, wc = wid & 3, fr = lane & 15, fq = lane >> 4;
    Unit u;
    for (int ui = 0; S.next(ui, u); ++ui) {
        f32x4 acc[2][2][4][2];
        for (int ai = 0; ai < 2; ++ai) for (int bj = 0; bj < 2; ++bj) for (int m = 0; m < 4; ++m) for (int n = 0; n < 2; ++n) for (int e = 0; e < 4; ++e) {
            const int row = u.pm * 256 + 128 * ai + 64 * wr + 16 * m + fr;
            const int col = u.pn * 256 + 128 * bj + 32 * wc + (Epi::PERM ? 8 * fq + 4 * n + e : 16 * n + 4 * fq + e);
            const bf16_t* a = g.A + (size_t)row * g.lda; const bf16_t* b = g.Bt + (size_t)col * g.ldb; float s = 0.f;
            for (int k = 0; k < g.K; ++k) s += bf2f(a[k]) * bf2f(b[k]);
            acc[ai][bj][m][n][e] = s;
        }
        E(acc, u, wr, wc, fr, fq);
    }
    __syncthreads();
}
#else
#define PG8_LAS __attribute__((address_space(3)))
template <class Epi, class Sched, bool ALIGN_EPI = false, bool SP2 = false>
__device__ __forceinline__ void gemm_phase(PG8_LAS unsigned char* lds, const Gemm g, const Sched& S, const Epi& E) {
    const int tid = threadIdx.x, wid = __builtin_amdgcn_readfirstlane(tid >> 6), lane = tid & 63, wr = wid >> 2, wc = wid & 3, fr = lane & 15, fq = lane >> 4;
    const int K = g.K, nt = K / BK;
    unsigned voffA[2], voffB[2];
#pragma unroll
    for (int i = 0; i < 2; ++i) { int R, C; stage_rc(tid * 16 + i * 8192, R, C); const int Rb = Epi::PERM ? ((R & ~31) + perm32(R & 31)) : R;
        voffA[i] = (unsigned)(R * g.lda + C) * 2u; voffB[i] = (unsigned)(Rb * g.ldb + C) * 2u; }
    const size_t kstep = (size_t)(BK * 2);
    const size_t hstepA = (size_t)HALF * g.lda * 2, hstepB = (size_t)HALF * g.ldb * 2;
    const size_t tstepA = 2 * hstepA, tstepB = 2 * hstepB;
    const unsigned ldsw = (unsigned)wid * 1024u;
    const int aoff = lds_byte(wr * 64 + fr, fq * 8), boff = lds_byte(wc * 32 + fr, fq * 8);
#define PG8_SA(b, h) (((b) * 2 + (h)) * HTB)
#define PG8_SB(b, h) ((4 + (b) * 2 + (h)) * HTB)
#define PG8_STAGE(bufoff, gbase, voff) do { _Pragma("unroll") for (int _i = 0; _i < 2; ++_i) \
        __builtin_amdgcn_global_load_lds((const unsigned*)((const char*)(gbase) + (voff)[_i]), (PG8_LAS unsigned*)(lds + (bufoff) + ldsw + _i * 8192), 16, 0, 0); } while (0)
#define PG8_LDA(dst, b, h) do { _Pragma("unroll") for (int m = 0; m < 4; ++m) _Pragma("unroll") for (int k = 0; k < 2; ++k) dst[m][k] = *(const PG8_LAS bf16x8*)(lds + PG8_SA(b, h) + aoff + m * 2048 + k * 1024); } while (0)
#define PG8_LDB(dst, b, h) do { _Pragma("unroll") for (int n = 0; n < 2; ++n) _Pragma("unroll") for (int k = 0; k < 2; ++k) dst[n][k] = *(const PG8_LAS bf16x8*)(lds + PG8_SB(b, h) + boff + n * 2048 + k * 1024); } while (0)
#define PG8_MMA(ai, bj, At, Bt) do { __builtin_amdgcn_s_setprio(1); _Pragma("unroll") for (int m = 0; m < 4; ++m) _Pragma("unroll") for (int n = 0; n < 2; ++n) _Pragma("unroll") for (int k = 0; k < 2; ++k) \
        acc[ai][bj][m][n] = __builtin_amdgcn_mfma_f32_16x16x32_bf16(Bt[n][k], At[m][k], acc[ai][bj][m][n], 0, 0, 0); __builtin_amdgcn_s_setprio(0); } while (0)
#define PG8_WAIT_V(n) asm volatile("s_waitcnt vmcnt(" #n ")" ::: "memory")
#define PG8_WAIT_L(n) asm volatile("s_waitcnt lgkmcnt(" #n ")" ::: "memory")
#define PG8_BAR __builtin_amdgcn_s_barrier()
#define PG8_SCHED __builtin_amdgcn_sched_barrier(0)
    Unit cur, nxt; int ui = 0;
    if (!S.next(0, cur)) return;
    f32x4 acc[2][2][4][2];
#pragma unroll
    for (int a = 0; a < 2; ++a)
#pragma unroll
        for (int b = 0; b < 2; ++b)
#pragma unroll
            for (int m = 0; m < 4; ++m)
#pragma unroll
                for (int n = 0; n < 2; ++n) acc[a][b][m][n] = (f32x4){0.f, 0.f, 0.f, 0.f};
    bf16x8 At[4][2], B0[2][2], B1[2][2];
    const char* cA = (const char*)g.A + (size_t)cur.pm * tstepA; const char* cB = (const char*)g.Bt + (size_t)cur.pn * tstepB;
    if constexpr (SP2) {
        PG8_STAGE(PG8_SB(0, 0), cB, voffB); PG8_STAGE(PG8_SB(0, 1), cB + hstepB, voffB); PG8_STAGE(PG8_SA(0, 0), cA, voffA); PG8_STAGE(PG8_SA(0, 1), cA + hstepA, voffA);
        if (wr == 1) PG8_BAR;
        PG8_WAIT_V(2); PG8_BAR;
        PG8_STAGE(PG8_SB(1, 0), cB + kstep, voffB); PG8_STAGE(PG8_SA(1, 0), cA + kstep, voffA); PG8_STAGE(PG8_SB(1, 1), cB + hstepB + kstep, voffB);
        PG8_WAIT_V(6); PG8_BAR;
    } else {
        PG8_STAGE(PG8_SB(0, 0), cB, voffB); PG8_STAGE(PG8_SA(0, 0), cA, voffA); PG8_STAGE(PG8_SB(0, 1), cB + hstepB, voffB); PG8_STAGE(PG8_SA(0, 1), cA + hstepA, voffA);
        if (wr == 1) PG8_BAR;
        PG8_WAIT_V(4); PG8_BAR;
        PG8_STAGE(PG8_SB(1, 0), cB + kstep, voffB); PG8_STAGE(PG8_SA(1, 0), cA + kstep, voffA); PG8_STAGE(PG8_SB(1, 1), cB + hstepB + kstep, voffB);
        PG8_WAIT_V(6); PG8_BAR;
    }
    for (;;) {
        const bool has_next = S.next(ui + 1, nxt);
        const char* nA = has_next ? (const char*)g.A + (size_t)nxt.pm * tstepA : cA; const char* nB = has_next ? (const char*)g.Bt + (size_t)nxt.pn * tstepB : cB;
        for (int t = 0; t < nt; t += 2) {
            const bool last = (t == nt - 2);
            const char* a1 = cA + (size_t)(t + 1) * kstep;
            const char* a2 = last ? nA : cA + (size_t)(t + 2) * kstep; const char* b2 = last ? nB : cB + (size_t)(t + 2) * kstep;
            const char* a3 = a2 + kstep; const char* b3 = b2 + kstep;
            if constexpr (SP2) {
            PG8_LDB(B0, 0, 0); PG8_LDB(B1, 0, 1); PG8_SCHED; PG8_LDA(At, 0, 0); PG8_STAGE(PG8_SA(1, 1), a1 + hstepA, voffA);
            PG8_WAIT_V(8); PG8_WAIT_L(0); PG8_BAR; PG8_MMA(0, 0, At, B0); PG8_MMA(0, 1, At, B1); PG8_BAR; PG8_SCHED;
            PG8_LDA(At, 0, 1); PG8_STAGE(PG8_SB(0, 0), b2, voffB); PG8_STAGE(PG8_SB(0, 1), b2 + hstepB, voffB); PG8_STAGE(PG8_SA(0, 0), a2, voffA);
            PG8_WAIT_V(8); PG8_WAIT_L(0); PG8_BAR; PG8_MMA(1, 0, At, B0); PG8_MMA(1, 1, At, B1); PG8_BAR; PG8_SCHED;
            PG8_LDB(B0, 1, 0); PG8_LDB(B1, 1, 1); PG8_SCHED; PG8_LDA(At, 1, 0); PG8_STAGE(PG8_SA(0, 1), a2 + hstepA, voffA);
            PG8_WAIT_V(8); PG8_WAIT_L(0); PG8_BAR; PG8_MMA(0, 0, At, B0); PG8_MMA(0, 1, At, B1); PG8_BAR; PG8_SCHED;
            PG8_LDA(At, 1, 1); PG8_STAGE(PG8_SB(1, 0), b3, voffB); PG8_STAGE(PG8_SB(1, 1), b3 + hstepB, voffB); PG8_STAGE(PG8_SA(1, 0), a3, voffA);
            PG8_WAIT_V(8); PG8_WAIT_L(0); PG8_BAR; PG8_MMA(1, 0, At, B0); PG8_MMA(1, 1, At, B1); PG8_BAR; PG8_SCHED;
            } else {
            PG8_LDB(B0, 0, 0); PG8_SCHED; PG8_LDA(At, 0, 0); PG8_STAGE(PG8_SA(1, 1), a1 + hstepA, voffA);
            PG8_WAIT_L(8); PG8_BAR; PG8_WAIT_L(0); PG8_MMA(0, 0, At, B0); PG8_BAR; PG8_SCHED;
            PG8_LDB(B1, 0, 1); PG8_STAGE(PG8_SB(0, 0), b2, voffB);
            PG8_BAR; PG8_WAIT_L(0); PG8_MMA(0, 1, At, B1); PG8_BAR;
            PG8_LDA(At, 0, 1); PG8_STAGE(PG8_SA(0, 0), a2, voffA);
            PG8_BAR; PG8_WAIT_L(0); PG8_MMA(1, 0, At, B0); PG8_BAR; PG8_SCHED;
            PG8_STAGE(PG8_SB(0, 1), b2 + hstepB, voffB);
            PG8_WAIT_V(6); PG8_BAR; PG8_MMA(1, 1, At, B1); PG8_BAR;
            PG8_LDB(B0, 1, 0); PG8_SCHED; PG8_LDA(At, 1, 0); PG8_STAGE(PG8_SA(0, 1), a2 + hstepA, voffA);
            PG8_WAIT_L(8); PG8_BAR; PG8_WAIT_L(0); PG8_MMA(0, 0, At, B0); PG8_BAR; PG8_SCHED;
            PG8_LDB(B1, 1, 1); PG8_STAGE(PG8_SB(1, 0), b3, voffB);
            PG8_BAR; PG8_WAIT_L(0); PG8_MMA(0, 1, At, B1); PG8_BAR;
            PG8_LDA(At, 1, 1); PG8_STAGE(PG8_SA(1, 0), a3, voffA);
            PG8_BAR; PG8_WAIT_L(0); PG8_MMA(1, 0, At, B0); PG8_BAR; PG8_SCHED;
            PG8_STAGE(PG8_SB(1, 1), b3 + hstepB, voffB);
            PG8_WAIT_V(6); PG8_BAR; PG8_MMA(1, 1, At, B1); PG8_BAR;
            }
        }
        if constexpr (ALIGN_EPI) { if (wr == 0) PG8_BAR; }
        E(acc, cur, wr, wc, fr, fq);
        if (!has_next) break;
#pragma unroll
        for (int a = 0; a < 2; ++a)
#pragma unroll
            for (int b = 0; b < 2; ++b)
#pragma unroll
                for (int m = 0; m < 4; ++m)
#pragma unroll
                    for (int n = 0; n < 2; ++n) acc[a][b][m][n] = (f32x4){0.f, 0.f, 0.f, 0.f};
        cur = nxt; cA = nA; cB = nB; ++ui;
        if constexpr (ALIGN_EPI) { if (wr == 1) PG8_BAR; }
    }
    PG8_WAIT_V(0);
    if constexpr (!ALIGN_EPI) { if (wr == 0) PG8_BAR; }
    PG8_BAR;
#undef PG8_SA
#undef PG8_SB
#undef PG8_STAGE
#undef PG8_LDA
#undef PG8_LDB
#undef PG8_MMA
#undef PG8_WAIT_V
#undef PG8_WAIT_L
#undef PG8_BAR
#undef PG8_SCHED
}
#endif
}
#ifdef CPU_EMU
#define GEMM_LDS(F) ((F).lds)
#else
#define GEMM_LDS(F) ((PG8_LAS unsigned char*)(F).lds)
#endif
#ifndef PG8_SP2
#define PG8_SP2 true
#endif
#ifndef PG8_ALIGN
#define PG8_ALIGN true
#endif

typedef const f32x4 (&AccRef)[2][2][4][2];
struct Lane4 { int wr, wc, fr, fq; };
__device__ __forceinline__ Lane4 epi_lane() {
    int t = threadIdx.x;
#ifndef CPU_EMU
    asm volatile("" : "+v"(t));
#endif
    const int wid = rfl(t >> 6); Lane4 L; L.wr = wid >> 2; L.wc = wid & 3; L.fr = t & 15; L.fq = (t >> 4) & 3; return L;
}
struct EpiF32 {
    static constexpr bool PERM = false;
    float* O; int ldc;
    __device__ __forceinline__ void operator()(AccRef acc, const pg8::Unit& u, int, int, int, int) const {
        const Lane4 L = epi_lane(); const int wr = L.wr, wc = L.wc, fr = L.fr, fq = L.fq;
        const int col0 = u.pn * 256 + wc * 32 + 4 * fq;
#pragma unroll
        for (int ai = 0; ai < 2; ++ai)
#pragma unroll
            for (int m = 0; m < 4; ++m) { float* rowp = O + (size_t)(u.pm * 256 + ai * 128 + wr * 64 + m * 16 + fr) * ldc + col0;
#pragma unroll
                for (int bj = 0; bj < 2; ++bj)
#pragma unroll
                    for (int n = 0; n < 2; ++n) *(f32x4*)(rowp + bj * 128 + n * 16) = acc[ai][bj][m][n]; }
    }
};
struct EpiGlu {
    static constexpr bool PERM = false;
    float* O;
    __device__ __forceinline__ void operator()(AccRef acc, const pg8::Unit& u, int, int, int, int) const {
        const Lane4 L = epi_lane(); const int wr = L.wr, wc = L.wc, fr = L.fr, fq = L.fq;
        const int col0 = u.pn * 128 + wc * 32 + 4 * fq;
#pragma unroll
        for (int ai = 0; ai < 2; ++ai)
#pragma unroll
            for (int m = 0; m < 4; ++m) { float* rowp = O + (size_t)(u.pm * 256 + ai * 128 + wr * 64 + m * 16 + fr) * DM + col0;
#pragma unroll
                for (int n = 0; n < 2; ++n) { const f32x4 v = acc[ai][0][m][n], g = acc[ai][1][m][n]; f32x4 o;
#pragma unroll
                    for (int e = 0; e < 4; ++e) o[e] = v[e] * sigmoidf_(g[e]);
                    *(f32x4*)(rowp + n * 16) = o; } }
    }
};
__device__ __forceinline__ u32x4 pack8(const f32x4 a, const f32x4 b, float s) {
    u32x4 w; w.x = pk2(a[0] * s, a[1] * s); w.y = pk2(a[2] * s, a[3] * s); w.z = pk2(b[0] * s, b[1] * s); w.w = pk2(b[2] * s, b[3] * s); return w;
}
struct EpiSsdIn {
    static constexpr bool PERM = true;
    bf16_t* Z; bf16_t* XBC; float* DT;
    __device__ __forceinline__ void operator()(AccRef acc, const pg8::Unit& u, int, int, int, int) const {
        const Lane4 L = epi_lane(); const int wr = L.wr, wc = L.wc, fr = L.fr, fq = L.fq;
        const int cw = wc * 32 + 8 * fq;
#pragma unroll
        for (int ai = 0; ai < 2; ++ai)
#pragma unroll
            for (int m = 0; m < 4; ++m) { const size_t row = (size_t)(u.pm * 256 + ai * 128 + wr * 64 + m * 16 + fr);
#pragma unroll
                for (int bj = 0; bj < 2; ++bj) { const int col = u.pn * 256 + bj * 128 + cw;
                    if (u.pn < 8) *(u32x4*)(Z + row * 2048 + col) = pack8(acc[ai][bj][m][0], acc[ai][bj][m][1], 1.f);
                    else if (u.pn < 20) *(u32x4*)(XBC + row * 3072 + (col - 2048)) = pack8(acc[ai][bj][m][0], acc[ai][bj][m][1], 1.f);
                    else if (col - 5120 < 64) { float* p = DT + row * 64 + (col - 5120); *(f32x4*)p = acc[ai][bj][m][0]; *(f32x4*)(p + 4) = acc[ai][bj][m][1]; } } }
    }
};
struct EpiMlaDown {
    static constexpr bool PERM = true;
    bf16_t* C; float* RS;
    __device__ __forceinline__ void operator()(AccRef acc, const pg8::Unit& u, int, int, int, int) const {
        const Lane4 L = epi_lane(); const int wr = L.wr, wc = L.wc, fr = L.fr, fq = L.fq;
        const int cw = wc * 32 + 8 * fq;
#pragma unroll
        for (int ai = 0; ai < 2; ++ai)
#pragma unroll
            for (int m = 0; m < 4; ++m) { const size_t row = (size_t)(u.pm * 256 + ai * 128 + wr * 64 + m * 16 + fr); float ss = 0.f;
#pragma unroll
                for (int bj = 0; bj < 2; ++bj) { const int col = u.pn * 256 + bj * 128 + cw; const f32x4 a = acc[ai][bj][m][0], b = acc[ai][bj][m][1];
                    *(u32x4*)(C + row * 512 + col) = pack8(a, b, 1.f);
                    if (u.pn == 0 || bj == 0) ss += (a[0] * a[0] + a[1] * a[1]) + (a[2] * a[2] + a[3] * a[3]) + (b[0] * b[0] + b[1] * b[1]) + (b[2] * b[2] + b[3] * b[3]); }
                ss += __shfl_xor(ss, 16); ss += __shfl_xor(ss, 32);
                if (fq == 0) RS[row * 8 + u.pn * 4 + wc] = ss; }
    }
};
struct EpiMlaUp {
    static constexpr bool PERM = true;
    bf16_t* Q; bf16_t* Kb; bf16_t* Vb; const float* RS;
    __device__ __forceinline__ void operator()(AccRef acc, const pg8::Unit& u, int, int, int, int) const {
        const Lane4 L = epi_lane(); const int wr = L.wr, wc = L.wc, fr = L.fr, fq = L.fq;
        const bool isq = u.pn < 8;
        if (isq && wc == 3) return;
#pragma unroll
        for (int ai = 0; ai < 2; ++ai)
#pragma unroll
            for (int m = 0; m < 4; ++m) { const int tok = u.pm * 256 + ai * 128 + wr * 64 + m * 16 + fr; const int b = tok / LTOK, p = tok - b * LTOK;
                const f32x4 rs = *(const f32x4*)(RS + ((unsigned)tok * 8u + (isq ? 0u : 4u)));
                const float rn = 1.0f / sqrtf(((rs[0] + rs[1]) + (rs[2] + rs[3])) * (isq ? (1.f / 256.f) : (1.f / 128.f)) + 1e-6f);
#pragma unroll
                for (int bj = 0; bj < 2; ++bj) { bf16_t* dst;
                    if (isq) dst = Q + ((unsigned)((b * 16 + u.pn * 2 + bj) * LTOK + p) * 128u + (unsigned)(wc * 32 + 8 * fq));
                    else { const int col = (u.pn & 3) * 256 + bj * 128 + wc * 32 + 8 * fq; const int head = col >> 6, d = col & 63; const unsigned rowi = (unsigned)((b * 16 + head) * LTOK + p);
                        dst = u.pn < 12 ? Kb + (rowi * 128u + (unsigned)d) : Vb + (rowi * 64u + (unsigned)d); }
                    *(u32x4*)dst = pack8(acc[ai][bj][m][0], acc[ai][bj][m][1], rn); }
                asm volatile("" ::: "memory"); }
    }
};

namespace att {
constexpr int NW = 8, QBLK = 32, KVBLK = 64, LDQ = 128, LDK = 128, LDV = 64, LDO = 1024;
constexpr float SCALE = 0.10206207261596575f;
constexpr float THR = 8.f;
constexpr size_t SHM_V = KVBLK * 128 * 2, SHM_K = KVBLK * 128 * 2, SHM_ATTN = 2 * SHM_V + 2 * SHM_K + NW * 64 * 4;
#ifdef CPU_EMU
__device__ __forceinline__ void attn_body(const bf16_t* Qb, const bf16_t* Kh, const bf16_t* Vh, bf16_t* Ob, int seq, unsigned char* lds, int tq0, const float* ROPE) {
    const int tid = threadIdx.x, wid = tid >> 6, lane = tid & 63, r32 = lane & 31, hi = lane >> 5;
    if (hi == 0) {
        const bf16_t* qg = Qb + (size_t)(wid * 32 + r32) * LDQ; float m = -1e30f; float q[96];
        for (int d = 0; d < 96; ++d) q[d] = bf2f(qg[d]);
        if (tq0 >= 0) { const int t = tq0 + wid * 32 + r32;
            for (int i = 0; i < 16; ++i) { const int pos = i < 8 ? (t >> 6) : (t & 63); const float c = ROPE[(pos * 8 + (i & 7)) * 2], sn = ROPE[(pos * 8 + (i & 7)) * 2 + 1];
                const float x1 = q[64 + 2 * i], x2 = q[64 + 2 * i + 1]; q[64 + 2 * i] = x1 * c - x2 * sn; q[64 + 2 * i + 1] = x2 * c + x1 * sn; }
            for (int d = 64; d < 96; ++d) q[d] = bf2f((bf16_t)f2bf(q[d])); }
        std::vector<float> sc(seq);
        for (int k = 0; k < seq; ++k) { float s = 0.f; for (int d = 0; d < 96; ++d) s += q[d] * bf2f(Kh[(size_t)k * LDK + d]); sc[k] = s * SCALE; m = fmaxf(m, sc[k]); }
        float l = 0.f; float o[64]; for (int d = 0; d < 64; ++d) o[d] = 0.f;
        for (int k = 0; k < seq; ++k) { const float pr = expf(sc[k] - m); l += pr; const float prb = bf2f((bf16_t)f2bf(pr)); for (int d = 0; d < 64; ++d) o[d] += prb * bf2f(Vh[(size_t)k * LDV + d]); }
        for (int d = 0; d < 64; ++d) Ob[(size_t)(wid * 32 + r32) * LDO + d] = (bf16_t)f2bf(o[d] / l);
    }
    __syncthreads();
}
#else
using s16x4 = __attribute__((ext_vector_type(4))) short;
#define KSWZ(row, colB) ((row) * 256 + ((colB) ^ (((row) & 7) << 4)))
#define SBAR() __builtin_amdgcn_sched_barrier(0)
__device__ __forceinline__ unsigned cvtpk(float lo, float hi) { unsigned r; asm volatile("v_cvt_pk_bf16_f32 %0, %1, %2" : "=v"(r) : "v"(lo), "v"(hi)); return r; }
__device__ __forceinline__ void partialSM(f32x16& p0, f32x16& p1, float& m_reg, float& mn, float& alpha) {
  constexpr float C = SCALE * 1.4426950408889634f;
  float pmax = p0[0]; for (int r = 1; r < 16; ++r) pmax = fmaxf(pmax, p0[r]); for (int r = 0; r < 16; ++r) pmax = fmaxf(pmax, p1[r]);
  { auto rr = __builtin_amdgcn_permlane32_swap(__float_as_uint(pmax), __float_as_uint(pmax), false, false);
    pmax = fmaxf(__uint_as_float(rr[0]), __uint_as_float(rr[1])); }
  if (__builtin_expect(__all(pmax - m_reg <= THR / SCALE), 1)) { mn = m_reg; alpha = 1.f; }
  else { mn = fmaxf(m_reg, pmax); alpha = __builtin_amdgcn_exp2f((m_reg - mn) * C); m_reg = mn; }
  float mnC = -mn * C;
  for (int r = 0; r < 16; ++r) p0[r] = fmaf(p0[r], C, mnC); for (int r = 0; r < 16; ++r) p1[r] = fmaf(p1[r], C, mnC);
  for (int r = 0; r < 16; ++r) p0[r] = __builtin_amdgcn_exp2f(p0[r]);
}
__device__ __forceinline__ void finishSM(f32x16& p0, f32x16& p1, float alpha, float& l_reg, bf16x8& pa0, bf16x8& pa1, bf16x8& pa2, bf16x8& pa3) {
  for (int r = 0; r < 16; ++r) p1[r] = __builtin_amdgcn_exp2f(p1[r]);
  float ps = 0; for (int r = 0; r < 16; ++r) ps += p0[r]; for (int r = 0; r < 16; ++r) ps += p1[r];
  { auto rr = __builtin_amdgcn_permlane32_swap(__float_as_uint(ps), __float_as_uint(ps), false, false);
    ps = __uint_as_float(rr[0]) + __uint_as_float(rr[1]); }
  l_reg = l_reg * alpha + ps;
#define PK4(P, BASE, OUT) do { unsigned a0 = cvtpk(P[BASE + 0], P[BASE + 1]), a1 = cvtpk(P[BASE + 2], P[BASE + 3]);   \
    unsigned b0 = cvtpk(P[BASE + 4], P[BASE + 5]), b1 = cvtpk(P[BASE + 6], P[BASE + 7]);                              \
    auto r0 = __builtin_amdgcn_permlane32_swap(a0, b0, false, false); auto r1 = __builtin_amdgcn_permlane32_swap(a1, b1, false, false); \
    u32x4 w = {r0[0], r1[0], r0[1], r1[1]}; OUT = *reinterpret_cast<bf16x8*>(&w); } while (0)
  PK4(p0, 0, pa0); PK4(p0, 8, pa1); PK4(p1, 0, pa2); PK4(p1, 8, pa3);
#undef PK4
}
__device__ __forceinline__ void qkt(f32x16& p0, f32x16& p1, const bf16_t* Ks, const bf16x8* qr, int r32, int hi) {
  p0 = f32x16{}; p1 = f32x16{};
#pragma unroll
  for (int d0 = 0; d0 < 6; ++d0) { int cb = (d0 * 16 + hi * 8) * 2;
    bf16x8 b0 = *reinterpret_cast<const bf16x8*>((const char*)Ks + KSWZ(r32, cb));
    bf16x8 b1 = *reinterpret_cast<const bf16x8*>((const char*)Ks + KSWZ(32 + r32, cb));
    p0 = __builtin_amdgcn_mfma_f32_32x32x16_bf16(b0, qr[d0], p0, 0, 0, 0);
    p1 = __builtin_amdgcn_mfma_f32_32x32x16_bf16(b1, qr[d0], p1, 0, 0, 0); }
}
__device__ __forceinline__ int v_st(int k, int c) { const int kk = (k & ~0xC) | ((k & 4) << 1) | ((k & 8) >> 1); return ((kk >> 3) * 4 + (c >> 5)) * 512 + ((kk & 7) * 32 + (c & 31)) * 2; }
__device__ __forceinline__ int v_rd_base(int lane) { return ((lane & 3) << 3) | (((lane >> 2) & 3) << 6) | (((lane >> 4) & 1) << 5) | (((lane >> 5) & 1) << 8); }
constexpr int v_rd_off(int d0, int ks, int half) { return d0 * 512 + ks * 4096 + half * 2048; }
template <int OFF> __device__ __forceinline__ s16x4 tr_read(int vb) {
  s16x4 r; asm volatile("ds_read_b64_tr_b16 %0, %1 offset:%2" : "=&v"(r) : "v"(vb), "i"(OFF) : "memory"); return r;
}
template <int D0> __device__ __forceinline__ void pv_one(f32x16& od, int vb, bf16x8 pa0, bf16x8 pa1, bf16x8 pa2, bf16x8 pa3) {
  const s16x4 l0 = tr_read<v_rd_off(D0, 0, 0)>(vb), h0 = tr_read<v_rd_off(D0, 0, 1)>(vb), l1 = tr_read<v_rd_off(D0, 1, 0)>(vb), h1 = tr_read<v_rd_off(D0, 1, 1)>(vb);
  const s16x4 l2 = tr_read<v_rd_off(D0, 2, 0)>(vb), h2 = tr_read<v_rd_off(D0, 2, 1)>(vb), l3 = tr_read<v_rd_off(D0, 3, 0)>(vb), h3 = tr_read<v_rd_off(D0, 3, 1)>(vb);
  asm volatile("s_waitcnt lgkmcnt(0)" ::: "memory"); SBAR();
#define PK(L, H) (bf16x8){L[0], L[1], L[2], L[3], H[0], H[1], H[2], H[3]}
  od = __builtin_amdgcn_mfma_f32_32x32x16_bf16(pa0, PK(l0, h0), od, 0, 0, 0);
  od = __builtin_amdgcn_mfma_f32_32x32x16_bf16(pa1, PK(l1, h1), od, 0, 0, 0);
  od = __builtin_amdgcn_mfma_f32_32x32x16_bf16(pa2, PK(l2, h2), od, 0, 0, 0);
  od = __builtin_amdgcn_mfma_f32_32x32x16_bf16(pa3, PK(l3, h3), od, 0, 0, 0);
#undef PK
}
__device__ __forceinline__ void pv_d0(f32x16* o, int vb, bf16x8 pa0, bf16x8 pa1, bf16x8 pa2, bf16x8 pa3) {
  pv_one<0>(o[0], vb, pa0, pa1, pa2, pa3); pv_one<1>(o[1], vb, pa0, pa1, pa2, pa3);
}
__device__ __forceinline__ void attn_body(const bf16_t* __restrict__ Qb, const bf16_t* __restrict__ Kh, const bf16_t* __restrict__ Vh, bf16_t* __restrict__ Ob, int seq, char* lds, int tq0, const float* __restrict__ ROPE) {
  const int tid = threadIdx.x, wid = tid >> 6, lane = tid & 63, r32 = lane & 31, hi = lane >> 5;
  bf16_t* V_lds = (bf16_t*)lds; bf16_t* K_lds = (bf16_t*)(lds + 2 * SHM_V);
  float* ws = (float*)(lds + 2 * SHM_V + 2 * SHM_K) + wid * 64; float* li_l = ws; float* al_l = ws + 32;
  float m_reg = -1e30f, l_reg = 0; f32x16 o[2] = {}; bf16x8 qr[6];
  const bf16_t* Qw = Qb + (long)(wid * QBLK + r32) * LDQ + hi * 8;
#pragma unroll
  for (int d0 = 0; d0 < 6; ++d0) qr[d0] = *reinterpret_cast<const bf16x8*>(Qw + d0 * 16);
  if (tq0 >= 0) {
    const int t = tq0 + wid * QBLK + r32;
#pragma unroll
    for (int dd = 0; dd < 2; ++dd) { const int pos = dd == 0 ? (t >> 6) : (t & 63);
      const f32x4 r0 = *(const f32x4*)(ROPE + pos * 16 + 8 * hi), r1 = *(const f32x4*)(ROPE + pos * 16 + 8 * hi + 4);
      const u32x4 w = *reinterpret_cast<const u32x4*>(&qr[4 + dd]); u32x4 o;
      { const float x1 = bflo(w.x), x2 = bfhi(w.x); o.x = pk2(x1 * r0[0] - x2 * r0[1], x2 * r0[0] + x1 * r0[1]); }
      { const float x1 = bflo(w.y), x2 = bfhi(w.y); o.y = pk2(x1 * r0[2] - x2 * r0[3], x2 * r0[2] + x1 * r0[3]); }
      { const float x1 = bflo(w.z), x2 = bfhi(w.z); o.z = pk2(x1 * r1[0] - x2 * r1[1], x2 * r1[0] + x1 * r1[1]); }
      { const float x1 = bflo(w.w), x2 = bfhi(w.w); o.w = pk2(x1 * r1[2] - x2 * r1[3], x2 * r1[2] + x1 * r1[3]); }
      qr[4 + dd] = *reinterpret_cast<const bf16x8*>(&o); }
  }
  const int sr = tid >> 4, sc = (tid & 15) * 8;
  const int vk = tid >> 3, vc = (tid & 7) * 8, vst0 = v_st(vk, vc);
  const int vb0 = (int)(uintptr_t)V_lds + v_rd_base(lane);
  struct { bf16x8 vs0, ks0, ks1; } sr_[2];
#define SLOAD(i, k0) do { sr_[i].vs0 = *reinterpret_cast<const bf16x8*>(&Vh[(long)((k0) + vk) * LDV + vc]); \
    sr_[i].ks0 = *reinterpret_cast<const bf16x8*>(&Kh[(long)((k0) + sr) * LDK + sc]); sr_[i].ks1 = *reinterpret_cast<const bf16x8*>(&Kh[(long)((k0) + 32 + sr) * LDK + sc]); } while (0)
#define SWRITE(b, i) do { *(bf16x8*)((char*)V_lds + (b) * SHM_V + vst0) = sr_[i].vs0; int kc = sc * 2;               \
    *(bf16x8*)((char*)K_lds + (b) * SHM_K + KSWZ(sr, kc)) = sr_[i].ks0;                       \
    *(bf16x8*)((char*)K_lds + (b) * SHM_K + KSWZ(32 + sr, kc)) = sr_[i].ks1; } while (0)
#define SWAIT() asm volatile("s_waitcnt vmcnt(3)" ::: "memory")
#define RESC(a) do { if (__any((a) < 1.f)) { if (hi == 0) al_l[r32] = (a); asm volatile("s_waitcnt lgkmcnt(0)" ::: "memory"); \
    for (int d = 0; d < 2; ++d) for (int r = 0; r < 16; ++r) o[d][r] *= al_l[crow(r, hi)]; } } while (0)
  f32x16 pA0, pA1, pB0, pB1; float mnA, mnB, alA, alB; bf16x8 pa0, pa1, pa2, pa3; const int NT = seq / KVBLK;
  constexpr int SE = 0, SO = 1;
  SLOAD(SE, 0); asm volatile("s_waitcnt vmcnt(0)" ::: "memory"); SWRITE(0, SE); __syncthreads();
  qkt(pA0, pA1, K_lds, qr, r32, hi); partialSM(pA0, pA1, m_reg, mnA, alA);
  SLOAD(SO, KVBLK); if (2 < NT) SLOAD(SE, 2 * KVBLK);
  SWAIT(); SWRITE(1, SO); __syncthreads();
  for (int j = 1; j + 1 < NT; j += 2) {
    SBAR(); qkt(pB0, pB1, (bf16_t*)((char*)K_lds + SHM_K), qr, r32, hi);
    finishSM(pA0, pA1, alA, l_reg, pa0, pa1, pa2, pa3); SBAR();
    SLOAD(SO, (j + 2) * KVBLK); SBAR();
    pv_d0(o, vb0, pa0, pa1, pa2, pa3); partialSM(pB0, pB1, m_reg, mnB, alB);
    __syncthreads(); SWAIT(); SWRITE(0, SE);
    RESC(alB); __syncthreads();
    SBAR(); qkt(pA0, pA1, K_lds, qr, r32, hi);
    finishSM(pB0, pB1, alB, l_reg, pa0, pa1, pa2, pa3); SBAR();
    if (j + 3 < NT) SLOAD(SE, (j + 3) * KVBLK); SBAR();
    pv_d0(o, vb0 + (int)SHM_V, pa0, pa1, pa2, pa3); partialSM(pA0, pA1, m_reg, mnA, alA);
    __syncthreads(); SWAIT(); SWRITE(1, SO);
    RESC(alA); __syncthreads();
  }
  SBAR(); qkt(pB0, pB1, (bf16_t*)((char*)K_lds + SHM_K), qr, r32, hi);
  finishSM(pA0, pA1, alA, l_reg, pa0, pa1, pa2, pa3); SBAR();
  pv_d0(o, vb0, pa0, pa1, pa2, pa3); partialSM(pB0, pB1, m_reg, mnB, alB);
  __syncthreads(); RESC(alB);
  finishSM(pB0, pB1, alB, l_reg, pa0, pa1, pa2, pa3); SBAR();
  pv_d0(o, vb0 + (int)SHM_V, pa0, pa1, pa2, pa3);
  if (hi == 0) li_l[r32] = l_reg; asm volatile("s_waitcnt lgkmcnt(0)" ::: "memory");
  float rli[16];
#pragma unroll
  for (int r = 0; r < 16; ++r) rli[r] = __builtin_amdgcn_rcpf(li_l[crow(r, hi)]);
  bf16_t* Ow = Ob + (long)(wid * QBLK) * LDO;
#pragma unroll
  for (int r = 0; r < 16; ++r) { int orow = crow(r, hi);
    for (int d0 = 0; d0 < 2; ++d0) Ow[(long)orow * LDO + d0 * 32 + r32] = (bf16_t)f2bf(o[d0][r] * rli[r]); }
  __syncthreads();
#undef SLOAD
#undef SWRITE
#undef SWAIT
#undef RESC
}
#undef KSWZ
#undef SBAR
#endif
}

template <class RowMap>
__device__ __forceinline__ void tr_item(const float* W, int ldw, int k0, int n0, bf16_t* WT, int ldt, int koff, const float* kscale, RowMap rm, float* scr, int lane) {
#pragma unroll 8
    for (int i = 0; i < 32; ++i) { const int kk = 2 * i + (lane >> 5); scr[kk * 33 + (lane & 31)] = W[(size_t)(k0 + kk) * ldw + n0 + (lane & 31)]; }
    wave_sync();
    const int c = lane & 7;
    float ks[8];
#pragma unroll
    for (int e = 0; e < 8; ++e) ks[e] = kscale ? kscale[k0 + 8 * c + e] : 1.f;
#pragma unroll
    for (int j = 0; j < 4; ++j) { const int n = (lane >> 3) + 8 * j; const float* s = scr + (8 * c) * 33 + n;
        u32x4 o; o.x = pk2(s[0 * 33] * ks[0], s[1 * 33] * ks[1]); o.y = pk2(s[2 * 33] * ks[2], s[3 * 33] * ks[3]); o.z = pk2(s[4 * 33] * ks[4], s[5 * 33] * ks[5]); o.w = pk2(s[6 * 33] * ks[6], s[7 * 33] * ks[7]);
        const int row = rm(n0 + n);
        if (row >= 0) *(u32x4*)(WT + (size_t)row * ldt + koff + k0 + 8 * c) = o; }
    wave_sync();
}
struct RmId { int off; __device__ __forceinline__ int operator()(int n) const { return off + n; } };
struct RmGlu { int off; __device__ __forceinline__ int operator()(int n) const { return ((n >> 7) << 8) + off + (n & 127); } };
struct RmUq { __device__ __forceinline__ int operator()(int n) const { const int h = n / 96, d = n - h * 96; int sd = d;
        if (d >= 64) { const int rho = d - 64; const int half = rho >> 4, w = rho & 15; const int i = half * 8 + (w & 7); sd = 64 + 2 * i + (w >> 3); }
        return h * 128 + sd; } };
__device__ __forceinline__ void s5_disc(const Args& A, int it, int p, float& are_bar, float& aim_bar, float& cre, float& cim) {
    const float are = A.in[8][(size_t)it * 64 + p], aim = A.in[9][(size_t)it * 64 + p]; const float dt = expf(A.in[10][it]);
    const float zr = are * dt, zi = aim * dt; const float ez = expf(zr), cs = cosf(zi), sn = sinf(zi), sh = sinf(0.5f * zi);
    are_bar = ez * cs; aim_bar = ez * sn;
    const float nr = expm1f(zr) * cs - 2.f * sh * sh, ni = ez * sn;
    const float den = are * are + aim * aim;
    cre = (nr * are + ni * aim) / den; cim = (ni * are - nr * aim) / den;
}
__device__ __forceinline__ void ph_prep(const Args& A, Frame& F) {
    const int tid = F.tid, lane = F.lane, wave = F.wave, G = F.G, bid = F.bid;
    unsigned char* ws = A.ws;
    { float* ca = (float*)F.lds; float* red = ca + NR * 1024; float* MOD = (float*)(ws + WS_MOD);
      for (int i = tid; i < NR * 1024; i += NTHR) { const int r = i >> 10, k = i & 1023; const float c = r < BATCH ? A.in[1][r * 1024 + k] : A.in[3][k]; ca[i] = siluf_(c); }
      __syncthreads();
      for (int it = bid; it < 4 * 96; it += G) { const int l = it / 96, cb = (it % 96) * 64; float acc[NR];
#pragma unroll
          for (int r = 0; r < NR; ++r) acc[r] = 0.f;
          const float* wp = A.in[4] + ((size_t)l * 1024 + wave * 128) * 6144 + cb + lane;
#pragma unroll 8
          for (int k = 0; k < 128; ++k) { const float w = wp[(size_t)k * 6144];
#pragma unroll
              for (int r = 0; r < NR; ++r) acc[r] += ca[r * 1024 + wave * 128 + k] * w; }
#pragma unroll
          for (int r = 0; r < NR; ++r) red[(wave * NR + r) * 64 + lane] = acc[r];
          __syncthreads();
          if (tid < NR * 64) { const int r = tid >> 6, c = tid & 63; float s = A.in[5][l * 6144 + cb + c];
              for (int w = 0; w < 8; ++w) s += red[(w * NR + r) * 64 + c];
              MOD[((size_t)l * NR + r) * 6144 + cb + c] = s; }
          __syncthreads(); } }
    { float* ROPE = (float*)(ws + WS_ROPE);
      for (int i = bid * NTHR + tid; i < 64 * 8; i += G * NTHR) { const int pos = i >> 3, f = i & 7; const float freq = powf(10000.f, -(float)f / 8.f); const float ang = (float)pos * freq;
          ROPE[2 * i] = cosf(ang); ROPE[2 * i + 1] = sinf(ang); } }
    { float* scr = (float*)(F.lds + wave * 16384);
      const int gw = bid * NWAVES + wave, NGW = G * NWAVES;
      bf16_t* WGLU = (bf16_t*)(ws + WS_WGLU); bf16_t* WIN = (bf16_t*)(ws + WS_WIN); bf16_t* WOUT = (bf16_t*)(ws + WS_WOUT); bf16_t* WDOWN = (bf16_t*)(ws + WS_WDOWN);
      bf16_t* WUP = (bf16_t*)(ws + WS_WUP); bf16_t* WO = (bf16_t*)(ws + WS_WO);
      constexpr int I_GLU = 16 * 32, I_IN = 16 * 162, I_OUT = 32 * 32, I_DOWN = 16 * 13, I_UQ = 4 * 48, I_UK = 2 * 32, I_WO = 16 * 32;
      constexpr int NIT = 4 * I_GLU + I_IN + I_OUT + I_DOWN + I_UQ + 2 * I_UK + I_WO;
      for (int it = gw; it < NIT; it += NGW) { int r = it;
          if (r < 4 * I_GLU) { const int which = r / I_GLU, q = r % I_GLU, j = which >> 1, isgate = which & 1;
              const float* W = (isgate ? A.in[16] : A.in[17]) + (size_t)j * 1024 * 1024;
              tr_item(W, 1024, (q / 32) * 64, (q % 32) * 32, WGLU + (size_t)j * 2048 * 1024, 1024, 0, nullptr, RmGlu{isgate * 128}, scr, lane); continue; } r -= 4 * I_GLU;
          if (r < I_IN) { tr_item(A.in[18], SSD_IN, (r / 162) * 64, (r % 162) * 32, WIN, 1024, 0, nullptr, RmId{0}, scr, lane); continue; } r -= I_IN;
          if (r < I_OUT) { tr_item(A.in[25], 1024, (r / 32) * 64, (r % 32) * 32, WOUT, 2048, 0, A.in[24], RmId{0}, scr, lane); continue; } r -= I_OUT;
          if (r < I_DOWN) { tr_item(A.in[26], 416, (r / 13) * 64, (r % 13) * 32, WDOWN, 1024, 0, nullptr, RmId{0}, scr, lane); continue; } r -= I_DOWN;
          if (r < I_UQ) { tr_item(A.in[29], 1536, (r / 48) * 64, (r % 48) * 32, WUP, 384, 0, A.in[27], RmUq{}, scr, lane); continue; } r -= I_UQ;
          if (r < I_UK) { tr_item(A.in[30], 1024, (r / 32) * 64, (r % 32) * 32, WUP, 384, 256, A.in[28], RmId{2048}, scr, lane); continue; } r -= I_UK;
          if (r < I_UK) { tr_item(A.in[31], 1024, (r / 32) * 64, (r % 32) * 32, WUP, 384, 256, A.in[28], RmId{3072}, scr, lane); continue; } r -= I_UK;
          tr_item(A.in[32], 1024, (r / 32) * 64, (r % 32) * 32, WO, 1024, 0, nullptr, RmId{0}, scr, lane); }
      const u32x4 z4 = {0u, 0u, 0u, 0u};
      const long gt = (long)bid * NTHR + tid, GT = (long)G * NTHR;
      for (long i = gt; i < (long)(SSD_IN_PAD - SSD_IN) * 128; i += GT) *(u32x4*)(WIN + (size_t)SSD_IN * 1024 + i * 8) = z4;
      for (long i = gt; i < (long)(512 - 416) * 128; i += GT) *(u32x4*)(WDOWN + (size_t)416 * 1024 + i * 8) = z4;
      for (long i = gt; i < 4096L * 48; i += GT) { const int R = (int)(i / 48), k = (int)(i % 48) * 8;
          const bool zero = R < 2048 ? (k >= 256 || (R & 127) >= 96) : (k < 256);
          if (zero) *(u32x4*)(WUP + (size_t)R * 384 + k) = z4; }
      { bf16_t* UT = (bf16_t*)(ws + WS_UT); bf16_t* VT = (bf16_t*)(ws + WS_VT); const long n8 = 4L * 16384 * 1024 / 8;
        for (long i = gt; i < 2 * n8; i += GT) { const bool isu = i < n8; const long j = isu ? i : i - n8; const float* src = (isu ? A.in[35] : A.in[36]) + j * 8;
            const f32x4 a = *(const f32x4*)src, b = *(const f32x4*)(src + 4); *(u32x4*)((isu ? UT : VT) + j * 8) = pack8(a, b, 1.f); } }
      for (int it = gw; it < 2 * 2 * 64; it += NGW) { unsigned char* base = ws + WS_S5C + (size_t)it * S5C_ITEM;
          float ar, ai, cr, ci; s5_disc(A, it, lane, ar, ai, cr, ci);
          ((f32x2*)base)[lane] = (f32x2){ar, ai};
          const int r = lane & 31, h = lane >> 5;
          const float* bre = A.in[11] + (size_t)it * 64 * 16; const float* bim = A.in[12] + (size_t)it * 64 * 16;
          const float* cre = A.in[13] + (size_t)it * 16 * 64; const float* cim = A.in[14] + (size_t)it * 16 * 64;
#pragma unroll
          for (int blk = 0; blk < 4; ++blk) { const int pst = (blk & 1) * 32 + r; float ar2, ai2, kr, ki; s5_disc(A, it, pst, ar2, ai2, kr, ki); float v[8];
#pragma unroll
              for (int j = 0; j < 8; ++j) { const int c = 8 * h + j; const float br = bre[pst * 16 + c], bi = bim[pst * 16 + c]; v[j] = blk < 2 ? (kr * br - ki * bi) : (kr * bi + ki * br); }
              u32x4 o; o.x = pk2(v[0], v[1]); o.y = pk2(v[2], v[3]); o.z = pk2(v[4], v[5]); o.w = pk2(v[6], v[7]);
              ((u32x4*)(base + 512))[blk * 64 + lane] = o; }
#pragma unroll
          for (int ks = 0; ks < 8; ++ks) { float v[8];
#pragma unroll
              for (int j = 0; j < 8; ++j) { const int k = 16 * ks + 8 * h + j, p = k >> 1, comp = k & 1; v[j] = r < 16 ? (comp == 0 ? cre[r * 64 + p] : -cim[r * 64 + p]) : 0.f; }
              u32x4 o; o.x = pk2(v[0], v[1]); o.y = pk2(v[2], v[3]); o.z = pk2(v[4], v[5]); o.w = pk2(v[6], v[7]);
              ((u32x4*)(base + 512 + 4096))[ks * 64 + lane] = o; } }
    }
    __syncthreads();
    { float* At = (float*)F.lds; float* Bs = At + 64 * 128;
      bf16_t* WSC = (bf16_t*)(ws + WS_WSC);
      for (int it = bid; it < 4 * 16 * 16; it += G) { const int l = it >> 8, hj = (it >> 4) & 15, kb = it & 15, k0 = kb * 64;
          const float* wq = A.in[33] + ((size_t)l * 1024 + k0) * 2048 + hj * 128; const float* sk = A.in[34] + ((size_t)l * 16 + hj) * 128 * 128;
          for (int i = tid; i < 64 * 32; i += NTHR) { const int kk = i >> 5, d4 = (i & 31) * 4; *(f32x4*)(At + kk * 128 + d4) = *(const f32x4*)(wq + (size_t)kk * 2048 + d4); }
          for (int i = tid; i < 128 * 32; i += NTHR) { const int ii = i >> 5, d4 = (i & 31) * 4; const f32x4 v = *(const f32x4*)(sk + (size_t)ii * 128 + d4); float* d = Bs + ii * 129 + d4; d[0] = v[0]; d[1] = v[1]; d[2] = v[2]; d[3] = v[3]; }
          __syncthreads();
          const int ii = tid & 127, kg = tid >> 7; float acc[16];
#pragma unroll
          for (int q = 0; q < 16; ++q) acc[q] = 0.f;
          for (int d = 0; d < 128; d += 4) { const float b0 = Bs[ii * 129 + d], b1 = Bs[ii * 129 + d + 1], b2 = Bs[ii * 129 + d + 2], b3 = Bs[ii * 129 + d + 3];
#pragma unroll
              for (int q = 0; q < 16; ++q) { const f32x4 a = *(const f32x4*)(At + (kg * 16 + q) * 128 + d); acc[q] += (a[0] * b0 + a[1] * b1) + (a[2] * b2 + a[3] * b3); } }
          bf16_t* dst = WSC + ((size_t)l * 2048 + hj * 128 + ii) * 1024 + k0 + kg * 16;
          u32x4 o0, o1; o0.x = pk2(acc[0], acc[1]); o0.y = pk2(acc[2], acc[3]); o0.z = pk2(acc[4], acc[5]); o0.w = pk2(acc[6], acc[7]);
          o1.x = pk2(acc[8], acc[9]); o1.y = pk2(acc[10], acc[11]); o1.z = pk2(acc[12], acc[13]); o1.w = pk2(acc[14], acc[15]);
          *(u32x4*)dst = o0; *(u32x4*)(dst + 8) = o1;
          __syncthreads(); } }
}

struct Row16 { float v[16]; };
__device__ __forceinline__ Row16 ld_row_f32(const float* p, int lane) { Row16 r; const f32x4 a = *(const f32x4*)(p + 8 * lane), b = *(const f32x4*)(p + 8 * lane + 4), c = *(const f32x4*)(p + 512 + 8 * lane), d = *(const f32x4*)(p + 512 + 8 * lane + 4);
#pragma unroll
    for (int e = 0; e < 4; ++e) { r.v[e] = a[e]; r.v[4 + e] = b[e]; r.v[8 + e] = c[e]; r.v[12 + e] = d[e]; } return r; }
__device__ __forceinline__ void st_row_f32(float* p, int lane, const Row16& r) {
    *(f32x4*)(p + 8 * lane) = (f32x4){r.v[0], r.v[1], r.v[2], r.v[3]}; *(f32x4*)(p + 8 * lane + 4) = (f32x4){r.v[4], r.v[5], r.v[6], r.v[7]};
    *(f32x4*)(p + 512 + 8 * lane) = (f32x4){r.v[8], r.v[9], r.v[10], r.v[11]}; *(f32x4*)(p + 512 + 8 * lane + 4) = (f32x4){r.v[12], r.v[13], r.v[14], r.v[15]}; }
__device__ __forceinline__ Row16 ld_row_bf16(const bf16_t* p, int lane) { Row16 r; const u32x4 a = *(const u32x4*)(p + 8 * lane), b = *(const u32x4*)(p + 512 + 8 * lane);
    r.v[0] = bflo(a.x); r.v[1] = bfhi(a.x); r.v[2] = bflo(a.y); r.v[3] = bfhi(a.y); r.v[4] = bflo(a.z); r.v[5] = bfhi(a.z); r.v[6] = bflo(a.w); r.v[7] = bfhi(a.w);
    r.v[8] = bflo(b.x); r.v[9] = bfhi(b.x); r.v[10] = bflo(b.y); r.v[11] = bfhi(b.y); r.v[12] = bflo(b.z); r.v[13] = bfhi(b.z); r.v[14] = bflo(b.w); r.v[15] = bfhi(b.w); return r; }
__device__ __forceinline__ void st_row_bf16(bf16_t* p, int lane, const Row16& r) {
    u32x4 a, b; a.x = pk2(r.v[0], r.v[1]); a.y = pk2(r.v[2], r.v[3]); a.z = pk2(r.v[4], r.v[5]); a.w = pk2(r.v[6], r.v[7]);
    b.x = pk2(r.v[8], r.v[9]); b.y = pk2(r.v[10], r.v[11]); b.z = pk2(r.v[12], r.v[13]); b.w = pk2(r.v[14], r.v[15]);
    *(u32x4*)(p + 8 * lane) = a; *(u32x4*)(p + 512 + 8 * lane) = b; }
__device__ __forceinline__ Row16 layer_norm_row(const Row16& v, const float* g, const float* b, int lane) {
    float s = 0.f;
#pragma unroll
    for (int e = 0; e < 16; ++e) s += v.v[e];
    const float mean = wave_sum(s) * (1.f / 1024.f); float q = 0.f;
#pragma unroll
    for (int e = 0; e < 16; ++e) { const float d = v.v[e] - mean; q += d * d; }
    const float rstd = 1.0f / sqrtf(wave_sum(q) * (1.f / 1024.f) + 1e-5f);
    const Row16 gg = ld_row_f32(g, lane), bb = ld_row_f32(b, lane); Row16 o;
#pragma unroll
    for (int e = 0; e < 16; ++e) o.v[e] = (v.v[e] - mean) * rstd * gg.v[e] + bb.v[e];
    return o;
}
__device__ __forceinline__ const float* mod_row(const Args& A, int layer, int tok) { const int b = tok / LTOK, p = tok - b * LTOK; return (const float*)(A.ws + WS_MOD) + ((size_t)layer * NR + (p < CTXL ? BATCH : b)) * 6144; }

__device__ __forceinline__ void ph_init(const Args& A, Frame& F) {
    float* X = (float*)(A.ws + WS_X); bf16_t* H = (bf16_t*)(A.ws + WS_H);
    for (int tok = F.bid * NWAVES + F.wave; tok < NTOK; tok += F.G * NWAVES) { const int b = tok / LTOK, p = tok - b * LTOK;
        const float* src = p < CTXL ? A.in[2] + ((size_t)b * CTXL + p) * DM : A.in[0] + ((size_t)b * SEQ + (p - CTXL)) * DM;
        const Row16 x = ld_row_f32(src, F.lane); st_row_f32(X + (size_t)tok * DM, F.lane, x);
        const float* mod = mod_row(A, 0, tok); const Row16 sh = ld_row_f32(mod, F.lane), sc = ld_row_f32(mod + 1024, F.lane); Row16 h;
#pragma unroll
        for (int e = 0; e < 16; ++e) h.v[e] = x.v[e] * (1.f + sc.v[e]) + sh.v[e];
        st_row_bf16(H + (size_t)tok * DM, F.lane, h); }
}
__device__ __forceinline__ void ph_rowop(const Args& A, Frame& F, int layer) {
    float* X = (float*)(A.ws + WS_X); const float* OUT = (const float*)(A.ws + WS_OUT); bf16_t* H2 = (bf16_t*)(A.ws + WS_H2);
    for (int tok = F.bid * NWAVES + F.wave; tok < NTOK; tok += F.G * NWAVES) { const int p = tok % LTOK;
        if (layer == 3 && p < CTXL) continue;
        const float* mod = mod_row(A, layer, tok);
        const Row16 x = ld_row_f32(X + (size_t)tok * DM, F.lane), o = ld_row_f32(OUT + (size_t)tok * DM, F.lane), g1 = ld_row_f32(mod + 2048, F.lane); Row16 v;
#pragma unroll
        for (int e = 0; e < 16; ++e) v.v[e] = DN_ALPHA * x.v[e] + g1.v[e] * o.v[e];
        const Row16 x1 = layer_norm_row(v, A.in[6] + (size_t)(layer * 2) * DM, A.in[7] + (size_t)(layer * 2) * DM, F.lane);
        st_row_f32(X + (size_t)tok * DM, F.lane, x1);
        const Row16 sh = ld_row_f32(mod + 3072, F.lane), sc = ld_row_f32(mod + 4096, F.lane); Row16 h;
#pragma unroll
        for (int e = 0; e < 16; ++e) h.v[e] = x1.v[e] * (1.f + sc.v[e]) + sh.v[e];
        st_row_bf16(H2 + (size_t)tok * DM, F.lane, h); }
}

__device__ __forceinline__ void ph_s5_scan(const Args& A, Frame& F, int j) {
    if (F.wave >= 4) return;
    const int lane = F.lane, r = lane & 31, h = lane >> 5;
    unsigned char* wl = F.lds + F.wave * 25600; float* BU = (float*)wl; unsigned char* Sb = wl + 16384;
    const bf16_t* H = (const bf16_t*)(A.ws + WS_H);
    for (int item = F.wave * F.G + F.bid; item < BATCH * 128; item += 4 * F.G) { const int g = item & 63, dir = (item >> 6) & 1, b = item >> 7;
        const unsigned char* cb = A.ws + WS_S5C + (size_t)((j * 2 + dir) * 64 + g) * S5C_ITEM;
        const f32x2 ab = ((const f32x2*)cb)[lane]; const float are = ab.x, aim = ab.y;
        bf16x8 Bf[4], Cf[8];
#pragma unroll
        for (int q = 0; q < 4; ++q) Bf[q] = ((const bf16x8*)(cb + 512))[q * 64 + lane];
#pragma unroll
        for (int q = 0; q < 8; ++q) Cf[q] = ((const bf16x8*)(cb + 512 + 4096))[q * 64 + lane];
        bf16_t* Y = (bf16_t*)(A.ws + (dir ? WS_YB : WS_YF));
        float sre = 0.f, sim = 0.f;
        for (int s0 = 0; s0 < LTOK; s0 += 32) {
            const size_t tokA = (size_t)b * LTOK + seqpos(dir, s0 + r);
            const bf16x8 ua = *(const bf16x8*)(H + tokA * DM + g * 16 + 8 * h);
#pragma unroll
            for (int blk = 0; blk < 4; ++blk) { f32x16 acc = {}; acc = mfma32(ua, Bf[blk], acc);
#pragma unroll
                for (int q = 0; q < 16; ++q) BU[crow(q, h) * 128 + blk * 32 + r] = acc[q]; }
            wave_sync();
#pragma unroll 8
            for (int t = 0; t < 32; ++t) { const float bre = BU[t * 128 + lane], bim = BU[t * 128 + 64 + lane];
                const float nre = are * sre - aim * sim + bre, nim = are * sim + aim * sre + bim; sre = nre; sim = nim;
                *(unsigned*)(Sb + t * 272 + lane * 4) = pk2(sre, sim); }
            wave_sync();
            f32x16 y = {};
#pragma unroll
            for (int ks = 0; ks < 8; ++ks) { const bf16x8 sa = *(const bf16x8*)(Sb + r * 272 + (16 * ks + 8 * h) * 2); y = mfma32(sa, Cf[ks], y); }
            if (r < 16) {
#pragma unroll
                for (int q = 0; q < 16; ++q) { const size_t tk = (size_t)b * LTOK + seqpos(dir, s0 + crow(q, h)); Y[tk * DM + g * 16 + r] = (bf16_t)f2bf(y[q]); } }
            wave_sync();
        }
    }
}
__device__ __forceinline__ void ph_s5_combine(const Args& A, Frame& F, int j) {
    const bf16_t* H = (const bf16_t*)(A.ws + WS_H); const bf16_t* YF = (const bf16_t*)(A.ws + WS_YF); const bf16_t* YB = (const bf16_t*)(A.ws + WS_YB); bf16_t* Gb = (bf16_t*)(A.ws + WS_G);
    const float* dv = A.in[15] + (size_t)j * DM;
    for (int tok = F.bid * NWAVES + F.wave; tok < NTOK; tok += F.G * NWAVES) {
        const Row16 h = ld_row_bf16(H + (size_t)tok * DM, F.lane), yf = ld_row_bf16(YF + (size_t)tok * DM, F.lane), yb = ld_row_bf16(YB + (size_t)tok * DM, F.lane), d = ld_row_f32(dv, F.lane); Row16 o;
#pragma unroll
        for (int e = 0; e < 16; ++e) o.v[e] = gelu_tanh(d.v[e] * h.v[e] + yf.v[e] + yb.v[e]);
        st_row_bf16(Gb + (size_t)tok * DM, F.lane, o); }
}

__device__ __forceinline__ void ph_ssd_conv(const Args& A, Frame& F) {
    const bf16_t* XBC = (const bf16_t*)(A.ws + WS_XBC); bf16_t* XC = (bf16_t*)(A.ws + WS_XBCC); const float* DT = (const float*)(A.ws + WS_DT); float* DTS = (float*)(A.ws + WS_DTS);
    const float* cw = A.in[19]; const float* cbias = A.in[20]; const float* dtb = A.in[21];
    const long gt = (long)F.bid * NTHR + F.tid, GT = (long)F.G * NTHR;
    for (long i = gt; i < (long)NTOK * 384; i += GT) { const int tok = (int)(i / 384), ch = (int)(i % 384) * 8; const int p = tok % LTOK;
        const bool hp = (p != 0 && p != CTXL), hn = (p != CTXL - 1 && p != LTOK - 1);
        const u32x4 z4 = {0u, 0u, 0u, 0u};
        const u32x4 c0 = *(const u32x4*)(XBC + (size_t)tok * 3072 + ch);
        const u32x4 cm = hp ? *(const u32x4*)(XBC + (size_t)(tok - 1) * 3072 + ch) : z4;
        const u32x4 cp = hn ? *(const u32x4*)(XBC + (size_t)(tok + 1) * 3072 + ch) : z4;
        float o[8];
#pragma unroll
        for (int e = 0; e < 4; ++e) { const unsigned wm = cm[e], w0 = c0[e], wp = cp[e]; const int c = ch + 2 * e;
            o[2 * e] = siluf_(cbias[c] + cw[c] * bflo(wm) + cw[3072 + c] * bflo(w0) + cw[6144 + c] * bflo(wp));
            o[2 * e + 1] = siluf_(cbias[c + 1] + cw[c + 1] * bfhi(wm) + cw[3072 + c + 1] * bfhi(w0) + cw[6144 + c + 1] * bfhi(wp)); }
        u32x4 w; w.x = pk2(o[0], o[1]); w.y = pk2(o[2], o[3]); w.z = pk2(o[4], o[5]); w.w = pk2(o[6], o[7]);
        *(u32x4*)(XC + (size_t)tok * 3072 + ch) = w; }
    for (long i = gt; i < (long)NTOK * 64; i += GT) { const float x = DT[i] + dtb[i & 63]; DTS[i] = x > 20.f ? x : log1pf(__expf(x)); }
}
__device__ __forceinline__ void ph_ssd_scan(const Args& A, Frame& F) {
    const int tid = F.tid;
    float* xs = (float*)F.lds; float* Bs = xs + 32 * 64; float* Cs = Bs + 32 * 128; float* dts = Cs + 32 * 128; float* dAs = dts + 32; float* yo = dAs + 32;
    const bf16_t* XC = (const bf16_t*)(A.ws + WS_XBCC); const float* DTS = (const float*)(A.ws + WS_DTS);
    const int p = tid >> 3, nq = tid & 7;
    for (int item = F.bid; item < BATCH * 64; item += F.G) { const int hh = item & 31, dir = (item >> 5) & 1, b = item >> 6, grp = hh >> 3;
        const float Ah = -__expf(A.in[22][dir * 32 + hh]);
        bf16_t* Y = (bf16_t*)(A.ws + (dir ? WS_YB2 : WS_YF2));
        float st[16];
#pragma unroll
        for (int q = 0; q < 16; ++q) st[q] = 0.f;
        u32x4 rB, rC, rX = {0u, 0u, 0u, 0u}; float rdt = 0.f;
#define SSD_LOAD(s0) do { const size_t tb = (size_t)b * LTOK + seqpos(dir, (s0) + (tid >> 4)); \
            rB = *(const u32x4*)(XC + tb * 3072 + 2048 + grp * 128 + (tid & 15) * 8); rC = *(const u32x4*)(XC + tb * 3072 + 2560 + grp * 128 + (tid & 15) * 8); \
            if (tid < 256) { const size_t tx = (size_t)b * LTOK + seqpos(dir, (s0) + (tid >> 3)); rX = *(const u32x4*)(XC + tx * 3072 + hh * 64 + (tid & 7) * 8); } \
            if (tid < 32) { const size_t td = (size_t)b * LTOK + seqpos(dir, (s0) + tid); rdt = DTS[td * 64 + dir * 32 + hh]; } } while (0)
#define UNPK8(dst, VV) do { (dst)[0] = bflo((VV)[0]); (dst)[1] = bfhi((VV)[0]); (dst)[2] = bflo((VV)[1]); (dst)[3] = bfhi((VV)[1]); (dst)[4] = bflo((VV)[2]); (dst)[5] = bfhi((VV)[2]); (dst)[6] = bflo((VV)[3]); (dst)[7] = bfhi((VV)[3]); } while (0)
#define SSD_WRITE() do { UNPK8(Bs + (tid >> 4) * 128 + (tid & 15) * 8, rB); UNPK8(Cs + (tid >> 4) * 128 + (tid & 15) * 8, rC); \
            if (tid < 256) UNPK8(xs + (tid >> 3) * 64 + (tid & 7) * 8, rX); if (tid < 32) { dts[tid] = rdt; dAs[tid] = __expf(rdt * Ah); } } while (0)
        SSD_LOAD(0); SSD_WRITE(); __syncthreads();
        for (int s0 = 0; s0 < LTOK; s0 += 32) {
            if (s0 + 32 < LTOK) SSD_LOAD(s0 + 32);
#pragma unroll 4
            for (int t = 0; t < 32; ++t) { const float dA = dAs[t], xdt = xs[t * 64 + p] * dts[t]; float y = 0.f;
                const float* bp = Bs + t * 128 + nq * 16; const float* cp = Cs + t * 128 + nq * 16;
#pragma unroll
                for (int q4 = 0; q4 < 4; ++q4) { const f32x4 bv = *(const f32x4*)(bp + 4 * q4), cv = *(const f32x4*)(cp + 4 * q4);
#pragma unroll
                    for (int e = 0; e < 4; ++e) { st[4 * q4 + e] = st[4 * q4 + e] * dA + xdt * bv[e]; y += cv[e] * st[4 * q4 + e]; } }
                y += __shfl_xor(y, 1); y += __shfl_xor(y, 2); y += __shfl_xor(y, 4);
                if (nq == 0) yo[t * 64 + p] = y; }
            __syncthreads();
            { const int t = tid >> 4, c4 = (tid & 15) * 4; const size_t tk = (size_t)b * LTOK + seqpos(dir, s0 + t);
              const f32x4 v = *(const f32x4*)(yo + t * 64 + c4); u32x2 w; w.x = pk2(v[0], v[1]); w.y = pk2(v[2], v[3]); *(u32x2*)(Y + tk * 2048 + hh * 64 + c4) = w; }
            if (s0 + 32 < LTOK) SSD_WRITE();
            __syncthreads();
        }
#undef SSD_LOAD
#undef SSD_WRITE
    }
}
__device__ __forceinline__ void ph_ssd_gate(const Args& A, Frame& F) {
    const bf16_t* YF = (const bf16_t*)(A.ws + WS_YF2); const bf16_t* YB = (const bf16_t*)(A.ws + WS_YB2); const bf16_t* XC = (const bf16_t*)(A.ws + WS_XBCC); const bf16_t* Z = (const bf16_t*)(A.ws + WS_Z);
    bf16_t* G2 = (bf16_t*)(A.ws + WS_G2); const float* Dh = A.in[23];
    for (int tok = F.bid * NWAVES + F.wave; tok < NTOK; tok += F.G * NWAVES) { float v[32]; float ss = 0.f;
#pragma unroll
        for (int j = 0; j < 4; ++j) { const int d0 = 512 * j + 8 * F.lane; const float dh = Dh[d0 >> 6];
            const u32x4 a = *(const u32x4*)(YF + (size_t)tok * 2048 + d0), bq = *(const u32x4*)(YB + (size_t)tok * 2048 + d0), x = *(const u32x4*)(XC + (size_t)tok * 3072 + d0), z = *(const u32x4*)(Z + (size_t)tok * 2048 + d0);
#pragma unroll
            for (int e = 0; e < 4; ++e) { const float v0 = (bflo(a[e]) + bflo(bq[e]) + dh * bflo(x[e])) * siluf_(bflo(z[e])), v1 = (bfhi(a[e]) + bfhi(bq[e]) + dh * bfhi(x[e])) * siluf_(bfhi(z[e]));
                v[8 * j + 2 * e] = v0; v[8 * j + 2 * e + 1] = v1; ss += v0 * v0 + v1 * v1; } }
        const float rn = 1.0f / sqrtf(wave_sum(ss) * (1.f / 2048.f) + 1e-6f);
#pragma unroll
        for (int j = 0; j < 4; ++j) { u32x4 w; w.x = pk2(v[8 * j] * rn, v[8 * j + 1] * rn); w.y = pk2(v[8 * j + 2] * rn, v[8 * j + 3] * rn); w.z = pk2(v[8 * j + 4] * rn, v[8 * j + 5] * rn); w.w = pk2(v[8 * j + 6] * rn, v[8 * j + 7] * rn);
            *(u32x4*)(G2 + (size_t)tok * 2048 + 512 * j + 8 * F.lane) = w; } }
}

__device__ __forceinline__ void mla_kr(const Args& A, Frame& F) {
    const bf16_t* C = (const bf16_t*)(A.ws + WS_CQKV); bf16_t* Kb = (bf16_t*)(A.ws + WS_K); const float* ROPE = (const float*)(A.ws + WS_ROPE);
    const long gt = (long)F.bid * NTHR + F.tid, GT = (long)F.G * NTHR;
    for (long idx = gt; idx < (long)NTOK * 16; idx += GT) { const int tok = (int)(idx >> 4), i = (int)(idx & 15); const int b = tok / LTOK, p = tok - b * LTOK;
        const int o1 = (i < 8) ? i : 16 + (i - 8); float x1 = bf2f(C[(size_t)tok * 512 + 384 + o1]), x2 = bf2f(C[(size_t)tok * 512 + 384 + o1 + 8]);
        if (p >= CTXL) { const int t = p - CTXL; const int pos = (i < 8) ? (t >> 6) : (t & 63); const float c = ROPE[(pos * 8 + (i & 7)) * 2], s = ROPE[(pos * 8 + (i & 7)) * 2 + 1];
            const float y1 = x1 * c - x2 * s, y2 = x2 * c + x1 * s; x1 = y1; x2 = y2; }
        const unsigned w = pk2(x1, x2);
#pragma unroll 4
        for (int hd = 0; hd < 16; ++hd) *(unsigned*)(Kb + ((size_t)(b * 16 + hd) * LTOK + p) * 128 + 64 + 2 * i) = w; }
}
__device__ __forceinline__ void ph_attn(const Args& A, Frame& F) {
    const bf16_t* Q = (const bf16_t*)(A.ws + WS_Q); const bf16_t* Kb = (const bf16_t*)(A.ws + WS_K); const bf16_t* Vb = (const bf16_t*)(A.ws + WS_V); bf16_t* O = (bf16_t*)(A.ws + WS_O);
    constexpr int NLQ = SEQ / 256, NCQ = CTXL / 256, NLU = BATCH * 16 * NLQ, NU = NLU + BATCH * 16 * NCQ;
    for (int u = F.bid; u < NU; u += F.G) { int bh, p0, seq;
        if (u < NLU) { bh = u / NLQ; p0 = CTXL + (u % NLQ) * 256; seq = LTOK; } else { const int v = u - NLU; bh = v / NCQ; p0 = (v % NCQ) * 256; seq = CTXL; }
        const int b = bh >> 4, hd = bh & 15;
        att::attn_body(Q + ((size_t)bh * LTOK + p0) * 128, Kb + (size_t)bh * LTOK * 128, Vb + (size_t)bh * LTOK * 64, O + ((size_t)b * LTOK + p0) * DM + hd * 64, seq,
#ifdef CPU_EMU
                       F.lds,
#else
                       (char*)F.lds,
#endif
                       p0 >= CTXL ? p0 - CTXL : -1, (const float*)(A.ws + WS_ROPE)); }
}

__device__ __forceinline__ unsigned fmono(float f) { const unsigned u = __float_as_uint(f); return (u & 0x80000000u) ? ~u : (u | 0x80000000u); }
__device__ __forceinline__ float funmono(unsigned m) { const unsigned u = (m & 0x80000000u) ? (m & 0x7fffffffu) : ~m; return __uint_as_float(u); }
__device__ __forceinline__ void ph_peer(const Args& A, Frame& F, int layer) {
    const int lane = F.lane;
    float* wsc = (float*)(F.lds + F.wave * 2048);
    float* T1v = wsc; float* T2v = wsc + 16; int* T1i = (int*)(wsc + 32); int* T2i = (int*)(wsc + 48); int* EL = (int*)(wsc + 64); float* GL = wsc + 192;
    const float* SC = (const float*)(A.ws + WS_SC); const bf16_t* H2 = (const bf16_t*)(A.ws + WS_H2); float* X = (float*)(A.ws + WS_X); bf16_t* H = (bf16_t*)(A.ws + WS_H);
    const bf16_t* UT = (const bf16_t*)(A.ws + WS_UT) + (size_t)layer * 16384 * 1024; const bf16_t* VT = (const bf16_t*)(A.ws + WS_VT) + (size_t)layer * 16384 * 1024;
    for (int tok = F.bid * NWAVES + F.wave; tok < NTOK; tok += F.G * NWAVES) { const int b = tok / LTOK, p = tok - b * LTOK;
        if (layer == 3 && p < CTXL) continue;
        const float* sc = SC + (size_t)tok * 2048;
        for (int hd = 0; hd < 8; ++hd) {
            const float a0 = sc[hd * 256 + lane], a1 = sc[hd * 256 + 64 + lane], b0 = sc[hd * 256 + 128 + lane], b1 = sc[hd * 256 + 192 + lane];
            unsigned ka0 = (fmono(a0) & ~127u) | (unsigned)(127 - lane), ka1 = (fmono(a1) & ~127u) | (unsigned)(63 - lane);
            unsigned kb0 = (fmono(b0) & ~127u) | (unsigned)(127 - lane), kb1 = (fmono(b1) & ~127u) | (unsigned)(63 - lane);
            for (int it = 0; it < 16; ++it) {
                unsigned ma = ka0 > ka1 ? ka0 : ka1, mb = kb0 > kb1 ? kb0 : kb1;
#pragma unroll
                for (int o = 1; o < 64; o <<= 1) { const unsigned ta = __shfl_xor(ma, o), tb = __shfl_xor(mb, o); ma = ta > ma ? ta : ma; mb = tb > mb ? tb : mb; }
                if (ka0 == ma) ka0 = 0u; if (ka1 == ma) ka1 = 0u; if (kb0 == mb) kb0 = 0u; if (kb1 == mb) kb1 = 0u;
                if (lane == 0) { T1v[it] = funmono(ma & ~127u); T1i[it] = 127 - (int)(ma & 127u); T2v[it] = funmono(mb & ~127u); T2i[it] = 127 - (int)(mb & 127u); }
            }
            wave_sync();
            const int ca = lane >> 2, cb4 = (lane & 3) * 4; const float va = T1v[ca];
            unsigned kc[4];
#pragma unroll
            for (int k = 0; k < 4; ++k) kc[k] = (fmono(va + T2v[cb4 + k]) & ~255u) | (unsigned)(255 - (ca * 16 + cb4 + k));
            float bestv = 0.f; int beste = 0;
            for (int it = 0; it < 16; ++it) {
                unsigned m = kc[0] > kc[1] ? kc[0] : kc[1]; { const unsigned m2 = kc[2] > kc[3] ? kc[2] : kc[3]; m = m2 > m ? m2 : m; }
                m = wave_umax(m);
#pragma unroll
                for (int k = 0; k < 4; ++k) if (kc[k] == m) kc[k] = 0u;
                if (lane == it) { const int ci = 255 - (int)(m & 255u); bestv = funmono(m & ~255u); beste = T1i[ci >> 4] * 128 + T2i[ci & 15]; }
            }
            float mx = lane < 16 ? bestv : -1e30f;
#pragma unroll
            for (int o = 1; o < 16; o <<= 1) mx = fmaxf(mx, __shfl_xor(mx, o));
            float ex = lane < 16 ? __expf(bestv - mx) : 0.f; float sm = ex;
#pragma unroll
            for (int o = 1; o < 16; o <<= 1) sm += __shfl_xor(sm, o);
            if (lane < 16) { EL[hd * 16 + lane] = beste; GL[hd * 16 + lane] = ex / sm; }
            wave_sync();
        }
        const Row16 hv = ld_row_bf16(H2 + (size_t)tok * DM, lane);
        Row16 out;
#pragma unroll
        for (int e = 0; e < 16; ++e) out.v[e] = 0.f;
        for (int e0 = 0; e0 < 128; e0 += 4) {
            u32x4 ua[4], ub[4], va_[4], vb_[4]; float gt[4];
#pragma unroll
            for (int k = 0; k < 4; ++k) { const int ex = EL[e0 + k]; gt[k] = GL[e0 + k]; const bf16_t* up = UT + (size_t)ex * 1024; const bf16_t* vp = VT + (size_t)ex * 1024;
                ua[k] = *(const u32x4*)(up + 8 * lane); ub[k] = *(const u32x4*)(up + 512 + 8 * lane); va_[k] = *(const u32x4*)(vp + 8 * lane); vb_[k] = *(const u32x4*)(vp + 512 + 8 * lane); }
            float dp[4];
#pragma unroll
            for (int k = 0; k < 4; ++k) { float s = 0.f;
#pragma unroll
                for (int e = 0; e < 4; ++e) { s += hv.v[2 * e] * bflo(ua[k][e]) + hv.v[2 * e + 1] * bfhi(ua[k][e]); s += hv.v[8 + 2 * e] * bflo(ub[k][e]) + hv.v[8 + 2 * e + 1] * bfhi(ub[k][e]); }
                dp[k] = s; }
#pragma unroll
            for (int k = 0; k < 4; ++k) dp[k] = wave_sum(dp[k]);
#pragma unroll
            for (int k = 0; k < 4; ++k) { const float w = gt[k] * gelu_tanh(dp[k]);
#pragma unroll
                for (int e = 0; e < 4; ++e) { out.v[2 * e] += w * bflo(va_[k][e]); out.v[2 * e + 1] += w * bfhi(va_[k][e]); out.v[8 + 2 * e] += w * bflo(vb_[k][e]); out.v[8 + 2 * e + 1] += w * bfhi(vb_[k][e]); } }
        }
        const float* mod = mod_row(A, layer, tok);
        const Row16 x1 = ld_row_f32(X + (size_t)tok * DM, lane), g2 = ld_row_f32(mod + 5120, lane); Row16 v;
#pragma unroll
        for (int e = 0; e < 16; ++e) v.v[e] = DN_ALPHA * x1.v[e] + g2.v[e] * out.v[e];
        const Row16 x2 = layer_norm_row(v, A.in[6] + (size_t)(layer * 2 + 1) * DM, A.in[7] + (size_t)(layer * 2 + 1) * DM, lane);
        if (layer < 3) { st_row_f32(X + (size_t)tok * DM, lane, x2);
            const float* modn = mod_row(A, layer + 1, tok); const Row16 sh = ld_row_f32(modn, lane), scl = ld_row_f32(modn + 1024, lane); Row16 hn;
#pragma unroll
            for (int e = 0; e < 16; ++e) hn.v[e] = x2.v[e] * (1.f + scl.v[e]) + sh.v[e];
            st_row_bf16(H + (size_t)tok * DM, lane, hn);
        } else { st_row_f32(A.out + ((size_t)b * SEQ + (p - CTXL)) * DM, lane, x2); }
        wave_sync();
    }
}

constexpr int NPHASE = 29;
__device__ __forceinline__ void gemm_f32(const Args& A, Frame& F, const bf16_t* Am, int lda, const bf16_t* Bt, int ldb, int N, int K, float* O, int ldc) {
    pg8::Gemm g{Am, Bt, NTOK, N, K, lda, ldb}; pg8::StaticOrder S; S.init(NTOK, N, F.G, F.bid); EpiF32 E{O, ldc};
    pg8::gemm_phase<EpiF32, pg8::StaticOrder, PG8_ALIGN, PG8_SP2>(GEMM_LDS(F), g, S, E);
}
__device__ __forceinline__ void run_phase(const Args& A, Frame& F, int ph) {
    unsigned char* ws = A.ws;
    switch (ph) {
    case 0: ph_prep(A, F); break;
    case 1: ph_init(A, F); break;
    case 2: case 23: ph_s5_scan(A, F, ph == 2 ? 0 : 1); break;
    case 3: case 24: ph_s5_combine(A, F, ph == 3 ? 0 : 1); break;
    case 4: case 25: { const int j = ph == 4 ? 0 : 1;
        pg8::Gemm g{(const bf16_t*)(ws + WS_G), (const bf16_t*)(ws + WS_WGLU) + (size_t)j * 2048 * 1024, NTOK, 2048, 1024, 1024, 1024}; pg8::StaticOrder S; S.init(NTOK, 2048, F.G, F.bid); EpiGlu E{(float*)(ws + WS_OUT)};
        pg8::gemm_phase<EpiGlu, pg8::StaticOrder, PG8_ALIGN, PG8_SP2>(GEMM_LDS(F), g, S, E); } break;
    case 5: ph_rowop(A, F, 0); break;
    case 13: ph_rowop(A, F, 1); break;
    case 20: ph_rowop(A, F, 2); break;
    case 26: ph_rowop(A, F, 3); break;
    case 6: case 14: case 21: case 27: { const int layer = ph == 6 ? 0 : ph == 14 ? 1 : ph == 21 ? 2 : 3;
        gemm_f32(A, F, (const bf16_t*)(ws + WS_H2), 1024, (const bf16_t*)(ws + WS_WSC) + (size_t)layer * 2048 * 1024, 1024, 2048, 1024, (float*)(ws + WS_SC), 2048); } break;
    case 7: ph_peer(A, F, 0); break;
    case 15: ph_peer(A, F, 1); break;
    case 22: ph_peer(A, F, 2); break;
    case 28: ph_peer(A, F, 3); break;
    case 8: { pg8::Gemm g{(const bf16_t*)(ws + WS_H), (const bf16_t*)(ws + WS_WIN), NTOK, SSD_IN_PAD, 1024, 1024, 1024}; pg8::StaticOrder S; S.init(NTOK, SSD_IN_PAD, F.G, F.bid);
        EpiSsdIn E{(bf16_t*)(ws + WS_Z), (bf16_t*)(ws + WS_XBC), (float*)(ws + WS_DT)};
        pg8::gemm_phase<EpiSsdIn, pg8::StaticOrder, PG8_ALIGN, PG8_SP2>(GEMM_LDS(F), g, S, E); } break;
    case 9: ph_ssd_conv(A, F); break;
    case 10: ph_ssd_scan(A, F); break;
    case 11: ph_ssd_gate(A, F); break;
    case 12: gemm_f32(A, F, (const bf16_t*)(ws + WS_G2), 2048, (const bf16_t*)(ws + WS_WOUT), 2048, 1024, 2048, (float*)(ws + WS_OUT), 1024); break;
    case 16: { pg8::Gemm g{(const bf16_t*)(ws + WS_H), (const bf16_t*)(ws + WS_WDOWN), NTOK, 512, 1024, 1024, 1024}; pg8::StaticOrder S; S.init(NTOK, 512, F.G, F.bid);
        EpiMlaDown E{(bf16_t*)(ws + WS_CQKV), (float*)(ws + WS_RS)};
        pg8::gemm_phase<EpiMlaDown, pg8::StaticOrder, PG8_ALIGN, PG8_SP2>(GEMM_LDS(F), g, S, E); } break;
    case 17: { mla_kr(A, F); __syncthreads();
        pg8::Gemm g{(const bf16_t*)(ws + WS_CQKV), (const bf16_t*)(ws + WS_WUP), NTOK, 4096, 384, 512, 384}; pg8::StaticOrder S; S.init(NTOK, 4096, F.G, F.bid);
        EpiMlaUp E{(bf16_t*)(ws + WS_Q), (bf16_t*)(ws + WS_K), (bf16_t*)(ws + WS_V), (const float*)(ws + WS_RS)};
        pg8::gemm_phase<EpiMlaUp, pg8::StaticOrder, PG8_ALIGN, PG8_SP2>(GEMM_LDS(F), g, S, E); } break;
    case 18: ph_attn(A, F); break;
    case 19: gemm_f32(A, F, (const bf16_t*)(ws + WS_O), 1024, (const bf16_t*)(ws + WS_WO), 1024, 1024, 1024, (float*)(ws + WS_OUT), 1024); break;
    default: break;
    }
}

#ifndef CPU_EMU
#define LAS __attribute__((address_space(3)))
#define XB_TMO      128
#define XB_XCNT(j)  (256  + 64 * (j))
#define XB_XSUB(j)  (1280 + 64 * (j))
#define XB_XGEN(j)  (2304 + 64 * (j))
#define XB_TOP      3328
#define XB_TOPGEN   3392
#define XCD_BAR_WORDS 3456
#define XB_SPIN_CAP (1u << 22)
__device__ __forceinline__ unsigned xb_ld(unsigned* p)              { return __hip_atomic_load(p, __ATOMIC_RELAXED, __HIP_MEMORY_SCOPE_AGENT); }
__device__ __forceinline__ unsigned xb_add(unsigned* p, unsigned v) { return __hip_atomic_fetch_add(p, v, __ATOMIC_RELAXED, __HIP_MEMORY_SCOPE_AGENT); }
__device__ __forceinline__ unsigned xb_xcc_id() { return (unsigned)__builtin_amdgcn_s_getreg((3 << 11) | 20) & 0xFu; }
#define XB_SPIN(cond, bar) do { unsigned _sp = 0; while (cond) { __builtin_amdgcn_s_sleep(1); \
    if ((++_sp & 255u) == 0u) { if (xb_ld(&(bar)[XB_TMO])) break; if (_sp > XB_SPIN_CAP) { atomicAdd(&(bar)[XB_TMO], 1u); break; } } } } while (0)
struct XcdBarrier { unsigned* bar; unsigned x; volatile LAS unsigned* st; };
__device__ __forceinline__ XcdBarrier xcd_barrier_post(unsigned* bar, volatile LAS unsigned* st) {
    XcdBarrier b; b.bar = bar; b.x = xb_xcc_id(); b.st = st;
    if (threadIdx.x == 0) (void)xb_add(&bar[XB_XCNT(b.x)], 1u);
    return b;
}
__device__ __forceinline__ void xcd_barrier_complete(unsigned* bar, unsigned x, unsigned& nloc, unsigned& nx) {
    const unsigned G = gridDim.x * gridDim.y * gridDim.z;
    unsigned sum, cnt, mine, sp = 0u;
    for (;;) {
        sum = 0u; cnt = 0u; mine = 0u;
#pragma unroll
        for (unsigned j = 0; j < 16; ++j) { const unsigned c = xb_ld(&bar[XB_XCNT(j)]); sum += c; cnt += (c > 0u) ? 1u : 0u; mine = (j == x) ? c : mine; }
        if (sum == G) break;
        __builtin_amdgcn_s_sleep(1);
        if ((++sp & 255u) == 0u) { if (xb_ld(&bar[XB_TMO])) break; if (sp > XB_SPIN_CAP) { atomicAdd(&bar[XB_TMO], 1u); break; } }
    }
    nloc = mine > 0u ? mine : 1u; nx = cnt > 0u ? cnt : 1u;
}
__device__ __forceinline__ void xcd_barrier(const XcdBarrier& b) {
    asm volatile("s_waitcnt vmcnt(0)" ::: "memory");
    __syncthreads();
    if (threadIdx.x == 0) {
        unsigned* bar = b.bar;
        __builtin_amdgcn_s_waitcnt(0);
        unsigned nloc = b.st[0], nx = b.st[1];
        if (nloc == 0u) { xcd_barrier_complete(bar, b.x, nloc, nx); b.st[0] = nloc; b.st[1] = nx; }
        const unsigned old = xb_add(&bar[XB_XSUB(b.x)], 1u);
        const unsigned gen = old / nloc;
        if (old + 1u == (gen + 1u) * nloc) {
            __builtin_amdgcn_fence(__ATOMIC_RELEASE, "agent");
            asm volatile("s_waitcnt vmcnt(0)" ::: "memory");
            const unsigned og = xb_add(&bar[XB_TOP], 1u);
            const unsigned tg = og / nx;
            if (og + 1u == (tg + 1u) * nx) xb_add(&bar[XB_TOPGEN], 1u);
            else XB_SPIN(xb_ld(&bar[XB_TOPGEN]) == tg, bar);
            __builtin_amdgcn_fence(__ATOMIC_ACQUIRE, "agent");
            xb_add(&bar[XB_XGEN(b.x)], 1u);
            asm volatile("s_waitcnt vmcnt(0)" ::: "memory");
        } else {
            XB_SPIN(xb_ld(&bar[XB_XGEN(b.x)]) == gen, bar);
            __builtin_amdgcn_fence(__ATOMIC_ACQUIRE, "agent");
            asm volatile("s_waitcnt vmcnt(0)" ::: "memory");
        }
    }
    __syncthreads();
}

constexpr int LDS_BYTES = 147456;
constexpr int LDSCTL_OFF = 131072;
__device__ __forceinline__ Frame mk_frame(unsigned char* lds) {
    int t = threadIdx.x; asm volatile("" : "+v"(t));
    Frame F; F.lds = lds; F.tid = t; F.lane = t & 63; F.wave = __builtin_amdgcn_readfirstlane(t >> 6); F.G = gridDim.x; F.bid = blockIdx.x; return F;
}
__device__ __forceinline__ void grid_bar(unsigned char* ws, unsigned char* lds) {
    XcdBarrier bar; bar.bar = (unsigned*)(ws + WS_CTL) + 1024; bar.x = xb_xcc_id(); bar.st = (volatile LAS unsigned*)((LAS unsigned char*)lds + LDSCTL_OFF) + 8;
    xcd_barrier(bar);
}
__global__ void __launch_bounds__(NTHR, 2) hybrid_fwd(Args args) {
    extern __shared__ __attribute__((aligned(16))) unsigned char lds[];
    { volatile LAS unsigned* MISC = (volatile LAS unsigned*)((LAS unsigned char*)lds + LDSCTL_OFF);
      if (threadIdx.x < 64) MISC[threadIdx.x] = 0u;
      __syncthreads();
      if (args.ph_hi - args.ph_lo > 1) (void)xcd_barrier_post((unsigned*)(args.ws + WS_CTL) + 1024, MISC + 8); }
    const int lo = args.ph_lo, hi = args.ph_hi;
#define PHASE(k) if (lo <= (k) && (k) < hi) { { Frame F = mk_frame(lds); run_phase(args, F, (k)); } if ((k) + 1 < hi) { if ((k) == 0) cg::this_grid().sync(); grid_bar(args.ws, lds); } }
    PHASE(0) PHASE(1) PHASE(2) PHASE(3) PHASE(4) PHASE(5) PHASE(6) PHASE(7) PHASE(8) PHASE(9)
    PHASE(10) PHASE(11) PHASE(12) PHASE(13) PHASE(14) PHASE(15) PHASE(16) PHASE(17) PHASE(18) PHASE(19)
    PHASE(20) PHASE(21) PHASE(22) PHASE(23) PHASE(24) PHASE(25) PHASE(26) PHASE(27) PHASE(28)
#undef PHASE
}

extern "C" void kernel_launch(void* const* d_in, const int* in_sizes, int n_in, void* d_out, int out_size, void* d_ws, size_t ws_size, hipStream_t stream) {
    static int grid = 0;
    if (grid == 0) {
        if (n_in != 37 || ws_size < WS_END) { fprintf(stderr, "kernel_launch: unexpected n_in %d / ws %zu\n", n_in, ws_size); grid = -1; return; }
        int dev = 0, cus = 0, per_cu = 0;
        hipGetDevice(&dev); hipDeviceGetAttribute(&cus, hipDeviceAttributeMultiprocessorCount, dev);
        hipFuncSetAttribute((const void*)hybrid_fwd, hipFuncAttributeMaxDynamicSharedMemorySize, LDS_BYTES);
        hipOccupancyMaxActiveBlocksPerMultiprocessor(&per_cu, (const void*)hybrid_fwd, NTHR, LDS_BYTES);
        (void)hipGetLastError();
        if (per_cu < 1) { fprintf(stderr, "kernel_launch: occupancy query says %d blocks/CU\n", per_cu); per_cu = 1; }
        grid = cus;
    }
    if (grid < 0) return;
    hipMemsetAsync((char*)d_ws + WS_CTL, 0, CTL_ZERO_BYTES, stream);
    Args a{};
    for (int i = 0; i < 37; ++i) a.in[i] = (const float*)d_in[i];
    a.out = (float*)d_out; a.ws = (unsigned char*)d_ws; a.ph_lo = 0; a.ph_hi = NPHASE;
    void* kargs[] = {&a};
    hipError_t e = hipLaunchCooperativeKernel((const void*)hybrid_fwd, dim3(grid), dim3(NTHR), kargs, LDS_BYTES, stream);
    if (e != hipSuccess) fprintf(stderr, "cooperative launch failed: %s (grid %d)\n", hipGetErrorString(e), grid);
}
#endif
```

```cpp
#ifndef CPU_EMU
#include <hip/hip_runtime.h>
#include <hip/hip_cooperative_groups.h>
#include <cstdio>
#include <cstdint>
#include <cmath>
namespace cg = cooperative_groups;
#endif

#ifndef BATCH
#define BATCH 4
#endif
#ifndef SEQ
#define SEQ 4096
#endif
#ifndef CTXL
#define CTXL 256
#endif
constexpr int DM = 1024, LTOK = CTXL + SEQ, NTOK = BATCH * LTOK, NR = BATCH + 1;
constexpr int NTHR = 512, NWAVES = 8;
static_assert(NTOK % 256 == 0 && SEQ % 256 == 0 && CTXL % 256 == 0 && LTOK % 32 == 0, "shape");
constexpr float DN_ALPHA = 1.6817928305074290f;
constexpr int SSD_IN = 5184, SSD_IN_PAD = 5376;

typedef unsigned short bf16_t;
typedef short bf16x8 __attribute__((ext_vector_type(8)));
typedef float f32x2 __attribute__((ext_vector_type(2)));
typedef float f32x4 __attribute__((ext_vector_type(4)));
typedef float f32x16 __attribute__((ext_vector_type(16)));
typedef unsigned u32x2 __attribute__((ext_vector_type(2)));
typedef unsigned u32x4 __attribute__((ext_vector_type(4)));

constexpr size_t MiB = 1u << 20;
constexpr size_t WS_CTL = 0, CTL_ZERO_BYTES = 64 * 1024;
constexpr size_t WS_MOD = 1 * MiB;
constexpr size_t WS_ROPE = WS_MOD + 768 * 1024;
constexpr size_t WS_S5C = 2 * MiB;
constexpr size_t S5C_ITEM = 12800;
constexpr size_t WS_WGLU = 6 * MiB;
constexpr size_t WS_WIN = 14 * MiB;
constexpr size_t WS_WOUT = 25 * MiB;
constexpr size_t WS_WDOWN = 29 * MiB;
constexpr size_t WS_WUP = 30 * MiB;
constexpr size_t WS_WO = 33 * MiB;
constexpr size_t WS_WSC = 35 * MiB;
constexpr size_t WS_UT = 52 * MiB;
constexpr size_t WS_VT = 116 * MiB;
constexpr size_t WS_US = 180 * MiB;
constexpr size_t WS_VS = 181 * MiB;
constexpr size_t WS_X = 308 * MiB;
constexpr size_t WS_H = 376 * MiB;
constexpr size_t WS_H2 = 410 * MiB;
constexpr size_t WS_OUT = 444 * MiB;
constexpr size_t WS_R = 512 * MiB;
constexpr size_t WS_SC = WS_R;
constexpr size_t WS_YF = WS_R, WS_YB = WS_R + 34 * MiB, WS_G = WS_R + 68 * MiB;
constexpr size_t WS_Z = WS_R, WS_XBC = WS_R + 68 * MiB, WS_XBCC = WS_R + 170 * MiB, WS_DT = WS_R + 272 * MiB, WS_DTS = WS_R + 277 * MiB, WS_ACUM = WS_R + 420 * MiB,
                 WS_YF2 = WS_R + 282 * MiB, WS_YB2 = WS_R + 350 * MiB, WS_G2 = WS_XBC;
constexpr size_t WS_CQKV = WS_R, WS_RS = WS_R + 17 * MiB, WS_Q = WS_R + 18 * MiB, WS_K = WS_R + 86 * MiB, WS_V = WS_R + 154 * MiB, WS_O = WS_R + 188 * MiB;
constexpr size_t WS_PL = WS_R + 68 * MiB;
constexpr size_t WS_PH = WS_R + 102 * MiB;
constexpr size_t WS_PS = WS_R + 136 * MiB;
constexpr size_t WS_PD = WS_R + 137 * MiB;
constexpr size_t WS_PW = WS_R + 205 * MiB;
constexpr size_t WS_PWS = WS_R + 214 * MiB;
constexpr size_t WS_PO = WS_R + 215 * MiB;
constexpr size_t WS_END = 1024 * MiB;
constexpr size_t WS_TS = 64 * 1024;
#ifndef PROBE
#define PROBE 0
#endif
#ifndef USE_CG
#define USE_CG 1
#endif
#ifndef DUPMASK
#define DUPMASK 0ull
#endif

__device__ __forceinline__ unsigned f2bf(float f) { unsigned u = __float_as_uint(f); return (u + 0x7fffu + ((u >> 16) & 1u)) >> 16; }
#ifdef CPU_EMU
__device__ __forceinline__ unsigned pk2(float lo, float hi) { return f2bf(lo) | (f2bf(hi) << 16); }
#else
typedef __bf16 bf16x2_hw __attribute__((ext_vector_type(2)));
__device__ __forceinline__ unsigned pk2(float lo, float hi) { const f32x2 v = {lo, hi}; const bf16x2_hw b = __builtin_convertvector(v, bf16x2_hw); return __builtin_bit_cast(unsigned, b); }
#endif
__device__ __forceinline__ float bflo(unsigned w) { return __uint_as_float(w << 16); }
__device__ __forceinline__ float bfhi(unsigned w) { return __uint_as_float(w & 0xffff0000u); }
__device__ __forceinline__ float bf2f(bf16_t s) { return __uint_as_float(((unsigned)s) << 16); }
__device__ __forceinline__ float gelu_tanh(float x) { const float u = 0.7978845608028654f * (x + 0.044715f * x * x * x); const float e = __expf(2.f * u); const float t = 1.f - 2.f / (e + 1.f); return 0.5f * x * (1.f + t); }
__device__ __forceinline__ float sigmoidf_(float x) { return 1.f / (1.f + __expf(-x)); }
__device__ __forceinline__ float siluf_(float x) { return x / (1.f + __expf(-x)); }
#ifdef CPU_EMU
__device__ __forceinline__ float wave_sum(float v) {
#pragma unroll
    for (int o = 1; o < 64; o <<= 1) v += __shfl_xor(v, o);
    return v;
}
__device__ __forceinline__ float wave_max(float v) {
#pragma unroll
    for (int o = 1; o < 64; o <<= 1) v = fmaxf(v, __shfl_xor(v, o));
    return v;
}
#else
template <int CTRL> __device__ __forceinline__ float dpp_f(float v) { return __builtin_bit_cast(float, __builtin_amdgcn_update_dpp(0, __builtin_bit_cast(int, v), CTRL, 0xF, 0xF, true)); }
__device__ __forceinline__ float wave_sum(float v) {
    v += dpp_f<0xB1>(v); v += dpp_f<0x4E>(v); v += dpp_f<0x141>(v); v += dpp_f<0x140>(v);
    { auto rr = __builtin_amdgcn_permlane16_swap(__float_as_uint(v), __float_as_uint(v), false, false); v = __uint_as_float(rr[0]) + __uint_as_float(rr[1]); }
    { auto rr = __builtin_amdgcn_permlane32_swap(__float_as_uint(v), __float_as_uint(v), false, false); v = __uint_as_float(rr[0]) + __uint_as_float(rr[1]); }
    return v;
}
__device__ __forceinline__ float wave_max(float v) {
    v = fmaxf(v, dpp_f<0xB1>(v)); v = fmaxf(v, dpp_f<0x4E>(v)); v = fmaxf(v, dpp_f<0x141>(v)); v = fmaxf(v, dpp_f<0x140>(v));
    { auto rr = __builtin_amdgcn_permlane16_swap(__float_as_uint(v), __float_as_uint(v), false, false); v = fmaxf(__uint_as_float(rr[0]), __uint_as_float(rr[1])); }
    { auto rr = __builtin_amdgcn_permlane32_swap(__float_as_uint(v), __float_as_uint(v), false, false); v = fmaxf(__uint_as_float(rr[0]), __uint_as_float(rr[1])); }
    return v;
}
#endif
__device__ __forceinline__ unsigned wave_umax(unsigned v) {
#pragma unroll
    for (int o = 1; o < 64; o <<= 1) { const unsigned t = __shfl_xor(v, o); v = t > v ? t : v; }
    return v;
}
#ifdef CPU_EMU
__device__ __forceinline__ void wave_sync() { emu::wave_barrier(); }
__device__ __forceinline__ f32x16 mfma32(bf16x8 a, bf16x8 b, f32x16 c) { return emu_mfma_32x32x16_bf16(a, b, c); }
__device__ __forceinline__ int rfl(int x) { return x; }
#else
__device__ __forceinline__ void wave_sync() { asm volatile("s_waitcnt lgkmcnt(0)" ::: "memory"); }
__device__ __forceinline__ f32x16 mfma32(bf16x8 a, bf16x8 b, f32x16 c) { return __builtin_amdgcn_mfma_f32_32x32x16_bf16(a, b, c, 0, 0, 0); }
__device__ __forceinline__ int rfl(int x) { return __builtin_amdgcn_readfirstlane(x); }
#endif
typedef short s16x4 __attribute__((ext_vector_type(4)));
typedef int i32x4 __attribute__((ext_vector_type(4)));
typedef int i32x2 __attribute__((ext_vector_type(2)));
typedef _Float16 h16x2 __attribute__((ext_vector_type(2)));
__device__ __forceinline__ h16x2 pk_h2(float a, float b) { h16x2 r; r[0] = (_Float16)a; r[1] = (_Float16)b; return r; }
#ifdef CPU_EMU
#define SCHED_FENCE() do {} while (0)
#else
#define SCHED_FENCE() __builtin_amdgcn_sched_barrier(0)
#endif
#ifdef CPU_EMU
__device__ __forceinline__ i32x4 mfma_i8(i32x4 a, i32x4 b, i32x4 c) { return emu_mfma_i32_16x16x64_i8(a, b, c); }
#else
__device__ __forceinline__ i32x4 mfma_i8(i32x4 a, i32x4 b, i32x4 c) { return __builtin_amdgcn_mfma_i32_16x16x64_i8(a, b, c, 0, 0, 0); }
#endif
#ifdef CPU_EMU
__device__ __forceinline__ s16x4 lds_tr(const unsigned char* p) { return emu_ds_read_tr16_b64(p); }
#else
__device__ __forceinline__ s16x4 lds_tr(const unsigned char* p) { return __builtin_bit_cast(s16x4, __builtin_amdgcn_ds_read_tr16_b64_v4i16((__attribute__((address_space(3))) s16x4*)p)); }
#endif
#ifdef CPU_EMU
__device__ __forceinline__ int hw_lane() { return (int)(threadIdx.x & 63); }
#else
__device__ __forceinline__ int hw_lane() { return (int)__builtin_amdgcn_mbcnt_hi(~0u, __builtin_amdgcn_mbcnt_lo(~0u, 0u)); }
#endif
__device__ __forceinline__ int crow(int r, int hi) { return (r & 3) + 8 * (r >> 2) + 4 * hi; }
__device__ __forceinline__ int seqpos(int dir, int s) { return dir == 0 ? s : (s < CTXL ? CTXL - 1 - s : LTOK + CTXL - 1 - s); }

struct Args { const float* in[37]; float* out; unsigned char* ws; int ph_lo, ph_hi; };
struct Frame { unsigned char* lds; int tid, lane, wave, G, bid; };

namespace pg8 {
constexpr int BM = 256, BK = 64, HALF = 128, HTB = HALF * BK * 2, STAGE_BYTES = 8 * HTB, NXCD = 8, WGM = 8;
__host__ __device__ __forceinline__ int lds_byte(int r, int c) { const int st = (r >> 4) * 2 + (c >> 5), rr = r & 15, cc = c & 31, ob = rr * 64 + cc * 2; return st * 1024 + (ob ^ (((ob >> 9) & 1) << 5)); }
__host__ __device__ __forceinline__ void stage_rc(int b, int& R, int& C) { const int st = b / 1024, sb = b % 1024, swz = sb ^ (((sb >> 9) & 1) << 5); R = (st >> 1) * 16 + swz / 64; C = (st & 1) * 32 + (swz % 64) / 2; }
__host__ __device__ __forceinline__ int perm32(int rho) { const int n = rho >> 4, i = rho & 15; return 8 * (i >> 2) + 4 * n + (i & 3); }
struct Unit { int pm, pn; };
struct Gemm { const bf16_t* A; const bf16_t* Bt; int M, N, K, lda, ldb; };
struct StaticOrder {
    int nM, nN, nwg, G, c; bool lat;
    __host__ __device__ void init(int M, int N, int G_, int c_, bool lat_ = false) { lat = lat_; nM = lat ? BATCH * (SEQ / 256) : M / BM; nN = N / BM; nwg = nM * nN; G = G_; c = c_; }
    __host__ __device__ bool next(int i, Unit& u) const {
        const long L = (long)i * G + c; if (L >= nwg) return false;
        int wgid = (int)L; { const int q = nwg / NXCD, r = nwg % NXCD, xcd = wgid % NXCD, off = wgid / NXCD; wgid = (xcd < r ? xcd * (q + 1) : r * (q + 1) + (xcd - r) * q) + off; }
        const int nig = WGM * nN, gid = wgid / nig, fm = gid * WGM, gsz = (nM - fm) < WGM ? (nM - fm) : WGM;
        u.pm = fm + ((wgid % nig) % gsz); u.pn = (wgid % nig) / gsz;
        if (lat) u.pm = (u.pm / (SEQ / 256)) * (LTOK / 256) + CTXL / 256 + u.pm % (SEQ / 256);
        return true;
    }
};
#ifdef CPU_EMU
template <class Epi, class Sched, bool ALIGN_EPI = false, bool SP2 = false>
__device__ __forceinline__ void gemm_phase(unsigned char* lds, const Gemm g, const Sched& S, const Epi& E, int wave_s) {
    const int tid = threadIdx.x, wid = tid >> 6, lane = tid & 63, wr = wid >> 2, wc = wid & 3, fr = lane & 15, fq = lane >> 4;
    Unit u;
    for (int ui = 0; S.next(ui, u); ++ui) {
        f32x4 acc[2][2][4][2];
        for (int ai = 0; ai < 2; ++ai) for (int bj = 0; bj < 2; ++bj) for (int m = 0; m < 4; ++m) for (int n = 0; n < 2; ++n) for (int e = 0; e < 4; ++e) {
            const int row = u.pm * 256 + 128 * ai + 64 * wr + 16 * m + fr;
            const int col = u.pn * 256 + 128 * bj + 32 * wc + (Epi::PERM ? 8 * fq + 4 * n + e : 16 * n + 4 * fq + e);
            const bf16_t* a = g.A + (size_t)row * g.lda; const bf16_t* b = g.Bt + (size_t)col * g.ldb; float s = 0.f;
            for (int k = 0; k < g.K; ++k) s += bf2f(a[k]) * bf2f(b[k]);
            acc[ai][bj][m][n][e] = s;
        }
        E(acc, u, wr, wc, fr, fq);
    }
    __syncthreads();
}
#else
#define PG8_LAS __attribute__((address_space(3)))
template <class Epi, class Sched, bool ALIGN_EPI = false, bool SP2 = false>
__device__ __forceinline__ void gemm_phase(PG8_LAS unsigned char* lds, const Gemm g, const Sched& S, const Epi& E, int wave_s) {
    int lane_ = hw_lane(); asm volatile("" : "+v"(lane_));
    const int wid = wave_s, lane = lane_, tid = wid * 64 + lane, wr = wid >> 2, wc = wid & 3, fr = lane & 15, fq = lane >> 4;
    const int K = g.K, nt = K / BK;
    unsigned voffA[2], voffB[2];
#pragma unroll
    for (int i = 0; i < 2; ++i) { int R, C; stage_rc(tid * 16 + i * 8192, R, C); const int Rb = Epi::PERM ? ((R & ~31) + perm32(R & 31)) : R;
        voffA[i] = (unsigned)(R * g.lda + C) * 2u; voffB[i] = (unsigned)(Rb * g.ldb + C) * 2u; }
    const size_t kstep = (size_t)(BK * 2);
    const size_t hstepA = (size_t)HALF * g.lda * 2, hstepB = (size_t)HALF * g.ldb * 2;
    const size_t tstepA = 2 * hstepA, tstepB = 2 * hstepB;
    const unsigned ldsw = (unsigned)wid * 1024u;
    const int aoff = lds_byte(wr * 64 + fr, fq * 8), boff = lds_byte(wc * 32 + fr, fq * 8);
#define PG8_SA(b, h) (((b) * 2 + (h)) * HTB)
#define PG8_SB(b, h) ((4 + (b) * 2 + (h)) * HTB)
#define PG8_STAGE(bufoff, gbase, voff) do { _Pragma("unroll") for (int _i = 0; _i < 2; ++_i) \
        __builtin_amdgcn_global_load_lds((const unsigned*)((const char*)(gbase) + (voff)[_i]), (PG8_LAS unsigned*)(lds + (bufoff) + ldsw + _i * 8192), 16, 0, 0); } while (0)
#define PG8_LDA(dst, b, h) do { _Pragma("unroll") for (int m = 0; m < 4; ++m) _Pragma("unroll") for (int k = 0; k < 2; ++k) dst[m][k] = *(const PG8_LAS bf16x8*)(lds + PG8_SA(b, h) + aoff + m * 2048 + k * 1024); } while (0)
#define PG8_LDB(dst, b, h) do { _Pragma("unroll") for (int n = 0; n < 2; ++n) _Pragma("unroll") for (int k = 0; k < 2; ++k) dst[n][k] = *(const PG8_LAS bf16x8*)(lds + PG8_SB(b, h) + boff + n * 2048 + k * 1024); } while (0)
#define PG8_MMA(ai, bj, At, Bt) do { __builtin_amdgcn_s_setprio(1); _Pragma("unroll") for (int m = 0; m < 4; ++m) _Pragma("unroll") for (int n = 0; n < 2; ++n) _Pragma("unroll") for (int k = 0; k < 2; ++k) \
        acc[ai][bj][m][n] = __builtin_amdgcn_mfma_f32_16x16x32_bf16(Bt[n][k], At[m][k], acc[ai][bj][m][n], 0, 0, 0); __builtin_amdgcn_s_setprio(0); } while (0)
#define PG8_WAIT_V(n) asm volatile("s_waitcnt vmcnt(" #n ")" ::: "memory")
#define PG8_WAIT_L(n) asm volatile("s_waitcnt lgkmcnt(" #n ")" ::: "memory")
#define PG8_BAR __builtin_amdgcn_s_barrier()
#define PG8_SCHED __builtin_amdgcn_sched_barrier(0)
    Unit cur, nxt; int ui = 0;
    if (!S.next(0, cur)) return;
    f32x4 acc[2][2][4][2];
#pragma unroll
    for (int a = 0; a < 2; ++a)
#pragma unroll
        for (int b = 0; b < 2; ++b)
#pragma unroll
            for (int m = 0; m < 4; ++m)
#pragma unroll
                for (int n = 0; n < 2; ++n) acc[a][b][m][n] = (f32x4){0.f, 0.f, 0.f, 0.f};
    bf16x8 At[4][2], B0[2][2], B1[2][2];
    const char* cA = (const char*)g.A + (size_t)cur.pm * tstepA; const char* cB = (const char*)g.Bt + (size_t)cur.pn * tstepB;
    if constexpr (SP2) {
        PG8_STAGE(PG8_SB(0, 0), cB, voffB); PG8_STAGE(PG8_SB(0, 1), cB + hstepB, voffB); PG8_STAGE(PG8_SA(0, 0), cA, voffA); PG8_STAGE(PG8_SA(0, 1), cA + hstepA, voffA);
        if (wr == 1) PG8_BAR;
        PG8_WAIT_V(2); PG8_BAR;
        PG8_STAGE(PG8_SB(1, 0), cB + kstep, voffB); PG8_STAGE(PG8_SA(1, 0), cA + kstep, voffA); PG8_STAGE(PG8_SB(1, 1), cB + hstepB + kstep, voffB);
        PG8_WAIT_V(6); PG8_BAR;
    } else {
        PG8_STAGE(PG8_SB(0, 0), cB, voffB); PG8_STAGE(PG8_SA(0, 0), cA, voffA); PG8_STAGE(PG8_SB(0, 1), cB + hstepB, voffB); PG8_STAGE(PG8_SA(0, 1), cA + hstepA, voffA);
        if (wr == 1) PG8_BAR;
        PG8_WAIT_V(4); PG8_BAR;
        PG8_STAGE(PG8_SB(1, 0), cB + kstep, voffB); PG8_STAGE(PG8_SA(1, 0), cA + kstep, voffA); PG8_STAGE(PG8_SB(1, 1), cB + hstepB + kstep, voffB);
        PG8_WAIT_V(6); PG8_BAR;
    }
    for (;;) {
        const bool has_next = S.next(ui + 1, nxt);
        const char* nA = has_next ? (const char*)g.A + (size_t)nxt.pm * tstepA : cA; const char* nB = has_next ? (const char*)g.Bt + (size_t)nxt.pn * tstepB : cB;
        for (int t = 0; t < nt; t += 2) {
            const bool last = (t == nt - 2);
            const char* a1 = cA + (size_t)(t + 1) * kstep;
            const char* a2 = last ? nA : cA + (size_t)(t + 2) * kstep; const char* b2 = last ? nB : cB + (size_t)(t + 2) * kstep;
            const char* a3 = a2 + kstep; const char* b3 = b2 + kstep;
            if constexpr (SP2) {
            PG8_LDB(B0, 0, 0); PG8_LDB(B1, 0, 1); PG8_SCHED; PG8_LDA(At, 0, 0); PG8_STAGE(PG8_SA(1, 1), a1 + hstepA, voffA);
            PG8_WAIT_V(8); PG8_WAIT_L(0); PG8_BAR; PG8_MMA(0, 0, At, B0); PG8_MMA(0, 1, At, B1); PG8_BAR; PG8_SCHED;
            PG8_LDA(At, 0, 1); PG8_STAGE(PG8_SB(0, 0), b2, voffB); PG8_STAGE(PG8_SB(0, 1), b2 + hstepB, voffB); PG8_STAGE(PG8_SA(0, 0), a2, voffA);
            PG8_WAIT_V(8); PG8_WAIT_L(0); PG8_BAR; PG8_MMA(1, 0, At, B0); PG8_MMA(1, 1, At, B1); PG8_BAR; PG8_SCHED;
            PG8_LDB(B0, 1, 0); PG8_LDB(B1, 1, 1); PG8_SCHED; PG8_LDA(At, 1, 0); PG8_STAGE(PG8_SA(0, 1), a2 + hstepA, voffA);
            PG8_WAIT_V(8); PG8_WAIT_L(0); PG8_BAR; PG8_MMA(0, 0, At, B0); PG8_MMA(0, 1, At, B1); PG8_BAR; PG8_SCHED;
            PG8_LDA(At, 1, 1); PG8_STAGE(PG8_SB(1, 0), b3, voffB); PG8_STAGE(PG8_SB(1, 1), b3 + hstepB, voffB); PG8_STAGE(PG8_SA(1, 0), a3, voffA);
            PG8_WAIT_V(8); PG8_WAIT_L(0); PG8_BAR; PG8_MMA(1, 0, At, B0); PG8_MMA(1, 1, At, B1); PG8_BAR; PG8_SCHED;
            } else {
            PG8_LDB(B0, 0, 0); PG8_SCHED; PG8_LDA(At, 0, 0); PG8_STAGE(PG8_SA(1, 1), a1 + hstepA, voffA);
            PG8_WAIT_L(8); PG8_BAR; PG8_WAIT_L(0); PG8_MMA(0, 0, At, B0); PG8_BAR; PG8_SCHED;
            PG8_LDB(B1, 0, 1); PG8_STAGE(PG8_SB(0, 0), b2, voffB);
            PG8_BAR; PG8_WAIT_L(0); PG8_MMA(0, 1, At, B1); PG8_BAR;
            PG8_LDA(At, 0, 1); PG8_STAGE(PG8_SA(0, 0), a2, voffA);
            PG8_BAR; PG8_WAIT_L(0); PG8_MMA(1, 0, At, B0); PG8_BAR; PG8_SCHED;
            PG8_STAGE(PG8_SB(0, 1), b2 + hstepB, voffB);
            PG8_WAIT_V(6); PG8_BAR; PG8_MMA(1, 1, At, B1); PG8_BAR;
            PG8_LDB(B0, 1, 0); PG8_SCHED; PG8_LDA(At, 1, 0); PG8_STAGE(PG8_SA(0, 1), a2 + hstepA, voffA);
            PG8_WAIT_L(8); PG8_BAR; PG8_WAIT_L(0); PG8_MMA(0, 0, At, B0); PG8_BAR; PG8_SCHED;
            PG8_LDB(B1, 1, 1); PG8_STAGE(PG8_SB(1, 0), b3, voffB);
            PG8_BAR; PG8_WAIT_L(0); PG8_MMA(0, 1, At, B1); PG8_BAR;
            PG8_LDA(At, 1, 1); PG8_STAGE(PG8_SA(1, 0), a3, voffA);
            PG8_BAR; PG8_WAIT_L(0); PG8_MMA(1, 0, At, B0); PG8_BAR; PG8_SCHED;
            PG8_STAGE(PG8_SB(1, 1), b3 + hstepB, voffB);
            PG8_WAIT_V(6); PG8_BAR; PG8_MMA(1, 1, At, B1); PG8_BAR;
            }
        }
        if constexpr (ALIGN_EPI) { if (wr == 0) PG8_BAR; }
        E(acc, cur, wr, wc, fr, fq);
        if (!has_next) break;
#pragma unroll
        for (int a = 0; a < 2; ++a)
#pragma unroll
            for (int b = 0; b < 2; ++b)
#pragma unroll
                for (int m = 0; m < 4; ++m)
#pragma unroll
                    for (int n = 0; n < 2; ++n) acc[a][b][m][n] = (f32x4){0.f, 0.f, 0.f, 0.f};
        cur = nxt; cA = nA; cB = nB; ++ui;
        if constexpr (ALIGN_EPI) { if (wr == 1) PG8_BAR; }
    }
    PG8_WAIT_V(0);
    if constexpr (!ALIGN_EPI) { if (wr == 0) PG8_BAR; }
    PG8_BAR;
#undef PG8_SA
#undef PG8_SB
#undef PG8_STAGE
#undef PG8_LDA
#undef PG8_LDB
#undef PG8_MMA
#undef PG8_WAIT_V
#undef PG8_WAIT_L
#undef PG8_BAR
#undef PG8_SCHED
}
#endif
}
#ifdef CPU_EMU
#define GEMM_LDS(F) ((F).lds)
#else
#define GEMM_LDS(F) ((PG8_LAS unsigned char*)(F).lds)
#endif
#ifndef PG8_SP2
#define PG8_SP2 true
#endif
#ifndef PG8_ALIGN
#define PG8_ALIGN true
#endif

typedef const f32x4 (&AccRef)[2][2][4][2];
struct Lane4 { int wr, wc, fr, fq; };
__device__ __forceinline__ Lane4 epi_lane(int wr, int wc) {
    int t = hw_lane();
#ifndef CPU_EMU
    asm volatile("" : "+v"(t));
#endif
    Lane4 L; L.wr = wr; L.wc = wc; L.fr = t & 15; L.fq = (t >> 4) & 3; return L;
}
struct EpiF32 {
    static constexpr bool PERM = false;
    float* O; int ldc;
    __device__ __forceinline__ void operator()(AccRef acc, const pg8::Unit& u, int wr_, int wc_, int, int) const {
        const Lane4 L = epi_lane(wr_, wc_); const int wr = L.wr, wc = L.wc, fr = L.fr, fq = L.fq;
        const int col0 = u.pn * 256 + wc * 32 + 4 * fq;
#pragma unroll
        for (int ai = 0; ai < 2; ++ai)
#pragma unroll
            for (int m = 0; m < 4; ++m) { float* rowp = O + (size_t)(u.pm * 256 + ai * 128 + wr * 64 + m * 16 + fr) * ldc + col0;
#pragma unroll
                for (int bj = 0; bj < 2; ++bj)
#pragma unroll
                    for (int n = 0; n < 2; ++n) *(f32x4*)(rowp + bj * 128 + n * 16) = acc[ai][bj][m][n]; }
    }
};
struct EpiGlu {
    static constexpr bool PERM = true;
    bf16_t* O;
    __device__ __forceinline__ void operator()(AccRef acc, const pg8::Unit& u, int wr_, int wc_, int, int) const {
        const Lane4 L = epi_lane(wr_, wc_); const int wr = L.wr, wc = L.wc, fr = L.fr, fq = L.fq;
        const int col0 = u.pn * 128 + wc * 32 + 8 * fq;
#pragma unroll
        for (int ai = 0; ai < 2; ++ai)
#pragma unroll
            for (int m = 0; m < 4; ++m) { bf16_t* rowp = O + (size_t)(u.pm * 256 + ai * 128 + wr * 64 + m * 16 + fr) * DM + col0; float o[8];
#pragma unroll
                for (int n = 0; n < 2; ++n) { const f32x4 v = acc[ai][0][m][n], g = acc[ai][1][m][n];
#pragma unroll
                    for (int e = 0; e < 4; ++e) o[4 * n + e] = v[e] * sigmoidf_(g[e]); }
                u32x4 w; w.x = pk2(o[0], o[1]); w.y = pk2(o[2], o[3]); w.z = pk2(o[4], o[5]); w.w = pk2(o[6], o[7]); *(u32x4*)rowp = w; }
    }
};
__device__ __forceinline__ u32x4 pack8(const f32x4 a, const f32x4 b, float s) {
    u32x4 w; w.x = pk2(a[0] * s, a[1] * s); w.y = pk2(a[2] * s, a[3] * s); w.z = pk2(b[0] * s, b[1] * s); w.w = pk2(b[2] * s, b[3] * s); return w;
}
struct EpiB16 {
    static constexpr bool PERM = true;
    bf16_t* O; int ldc;
    __device__ __forceinline__ void operator()(AccRef acc, const pg8::Unit& u, int wr_, int wc_, int, int) const {
        const Lane4 L = epi_lane(wr_, wc_); const int wr = L.wr, wc = L.wc, fr = L.fr, fq = L.fq;
        const int col0 = u.pn * 256 + wc * 32 + 8 * fq;
#pragma unroll
        for (int ai = 0; ai < 2; ++ai)
#pragma unroll
            for (int m = 0; m < 4; ++m) { bf16_t* rowp = O + (size_t)(u.pm * 256 + ai * 128 + wr * 64 + m * 16 + fr) * ldc + col0;
#pragma unroll
                for (int bj = 0; bj < 2; ++bj) *(u32x4*)(rowp + bj * 128) = pack8(acc[ai][bj][m][0], acc[ai][bj][m][1], 1.f); }
    }
};
typedef _Float16 f16x2_hw __attribute__((ext_vector_type(2)));
#ifdef CPU_EMU
__device__ __forceinline__ unsigned pkh2(float lo, float hi) { const f16x2_hw v = {(_Float16)lo, (_Float16)hi}; unsigned r; memcpy(&r, &v, 4); return r; }
__device__ __forceinline__ float hlo(unsigned w) { f16x2_hw v; memcpy(&v, &w, 4); return (float)v[0]; }
__device__ __forceinline__ float hhi(unsigned w) { f16x2_hw v; memcpy(&v, &w, 4); return (float)v[1]; }
#else
__device__ __forceinline__ unsigned pkh2(float lo, float hi) { const f32x2 v = {lo, hi}; const f16x2_hw b = __builtin_convertvector(v, f16x2_hw); return __builtin_bit_cast(unsigned, b); }
__device__ __forceinline__ float hlo(unsigned w) { return (float)__builtin_bit_cast(f16x2_hw, w)[0]; }
__device__ __forceinline__ float hhi(unsigned w) { return (float)__builtin_bit_cast(f16x2_hw, w)[1]; }
#endif
struct EpiH16 {
    static constexpr bool PERM = true;
    unsigned short* O; int ldc;
    __device__ __forceinline__ void operator()(AccRef acc, const pg8::Unit& u, int wr_, int wc_, int, int) const {
        const Lane4 L = epi_lane(wr_, wc_); const int wr = L.wr, wc = L.wc, fr = L.fr, fq = L.fq;
        const int col0 = u.pn * 256 + wc * 32 + 8 * fq;
#pragma unroll
        for (int ai = 0; ai < 2; ++ai)
#pragma unroll
            for (int m = 0; m < 4; ++m) { unsigned short* rowp = O + (size_t)(u.pm * 256 + ai * 128 + wr * 64 + m * 16 + fr) * ldc + col0;
#pragma unroll
                for (int bj = 0; bj < 2; ++bj) { const f32x4 a = acc[ai][bj][m][0], b = acc[ai][bj][m][1]; u32x4 w; w.x = pkh2(a[0], a[1]); w.y = pkh2(a[2], a[3]); w.z = pkh2(b[0], b[1]); w.w = pkh2(b[2], b[3]);
                    *(u32x4*)(rowp + bj * 128) = w; } }
    }
};
struct EpiSsdIn {
    static constexpr bool PERM = true;
    bf16_t* Z; bf16_t* XBC; float* DT;
    __device__ __forceinline__ void operator()(AccRef acc, const pg8::Unit& u, int wr_, int wc_, int, int) const {
        const Lane4 L = epi_lane(wr_, wc_); const int wr = L.wr, wc = L.wc, fr = L.fr, fq = L.fq;
        const int cw = wc * 32 + 8 * fq;
#pragma unroll
        for (int ai = 0; ai < 2; ++ai)
#pragma unroll
            for (int m = 0; m < 4; ++m) { const size_t row = (size_t)(u.pm * 256 + ai * 128 + wr * 64 + m * 16 + fr);
#pragma unroll
                for (int bj = 0; bj < 2; ++bj) { const int col = u.pn * 256 + bj * 128 + cw;
                    if (u.pn < 8) *(u32x4*)(Z + row * 2048 + col) = pack8(acc[ai][bj][m][0], acc[ai][bj][m][1], 1.f);
                    else if (u.pn < 20) *(u32x4*)(XBC + row * 3072 + (col - 2048)) = pack8(acc[ai][bj][m][0], acc[ai][bj][m][1], 1.f);
                    else if (col - 5120 < 64) { float* p = DT + row * 64 + (col - 5120); *(f32x4*)p = acc[ai][bj][m][0]; *(f32x4*)(p + 4) = acc[ai][bj][m][1]; } } }
    }
};
struct EpiMlaDown {
    static constexpr bool PERM = true;
    bf16_t* C; float* RS;
    __device__ __forceinline__ void operator()(AccRef acc, const pg8::Unit& u, int wr_, int wc_, int, int) const {
        const Lane4 L = epi_lane(wr_, wc_); const int wr = L.wr, wc = L.wc, fr = L.fr, fq = L.fq;
        const int cw = wc * 32 + 8 * fq;
#pragma unroll
        for (int ai = 0; ai < 2; ++ai)
#pragma unroll
            for (int m = 0; m < 4; ++m) { const size_t row = (size_t)(u.pm * 256 + ai * 128 + wr * 64 + m * 16 + fr); float ss = 0.f;
#pragma unroll
                for (int bj = 0; bj < 2; ++bj) { const int col = u.pn * 256 + bj * 128 + cw; const f32x4 a = acc[ai][bj][m][0], b = acc[ai][bj][m][1];
                    *(u32x4*)(C + row * 512 + col) = pack8(a, b, 1.f);
                    if (u.pn == 0 || bj == 0) ss += (a[0] * a[0] + a[1] * a[1]) + (a[2] * a[2] + a[3] * a[3]) + (b[0] * b[0] + b[1] * b[1]) + (b[2] * b[2] + b[3] * b[3]); }
                ss += __shfl_xor(ss, 16); ss += __shfl_xor(ss, 32);
                if (fq == 0) RS[row * 8 + u.pn * 4 + wc] = ss; }
    }
};
struct EpiMlaUp {
    static constexpr bool PERM = true;
    bf16_t* Q; bf16_t* Kb; bf16_t* Vb; const float* RS;
    __device__ __forceinline__ void operator()(AccRef acc, const pg8::Unit& u, int wr_, int wc_, int, int) const {
        const Lane4 L = epi_lane(wr_, wc_); const int wr = L.wr, wc = L.wc, fr = L.fr, fq = L.fq;
        const bool isq = u.pn < 8;
        if (isq && wc == 3) return;
#pragma unroll
        for (int ai = 0; ai < 2; ++ai)
#pragma unroll
            for (int m = 0; m < 4; ++m) { const int tok = u.pm * 256 + ai * 128 + wr * 64 + m * 16 + fr; const int b = tok / LTOK, p = tok - b * LTOK;
                const f32x4 rs = *(const f32x4*)(RS + ((unsigned)tok * 8u + (isq ? 0u : 4u)));
                const float rn = 1.0f / sqrtf(((rs[0] + rs[1]) + (rs[2] + rs[3])) * (isq ? (1.f / 256.f) : (1.f / 128.f)) + 1e-6f);
#pragma unroll
                for (int bj = 0; bj < 2; ++bj) { bf16_t* dst;
                    if (isq) dst = Q + ((unsigned)((b * 16 + u.pn * 2 + bj) * LTOK + p) * 128u + (unsigned)(wc * 32 + 8 * fq));
                    else { const int col = (u.pn & 3) * 256 + bj * 128 + wc * 32 + 8 * fq; const int head = col >> 6, d = col & 63; const unsigned rowi = (unsigned)((b * 16 + head) * LTOK + p);
                        dst = u.pn < 12 ? Kb + (rowi * 128u + (unsigned)d) : Vb + (rowi * 64u + (unsigned)d); }
                    *(u32x4*)dst = pack8(acc[ai][bj][m][0], acc[ai][bj][m][1], rn); }
                asm volatile("" ::: "memory"); }
    }
};

namespace att {
constexpr int NW = 8, QBLK = 32, KVBLK = 64, LDQ = 128, LDK = 128, LDV = 64, LDO = 1024;
constexpr float SCALE = 0.10206207261596575f;
constexpr float THR = 8.f;
constexpr size_t SHM_V = KVBLK * 128 * 2, SHM_K = KVBLK * 128 * 2, SHM_ATTN = 2 * SHM_V + 2 * SHM_K + NW * 64 * 4;
#ifdef CPU_EMU
__device__ __forceinline__ void attn_body(const bf16_t* Qb, const bf16_t* Kh, const bf16_t* Vh, bf16_t* Ob, int seq, unsigned char* lds, int tq0, const float* ROPE, int wave_s) {
    const int tid = threadIdx.x, wid = tid >> 6, lane = tid & 63, r32 = lane & 31, hi = lane >> 5;
    if (hi == 0) {
        const bf16_t* qg = Qb + (size_t)(wid * 32 + r32) * LDQ; float m = -1e30f; float q[96];
        for (int d = 0; d < 96; ++d) q[d] = bf2f(qg[d]);
        if (tq0 >= 0) { const int t = tq0 + wid * 32 + r32;
            for (int i = 0; i < 16; ++i) { const int pos = i < 8 ? (t >> 6) : (t & 63); const float c = ROPE[(pos * 8 + (i & 7)) * 2], sn = ROPE[(pos * 8 + (i & 7)) * 2 + 1];
                const float x1 = q[64 + 2 * i], x2 = q[64 + 2 * i + 1]; q[64 + 2 * i] = x1 * c - x2 * sn; q[64 + 2 * i + 1] = x2 * c + x1 * sn; }
            for (int d = 64; d < 96; ++d) q[d] = bf2f((bf16_t)f2bf(q[d])); }
        std::vector<float> sc(seq);
        for (int k = 0; k < seq; ++k) { float s = 0.f; for (int d = 0; d < 96; ++d) s += q[d] * bf2f(Kh[(size_t)k * LDK + d]); sc[k] = s * SCALE; m = fmaxf(m, sc[k]); }
        float l = 0.f; float o[64]; for (int d = 0; d < 64; ++d) o[d] = 0.f;
        for (int k = 0; k < seq; ++k) { const float pr = expf(sc[k] - m); l += pr; const float prb = bf2f((bf16_t)f2bf(pr)); for (int d = 0; d < 64; ++d) o[d] += prb * bf2f(Vh[(size_t)k * LDV + d]); }
        for (int d = 0; d < 64; ++d) Ob[(size_t)(wid * 32 + r32) * LDO + d] = (bf16_t)f2bf(o[d] / l);
    }
    __syncthreads();
}
#else
using s16x4 = __attribute__((ext_vector_type(4))) short;
#define KSWZ(row, colB) ((row) * 256 + ((colB) ^ (((row) & 7) << 4)))
#define SBAR() __builtin_amdgcn_sched_barrier(0)
__device__ __forceinline__ unsigned cvtpk(float lo, float hi) { unsigned r; asm volatile("v_cvt_pk_bf16_f32 %0, %1, %2" : "=v"(r) : "v"(lo), "v"(hi)); return r; }
__device__ __forceinline__ void partialSM(f32x16& p0, f32x16& p1, float& m_reg, float& mn, float& alpha) {
  constexpr float C = SCALE * 1.4426950408889634f;
  float pmax = p0[0]; for (int r = 1; r < 16; ++r) pmax = fmaxf(pmax, p0[r]); for (int r = 0; r < 16; ++r) pmax = fmaxf(pmax, p1[r]);
  { auto rr = __builtin_amdgcn_permlane32_swap(__float_as_uint(pmax), __float_as_uint(pmax), false, false);
    pmax = fmaxf(__uint_as_float(rr[0]), __uint_as_float(rr[1])); }
  if (__builtin_expect(__all(pmax - m_reg <= THR / SCALE), 1)) { mn = m_reg; alpha = 1.f; }
  else { mn = fmaxf(m_reg, pmax); alpha = __builtin_amdgcn_exp2f((m_reg - mn) * C); m_reg = mn; }
  float mnC = -mn * C;
  for (int r = 0; r < 16; ++r) p0[r] = fmaf(p0[r], C, mnC); for (int r = 0; r < 16; ++r) p1[r] = fmaf(p1[r], C, mnC);
  for (int r = 0; r < 16; ++r) p0[r] = __builtin_amdgcn_exp2f(p0[r]);
}
__device__ __forceinline__ void finishSM(f32x16& p0, f32x16& p1, float alpha, float& l_reg, bf16x8& pa0, bf16x8& pa1, bf16x8& pa2, bf16x8& pa3) {
  for (int r = 0; r < 16; ++r) p1[r] = __builtin_amdgcn_exp2f(p1[r]);
  float ps = 0; for (int r = 0; r < 16; ++r) ps += p0[r]; for (int r = 0; r < 16; ++r) ps += p1[r];
  { auto rr = __builtin_amdgcn_permlane32_swap(__float_as_uint(ps), __float_as_uint(ps), false, false);
    ps = __uint_as_float(rr[0]) + __uint_as_float(rr[1]); }
  l_reg = l_reg * alpha + ps;
#define PK4(P, BASE, OUT) do { unsigned a0 = cvtpk(P[BASE + 0], P[BASE + 1]), a1 = cvtpk(P[BASE + 2], P[BASE + 3]);   \
    unsigned b0 = cvtpk(P[BASE + 4], P[BASE + 5]), b1 = cvtpk(P[BASE + 6], P[BASE + 7]);                              \
    auto r0 = __builtin_amdgcn_permlane32_swap(a0, b0, false, false); auto r1 = __builtin_amdgcn_permlane32_swap(a1, b1, false, false); \
    u32x4 w = {r0[0], r1[0], r0[1], r1[1]}; OUT = *reinterpret_cast<bf16x8*>(&w); } while (0)
  PK4(p0, 0, pa0); PK4(p0, 8, pa1); PK4(p1, 0, pa2); PK4(p1, 8, pa3);
#undef PK4
}
__device__ __forceinline__ void qkt(f32x16& p0, f32x16& p1, const bf16_t* Ks, const bf16x8* qr, int r32, int hi) {
  p0 = f32x16{}; p1 = f32x16{};
#pragma unroll
  for (int d0 = 0; d0 < 6; ++d0) { int cb = (d0 * 16 + hi * 8) * 2;
    bf16x8 b0 = *reinterpret_cast<const bf16x8*>((const char*)Ks + KSWZ(r32, cb));
    bf16x8 b1 = *reinterpret_cast<const bf16x8*>((const char*)Ks + KSWZ(32 + r32, cb));
    p0 = __builtin_amdgcn_mfma_f32_32x32x16_bf16(b0, qr[d0], p0, 0, 0, 0);
    p1 = __builtin_amdgcn_mfma_f32_32x32x16_bf16(b1, qr[d0], p1, 0, 0, 0); }
}
__device__ __forceinline__ int v_st(int k, int c) { const int kk = (k & ~0xC) | ((k & 4) << 1) | ((k & 8) >> 1); return ((kk >> 3) * 4 + (c >> 5)) * 512 + ((kk & 7) * 32 + (c & 31)) * 2; }
__device__ __forceinline__ int v_rd_base(int lane) { return ((lane & 3) << 3) | (((lane >> 2) & 3) << 6) | (((lane >> 4) & 1) << 5) | (((lane >> 5) & 1) << 8); }
constexpr int v_rd_off(int d0, int ks, int half) { return d0 * 512 + ks * 4096 + half * 2048; }
template <int OFF> __device__ __forceinline__ s16x4 tr_read(int vb) {
  s16x4 r; asm volatile("ds_read_b64_tr_b16 %0, %1 offset:%2" : "=&v"(r) : "v"(vb), "i"(OFF) : "memory"); return r;
}
template <int D0> __device__ __forceinline__ void pv_one(f32x16& od, int vb, bf16x8 pa0, bf16x8 pa1, bf16x8 pa2, bf16x8 pa3) {
  const s16x4 l0 = tr_read<v_rd_off(D0, 0, 0)>(vb), h0 = tr_read<v_rd_off(D0, 0, 1)>(vb), l1 = tr_read<v_rd_off(D0, 1, 0)>(vb), h1 = tr_read<v_rd_off(D0, 1, 1)>(vb);
  const s16x4 l2 = tr_read<v_rd_off(D0, 2, 0)>(vb), h2 = tr_read<v_rd_off(D0, 2, 1)>(vb), l3 = tr_read<v_rd_off(D0, 3, 0)>(vb), h3 = tr_read<v_rd_off(D0, 3, 1)>(vb);
  asm volatile("s_waitcnt lgkmcnt(0)" ::: "memory"); SBAR();
#define PK(L, H) (bf16x8){L[0], L[1], L[2], L[3], H[0], H[1], H[2], H[3]}
  od = __builtin_amdgcn_mfma_f32_32x32x16_bf16(pa0, PK(l0, h0), od, 0, 0, 0);
  od = __builtin_amdgcn_mfma_f32_32x32x16_bf16(pa1, PK(l1, h1), od, 0, 0, 0);
  od = __builtin_amdgcn_mfma_f32_32x32x16_bf16(pa2, PK(l2, h2), od, 0, 0, 0);
  od = __builtin_amdgcn_mfma_f32_32x32x16_bf16(pa3, PK(l3, h3), od, 0, 0, 0);
#undef PK
}
__device__ __forceinline__ void pv_d0(f32x16* o, int vb, bf16x8 pa0, bf16x8 pa1, bf16x8 pa2, bf16x8 pa3) {
  pv_one<0>(o[0], vb, pa0, pa1, pa2, pa3); pv_one<1>(o[1], vb, pa0, pa1, pa2, pa3);
}
__device__ __forceinline__ void attn_body(const bf16_t* __restrict__ Qb, const bf16_t* __restrict__ Kh, const bf16_t* __restrict__ Vh, bf16_t* __restrict__ Ob, int seq, char* lds, int tq0, const float* __restrict__ ROPE, int wave_s) {
  const int wid = wave_s, lane = hw_lane(), tid = wid * 64 + lane, r32 = lane & 31, hi = lane >> 5;
  bf16_t* V_lds = (bf16_t*)lds; bf16_t* K_lds = (bf16_t*)(lds + 2 * SHM_V);
  float* ws = (float*)(lds + 2 * SHM_V + 2 * SHM_K) + wid * 64; float* li_l = ws; float* al_l = ws + 32;
  float m_reg = -1e30f, l_reg = 0; f32x16 o[2] = {}; bf16x8 qr[6];
  const bf16_t* Qw = Qb + (long)(wid * QBLK + r32) * LDQ + hi * 8;
#pragma unroll
  for (int d0 = 0; d0 < 6; ++d0) qr[d0] = *reinterpret_cast<const bf16x8*>(Qw + d0 * 16);
  if (tq0 >= 0) {
    const int t = tq0 + wid * QBLK + r32;
#pragma unroll
    for (int dd = 0; dd < 2; ++dd) { const int pos = dd == 0 ? (t >> 6) : (t & 63);
      const f32x4 r0 = *(const f32x4*)(ROPE + pos * 16 + 8 * hi), r1 = *(const f32x4*)(ROPE + pos * 16 + 8 * hi + 4);
      const u32x4 w = *reinterpret_cast<const u32x4*>(&qr[4 + dd]); u32x4 o;
      { const float x1 = bflo(w.x), x2 = bfhi(w.x); o.x = pk2(x1 * r0[0] - x2 * r0[1], x2 * r0[0] + x1 * r0[1]); }
      { const float x1 = bflo(w.y), x2 = bfhi(w.y); o.y = pk2(x1 * r0[2] - x2 * r0[3], x2 * r0[2] + x1 * r0[3]); }
      { const float x1 = bflo(w.z), x2 = bfhi(w.z); o.z = pk2(x1 * r1[0] - x2 * r1[1], x2 * r1[0] + x1 * r1[1]); }
      { const float x1 = bflo(w.w), x2 = bfhi(w.w); o.w = pk2(x1 * r1[2] - x2 * r1[3], x2 * r1[2] + x1 * r1[3]); }
      qr[4 + dd] = *reinterpret_cast<const bf16x8*>(&o); }
  }
  const int sr = tid >> 4, sc = (tid & 15) * 8;
  const int vk = tid >> 3, vc = (tid & 7) * 8, vst0 = v_st(vk, vc);
  const int vb0 = (int)(uintptr_t)V_lds + v_rd_base(lane);
  struct { bf16x8 vs0, ks0, ks1; } sr_[2];
#define SLOAD(i, k0) do { sr_[i].vs0 = *reinterpret_cast<const bf16x8*>(&Vh[(long)((k0) + vk) * LDV + vc]); \
    sr_[i].ks0 = *reinterpret_cast<const bf16x8*>(&Kh[(long)((k0) + sr) * LDK + sc]); sr_[i].ks1 = *reinterpret_cast<const bf16x8*>(&Kh[(long)((k0) + 32 + sr) * LDK + sc]); } while (0)
#define SWRITE(b, i) do { *(bf16x8*)((char*)V_lds + (b) * SHM_V + vst0) = sr_[i].vs0; int kc = sc * 2;               \
    *(bf16x8*)((char*)K_lds + (b) * SHM_K + KSWZ(sr, kc)) = sr_[i].ks0;                       \
    *(bf16x8*)((char*)K_lds + (b) * SHM_K + KSWZ(32 + sr, kc)) = sr_[i].ks1; } while (0)
#define SWAIT() asm volatile("s_waitcnt vmcnt(3)" ::: "memory")
#define RESC(a) do { if (__any((a) < 1.f)) { if (hi == 0) al_l[r32] = (a); asm volatile("s_waitcnt lgkmcnt(0)" ::: "memory"); \
    for (int d = 0; d < 2; ++d) for (int r = 0; r < 16; ++r) o[d][r] *= al_l[crow(r, hi)]; } } while (0)
  f32x16 pA0, pA1, pB0, pB1; float mnA, mnB, alA, alB; bf16x8 pa0, pa1, pa2, pa3; const int NT = seq / KVBLK;
  constexpr int SE = 0, SO = 1;
  SLOAD(SE, 0); asm volatile("s_waitcnt vmcnt(0)" ::: "memory"); SWRITE(0, SE); __syncthreads();
  qkt(pA0, pA1, K_lds, qr, r32, hi); partialSM(pA0, pA1, m_reg, mnA, alA);
  SLOAD(SO, KVBLK); if (2 < NT) SLOAD(SE, 2 * KVBLK);
  SWAIT(); SWRITE(1, SO); __syncthreads();
  for (int j = 1; j + 1 < NT; j += 2) {
    SBAR(); qkt(pB0, pB1, (bf16_t*)((char*)K_lds + SHM_K), qr, r32, hi);
    finishSM(pA0, pA1, alA, l_reg, pa0, pa1, pa2, pa3); SBAR();
    SLOAD(SO, (j + 2) * KVBLK); SBAR();
    pv_d0(o, vb0, pa0, pa1, pa2, pa3); partialSM(pB0, pB1, m_reg, mnB, alB);
    __syncthreads(); SWAIT(); SWRITE(0, SE);
    RESC(alB); __syncthreads();
    SBAR(); qkt(pA0, pA1, K_lds, qr, r32, hi);
    finishSM(pB0, pB1, alB, l_reg, pa0, pa1, pa2, pa3); SBAR();
    if (j + 3 < NT) SLOAD(SE, (j + 3) * KVBLK); SBAR();
    pv_d0(o, vb0 + (int)SHM_V, pa0, pa1, pa2, pa3); partialSM(pA0, pA1, m_reg, mnA, alA);
    __syncthreads(); SWAIT(); SWRITE(1, SO);
    RESC(alA); __syncthreads();
  }
  SBAR(); qkt(pB0, pB1, (bf16_t*)((char*)K_lds + SHM_K), qr, r32, hi);
  finishSM(pA0, pA1, alA, l_reg, pa0, pa1, pa2, pa3); SBAR();
  pv_d0(o, vb0, pa0, pa1, pa2, pa3); partialSM(pB0, pB1, m_reg, mnB, alB);
  __syncthreads(); RESC(alB);
  finishSM(pB0, pB1, alB, l_reg, pa0, pa1, pa2, pa3); SBAR();
  pv_d0(o, vb0 + (int)SHM_V, pa0, pa1, pa2, pa3);
  if (hi == 0) li_l[r32] = l_reg; asm volatile("s_waitcnt lgkmcnt(0)" ::: "memory");
  float rli[16];
#pragma unroll
  for (int r = 0; r < 16; ++r) rli[r] = __builtin_amdgcn_rcpf(li_l[crow(r, hi)]);
  bf16_t* Ow = Ob + (long)(wid * QBLK) * LDO;
#pragma unroll
  for (int r = 0; r < 16; ++r) { int orow = crow(r, hi);
    for (int d0 = 0; d0 < 2; ++d0) Ow[(long)orow * LDO + d0 * 32 + r32] = (bf16_t)f2bf(o[d0][r] * rli[r]); }
  __syncthreads();
#undef SLOAD
#undef SWRITE
#undef SWAIT
#undef RESC
}
#undef KSWZ
#undef SBAR
#endif
}

template <class RowMap>
__device__ __forceinline__ void tr_item(const float* W, int ldw, int k0, int n0, bf16_t* WT, int ldt, int koff, const float* kscale, RowMap rm, float* scr, int lane) {
#pragma unroll 8
    for (int i = 0; i < 32; ++i) { const int kk = 2 * i + (lane >> 5); scr[kk * 33 + (lane & 31)] = W[(size_t)(k0 + kk) * ldw + n0 + (lane & 31)]; }
    wave_sync();
    const int c = lane & 7;
    float ks[8];
#pragma unroll
    for (int e = 0; e < 8; ++e) ks[e] = kscale ? kscale[k0 + 8 * c + e] : 1.f;
#pragma unroll
    for (int j = 0; j < 4; ++j) { const int n = (lane >> 3) + 8 * j; const float* s = scr + (8 * c) * 33 + n;
        u32x4 o; o.x = pk2(s[0 * 33] * ks[0], s[1 * 33] * ks[1]); o.y = pk2(s[2 * 33] * ks[2], s[3 * 33] * ks[3]); o.z = pk2(s[4 * 33] * ks[4], s[5 * 33] * ks[5]); o.w = pk2(s[6 * 33] * ks[6], s[7 * 33] * ks[7]);
        const int row = rm(n0 + n);
        if (row >= 0) *(u32x4*)(WT + (size_t)row * ldt + koff + k0 + 8 * c) = o; }
    wave_sync();
}
struct RmId { int off; __device__ __forceinline__ int operator()(int n) const { return off + n; } };
struct RmGlu { int off; __device__ __forceinline__ int operator()(int n) const { return ((n >> 7) << 8) + off + (n & 127); } };
struct RmUq { __device__ __forceinline__ int operator()(int n) const { const int h = n / 96, d = n - h * 96; int sd = d;
        if (d >= 64) { const int rho = d - 64; const int half = rho >> 4, w = rho & 15; const int i = half * 8 + (w & 7); sd = 64 + 2 * i + (w >> 3); }
        return h * 128 + sd; } };
__device__ __forceinline__ void s5_disc(const Args& A, int it, int p, float& are_bar, float& aim_bar, float& cre, float& cim) {
    const float are = A.in[8][(size_t)it * 64 + p], aim = A.in[9][(size_t)it * 64 + p]; const float dt = expf(A.in[10][it]);
    const float zr = are * dt, zi = aim * dt; const float ez = expf(zr), cs = cosf(zi), sn = sinf(zi), sh = sinf(0.5f * zi);
    are_bar = ez * cs; aim_bar = ez * sn;
    const float nr = expm1f(zr) * cs - 2.f * sh * sh, ni = ez * sn;
    const float den = are * are + aim * aim;
    cre = (nr * are + ni * aim) / den; cim = (ni * are - nr * aim) / den;
}
__device__ __forceinline__ void ph_prep(const Args& A, Frame& F) {
    const int tid = F.tid, lane = F.lane, wave = F.wave, G = F.G, bid = F.bid;
    unsigned char* ws = A.ws;
    { float* ca = (float*)F.lds; float* red = ca + NR * 1024; float* MOD = (float*)(ws + WS_MOD);
      for (int i = tid; i < NR * 1024; i += NTHR) { const int r = i >> 10, k = i & 1023; const float c = r < BATCH ? A.in[1][r * 1024 + k] : A.in[3][k]; ca[i] = siluf_(c); }
      __syncthreads();
      for (int it = bid; it < 4 * 96; it += G) { const int l = it / 96, cb = (it % 96) * 64; float acc[NR];
#pragma unroll
          for (int r = 0; r < NR; ++r) acc[r] = 0.f;
          const float* wp = A.in[4] + ((size_t)l * 1024 + wave * 128) * 6144 + cb + lane;
#pragma unroll 8
          for (int k = 0; k < 128; ++k) { const float w = wp[(size_t)k * 6144];
#pragma unroll
              for (int r = 0; r < NR; ++r) acc[r] += ca[r * 1024 + wave * 128 + k] * w; }
#pragma unroll
          for (int r = 0; r < NR; ++r) red[(wave * NR + r) * 64 + lane] = acc[r];
          __syncthreads();
          if (tid < NR * 64) { const int r = tid >> 6, c = tid & 63; float s = A.in[5][l * 6144 + cb + c];
              for (int w = 0; w < 8; ++w) s += red[(w * NR + r) * 64 + c];
              MOD[((size_t)l * NR + r) * 6144 + cb + c] = s; }
          __syncthreads(); } }
    { float* ROPE = (float*)(ws + WS_ROPE);
      for (int i = bid * NTHR + tid; i < 64 * 8; i += G * NTHR) { const int pos = i >> 3, f = i & 7; const float freq = powf(10000.f, -(float)f / 8.f); const float ang = (float)pos * freq;
          ROPE[2 * i] = cosf(ang); ROPE[2 * i + 1] = sinf(ang); } }
    { float* scr = (float*)(F.lds + wave * 16384);
      const int gw = bid * NWAVES + wave, NGW = G * NWAVES;
      bf16_t* WGLU = (bf16_t*)(ws + WS_WGLU); bf16_t* WIN = (bf16_t*)(ws + WS_WIN); bf16_t* WOUT = (bf16_t*)(ws + WS_WOUT); bf16_t* WDOWN = (bf16_t*)(ws + WS_WDOWN);
      bf16_t* WUP = (bf16_t*)(ws + WS_WUP); bf16_t* WO = (bf16_t*)(ws + WS_WO);
      constexpr int I_GLU = 16 * 32, I_IN = 16 * 162, I_OUT = 32 * 32, I_DOWN = 16 * 13, I_UQ = 4 * 48, I_UK = 2 * 32, I_WO = 16 * 32;
      constexpr int NIT = 4 * I_GLU + I_IN + I_OUT + I_DOWN + I_UQ + 2 * I_UK + I_WO;
      for (int it = gw; it < NIT; it += NGW) { int r = it;
          if (r < 4 * I_GLU) { const int which = r / I_GLU, q = r % I_GLU, j = which >> 1, isgate = which & 1;
              const float* W = (isgate ? A.in[16] : A.in[17]) + (size_t)j * 1024 * 1024;
              tr_item(W, 1024, (q / 32) * 64, (q % 32) * 32, WGLU + (size_t)j * 2048 * 1024, 1024, 0, nullptr, RmGlu{isgate * 128}, scr, lane); continue; } r -= 4 * I_GLU;
          if (r < I_IN) { tr_item(A.in[18], SSD_IN, (r / 162) * 64, (r % 162) * 32, WIN, 1024, 0, nullptr, RmId{0}, scr, lane); continue; } r -= I_IN;
          if (r < I_OUT) { tr_item(A.in[25], 1024, (r / 32) * 64, (r % 32) * 32, WOUT, 2048, 0, A.in[24], RmId{0}, scr, lane); continue; } r -= I_OUT;
          if (r < I_DOWN) { tr_item(A.in[26], 416, (r / 13) * 64, (r % 13) * 32, WDOWN, 1024, 0, nullptr, RmId{0}, scr, lane); continue; } r -= I_DOWN;
          if (r < I_UQ) { tr_item(A.in[29], 1536, (r / 48) * 64, (r % 48) * 32, WUP, 384, 0, A.in[27], RmUq{}, scr, lane); continue; } r -= I_UQ;
          if (r < I_UK) { tr_item(A.in[30], 1024, (r / 32) * 64, (r % 32) * 32, WUP, 384, 256, A.in[28], RmId{2048}, scr, lane); continue; } r -= I_UK;
          if (r < I_UK) { tr_item(A.in[31], 1024, (r / 32) * 64, (r % 32) * 32, WUP, 384, 256, A.in[28], RmId{3072}, scr, lane); continue; } r -= I_UK;
          tr_item(A.in[32], 1024, (r / 32) * 64, (r % 32) * 32, WO, 1024, 0, nullptr, RmId{0}, scr, lane); }
      const u32x4 z4 = {0u, 0u, 0u, 0u};
      const long gt = (long)bid * NTHR + tid, GT = (long)G * NTHR;
      for (long i = gt; i < (long)(SSD_IN_PAD - SSD_IN) * 128; i += GT) *(u32x4*)(WIN + (size_t)SSD_IN * 1024 + i * 8) = z4;
      for (long i = gt; i < (long)(512 - 416) * 128; i += GT) *(u32x4*)(WDOWN + (size_t)416 * 1024 + i * 8) = z4;
      for (long i = gt; i < 4096L * 48; i += GT) { const int R = (int)(i / 48), k = (int)(i % 48) * 8;
          const bool zero = R < 2048 ? (k >= 256 || (R & 127) >= 96) : (k < 256);
          if (zero) *(u32x4*)(WUP + (size_t)R * 384 + k) = z4; }
      { unsigned char* UT = ws + WS_UT; unsigned char* VT = ws + WS_VT; float* US = (float*)(ws + WS_US); float* VS = (float*)(ws + WS_VS);
        for (int rw = gw; rw < 2 * 4 * 16384; rw += NGW) { const bool isu = rw < 4 * 16384; const int row = isu ? rw : rw - 4 * 16384;
            const float* src = (isu ? A.in[35] : A.in[36]) + (size_t)row * 1024;
            const f32x4 a = *(const f32x4*)(src + 8 * lane), b = *(const f32x4*)(src + 8 * lane + 4), c = *(const f32x4*)(src + 512 + 8 * lane), d = *(const f32x4*)(src + 512 + 8 * lane + 4);
            float v[16];
#pragma unroll
            for (int e = 0; e < 4; ++e) { v[e] = a[e]; v[4 + e] = b[e]; v[8 + e] = c[e]; v[12 + e] = d[e]; }
            float mx = 0.f;
#pragma unroll
            for (int e = 0; e < 16; ++e) mx = fmaxf(mx, fabsf(v[e]));
            mx = wave_max(mx);
            const float inv = mx > 0.f ? 127.f / mx : 0.f;
            unsigned q[16];
#pragma unroll
            for (int e = 0; e < 16; ++e) q[e] = (unsigned)(int)(rintf(v[e] * inv) + 128.f);
            u32x4 o;
            o.x = q[0] | (q[1] << 8) | (q[2] << 16) | (q[3] << 24); o.y = q[4] | (q[5] << 8) | (q[6] << 16) | (q[7] << 24);
            o.z = q[8] | (q[9] << 8) | (q[10] << 16) | (q[11] << 24); o.w = q[12] | (q[13] << 8) | (q[14] << 16) | (q[15] << 24);
            o.x ^= 0x80808080u; o.y ^= 0x80808080u; o.z ^= 0x80808080u; o.w ^= 0x80808080u;
            *(u32x4*)((isu ? UT : VT) + (size_t)(row >> 14) * 16384 * 1024 + (size_t)(lane >> 3) * 16384 * 128 + (size_t)(row & 16383) * 128 + 16 * (lane & 7)) = o;
            float qs = 0.f;
#pragma unroll
            for (int e = 0; e < 16; ++e) qs += (float)q[e];
            qs = wave_sum(qs);
            if (lane == 0) { if (isu) { US[2 * row] = mx * (1.f / 127.f); US[2 * row + 1] = qs; } else VS[row] = mx * (1.f / 127.f); } } }
      for (int it = gw; it < 2 * 2 * 64; it += NGW) { unsigned char* base = ws + WS_S5C + (size_t)it * S5C_ITEM;
          float ar, ai, cr, ci; s5_disc(A, it, lane, ar, ai, cr, ci);
          ((f32x2*)base)[lane] = (f32x2){ar, ai};
          const int r = lane & 31, h = lane >> 5;
          const float* bre = A.in[11] + (size_t)it * 64 * 16; const float* bim = A.in[12] + (size_t)it * 64 * 16;
          const float* cre = A.in[13] + (size_t)it * 16 * 64; const float* cim = A.in[14] + (size_t)it * 16 * 64;
#pragma unroll
          for (int blk = 0; blk < 4; ++blk) { const int pst = (blk & 1) * 32 + r; float ar2, ai2, kr, ki; s5_disc(A, it, pst, ar2, ai2, kr, ki); float v[8];
#pragma unroll
              for (int j = 0; j < 8; ++j) { const int c = 8 * h + j; const float br = bre[pst * 16 + c], bi = bim[pst * 16 + c]; v[j] = blk < 2 ? (kr * br - ki * bi) : (kr * bi + ki * br); }
              u32x4 o; o.x = pk2(v[0], v[1]); o.y = pk2(v[2], v[3]); o.z = pk2(v[4], v[5]); o.w = pk2(v[6], v[7]);
              ((u32x4*)(base + 512))[blk * 64 + lane] = o; }
#pragma unroll
          for (int ks = 0; ks < 8; ++ks) { float v[8];
#pragma unroll
              for (int j = 0; j < 8; ++j) { const int k = 16 * ks + 8 * h + j, p = k >> 1, comp = k & 1; v[j] = r < 16 ? (comp == 0 ? cre[r * 64 + p] : -cim[r * 64 + p]) : 0.f; }
              u32x4 o; o.x = pk2(v[0], v[1]); o.y = pk2(v[2], v[3]); o.z = pk2(v[4], v[5]); o.w = pk2(v[6], v[7]);
              ((u32x4*)(base + 512 + 4096))[ks * 64 + lane] = o; } }
    }
    __syncthreads();
    { bf16_t* WSC = (bf16_t*)(ws + WS_WSC); const int gw = bid * NWAVES + wave, NGW = G * NWAVES; const int r = lane & 31, hh = lane >> 5;
      for (int it = gw; it < 4 * 16 * 32; it += NGW) { const int l = it >> 9, hj = (it >> 5) & 15, kb = it & 31, k0 = kb * 32;
          const float* wq = A.in[33] + ((size_t)l * 1024 + k0 + r) * 2048 + hj * 128; const float* sk = A.in[34] + ((size_t)l * 16 + hj) * 128 * 128;
          f32x16 acc[4];
#pragma unroll
          for (int ib = 0; ib < 4; ++ib) acc[ib] = f32x16{};
#pragma unroll 2
          for (int t = 0; t < 8; ++t) { const int d0 = 16 * t + 8 * hh;
              const f32x4 a0 = *(const f32x4*)(wq + d0), a1 = *(const f32x4*)(wq + d0 + 4);
              u32x4 ah, al; { float hi_[8], lo_[8];
#pragma unroll
                  for (int e = 0; e < 4; ++e) { hi_[e] = bflo(pk2(a0[e], 0.f)); lo_[e] = a0[e] - hi_[e]; hi_[4 + e] = bflo(pk2(a1[e], 0.f)); lo_[4 + e] = a1[e] - hi_[4 + e]; }
                  ah.x = pk2(hi_[0], hi_[1]); ah.y = pk2(hi_[2], hi_[3]); ah.z = pk2(hi_[4], hi_[5]); ah.w = pk2(hi_[6], hi_[7]);
                  al.x = pk2(lo_[0], lo_[1]); al.y = pk2(lo_[2], lo_[3]); al.z = pk2(lo_[4], lo_[5]); al.w = pk2(lo_[6], lo_[7]); }
              const bf16x8 Ah = __builtin_bit_cast(bf16x8, ah), Al = __builtin_bit_cast(bf16x8, al);
#pragma unroll
              for (int ib = 0; ib < 4; ++ib) { const float* sp = sk + (size_t)(32 * ib + r) * 128 + d0; const f32x4 b0 = *(const f32x4*)sp, b1 = *(const f32x4*)(sp + 4);
                  u32x4 bh, bl; { float hi_[8], lo_[8];
#pragma unroll
                      for (int e = 0; e < 4; ++e) { hi_[e] = bflo(pk2(b0[e], 0.f)); lo_[e] = b0[e] - hi_[e]; hi_[4 + e] = bflo(pk2(b1[e], 0.f)); lo_[4 + e] = b1[e] - hi_[4 + e]; }
                      bh.x = pk2(hi_[0], hi_[1]); bh.y = pk2(hi_[2], hi_[3]); bh.z = pk2(hi_[4], hi_[5]); bh.w = pk2(hi_[6], hi_[7]);
                      bl.x = pk2(lo_[0], lo_[1]); bl.y = pk2(lo_[2], lo_[3]); bl.z = pk2(lo_[4], lo_[5]); bl.w = pk2(lo_[6], lo_[7]); }
                  const bf16x8 Bh = __builtin_bit_cast(bf16x8, bh), Bl = __builtin_bit_cast(bf16x8, bl);
                  acc[ib] = mfma32(Ah, Bh, acc[ib]); acc[ib] = mfma32(Ah, Bl, acc[ib]); acc[ib] = mfma32(Al, Bh, acc[ib]); } }
#pragma unroll
          for (int ib = 0; ib < 4; ++ib) { bf16_t* dst = WSC + ((size_t)l * 2048 + hj * 128 + 32 * ib + r) * 1024 + k0;
#pragma unroll
              for (int g4 = 0; g4 < 4; ++g4) { u32x2 w; w.x = pk2(acc[ib][4 * g4], acc[ib][4 * g4 + 1]); w.y = pk2(acc[ib][4 * g4 + 2], acc[ib][4 * g4 + 3]); *(u32x2*)(dst + 8 * g4 + 4 * hh) = w; } } } }
}

struct Row16 { float v[16]; };
__device__ __forceinline__ Row16 ld_row_f32(const float* p, int lane) { Row16 r; const f32x4 a = *(const f32x4*)(p + 8 * lane), b = *(const f32x4*)(p + 8 * lane + 4), c = *(const f32x4*)(p + 512 + 8 * lane), d = *(const f32x4*)(p + 512 + 8 * lane + 4);
#pragma unroll
    for (int e = 0; e < 4; ++e) { r.v[e] = a[e]; r.v[4 + e] = b[e]; r.v[8 + e] = c[e]; r.v[12 + e] = d[e]; } return r; }
__device__ __forceinline__ void st_row_f32(float* p, int lane, const Row16& r) {
    *(f32x4*)(p + 8 * lane) = (f32x4){r.v[0], r.v[1], r.v[2], r.v[3]}; *(f32x4*)(p + 8 * lane + 4) = (f32x4){r.v[4], r.v[5], r.v[6], r.v[7]};
    *(f32x4*)(p + 512 + 8 * lane) = (f32x4){r.v[8], r.v[9], r.v[10], r.v[11]}; *(f32x4*)(p + 512 + 8 * lane + 4) = (f32x4){r.v[12], r.v[13], r.v[14], r.v[15]}; }
__device__ __forceinline__ Row16 ld_row_bf16(const bf16_t* p, int lane) { Row16 r; const u32x4 a = *(const u32x4*)(p + 8 * lane), b = *(const u32x4*)(p + 512 + 8 * lane);
    r.v[0] = bflo(a.x); r.v[1] = bfhi(a.x); r.v[2] = bflo(a.y); r.v[3] = bfhi(a.y); r.v[4] = bflo(a.z); r.v[5] = bfhi(a.z); r.v[6] = bflo(a.w); r.v[7] = bfhi(a.w);
    r.v[8] = bflo(b.x); r.v[9] = bfhi(b.x); r.v[10] = bflo(b.y); r.v[11] = bfhi(b.y); r.v[12] = bflo(b.z); r.v[13] = bfhi(b.z); r.v[14] = bflo(b.w); r.v[15] = bfhi(b.w); return r; }
__device__ __forceinline__ void st_row_bf16(bf16_t* p, int lane, const Row16& r) {
    u32x4 a, b; a.x = pk2(r.v[0], r.v[1]); a.y = pk2(r.v[2], r.v[3]); a.z = pk2(r.v[4], r.v[5]); a.w = pk2(r.v[6], r.v[7]);
    b.x = pk2(r.v[8], r.v[9]); b.y = pk2(r.v[10], r.v[11]); b.z = pk2(r.v[12], r.v[13]); b.w = pk2(r.v[14], r.v[15]);
    *(u32x4*)(p + 8 * lane) = a; *(u32x4*)(p + 512 + 8 * lane) = b; }
__device__ __forceinline__ Row16 layer_norm_row(const Row16& v, const float* g, const float* b, int lane) {
    float s = 0.f;
#pragma unroll
    for (int e = 0; e < 16; ++e) s += v.v[e];
    const float mean = wave_sum(s) * (1.f / 1024.f); float q = 0.f;
#pragma unroll
    for (int e = 0; e < 16; ++e) { const float d = v.v[e] - mean; q += d * d; }
    const float rstd = 1.0f / sqrtf(wave_sum(q) * (1.f / 1024.f) + 1e-5f);
    const Row16 gg = ld_row_f32(g, lane), bb = ld_row_f32(b, lane); Row16 o;
#pragma unroll
    for (int e = 0; e < 16; ++e) o.v[e] = (v.v[e] - mean) * rstd * gg.v[e] + bb.v[e];
    return o;
}
__device__ __forceinline__ const float* mod_row(const Args& A, int layer, int tok) { const int b = tok / LTOK, p = tok - b * LTOK; return (const float*)(A.ws + WS_MOD) + ((size_t)layer * NR + (p < CTXL ? BATCH : b)) * 6144; }

__device__ __forceinline__ void ph_init(const Args& A, Frame& F) {
    bf16_t* X = (bf16_t*)(A.ws + WS_X); bf16_t* H = (bf16_t*)(A.ws + WS_H);
    for (int tok = F.bid * NWAVES + F.wave; tok < NTOK; tok += F.G * NWAVES) { const int b = tok / LTOK, p = tok - b * LTOK;
        const float* src = p < CTXL ? A.in[2] + ((size_t)b * CTXL + p) * DM : A.in[0] + ((size_t)b * SEQ + (p - CTXL)) * DM;
        const Row16 x = ld_row_f32(src, F.lane); st_row_bf16(X + (size_t)tok * DM, F.lane, x);
        const float* mod = mod_row(A, 0, tok); const Row16 sh = ld_row_f32(mod, F.lane), sc = ld_row_f32(mod + 1024, F.lane); Row16 h;
#pragma unroll
        for (int e = 0; e < 16; ++e) h.v[e] = x.v[e] * (1.f + sc.v[e]) + sh.v[e];
        st_row_bf16(H + (size_t)tok * DM, F.lane, h); }
}
struct LnStat { float mean, rstd; };
__device__ __forceinline__ LnStat ln_stats(const Row16& v) {
    float s = 0.f;
#pragma unroll
    for (int e = 0; e < 16; ++e) s += v.v[e];
    const float mean = wave_sum(s) * (1.f / 1024.f); float q = 0.f;
#pragma unroll
    for (int e = 0; e < 16; ++e) { const float d = v.v[e] - mean; q += d * d; }
    LnStat r; r.mean = mean; r.rstd = 1.0f / sqrtf(wave_sum(q) * (1.f / 1024.f) + 1e-5f); return r;
}
__device__ __forceinline__ void ph_rowop(const Args& A, Frame& F, int layer, bool dry = false) {
    bf16_t* X = (bf16_t*)(A.ws + WS_X); const bf16_t* OUT = (const bf16_t*)(A.ws + WS_OUT); bf16_t* H2 = (bf16_t*)(A.ws + WS_H2);
    const int ntk = layer == 3 ? BATCH * SEQ : NTOK; const int gw = F.bid * NWAVES + F.wave, NGW = F.G * NWAVES;
    const int t_beg = (int)(((long)gw * ntk) / NGW), t_end = (int)(((long)(gw + 1) * ntk) / NGW);
    const Row16 lg = ld_row_f32(A.in[6] + (size_t)(layer * 2) * DM, F.lane), lb = ld_row_f32(A.in[7] + (size_t)(layer * 2) * DM, F.lane);
    Row16 g1, sh, sc; int cls = -1;
    auto tokof = [&](int ti) { return layer == 3 ? (ti / SEQ) * LTOK + CTXL + (ti % SEQ) : ti; };
    auto finish = [&](int tok, const Row16& x, const Row16& o) {
        Row16 v;
#pragma unroll
        for (int e = 0; e < 16; ++e) v.v[e] = DN_ALPHA * x.v[e] + g1.v[e] * o.v[e];
        const LnStat st = ln_stats(v); Row16 x1, h;
#pragma unroll
        for (int e = 0; e < 16; ++e) { x1.v[e] = (v.v[e] - st.mean) * st.rstd * lg.v[e] + lb.v[e]; h.v[e] = x1.v[e] * (1.f + sc.v[e]) + sh.v[e]; }
        if (dry) { if (x1.v[0] == 12345.678f) st_row_bf16(H2 + (size_t)tok * DM, F.lane, x1); return; }
        st_row_bf16(X + (size_t)tok * DM, F.lane, x1); st_row_bf16(H2 + (size_t)tok * DM, F.lane, h); };
    for (int ti = t_beg; ti < t_end; ti += 2) { const int tokA = tokof(ti); const bool two = ti + 1 < t_end; const int tokB = two ? tokof(ti + 1) : tokA;
        const int clsA = (tokA / LTOK) * 2 + ((tokA % LTOK) < CTXL), clsB = (tokB / LTOK) * 2 + ((tokB % LTOK) < CTXL);
        const Row16 xA = ld_row_bf16(X + (size_t)tokA * DM, F.lane), oA = ld_row_bf16(OUT + (size_t)tokA * DM, F.lane);
        const Row16 xB = ld_row_bf16(X + (size_t)tokB * DM, F.lane), oB = ld_row_bf16(OUT + (size_t)tokB * DM, F.lane);
        if (clsA != cls) { const float* mod = mod_row(A, layer, tokA); g1 = ld_row_f32(mod + 2048, F.lane); sh = ld_row_f32(mod + 3072, F.lane); sc = ld_row_f32(mod + 4096, F.lane); cls = clsA; }
        finish(tokA, xA, oA);
        if (two) { if (clsB != cls) { const float* mod = mod_row(A, layer, tokB); g1 = ld_row_f32(mod + 2048, F.lane); sh = ld_row_f32(mod + 3072, F.lane); sc = ld_row_f32(mod + 4096, F.lane); cls = clsB; }
            finish(tokB, xB, oB); } }
}

__device__ __forceinline__ void ph_s5_scan(const Args& A, Frame& F, int j) {
    const int lane = F.lane, wave = F.wave, r = lane & 31, h = lane >> 5;
    constexpr int RS = 272, NSEG = 4, CPS = (LTOK / 32) / NSEG;
    static_assert((LTOK / 32) % NSEG == 0, "segments");
    unsigned char* Sb = F.lds + wave * (32 * RS);
    f32x2* XCH = (f32x2*)(F.lds + 8 * 32 * RS);
    const bf16_t* H = (const bf16_t*)(A.ws + WS_H);
    const int il = wave >> 2, seg = wave & 3;
    for (int it0 = 2 * F.bid; it0 < BATCH * 128; it0 += 2 * F.G) { const int item = it0 + il; const bool act = item < BATCH * 128;
        const int g = item & 63, dir = (item >> 6) & 1, b = item >> 7;
        const unsigned char* cb = A.ws + WS_S5C + (size_t)((j * 2 + dir) * 64 + g) * S5C_ITEM;
        f32x2 ab = {0.f, 0.f}; bf16x8 Bf[4], Cf[8];
        if (act) { ab = ((const f32x2*)cb)[lane];
#pragma unroll
            for (int q = 0; q < 4; ++q) Bf[q] = ((const bf16x8*)(cb + 512))[q * 64 + lane]; }
        const float are = ab.x, aim = ab.y;
        bf16_t* Y = (bf16_t*)(A.ws + (dir ? WS_YB : WS_YF));
        float sre = 0.f, sim = 0.f;
        const int sbeg = seg * CPS * 32;
#define S5_LOADU(s0) (*(const bf16x8*)(H + ((size_t)b * LTOK + seqpos(dir, (s0) + r)) * DM + g * 16 + 8 * h))
#define S5_BU(ua) do { f32x16 a0 = {}, a1 = {}, a2 = {}, a3 = {}; a0 = mfma32(ua, Bf[0], a0); a2 = mfma32(ua, Bf[2], a2); a1 = mfma32(ua, Bf[1], a1); a3 = mfma32(ua, Bf[3], a3); \
            _Pragma("unroll") for (int q = 0; q < 16; ++q) { *(unsigned*)(Sb + crow(q, h) * RS + r * 4) = pk2(a0[q], a2[q]); *(unsigned*)(Sb + crow(q, h) * RS + (32 + r) * 4) = pk2(a1[q], a3[q]); } } while (0)
        if (act && seg < NSEG - 1) {
            const f32x2 abx = ((const f32x2*)cb)[32 + r]; const float ar0 = ((const f32x2*)cb)[r].x, ai0 = ((const f32x2*)cb)[r].y, ar1 = abx.x, ai1 = abx.y;
            float w0r[16], w0i[16], w1r[16], w1i[16];
            { float p0r = 1.f, p0i = 0.f, p1r = 1.f, p1i = 0.f;
#pragma unroll
              for (int q = 0; q < 16; ++q) { w0r[q] = 0.f; w0i[q] = 0.f; w1r[q] = 0.f; w1i[q] = 0.f; }
#pragma unroll
              for (int k = 0; k < 32; ++k) {
#pragma unroll
                  for (int q = 0; q < 16; ++q) { const int k0 = 31 - ((q & 3) + 8 * (q >> 2));
                      if (k0 == k) { w0r[q] = h ? w0r[q] : p0r; w0i[q] = h ? w0i[q] : p0i; w1r[q] = h ? w1r[q] : p1r; w1i[q] = h ? w1i[q] : p1i; }
                      if (k0 - 4 == k) { w0r[q] = h ? p0r : w0r[q]; w0i[q] = h ? p0i : w0i[q]; w1r[q] = h ? p1r : w1r[q]; w1i[q] = h ? p1i : w1i[q]; } }
                  { const float t_ = p0r * ar0 - p0i * ai0; p0i = p0r * ai0 + p0i * ar0; p0r = t_; } { const float t_ = p1r * ar1 - p1i * ai1; p1i = p1r * ai1 + p1i * ar1; p1r = t_; } }
              float s0r = 0.f, s0i = 0.f, s1r = 0.f, s1i = 0.f; bf16x8 un = S5_LOADU(sbeg);
              for (int c = 0; c < CPS; ++c) { const int s0 = sbeg + 32 * c; const bf16x8 ua = un; if (c + 1 < CPS) un = S5_LOADU(s0 + 32);
                  f32x16 a0 = {}, a1 = {}, a2 = {}, a3 = {}; a0 = mfma32(ua, Bf[0], a0); a2 = mfma32(ua, Bf[2], a2); a1 = mfma32(ua, Bf[1], a1); a3 = mfma32(ua, Bf[3], a3);
                  float q0r = 0.f, q0i = 0.f, q1r = 0.f, q1i = 0.f;
#pragma unroll
                  for (int q = 0; q < 16; ++q) { q0r += w0r[q] * a0[q] - w0i[q] * a2[q]; q0i += w0r[q] * a2[q] + w0i[q] * a0[q]; q1r += w1r[q] * a1[q] - w1i[q] * a3[q]; q1i += w1r[q] * a3[q] + w1i[q] * a1[q]; }
                  { const float t_ = p0r * s0r - p0i * s0i + q0r; s0i = p0r * s0i + p0i * s0r + q0i; s0r = t_; } { const float t_ = p1r * s1r - p1i * s1i + q1r; s1i = p1r * s1i + p1i * s1r + q1i; s1r = t_; } }
              s0r += __shfl_xor(s0r, 32); s0i += __shfl_xor(s0i, 32); s1r += __shfl_xor(s1r, 32); s1i += __shfl_xor(s1i, 32);
              XCH[(il * NSEG + seg) * 64 + lane] = h == 0 ? (f32x2){s0r, s0i} : (f32x2){s1r, s1i}; } }
        __syncthreads();
        { float pr = are, pi = aim, ar_ = 1.f, ai_ = 0.f;
          for (int e = CPS * 32; e > 0; e >>= 1) { if (e & 1) { const float t_ = ar_ * pr - ai_ * pi; ai_ = ar_ * pi + ai_ * pr; ar_ = t_; } const float t2 = pr * pr - pi * pi; pi = 2.f * pr * pi; pr = t2; }
          sre = 0.f; sim = 0.f;
          for (int k = 0; k < seg; ++k) { const f32x2 f = XCH[(il * NSEG + k) * 64 + lane]; const float nre = ar_ * sre - ai_ * sim + f.x, nim = ar_ * sim + ai_ * sre + f.y; sre = nre; sim = nim; } }
        if (act) {
            int lane2 = lane;
#ifndef CPU_EMU
            asm volatile("" : "+v"(lane2));
#endif
            const int r = lane2 & 31, h = lane2 >> 5, lane = lane2; (void)lane;
#pragma unroll
            for (int q = 0; q < 8; ++q) Cf[q] = ((const bf16x8*)(cb + 512 + 4096))[q * 64 + lane];
            bf16x8 un = S5_LOADU(sbeg);
            for (int c = 0; c < CPS; ++c) { const int s0 = sbeg + 32 * c; const bf16x8 ua = un; if (c + 1 < CPS) un = S5_LOADU(s0 + 32);
                S5_BU(ua); wave_sync();
#pragma unroll 8
                for (int t = 0; t < 32; ++t) { unsigned* wp = (unsigned*)(Sb + t * RS + lane * 4); const unsigned w = *wp; const float bre = bflo(w), bim = bfhi(w);
                    const float nre = are * sre - aim * sim + bre, nim = are * sim + aim * sre + bim; sre = nre; sim = nim; *wp = pk2(sre, sim); }
                wave_sync();
                f32x16 y = {};
#pragma unroll
                for (int ks = 0; ks < 8; ++ks) { const bf16x8 sa = *(const bf16x8*)(Sb + r * RS + (16 * ks + 8 * h) * 2); y = mfma32(Cf[ks], sa, y); }
                { bf16_t* yp = Y + ((size_t)b * LTOK + seqpos(dir, s0 + r)) * DM + g * 16 + 4 * h;
                  u32x2 w0, w1; w0.x = pk2(y[0], y[1]); w0.y = pk2(y[2], y[3]); w1.x = pk2(y[4], y[5]); w1.y = pk2(y[6], y[7]);
                  *(u32x2*)yp = w0; *(u32x2*)(yp + 8) = w1; }
                wave_sync(); } }
        __syncthreads();
#undef S5_LOADU
#undef S5_BU
    }
}
__device__ __forceinline__ void ph_s5_combine(const Args& A, Frame& F, int j) {
    const bf16_t* H = (const bf16_t*)(A.ws + WS_H); const bf16_t* YF = (const bf16_t*)(A.ws + WS_YF); const bf16_t* YB = (const bf16_t*)(A.ws + WS_YB); bf16_t* Gb = (bf16_t*)(A.ws + WS_G);
    const Row16 d = ld_row_f32(A.in[15] + (size_t)j * DM, F.lane); const int NGW = F.G * NWAVES;
    for (int tok = F.bid * NWAVES + F.wave; tok < NTOK; tok += 2 * NGW) { const int tokB = tok + NGW; const bool two = tokB < NTOK; const size_t oA = (size_t)tok * DM, oB = (size_t)(two ? tokB : tok) * DM;
        const Row16 hA = ld_row_bf16(H + oA, F.lane), fA = ld_row_bf16(YF + oA, F.lane), bA = ld_row_bf16(YB + oA, F.lane);
        const Row16 hB = ld_row_bf16(H + oB, F.lane), fB = ld_row_bf16(YF + oB, F.lane), bB = ld_row_bf16(YB + oB, F.lane); Row16 o;
#pragma unroll
        for (int e = 0; e < 16; ++e) o.v[e] = gelu_tanh(d.v[e] * hA.v[e] + fA.v[e] + bA.v[e]);
        st_row_bf16(Gb + oA, F.lane, o);
        if (two) {
#pragma unroll
            for (int e = 0; e < 16; ++e) o.v[e] = gelu_tanh(d.v[e] * hB.v[e] + fB.v[e] + bB.v[e]);
            st_row_bf16(Gb + oB, F.lane, o); } }
}

__device__ __forceinline__ void ph_ssd_conv(const Args& A, Frame& F) {
    const bf16_t* XBC = (const bf16_t*)(A.ws + WS_XBC); bf16_t* XC = (bf16_t*)(A.ws + WS_XBCC); const float* DT = (const float*)(A.ws + WS_DT); float* DTS = (float*)(A.ws + WS_DTS);
    const float* cw = A.in[19]; const float* cbias = A.in[20]; const float* dtb = A.in[21];
    const long gt = (long)F.bid * NTHR + F.tid, GT = (long)F.G * NTHR;
    for (long i = gt; i < (long)NTOK * 384; i += GT) { const int tok = (int)(i / 384), ch = (int)(i % 384) * 8; const int p = tok % LTOK;
        const bool hp = (p != 0 && p != CTXL), hn = (p != CTXL - 1 && p != LTOK - 1);
        const u32x4 z4 = {0u, 0u, 0u, 0u};
        const u32x4 c0 = *(const u32x4*)(XBC + (size_t)tok * 3072 + ch);
        const u32x4 cm = hp ? *(const u32x4*)(XBC + (size_t)(tok - 1) * 3072 + ch) : z4;
        const u32x4 cp = hn ? *(const u32x4*)(XBC + (size_t)(tok + 1) * 3072 + ch) : z4;
        float o[8];
#pragma unroll
        for (int e = 0; e < 4; ++e) { const unsigned wm = cm[e], w0 = c0[e], wp = cp[e]; const int c = ch + 2 * e;
            o[2 * e] = siluf_(cbias[c] + cw[c] * bflo(wm) + cw[3072 + c] * bflo(w0) + cw[6144 + c] * bflo(wp));
            o[2 * e + 1] = siluf_(cbias[c + 1] + cw[c + 1] * bfhi(wm) + cw[3072 + c + 1] * bfhi(w0) + cw[6144 + c + 1] * bfhi(wp)); }
        u32x4 w; w.x = pk2(o[0], o[1]); w.y = pk2(o[2], o[3]); w.z = pk2(o[4], o[5]); w.w = pk2(o[6], o[7]);
        *(u32x4*)(XC + (size_t)tok * 3072 + ch) = w; }
    { float* ACUM = (float*)(A.ws + WS_ACUM);
      for (long i = gt; i < (long)(NTOK / 64) * 64; i += GT) { const int blk = (int)(i >> 6), j = (int)(i & 63); const int dir = j >> 5; const float Aj = -__expf(A.in[22][j]); const float bj = dtb[j]; float ac = 0.f;
          for (int k = 0; k < 64; ++k) { const size_t tk = (size_t)blk * 64 + (dir ? 63 - k : k); const float x = DT[tk * 64 + j] + bj; const float dt = x > 20.f ? x : log1pf(__expf(x));
              DTS[tk * 64 + j] = dt; ac += dt * Aj; ACUM[tk * 64 + j] = ac; } } }
}
__device__ __forceinline__ int ssd_tokbase(int dir, int c) { return dir == 0 ? 64 * c : (c < CTXL / 64 ? CTXL - 64 * (c + 1) : LTOK + CTXL - 64 * (c + 1)); }
__device__ __forceinline__ bf16x8 tr_frag(const unsigned char* T, int rs, int s0, int c0, int lane) {
    const int i = lane & 15, hh = lane >> 5, rb = 16 * ((lane >> 4) & 1); const unsigned char* p = T + (s0 + 8 * hh + (i >> 2)) * rs + (c0 + rb + 4 * (i & 3)) * 2;
    const s16x4 lo = lds_tr(p), hi = lds_tr(p + 4 * rs); return (bf16x8){lo[0], lo[1], lo[2], lo[3], hi[0], hi[1], hi[2], hi[3]};
}
__device__ __forceinline__ void ph_ssd_scan(const Args& A, Frame& F) {
    const int tid = F.tid, lane = F.lane, wave = F.wave, r = lane & 31, hi = lane >> 5;
    constexpr int RS_BC = 272, RS_X = 144, O_CN = 0, O_BN = 17408, O_XN = 34816, O_XS = 44032, O_ML = 53248, O_SP = 62464, O_VEC = 79872;
    constexpr int O_CN2 = 80896, O_BN2 = 98304, O_XN2 = 115712, O_XS2 = 132096, O_VEC2 = 141312;
    unsigned char* L = F.lds;
    const bf16_t* XC = (const bf16_t*)(A.ws + WS_XBCC); const float* DTS = (const float*)(A.ws + WS_DTS); const float* ACUM = (const float*)(A.ws + WS_ACUM);
    constexpr int NCH = LTOK / 64;
    for (int item = F.bid; item < BATCH * 64; item += F.G) { const int hh = item & 31, dir = (item >> 5) & 1, b = item >> 6, grp = hh >> 3, jj = dir * 32 + hh;
        bf16_t* Y = (bf16_t*)(A.ws + (dir ? WS_YB2 : WS_YF2));
        f32x16 st = {};
        for (int i = tid; i < 64 * 17; i += NTHR) *(u32x4*)(L + O_SP + i * 16) = (u32x4){0u, 0u, 0u, 0u};
        u32x4 rC[2], rB[2], rX; float rdt = 0.f, rac = 0.f, rws = 0.f;
#define SSD_LOAD(c) do { const size_t t0 = (size_t)b * LTOK + ssd_tokbase(dir, (c)); \
            _Pragma("unroll") for (int k = 0; k < 2; ++k) { const int id = tid + 512 * k, row = id >> 4, c8 = (id & 15) * 8; \
                rC[k] = *(const u32x4*)(XC + (t0 + row) * 3072 + 2560 + grp * 128 + c8); rB[k] = *(const u32x4*)(XC + (t0 + row) * 3072 + 2048 + grp * 128 + c8); } \
            { const int row = tid >> 3; rX = *(const u32x4*)(XC + (t0 + row) * 3072 + hh * 64 + (tid & 7) * 8); \
              const float dt_ = DTS[(t0 + row) * 64 + jj], ac_ = ACUM[(t0 + row) * 64 + jj], at_ = ACUM[(t0 + (dir ? 0 : 63)) * 64 + jj]; rws = dt_ * __expf(at_ - ac_); \
              if (tid < 64) { rdt = DTS[(t0 + tid) * 64 + jj]; rac = ACUM[(t0 + tid) * 64 + jj]; } } } while (0)
#define SSD_WRITE(oCN_, oBN_, oXN_, oXS_, oV_) do { float* dtv_ = (float*)(L + (oV_)); float* acv_ = dtv_ + 64; float* eac_ = acv_ + 64; _Pragma("unroll") for (int k = 0; k < 2; ++k) { const int id = tid + 512 * k, row = id >> 4, c8 = (id & 15) * 8; \
                *(u32x4*)(L + (oCN_) + row * RS_BC + c8 * 2) = rC[k]; *(u32x4*)(L + (oBN_) + row * RS_BC + c8 * 2) = rB[k]; } \
            { const int row = tid >> 3, c8 = (tid & 7) * 8; *(u32x4*)(L + (oXN_) + row * RS_X + c8 * 2) = rX; u32x4 xs_; \
              xs_.x = pk2(bflo(rX.x) * rws, bfhi(rX.x) * rws); xs_.y = pk2(bflo(rX.y) * rws, bfhi(rX.y) * rws); xs_.z = pk2(bflo(rX.z) * rws, bfhi(rX.z) * rws); xs_.w = pk2(bflo(rX.w) * rws, bfhi(rX.w) * rws); \
              *(u32x4*)(L + (oXS_) + row * RS_X + c8 * 2) = xs_; } \
            if (tid < 64) { dtv_[tid] = rdt; acv_[tid] = rac; eac_[tid] = __expf(rac); } } while (0)
        SSD_LOAD(0); __syncthreads(); SSD_WRITE(O_CN, O_BN, O_XN, O_XS, O_VEC); __syncthreads();
        for (int c = 0; c < NCH; ++c) { const bool par = (c & 1) != 0;
            const int oCN = par ? O_CN2 : O_CN, oBN = par ? O_BN2 : O_BN, oXN = par ? O_XN2 : O_XN, oXS = par ? O_XS2 : O_XS; const float* dtv = (const float*)(L + (par ? O_VEC2 : O_VEC)); const float* acv = dtv + 64; const float* eac = acv + 64;
            if (c + 1 < NCH) SSD_LOAD(c + 1);
            const size_t t0 = (size_t)b * LTOK + ssd_tokbase(dir, c);
            f32x16 yacc = {};
            int pb = 0, qb = 0;
            if (wave < 4) { pb = wave >> 1; qb = wave & 1;
#pragma unroll
                for (int t = 0; t < 8; ++t) { const bf16x8 af = *(const bf16x8*)(L + O_SP + (32 * pb + r) * RS_BC + (16 * t + 8 * hi) * 2), bfr = *(const bf16x8*)(L + oCN + (32 * qb + r) * RS_BC + (16 * t + 8 * hi) * 2);
                    yacc = mfma32(af, bfr, yacc); }
                const float eq = eac[32 * qb + r];
#pragma unroll
                for (int q = 0; q < 16; ++q) yacc[q] *= eq;
            } else if (wave < 7) { const int ti = wave - 4; const int sb = dir == 0 ? (ti == 2) : (ti >= 1), qb2 = dir == 0 ? (ti >= 1) : (ti == 2);
                f32x16 m = {};
#pragma unroll
                for (int t = 0; t < 8; ++t) { const bf16x8 af = *(const bf16x8*)(L + oBN + (32 * sb + r) * RS_BC + (16 * t + 8 * hi) * 2), bfr = *(const bf16x8*)(L + oCN + (32 * qb2 + r) * RS_BC + (16 * t + 8 * hi) * 2);
                    m = mfma32(af, bfr, m); }
                const int qi = 32 * qb2 + r; const float aq = acv[qi];
#pragma unroll
                for (int g4 = 0; g4 < 4; ++g4) { float v[4];
#pragma unroll
                    for (int e = 0; e < 4; ++e) { const int si = 32 * sb + 8 * g4 + 4 * hi + e; const bool ok = dir == 0 ? (si <= qi) : (si >= qi);
                        v[e] = ok ? m[4 * g4 + e] * dtv[si] * __expf(aq - acv[si]) : 0.f; }
                    u32x2 w; w.x = pk2(v[0], v[1]); w.y = pk2(v[2], v[3]); *(u32x2*)(L + O_ML + qi * RS_X + (32 * sb + 8 * g4 + 4 * hi) * 2) = w; }
            }
            __syncthreads();
            if (wave < 4) {
#pragma unroll
                for (int sb = 0; sb < 2; ++sb) { const bool use = dir == 0 ? (sb <= qb) : (sb >= qb);
                    if (use) {
#pragma unroll
                        for (int kk = 0; kk < 2; ++kk) { const int s0 = 32 * sb + 16 * kk;
                            const bf16x8 af = tr_frag(L + oXN, RS_X, s0, 32 * pb, lane);
                            const bf16x8 bfr = *(const bf16x8*)(L + O_ML + (32 * qb + r) * RS_X + (s0 + 8 * hi) * 2);
                            yacc = mfma32(af, bfr, yacc); } } }
                bf16_t* yp = Y + (t0 + 32 * qb + r) * 2048 + hh * 64 + 32 * pb;
#pragma unroll
                for (int g4 = 0; g4 < 4; ++g4) { u32x2 w; w.x = pk2(yacc[4 * g4], yacc[4 * g4 + 1]); w.y = pk2(yacc[4 * g4 + 2], yacc[4 * g4 + 3]); *(u32x2*)(yp + 8 * g4 + 4 * hi) = w; }
            }
            { const int nb = wave >> 1, pb2 = wave & 1; const float dec = __expf(acv[dir ? 0 : 63]);
#pragma unroll
              for (int q = 0; q < 16; ++q) st[q] *= dec;
#pragma unroll
              for (int t = 0; t < 4; ++t) { const bf16x8 af = tr_frag(L + oBN, RS_BC, 16 * t, 32 * nb, lane), bfr = tr_frag(L + oXS, RS_X, 16 * t, 32 * pb2, lane); st = mfma32(af, bfr, st); }
            }
            { const int nb = wave >> 1, pb2 = wave & 1;
#pragma unroll
              for (int g4 = 0; g4 < 4; ++g4) { u32x2 w; w.x = pk2(st[4 * g4], st[4 * g4 + 1]); w.y = pk2(st[4 * g4 + 2], st[4 * g4 + 3]); *(u32x2*)(L + O_SP + (32 * pb2 + r) * RS_BC + (32 * nb + 8 * g4 + 4 * hi) * 2) = w; } }
            if (c + 1 < NCH) { if (par) SSD_WRITE(O_CN, O_BN, O_XN, O_XS, O_VEC); else SSD_WRITE(O_CN2, O_BN2, O_XN2, O_XS2, O_VEC2); }
            __syncthreads();
        }
#undef SSD_LOAD
#undef SSD_WRITE
    }
}
__device__ __forceinline__ void ph_ssd_gate(const Args& A, Frame& F) {
    const bf16_t* YF = (const bf16_t*)(A.ws + WS_YF2); const bf16_t* YB = (const bf16_t*)(A.ws + WS_YB2); const bf16_t* XC = (const bf16_t*)(A.ws + WS_XBCC); const bf16_t* Z = (const bf16_t*)(A.ws + WS_Z);
    bf16_t* G2 = (bf16_t*)(A.ws + WS_G2); const float* Dh = A.in[23]; const int NGW = F.G * NWAVES;
    float dh[4];
#pragma unroll
    for (int j = 0; j < 4; ++j) dh[j] = Dh[(512 * j + 8 * F.lane) >> 6];
    for (int tok = F.bid * NWAVES + F.wave; tok < NTOK; tok += 2 * NGW) { const int tokB = tok + NGW; const bool two = tokB < NTOK; const int tk[2] = {tok, two ? tokB : tok};
        u32x4 a[2][4], bq[2][4], x[2][4], z[2][4];
#pragma unroll
        for (int t = 0; t < 2; ++t)
#pragma unroll
            for (int j = 0; j < 4; ++j) { const int d0 = 512 * j + 8 * F.lane;
                a[t][j] = *(const u32x4*)(YF + (size_t)tk[t] * 2048 + d0); bq[t][j] = *(const u32x4*)(YB + (size_t)tk[t] * 2048 + d0); x[t][j] = *(const u32x4*)(XC + (size_t)tk[t] * 3072 + d0); z[t][j] = *(const u32x4*)(Z + (size_t)tk[t] * 2048 + d0); }
#pragma unroll
        for (int t = 0; t < 2; ++t) { if (t == 1 && !two) break; float v[32]; float ss = 0.f;
#pragma unroll
            for (int j = 0; j < 4; ++j)
#pragma unroll
                for (int e = 0; e < 4; ++e) { const float v0 = (bflo(a[t][j][e]) + bflo(bq[t][j][e]) + dh[j] * bflo(x[t][j][e])) * siluf_(bflo(z[t][j][e])), v1 = (bfhi(a[t][j][e]) + bfhi(bq[t][j][e]) + dh[j] * bfhi(x[t][j][e])) * siluf_(bfhi(z[t][j][e]));
                    v[8 * j + 2 * e] = v0; v[8 * j + 2 * e + 1] = v1; ss += v0 * v0 + v1 * v1; }
            const float rn = 1.0f / sqrtf(wave_sum(ss) * (1.f / 2048.f) + 1e-6f);
#pragma unroll
            for (int j = 0; j < 4; ++j) { u32x4 w; w.x = pk2(v[8 * j] * rn, v[8 * j + 1] * rn); w.y = pk2(v[8 * j + 2] * rn, v[8 * j + 3] * rn); w.z = pk2(v[8 * j + 4] * rn, v[8 * j + 5] * rn); w.w = pk2(v[8 * j + 6] * rn, v[8 * j + 7] * rn);
                *(u32x4*)(G2 + (size_t)tk[t] * 2048 + 512 * j + 8 * F.lane) = w; } } }
}

__device__ __forceinline__ void mla_kr(const Args& A, Frame& F) {
    const bf16_t* C = (const bf16_t*)(A.ws + WS_CQKV); bf16_t* Kb = (bf16_t*)(A.ws + WS_K); const float* ROPE = (const float*)(A.ws + WS_ROPE);
    const long gt = (long)F.bid * NTHR + F.tid, GT = (long)F.G * NTHR;
    for (long idx = gt; idx < (long)NTOK * 16; idx += GT) { const int tok = (int)(idx >> 4), i = (int)(idx & 15); const int b = tok / LTOK, p = tok - b * LTOK;
        const int o1 = (i < 8) ? i : 16 + (i - 8); float x1 = bf2f(C[(size_t)tok * 512 + 384 + o1]), x2 = bf2f(C[(size_t)tok * 512 + 384 + o1 + 8]);
        if (p >= CTXL) { const int t = p - CTXL; const int pos = (i < 8) ? (t >> 6) : (t & 63); const float c = ROPE[(pos * 8 + (i & 7)) * 2], s = ROPE[(pos * 8 + (i & 7)) * 2 + 1];
            const float y1 = x1 * c - x2 * s, y2 = x2 * c + x1 * s; x1 = y1; x2 = y2; }
        const unsigned w = pk2(x1, x2);
#pragma unroll 4
        for (int hd = 0; hd < 16; ++hd) *(unsigned*)(Kb + ((size_t)(b * 16 + hd) * LTOK + p) * 128 + 64 + 2 * i) = w; }
}
__device__ __forceinline__ void ph_attn(const Args& A, Frame& F) {
    const bf16_t* Q = (const bf16_t*)(A.ws + WS_Q); const bf16_t* Kb = (const bf16_t*)(A.ws + WS_K); const bf16_t* Vb = (const bf16_t*)(A.ws + WS_V); bf16_t* O = (bf16_t*)(A.ws + WS_O);
    constexpr int NLQ = SEQ / 256, NCQ = CTXL / 256, NLU = BATCH * 16 * NLQ, NU = NLU + BATCH * 16 * NCQ;
    const int vb = (F.G % 8 == 0) ? (F.bid % 8) * (F.G / 8) + F.bid / 8 : F.bid;
    for (int u = vb; u < NU; u += F.G) { int bh, p0, seq;
        if (u < NLU) { bh = u / NLQ; p0 = CTXL + (u % NLQ) * 256; seq = LTOK; } else { const int v = u - NLU; bh = v / NCQ; p0 = (v % NCQ) * 256; seq = CTXL; }
        const int b = bh >> 4, hd = bh & 15;
        att::attn_body(Q + ((size_t)bh * LTOK + p0) * 128, Kb + (size_t)bh * LTOK * 128, Vb + (size_t)bh * LTOK * 64, O + ((size_t)b * LTOK + p0) * DM + hd * 64, seq,
#ifdef CPU_EMU
                       F.lds,
#else
                       (char*)F.lds,
#endif
                       p0 >= CTXL ? p0 - CTXL : -1, (const float*)(A.ws + WS_ROPE), F.wave); }
}

__device__ __forceinline__ float ub0(unsigned w) { return (float)(w & 0xffu); }
__device__ __forceinline__ float ub1(unsigned w) { return (float)((w >> 8) & 0xffu); }
__device__ __forceinline__ float ub2(unsigned w) { return (float)((w >> 16) & 0xffu); }
__device__ __forceinline__ float ub3(unsigned w) { return (float)(w >> 24); }
#ifdef CPU_EMU
__device__ __forceinline__ unsigned udot4(unsigned a, unsigned b, unsigned c) { for (int i = 0; i < 4; ++i) c += ((a >> (8 * i)) & 255u) * ((b >> (8 * i)) & 255u); return c; }
#else
__device__ __forceinline__ unsigned udot4(unsigned a, unsigned b, unsigned c) { return __builtin_amdgcn_udot4(a, b, c, false); }
#endif
#ifdef CPU_EMU
__device__ __forceinline__ unsigned med3u(unsigned a, unsigned b, unsigned c) { const unsigned mn = a < b ? a : b, mx = a < b ? b : a; const unsigned t = mx < c ? mx : c; return mn > t ? mn : t; }
__device__ __forceinline__ unsigned lane_xor1(unsigned x) { return __shfl_xor(x, 1); }
#else
__device__ __forceinline__ unsigned med3u(unsigned a, unsigned b, unsigned c) { unsigned r; asm("v_med3_u32 %0, %1, %2, %3" : "=v"(r) : "v"(a), "v"(b), "v"(c)); return r; }
__device__ __forceinline__ unsigned lane_xor1(unsigned x) { return (unsigned)__builtin_amdgcn_update_dpp(0, (int)x, 0xB1, 0xF, 0xF, true); }
#endif
#define TOP16_INSERT(t, x) do { _Pragma("unroll") for (int k_ = 15; k_ >= 1; --k_) t[k_] = med3u(t[k_ - 1], t[k_], (x)); t[0] = t[0] > (x) ? t[0] : (x); } while (0)
__device__ __forceinline__ int peer_tok(int layer, int ti) { return layer == 3 ? (ti / SEQ) * LTOK + CTXL + (ti % SEQ) : ti; }
#ifdef CPU_EMU
__device__ __forceinline__ int ror8_i(int v) { return __shfl_xor(v, 8); }
__device__ __forceinline__ void lane_pair16(int x, int& lo, int& hi) { const int o = __shfl_xor(x, 16); const bool up = (threadIdx.x >> 4) & 1; lo = up ? o : x; hi = up ? x : o; }
__device__ __forceinline__ void lane_pair32(int x, int& lo, int& hi) { const int o = __shfl_xor(x, 32); const bool up = (threadIdx.x >> 5) & 1; lo = up ? o : x; hi = up ? x : o; }
#else
__device__ __forceinline__ int ror8_i(int v) { return __builtin_amdgcn_update_dpp(0, v, 0x128, 0xF, 0xF, true); }
__device__ __forceinline__ void lane_pair16(int x, int& lo, int& hi) { auto rr = __builtin_amdgcn_permlane16_swap((unsigned)x, (unsigned)x, false, false); lo = (int)rr[0]; hi = (int)rr[1]; }
__device__ __forceinline__ void lane_pair32(int x, int& lo, int& hi) { auto rr = __builtin_amdgcn_permlane32_swap((unsigned)x, (unsigned)x, false, false); lo = (int)rr[0]; hi = (int)rr[1]; }
#endif
#ifdef CPU_EMU
__device__ __forceinline__ unsigned bperm(unsigned s0, unsigned s1, unsigned sel) { const unsigned long long v = ((unsigned long long)s0 << 32) | s1; unsigned r = 0; for (int i = 0; i < 4; ++i) { const unsigned k = (sel >> (8 * i)) & 255u; const unsigned byte = k < 8u ? (unsigned)((v >> (8 * k)) & 255ull) : (k == 12u ? 0u : 255u); r |= byte << (8 * i); } return r; }
#else
__device__ __forceinline__ unsigned bperm(unsigned s0, unsigned s1, unsigned sel) { return __builtin_amdgcn_perm(s0, s1, sel); }
#endif
#ifdef CPU_EMU
__device__ __forceinline__ int sdot4(unsigned a, unsigned b, int c) { for (int i = 0; i < 4; ++i) c += (int)(signed char)(a >> (8 * i)) * (int)(signed char)(b >> (8 * i)); return c; }
__device__ __forceinline__ float sum_bits012(float v) { v += __shfl_xor(v, 1); v += __shfl_xor(v, 2); v += __shfl_xor(v, 4); return v; }
#else
__device__ __forceinline__ int sdot4(unsigned a, unsigned b, int c) { return __builtin_amdgcn_sdot4((int)a, (int)b, c, false); }
__device__ __forceinline__ float sum_bits012(float v) { v += dpp_f<0xB1>(v); v += dpp_f<0x4E>(v); v += dpp_f<0x141>(v); return v; }
#endif
#ifdef CPU_EMU
__device__ __forceinline__ float sum_bits345(float v) { v += __shfl_xor(v, 8); v += __shfl_xor(v, 16); v += __shfl_xor(v, 32); return v; }
#else
__device__ __forceinline__ float sum_bits345(float v) {
    v += dpp_f<0x128>(v);
    { auto rr = __builtin_amdgcn_permlane16_swap(__float_as_uint(v), __float_as_uint(v), false, false); v = __uint_as_float(rr[0]) + __uint_as_float(rr[1]); }
    { auto rr = __builtin_amdgcn_permlane32_swap(__float_as_uint(v), __float_as_uint(v), false, false); v = __uint_as_float(rr[0]) + __uint_as_float(rr[1]); }
    return v;
}
#endif
#ifdef CPU_EMU
__device__ __forceinline__ float merge_bit3(float a, float b) { const bool hi = (threadIdx.x >> 3) & 1; const float k = hi ? b : a, t = hi ? a : b; return k + __shfl_xor(t, 8); }
__device__ __forceinline__ float merge_bit4(float a, float b) { const bool hi = (threadIdx.x >> 4) & 1; const float k = hi ? b : a, t = hi ? a : b; return k + __shfl_xor(t, 16); }
__device__ __forceinline__ float merge_bit5(float a, float b) { const bool hi = (threadIdx.x >> 5) & 1; const float k = hi ? b : a, t = hi ? a : b; return k + __shfl_xor(t, 32); }
#else
__device__ __forceinline__ float merge_bit3(float a, float b) {
    const int x = __builtin_amdgcn_update_dpp(__builtin_bit_cast(int, b), __builtin_bit_cast(int, a), 0x128, 0xF, 0x3, false);
    const int y = __builtin_amdgcn_update_dpp(__builtin_bit_cast(int, a), __builtin_bit_cast(int, b), 0x128, 0xF, 0xC, false);
    return __builtin_bit_cast(float, x) + __builtin_bit_cast(float, y); }
__device__ __forceinline__ float merge_bit4(float a, float b) { auto rr = __builtin_amdgcn_permlane16_swap(__float_as_uint(a), __float_as_uint(b), false, false); return __uint_as_float(rr[0]) + __uint_as_float(rr[1]); }
__device__ __forceinline__ float merge_bit5(float a, float b) { auto rr = __builtin_amdgcn_permlane32_swap(__float_as_uint(a), __float_as_uint(b), false, false); return __uint_as_float(rr[0]) + __uint_as_float(rr[1]); }
#endif
#ifdef CPU_EMU
template <int K> __device__ __forceinline__ unsigned quad_bcast(unsigned v) { return __shfl(v, (int)((threadIdx.x & 63 & ~3) | K)); }
#else
template <int K> __device__ __forceinline__ unsigned quad_bcast(unsigned v) { return (unsigned)__builtin_amdgcn_update_dpp(0, (int)v, K * 0x55, 0xF, 0xF, true); }
#endif
#define EL_LOAD(ELQ, TOK) do { ELQ = *(const u32x4*)(PL + (size_t)(TOK) * 512 + 16 * e8 + 4 * (lane & 3)); } while (0)
#define EL_GET(ELQ, i) ((i) >> 2) == 0 ? quad_bcast<0>(ELQ[(i) & 3]) : ((i) >> 2) == 1 ? quad_bcast<1>(ELQ[(i) & 3]) : ((i) >> 2) == 2 ? quad_bcast<2>(ELQ[(i) & 3]) : quad_bcast<3>(ELQ[(i) & 3])
#ifdef CPU_EMU
__device__ __forceinline__ float fmerge_bit2(float a, float b) { const bool hi = (threadIdx.x >> 2) & 1; const float k = hi ? b : a, t = hi ? a : b; return k + __shfl_xor(t, 7); }
__device__ __forceinline__ float fmerge_bit1(float a, float b, int lane) { const bool hi = (lane >> 1) & 1; const float k = hi ? b : a, t = hi ? a : b; return k + __shfl_xor(t, 2); }
__device__ __forceinline__ float fmerge_bit0(float a, float b, int lane) { const bool hi = lane & 1; const float k = hi ? b : a, t = hi ? a : b; return k + __shfl_xor(t, 1); }
#else
__device__ __forceinline__ float fmerge_bit2(float a, float b) {
    const int x = __builtin_amdgcn_update_dpp(__builtin_bit_cast(int, b), __builtin_bit_cast(int, a), 0x141, 0xF, 0x5, false), y = __builtin_amdgcn_update_dpp(__builtin_bit_cast(int, a), __builtin_bit_cast(int, b), 0x141, 0xF, 0xA, false);
    return __builtin_bit_cast(float, x) + __builtin_bit_cast(float, y); }
__device__ __forceinline__ float fmerge_bit1(float a, float b, int lane) { const bool hi = (lane >> 1) & 1; const float k = hi ? b : a, t = hi ? a : b; return k + dpp_f<0x4E>(t); }
__device__ __forceinline__ float fmerge_bit0(float a, float b, int lane) { const bool hi = lane & 1; const float k = hi ? b : a, t = hi ? a : b; return k + dpp_f<0xB1>(t); }
#endif
#ifdef CPU_EMU
__device__ __forceinline__ int imerge_bit2(int a, int b) { const bool hi = (threadIdx.x >> 2) & 1; const int k = hi ? b : a, t = hi ? a : b; return k + __shfl_xor(t, 7); }
__device__ __forceinline__ int imerge_bit1(int a, int b, int lane) { const bool hi = (lane >> 1) & 1; const int k = hi ? b : a, t = hi ? a : b; return k + __shfl_xor(t, 2); }
__device__ __forceinline__ int imerge_bit0(int a, int b, int lane) { const bool hi = lane & 1; const int k = hi ? b : a, t = hi ? a : b; return k + __shfl_xor(t, 1); }
#else
__device__ __forceinline__ int imerge_bit2(int a, int b) {
    const int x = __builtin_amdgcn_update_dpp(b, a, 0x141, 0xF, 0x5, false), y = __builtin_amdgcn_update_dpp(a, b, 0x141, 0xF, 0xA, false); return x + y; }
__device__ __forceinline__ int imerge_bit1(int a, int b, int lane) { const bool hi = (lane >> 1) & 1; const int k = hi ? b : a, t = hi ? a : b; return k + __builtin_amdgcn_update_dpp(0, t, 0x4E, 0xF, 0xF, true); }
__device__ __forceinline__ int imerge_bit0(int a, int b, int lane) { const bool hi = lane & 1; const int k = hi ? b : a, t = hi ? a : b; return k + __builtin_amdgcn_update_dpp(0, t, 0xB1, 0xF, 0xF, true); }
#endif
__device__ __forceinline__ void ph_peer_a(const Args& A, Frame& F, int layer) {
    const int lane = F.lane;
    float* wsc = (float*)(F.lds + F.wave * 10240);
    const unsigned short* SC = (const unsigned short*)(A.ws + WS_SC); const bf16_t* H2 = (const bf16_t*)(A.ws + WS_H2);
    const float* US = (const float*)(A.ws + WS_US) + (size_t)layer * 16384 * 2; const float* VS = (const float*)(A.ws + WS_VS) + (size_t)layer * 16384;
    unsigned* PL = (unsigned*)(A.ws + WS_PL); unsigned char* PH = A.ws + WS_PH;
    const int ntk = layer == 3 ? BATCH * SEQ : NTOK; const int gw = F.bid * NWAVES + F.wave, NGW = F.G * NWAVES;
    const int t_beg = (int)(((long)gw * ntk) / NGW), t_end = (int)(((long)(gw + 1) * ntk) / NGW);
    for (int tg = t_beg; tg < t_end; tg += 4) {
        { const int tq = lane >> 4, li = lane & 15; const int ti = (tg + tq < t_end) ? tg + tq : t_end - 1;
          const int tokL = peer_tok(layer, ti);
          const unsigned short* src = SC + (size_t)tokL * 2048 + li * 128;
          unsigned t1[16];
#pragma unroll
          for (int k = 0; k < 16; ++k) t1[k] = 0u;
#pragma unroll 1
          for (int i = 0; i < 128; i += 8) { const u32x4 v = *(const u32x4*)(src + i);
#pragma unroll
              for (int e = 0; e < 8; ++e) { const float sv_ = (e & 1) ? hhi(v[e >> 1]) : hlo(v[e >> 1]); const float fv = fminf(fmaxf(sv_, -63.99f), 63.99f); const unsigned key = ((unsigned)((fv + 64.f) * 262144.f) << 7) | (unsigned)(i + e); TOP16_INSERT(t1, key); } }
          float v1[16], v2[16]; unsigned i1[16], i2[16];
#pragma unroll
          for (int k = 0; k < 16; ++k) { const unsigned p = lane_xor1(t1[k]); v1[k] = (float)(t1[k] >> 7) * (1.f / 262144.f) - 64.f; i1[k] = (t1[k] & 127u) << 7; v2[k] = (float)(p >> 7) * (1.f / 262144.f) - 64.f; i2[k] = p & 127u; }
          unsigned c[16];
#pragma unroll
          for (int k = 0; k < 16; ++k) c[k] = 0u;
#pragma unroll
          for (int ia = 0; ia < 16; ++ia)
#pragma unroll
              for (int ib = 0; ib < 16 / (ia + 1); ++ib) { const float sm = fminf(fmaxf(v1[ia] + v2[ib], -127.9f), 127.9f); const unsigned key = ((unsigned)((sm + 128.f) * 1024.f) << 14) | i1[ia] | i2[ib]; TOP16_INSERT(c, key); }
          if ((li & 1) == 0 && tg + tq < t_end) { float* Lb = wsc + tq * 640; int* EL = (int*)Lb; float* GL = Lb + 128; float* SUL = Lb + 256; float* SVL = Lb + 384; const int hd = li >> 1;
              const float mx = (float)(c[0] >> 14) * (1.f / 1024.f); float ex[16]; float sum = 0.f;
#pragma unroll
              for (int k = 0; k < 16; ++k) { ex[k] = __expf((float)(c[k] >> 14) * (1.f / 1024.f) - mx); sum += ex[k]; }
              const float inv = 1.f / sum;
#pragma unroll
              for (int k = 0; k < 16; ++k) { const int e = (int)(c[k] & 16383u); EL[hd * 16 + k] = e; GL[hd * 16 + k] = ex[k] * inv; SUL[hd * 16 + k] = US[2 * e]; SVL[hd * 16 + k] = VS[e]; } }
          wave_sync(); }
        for (int tq = 0; tq < 4 && tg + tq < t_end; ++tq) { const int tok = peer_tok(layer, tg + tq); const unsigned* Lb = (const unsigned*)(wsc + tq * 640);
            const Row16 hv = ld_row_bf16(H2 + (size_t)tok * DM, lane);
#pragma unroll
            for (int a = 0; a < 4; ++a)
#pragma unroll
                for (int r = 0; r < 2; ++r) { const int p = 64 * r + lane; PL[(size_t)tok * 512 + a * 128 + p] = Lb[a * 128 + (p & 7) * 16 + (p >> 3)]; }
            float amax = 0.f;
#pragma unroll
            for (int e = 0; e < 16; ++e) amax = fmaxf(amax, fabsf(hv.v[e]));
            const float shc = amax * (1.f / 127.f), inv1 = amax > 0.f ? 127.f / amax : 0.f;
            u32x4 h1w;
#pragma unroll
            for (int k = 0; k < 4; ++k) { unsigned w1 = 0u;
#pragma unroll
                for (int e = 0; e < 4; ++e) w1 |= ((unsigned)(int)rintf(hv.v[4 * k + e] * inv1) & 255u) << (8 * e);
                h1w[k] = w1; }
            *(u32x4*)(PH + (size_t)tok * 2048 + 16 * lane) = h1w; *(float*)(PH + (size_t)tok * 2048 + 1024 + 4 * lane) = shc; }
        wave_sync();
    }
}
struct PeerSlice { int s0, sstep, t_beg, t_end; };
__device__ __forceinline__ PeerSlice peer_slice(const Args& A, const Frame& F, int layer) {
    int m = F.G < 8 ? F.G : 8, r = F.bid % m, rank = F.bid / m, nrank = (F.G - 1 - r) / m + 1;
#ifndef CPU_EMU
    if (A.ph_hi - A.ph_lo > 1) { const unsigned* bar = (const unsigned*)(A.ws + WS_CTL) + 1024; bool ok = true; unsigned tot = 0u;
#pragma unroll
        for (int j = 0; j < 16; ++j) { const unsigned cj = __hip_atomic_load(&bar[256 + 64 * j], __ATOMIC_RELAXED, __HIP_MEMORY_SCOPE_AGENT); tot += cj; ok = ok && ((j < 8) == (cj > 0u)); }
        const volatile __attribute__((address_space(3))) unsigned* st = (const volatile __attribute__((address_space(3))) unsigned*)((__attribute__((address_space(3))) unsigned char*)F.lds + 131072) + 8;
        if (ok && tot == (unsigned)F.G) { const int x = rfl((int)st[3]); m = 8; r = x; rank = rfl((int)st[2]); nrank = rfl((int)__hip_atomic_load(&bar[256 + 64 * x], __ATOMIC_RELAXED, __HIP_MEMORY_SCOPE_AGENT)); } }
#endif
    const int ntk = layer == 3 ? BATCH * SEQ : NTOK, wi = rank * NWAVES + F.wave, nws = nrank * NWAVES;
    PeerSlice P; P.s0 = r; P.sstep = m; P.t_beg = (int)(((long)wi * ntk) / nws); P.t_end = (int)(((long)(wi + 1) * ntk) / nws); return P;
}
__device__ __forceinline__ void ph_peer_u(const Args& A, Frame& F, int layer) {
    const int lane = F.lane, e8 = lane >> 3, c = lane & 7; const PeerSlice P = peer_slice(A, F, layer);
    const unsigned* PL = (const unsigned*)(A.ws + WS_PL); const unsigned char* PH = A.ws + WS_PH; float* PD = (float*)(A.ws + WS_PD);
    const int kx = (lane & 1) * 4 + ((lane >> 1) & 1) * 2 + ((lane >> 2) & 1);
#define PU_LISTS(EL, H1, HS, TOK) do { H1 = *(const u32x4*)(PH + (size_t)(TOK) * 2048 + hoff); HS = *(const float*)(PH + (size_t)(TOK) * 2048 + 1024 + soff); \
        EL_LOAD(EL, TOK); } while (0)
#define PU_ROWS(Q, EL) do { _Pragma("unroll") for (int i = 0; i < 16; ++i) { const unsigned e_ = EL_GET(EL, i); Q[i] = *(const u32x4*)(UTs + (e_ * 128u + c16)); } } while (0)
#define PU_COMP(Q, C1, HS, TOK) do { float d[16]; \
        _Pragma("unroll") for (int i = 0; i < 16; ++i) { int d1 = 0; \
            _Pragma("unroll") for (int j = 0; j < 4; ++j) d1 = sdot4(Q[i][j], C1[j], d1); \
            d[i] = (float)d1 * HS; } \
        float m_[8], n_[4]; \
        _Pragma("unroll") for (int j = 0; j < 8; ++j) m_[j] = fmerge_bit2(d[2 * j], d[2 * j + 1]); \
        _Pragma("unroll") for (int j = 0; j < 4; ++j) n_[j] = fmerge_bit1(m_[2 * j], m_[2 * j + 1], lane); \
        const float p0_ = fmerge_bit0(n_[0], n_[1], lane), p1_ = fmerge_bit0(n_[2], n_[3], lane); \
        *(h16x2*)((_Float16*)PD + ((size_t)(TOK) * 8 + s) * 128 + 16 * e8 + 2 * kx) = pk_h2(p0_ * (1.f / 64.f), p1_ * (1.f / 64.f)); } while (0)
    for (int s = P.s0; s < 8; s += P.sstep) {
        const unsigned char* UTs = A.ws + WS_UT + (size_t)layer * 16384 * 1024 + (size_t)s * 16384 * 128; const unsigned c16 = 16u * (unsigned)c;
        const unsigned hoff = (unsigned)(128 * s + 16 * c), soff = (unsigned)(4 * (8 * s + c));
        if (P.t_beg >= P.t_end) continue;
        u32x4 ela, elb, ha1, hb1, qa[16], qb[16]; float ha2 = 0.f, hb2 = 0.f;
        int toka = peer_tok(layer, P.t_beg), tokb = toka;
        PU_LISTS(ela, ha1, ha2, toka); PU_ROWS(qa, ela);
        if (P.t_beg + 1 < P.t_end) { tokb = peer_tok(layer, P.t_beg + 1); PU_LISTS(elb, hb1, hb2, tokb); }
#pragma unroll 1
        for (int ti = P.t_beg; ti < P.t_end; ti += 2) {
            { if (ti + 1 < P.t_end) PU_ROWS(qb, elb);
              const int tc = toka; const u32x4 c1 = ha1; const float c2 = ha2;
              if (ti + 2 < P.t_end) { toka = peer_tok(layer, ti + 2); PU_LISTS(ela, ha1, ha2, toka); }
              PU_COMP(qa, c1, c2, tc); }
            if (ti + 1 >= P.t_end) break;
            { if (ti + 2 < P.t_end) PU_ROWS(qa, ela);
              const int tc = tokb; const u32x4 c1 = hb1; const float c2 = hb2;
              if (ti + 3 < P.t_end) { tokb = peer_tok(layer, ti + 3); PU_LISTS(elb, hb1, hb2, tokb); }
              PU_COMP(qb, c1, c2, tc); }
        }
    }
#undef PU_LISTS
#undef PU_ROWS
#undef PU_COMP
}
__device__ __forceinline__ void ph_peer_w(const Args& A, Frame& F, int layer) {
    const int lane = F.lane; const unsigned* PL = (const unsigned*)(A.ws + WS_PL); const float* PD = (const float*)(A.ws + WS_PD);
    unsigned char* PWB = A.ws + WS_PW; float* PWS = (float*)(A.ws + WS_PWS);
    const int ntk = layer == 3 ? BATCH * SEQ : NTOK; const int gw = F.bid * NWAVES + F.wave, NGW = F.G * NWAVES;
    const int t_beg = (int)(((long)gw * ntk) / NGW), t_end = (int)(((long)(gw + 1) * ntk) / NGW);
#pragma unroll 2
    for (int ti = t_beg; ti < t_end; ++ti) { const int tok = peer_tok(layer, ti); const _Float16* pd = (const _Float16*)PD + (size_t)tok * 1024 + (lane & 48) + 2 * (lane & 7) + ((lane >> 3) & 1);     const float* pl = (const float*)(PL + (size_t)tok * 512) + lane;
        float d0 = 0.f, d1 = 0.f;
#pragma unroll
        for (int s = 0; s < 8; ++s) { d0 += (float)pd[s * 128]; d1 += (float)pd[s * 128 + 64]; }
        d0 *= 64.f; d1 *= 64.f;
        const float w0 = pl[128] * gelu_tanh(d0 * pl[256]) * pl[384], w1 = pl[128 + 64] * gelu_tanh(d1 * pl[256 + 64]) * pl[384 + 64];
        const float wmax = wave_max(fmaxf(fabsf(w0), fabsf(w1))); const float wsc = wmax * (1.f / 16256.f), winv = wmax > 0.f ? 16256.f / wmax : 0.f;
        const int q0 = (int)rintf(w0 * winv), q1 = (int)rintf(w1 * winv); const int h0 = q0 >> 7, h1 = q1 >> 7;
        unsigned char* pw = PWB + (size_t)tok * 256 + lane;
        pw[0] = (unsigned char)(h0 & 255); pw[64] = (unsigned char)(h1 & 255); pw[128] = (unsigned char)(q0 - h0 * 128); pw[192] = (unsigned char)(q1 - h1 * 128);
        if (lane == 0) PWS[tok] = wsc; }
}
__device__ __forceinline__ void ph_peer_v(const Args& A, Frame& F, int layer) {
    const int lane = F.lane, e8 = lane >> 3, c = lane & 7; const PeerSlice P = peer_slice(A, F, layer);
    const unsigned* PL = (const unsigned*)(A.ws + WS_PL); const unsigned char* PWB = A.ws + WS_PW; float* PO = (float*)(A.ws + WS_PO);
    const unsigned c16 = 16u * (unsigned)c;
    const int am = lane & 15, aterm = am & 1, acb = ((am >> 1) & 1) + 2 * (am >> 3), apar = (am >> 2) & 1;
    const unsigned aoff = (unsigned)(aterm * 128 + 16 * (2 * (lane >> 4) + apar));
    unsigned asel[4];
#pragma unroll
    for (int sl = 0; sl < 4; ++sl) asel[sl] = 0x0C0C0C0Cu ^ ((0x0Cu ^ (unsigned)sl) << (8 * acb));
    for (int s = P.s0; s < 8; s += P.sstep) {
        const unsigned char* VTs = A.ws + WS_VT + (size_t)layer * 16384 * 1024 + (size_t)s * 16384 * 128;
        if (P.t_beg >= P.t_end) continue;
        int tok = peer_tok(layer, P.t_beg);
        u32x4 el; EL_LOAD(el, tok);
        u32x4 wa = *(const u32x4*)(PWB + (size_t)tok * 256 + aoff);
#pragma unroll 1
        for (int ti = P.t_beg; ti < P.t_end; ++ti) {
            u32x4 q[16];
#pragma unroll
            for (int i = 0; i < 16; ++i) { const unsigned e_ = EL_GET(el, i); q[i] = *(const u32x4*)(VTs + (e_ * 128u + c16)); }
            const int tokc = tok; const u32x4 wc = wa;
            if (ti + 1 < P.t_end) { tok = peer_tok(layer, ti + 1); EL_LOAD(el, tok);
                wa = *(const u32x4*)(PWB + (size_t)tok * 256 + aoff); }
            i32x4 acc[4];
#pragma unroll
            for (int d = 0; d < 4; ++d) acc[d] = (i32x4){0, 0, 0, 0};
#pragma unroll
            for (int j = 0; j < 4; ++j) { i32x4 aj;
#pragma unroll
                for (int sl = 0; sl < 4; ++sl) aj[sl] = (int)bperm(0u, wc[j], asel[sl]);
#pragma unroll
                for (int d = 0; d < 4; ++d) { const i32x4 bj = {(int)q[4 * j][d], (int)q[4 * j + 1][d], (int)q[4 * j + 2][d], (int)q[4 * j + 3][d]}; acc[d] = mfma_i8(aj, bj, acc[d]); } }
            int o[8];
#pragma unroll
            for (int d = 0; d < 4; ++d)
#pragma unroll
                for (int cl = 0; cl < 2; ++cl) { const int w_ = acc[d][2 * cl] * 128 + acc[d][2 * cl + 1]; int x0, x1; lane_pair16(w_, x0, x1); o[2 * d + cl] = x0 + ror8_i(x1); }
            if ((lane & 0x18) == 0) { int* dst = (int*)PO + (size_t)tokc * 1024 + 128 * s + 16 * c + 2 * (lane >> 5);
#pragma unroll
                for (int d = 0; d < 4; ++d) *(i32x2*)(dst + 4 * d) = (i32x2){o[2 * d], o[2 * d + 1]}; }
        }
    }
}
__device__ __forceinline__ void ph_peer_e(const Args& A, Frame& F, int layer, bool dry = false) {
    const int lane = F.lane; bf16_t* X = (bf16_t*)(A.ws + WS_X); bf16_t* H = (bf16_t*)(A.ws + WS_H); const float* PO = (const float*)(A.ws + WS_PO); const float* PWS = (const float*)(A.ws + WS_PWS);
    const int ntk = layer == 3 ? BATCH * SEQ : NTOK; const int gw = F.bid * NWAVES + F.wave, NGW = F.G * NWAVES;
    const int t_beg = (int)(((long)gw * ntk) / NGW), t_end = (int)(((long)(gw + 1) * ntk) / NGW);
    const Row16 lg = ld_row_f32(A.in[6] + (size_t)(layer * 2 + 1) * DM, lane), lb = ld_row_f32(A.in[7] + (size_t)(layer * 2 + 1) * DM, lane);
    Row16 g2, sh, scl; int cls = -1;
    auto setcls = [&](int tok) { const int c_ = (tok / LTOK) * 2 + ((tok % LTOK) < CTXL); if (c_ != cls) { cls = c_; g2 = ld_row_f32(mod_row(A, layer, tok) + 5120, lane);
            if (layer < 3) { const float* modn = mod_row(A, layer + 1, tok); sh = ld_row_f32(modn, lane); scl = ld_row_f32(modn + 1024, lane); } } };
    auto ldpo = [&](int tok) { const int* po = (const int*)PO + (size_t)tok * 1024 + 16 * lane; const i32x4 o0 = *(const i32x4*)po, o1 = *(const i32x4*)(po + 4), o2 = *(const i32x4*)(po + 8), o3 = *(const i32x4*)(po + 12); const float ws_ = PWS[tok]; Row16 out;
#pragma unroll
        for (int e = 0; e < 4; ++e) { out.v[e] = (float)o0[e] * ws_; out.v[4 + e] = (float)o1[e] * ws_; out.v[8 + e] = (float)o2[e] * ws_; out.v[12 + e] = (float)o3[e] * ws_; }
        return out; };
    auto finish = [&](int tok, const Row16& x1, const Row16& out) { const int b = tok / LTOK, p = tok - b * LTOK; Row16 v;
#pragma unroll
        for (int e = 0; e < 16; ++e) v.v[e] = DN_ALPHA * x1.v[e] + g2.v[e] * out.v[e];
        const LnStat st = ln_stats(v); Row16 x2;
#pragma unroll
        for (int e = 0; e < 16; ++e) x2.v[e] = (v.v[e] - st.mean) * st.rstd * lg.v[e] + lb.v[e];
        if (dry) { if (x2.v[0] == 12345.678f) st_row_f32((float*)(A.ws + WS_OUT) + (size_t)tok * DM, lane, x2); return; }
        if (layer < 3) { st_row_bf16(X + (size_t)tok * DM, lane, x2); Row16 hn;
#pragma unroll
            for (int e = 0; e < 16; ++e) hn.v[e] = x2.v[e] * (1.f + scl.v[e]) + sh.v[e];
            st_row_bf16(H + (size_t)tok * DM, lane, hn);
        } else { st_row_f32(A.out + ((size_t)b * SEQ + (p - CTXL)) * DM, lane, x2); } };
    for (int ti = t_beg; ti < t_end; ti += 2) { const int tokA = peer_tok(layer, ti); const bool two = ti + 1 < t_end; const int tokB = two ? peer_tok(layer, ti + 1) : tokA;
        const Row16 oA = ldpo(tokA), xA = ld_row_bf16(X + (size_t)tokA * DM, lane), oB = ldpo(tokB), xB = ld_row_bf16(X + (size_t)tokB * DM, lane);
        setcls(tokA); finish(tokA, xA, oA);
        if (two) { setcls(tokB); finish(tokB, xB, oB); } }
}

constexpr int NPHASE = 45;
constexpr int PH_ORDER[NPHASE] = {0, 1, 2, 3, 4, 5, 6, 29, 30, 31, 32, 7, 8, 9, 10, 11, 12, 13, 14, 33, 34, 35, 36, 15, 16, 17, 18, 19, 20, 21, 37, 38, 39, 40, 22, 23, 24, 25, 26, 27, 41, 42, 43, 44, 28};
__device__ __forceinline__ void gemm_f32(const Args& A, Frame& F, const bf16_t* Am, int lda, const bf16_t* Bt, int ldb, int N, int K, float* O, int ldc, bool lat = false) {
    pg8::Gemm g{Am, Bt, NTOK, N, K, lda, ldb}; pg8::StaticOrder S; S.init(NTOK, N, F.G, F.bid, lat); EpiF32 E{O, ldc};
    pg8::gemm_phase<EpiF32, pg8::StaticOrder, PG8_ALIGN, PG8_SP2>(GEMM_LDS(F), g, S, E, F.wave);
}
__device__ __forceinline__ void gemm_b16(const Args& A, Frame& F, const bf16_t* Am, int lda, const bf16_t* Bt, int ldb, int N, int K, bf16_t* O, int ldc) {
    pg8::Gemm g{Am, Bt, NTOK, N, K, lda, ldb}; pg8::StaticOrder S; S.init(NTOK, N, F.G, F.bid); EpiB16 E{O, ldc};
    pg8::gemm_phase<EpiB16, pg8::StaticOrder, PG8_ALIGN, PG8_SP2>(GEMM_LDS(F), g, S, E, F.wave);
}
__device__ __forceinline__ void run_phase(const Args& A, Frame& F, int ph, bool dry = false) {
    unsigned char* ws = A.ws;
    switch (ph) {
    case 0: ph_prep(A, F); break;
    case 1: ph_init(A, F); break;
    case 2: case 23: ph_s5_scan(A, F, ph == 2 ? 0 : 1); break;
    case 3: case 24: ph_s5_combine(A, F, ph == 3 ? 0 : 1); break;
    case 4: case 25: { const int j = ph == 4 ? 0 : 1;
        pg8::Gemm g{(const bf16_t*)(ws + WS_G), (const bf16_t*)(ws + WS_WGLU) + (size_t)j * 2048 * 1024, NTOK, 2048, 1024, 1024, 1024}; pg8::StaticOrder S; S.init(NTOK, 2048, F.G, F.bid, j == 1); EpiGlu E{(bf16_t*)(ws + WS_OUT)};
        pg8::gemm_phase<EpiGlu, pg8::StaticOrder, PG8_ALIGN, PG8_SP2>(GEMM_LDS(F), g, S, E, F.wave); } break;
    case 5: ph_rowop(A, F, 0, dry); break;
    case 13: ph_rowop(A, F, 1, dry); break;
    case 20: ph_rowop(A, F, 2, dry); break;
    case 26: ph_rowop(A, F, 3, dry); break;
    case 6: case 14: case 21: case 27: { const int layer = ph == 6 ? 0 : ph == 14 ? 1 : ph == 21 ? 2 : 3;
        pg8::Gemm g{(const bf16_t*)(ws + WS_H2), (const bf16_t*)(ws + WS_WSC) + (size_t)layer * 2048 * 1024, NTOK, 2048, 1024, 1024, 1024}; pg8::StaticOrder S; S.init(NTOK, 2048, F.G, F.bid, layer == 3);
        EpiH16 E{(unsigned short*)(ws + WS_SC), 2048};
        pg8::gemm_phase<EpiH16, pg8::StaticOrder, PG8_ALIGN, PG8_SP2>(GEMM_LDS(F), g, S, E, F.wave); } break;
    case 7: ph_peer_e(A, F, 0, dry); break;
    case 15: ph_peer_e(A, F, 1, dry); break;
    case 22: ph_peer_e(A, F, 2, dry); break;
    case 28: ph_peer_e(A, F, 3, dry); break;
    case 29: case 33: case 37: case 41: ph_peer_a(A, F, (ph - 29) >> 2); break;
    case 30: case 34: case 38: case 42: ph_peer_u(A, F, (ph - 29) >> 2); break;
    case 31: case 35: case 39: case 43: ph_peer_w(A, F, (ph - 29) >> 2); break;
    case 32: case 36: case 40: case 44: ph_peer_v(A, F, (ph - 29) >> 2); break;
    case 8: { pg8::Gemm g{(const bf16_t*)(ws + WS_H), (const bf16_t*)(ws + WS_WIN), NTOK, SSD_IN_PAD, 1024, 1024, 1024}; pg8::StaticOrder S; S.init(NTOK, SSD_IN_PAD, F.G, F.bid);
        EpiSsdIn E{(bf16_t*)(ws + WS_Z), (bf16_t*)(ws + WS_XBC), (float*)(ws + WS_DT)};
        pg8::gemm_phase<EpiSsdIn, pg8::StaticOrder, PG8_ALIGN, PG8_SP2>(GEMM_LDS(F), g, S, E, F.wave); } break;
    case 9: ph_ssd_conv(A, F); break;
    case 10: ph_ssd_scan(A, F); break;
    case 11: ph_ssd_gate(A, F); break;
    case 12: gemm_b16(A, F, (const bf16_t*)(ws + WS_G2), 2048, (const bf16_t*)(ws + WS_WOUT), 2048, 1024, 2048, (bf16_t*)(ws + WS_OUT), 1024); break;
    case 16: { pg8::Gemm g{(const bf16_t*)(ws + WS_H), (const bf16_t*)(ws + WS_WDOWN), NTOK, 512, 1024, 1024, 1024}; pg8::StaticOrder S; S.init(NTOK, 512, F.G, F.bid);
        EpiMlaDown E{(bf16_t*)(ws + WS_CQKV), (float*)(ws + WS_RS)};
        pg8::gemm_phase<EpiMlaDown, pg8::StaticOrder, PG8_ALIGN, PG8_SP2>(GEMM_LDS(F), g, S, E, F.wave); } break;
    case 17: { mla_kr(A, F); __syncthreads();
        pg8::Gemm g{(const bf16_t*)(ws + WS_CQKV), (const bf16_t*)(ws + WS_WUP), NTOK, 4096, 384, 512, 384}; pg8::StaticOrder S; S.init(NTOK, 4096, F.G, F.bid);
        EpiMlaUp E{(bf16_t*)(ws + WS_Q), (bf16_t*)(ws + WS_K), (bf16_t*)(ws + WS_V), (const float*)(ws + WS_RS)};
        pg8::gemm_phase<EpiMlaUp, pg8::StaticOrder, PG8_ALIGN, PG8_SP2>(GEMM_LDS(F), g, S, E, F.wave); } break;
    case 18: ph_attn(A, F); break;
    case 19: gemm_b16(A, F, (const bf16_t*)(ws + WS_O), 1024, (const bf16_t*)(ws + WS_WO), 1024, 1024, 1024, (bf16_t*)(ws + WS_OUT), 1024); break;
    default: break;
    }
}

#ifndef CPU_EMU
#define LAS __attribute__((address_space(3)))
#define XB_TMO      128
#define XB_XCNT(j)  (256  + 64 * (j))
#define XB_XSUB(j)  (1280 + 64 * (j))
#define XB_XGEN(j)  (2304 + 64 * (j))
#define XB_TOP      3328
#define XB_TOPGEN   3392
#define XCD_BAR_WORDS 3456
#define XB_SPIN_CAP (1u << 22)
__device__ __forceinline__ unsigned xb_ld(unsigned* p)              { return __hip_atomic_load(p, __ATOMIC_RELAXED, __HIP_MEMORY_SCOPE_AGENT); }
__device__ __forceinline__ unsigned xb_add(unsigned* p, unsigned v) { return __hip_atomic_fetch_add(p, v, __ATOMIC_RELAXED, __HIP_MEMORY_SCOPE_AGENT); }
__device__ __forceinline__ unsigned xb_xcc_id() { return (unsigned)__builtin_amdgcn_s_getreg((3 << 11) | 20) & 0xFu; }
#define XB_SPIN(cond, bar) do { unsigned _sp = 0; while (cond) { __builtin_amdgcn_s_sleep(1); \
    if ((++_sp & 255u) == 0u) { if (xb_ld(&(bar)[XB_TMO])) break; if (_sp > XB_SPIN_CAP) { atomicAdd(&(bar)[XB_TMO], 1u); break; } } } } while (0)
struct XcdBarrier { unsigned* bar; unsigned x; volatile LAS unsigned* st; };
__device__ __forceinline__ XcdBarrier xcd_barrier_post(unsigned* bar, volatile LAS unsigned* st) {
    XcdBarrier b; b.bar = bar; b.x = xb_xcc_id(); b.st = st;
    if (threadIdx.x == 0) { st[2] = xb_add(&bar[XB_XCNT(b.x)], 1u); st[3] = b.x; }
    return b;
}
__device__ __forceinline__ void xcd_barrier_complete(unsigned* bar, unsigned x, unsigned& nloc, unsigned& nx) {
    const unsigned G = gridDim.x * gridDim.y * gridDim.z;
    unsigned sum, cnt, mine, sp = 0u;
    for (;;) {
        sum = 0u; cnt = 0u; mine = 0u;
#pragma unroll
        for (unsigned j = 0; j < 16; ++j) { const unsigned c = xb_ld(&bar[XB_XCNT(j)]); sum += c; cnt += (c > 0u) ? 1u : 0u; mine = (j == x) ? c : mine; }
        if (sum == G) break;
        __builtin_amdgcn_s_sleep(1);
        if ((++sp & 255u) == 0u) { if (xb_ld(&bar[XB_TMO])) break; if (sp > XB_SPIN_CAP) { atomicAdd(&bar[XB_TMO], 1u); break; } }
    }
    nloc = mine > 0u ? mine : 1u; nx = cnt > 0u ? cnt : 1u;
}
__device__ __forceinline__ void xcd_barrier(const XcdBarrier& b, int wave_s) {
    asm volatile("s_waitcnt vmcnt(0)" ::: "memory");
    __syncthreads();
    if (wave_s == 0 && hw_lane() == 0) {
        unsigned* bar = b.bar;
        __builtin_amdgcn_s_waitcnt(0);
        unsigned nloc = b.st[0], nx = b.st[1];
        if (nloc == 0u) { xcd_barrier_complete(bar, b.x, nloc, nx); b.st[0] = nloc; b.st[1] = nx; }
        const unsigned old = xb_add(&bar[XB_XSUB(b.x)], 1u);
        const unsigned gen = old / nloc;
        if (old + 1u == (gen + 1u) * nloc) {
            __builtin_amdgcn_fence(__ATOMIC_RELEASE, "agent");
            asm volatile("s_waitcnt vmcnt(0)" ::: "memory");
            const unsigned og = xb_add(&bar[XB_TOP], 1u);
            const unsigned tg = og / nx;
            if (og + 1u == (tg + 1u) * nx) xb_add(&bar[XB_TOPGEN], 1u);
            else XB_SPIN(xb_ld(&bar[XB_TOPGEN]) == tg, bar);
            __builtin_amdgcn_fence(__ATOMIC_ACQUIRE, "agent");
            xb_add(&bar[XB_XGEN(b.x)], 1u);
            asm volatile("s_waitcnt vmcnt(0)" ::: "memory");
        } else {
            XB_SPIN(xb_ld(&bar[XB_XGEN(b.x)]) == gen, bar);
            __builtin_amdgcn_fence(__ATOMIC_ACQUIRE, "agent");
            asm volatile("s_waitcnt vmcnt(0)" ::: "memory");
        }
    }
    __syncthreads();
}

constexpr int LDS_BYTES = 147456;
constexpr int LDSCTL_OFF = 131072;
__device__ __forceinline__ Frame mk_frame(unsigned char* lds, int wave_s) {
    int l = hw_lane(); asm volatile("" : "+v"(l));
    Frame F; F.lds = lds; F.lane = l; F.wave = wave_s; F.tid = wave_s * 64 + l; F.G = gridDim.x; F.bid = blockIdx.x; return F;
}
__device__ __forceinline__ void grid_bar(unsigned char* ws, unsigned char* lds, int wave_s) {
    XcdBarrier bar; bar.bar = (unsigned*)(ws + WS_CTL) + 1024; bar.x = xb_xcc_id(); bar.st = (volatile LAS unsigned*)((LAS unsigned char*)lds + LDSCTL_OFF) + 8;
    xcd_barrier(bar, wave_s);
}
__global__ void __launch_bounds__(NTHR, 2) hybrid_fwd(Args args) {
    extern __shared__ __attribute__((aligned(16))) unsigned char lds[];
    const int wave_s = __builtin_amdgcn_readfirstlane((int)threadIdx.x >> 6);
    { volatile LAS unsigned* MISC = (volatile LAS unsigned*)((LAS unsigned char*)lds + LDSCTL_OFF);
      if (wave_s == 0) MISC[hw_lane()] = 0u;
      __syncthreads();
      if (args.ph_hi - args.ph_lo > 1) (void)xcd_barrier_post((unsigned*)(args.ws + WS_CTL) + 1024, MISC + 8); }
    const int lo = args.ph_lo, hi = args.ph_hi;
    if (PROBE && blockIdx.x == 0 && wave_s == 0 && hw_lane() == 0) { ((unsigned long long*)(args.ws + WS_TS))[0] = __builtin_amdgcn_s_memrealtime(); ((unsigned long long*)(args.ws + WS_TS))[40] = 0ull; ((unsigned long long*)(args.ws + WS_TS))[41] = 0ull; }
#define PHASE(k, id) if (lo <= (k) && (k) < hi) { if ((DUPMASK >> (k)) & 1ull) { Frame F = mk_frame(lds, wave_s); run_phase(args, F, (id), true); grid_bar(args.ws, lds, wave_s); } { Frame F = mk_frame(lds, wave_s); run_phase(args, F, (id)); } if ((k) + 1 < hi) { if (USE_CG && (k) == 0) cg::this_grid().sync(); grid_bar(args.ws, lds, wave_s); } }
    PHASE(0, 0) PHASE(1, 1) PHASE(2, 2) PHASE(3, 3) PHASE(4, 4) PHASE(5, 5) PHASE(6, 6) PHASE(7, 29) PHASE(8, 30) PHASE(9, 31) PHASE(10, 32) PHASE(11, 7)
    PHASE(12, 8) PHASE(13, 9) PHASE(14, 10) PHASE(15, 11) PHASE(16, 12) PHASE(17, 13) PHASE(18, 14) PHASE(19, 33) PHASE(20, 34) PHASE(21, 35) PHASE(22, 36) PHASE(23, 15)
    PHASE(24, 16) PHASE(25, 17) PHASE(26, 18) PHASE(27, 19) PHASE(28, 20) PHASE(29, 21) PHASE(30, 37) PHASE(31, 38) PHASE(32, 39) PHASE(33, 40) PHASE(34, 22)
    PHASE(35, 23) PHASE(36, 24) PHASE(37, 25) PHASE(38, 26) PHASE(39, 27) PHASE(40, 41) PHASE(41, 42) PHASE(42, 43) PHASE(43, 44) PHASE(44, 28)
#undef PHASE
}

extern "C" void kernel_launch(void* const* d_in, const int* in_sizes, int n_in, void* d_out, int out_size, void* d_ws, size_t ws_size, hipStream_t stream) {
    static int grid = 0;
    if (grid == 0) {
        if (n_in != 37 || ws_size < WS_END) { fprintf(stderr, "kernel_launch: unexpected n_in %d / ws %zu\n", n_in, ws_size); grid = -1; return; }
        int dev = 0, cus = 0, per_cu = 0;
        hipGetDevice(&dev); hipDeviceGetAttribute(&cus, hipDeviceAttributeMultiprocessorCount, dev);
        hipFuncSetAttribute((const void*)hybrid_fwd, hipFuncAttributeMaxDynamicSharedMemorySize, LDS_BYTES);
        hipOccupancyMaxActiveBlocksPerMultiprocessor(&per_cu, (const void*)hybrid_fwd, NTHR, LDS_BYTES);
        (void)hipGetLastError();
        if (per_cu < 1) { fprintf(stderr, "kernel_launch: occupancy query says %d blocks/CU\n", per_cu); per_cu = 1; }
        grid = cus;
    }
    if (grid < 0) return;
    hipMemsetAsync((char*)d_ws + WS_CTL, 0, CTL_ZERO_BYTES, stream);
    Args a{};
    for (int i = 0; i < 37; ++i) a.in[i] = (const float*)d_in[i];
    a.out = (float*)d_out; a.ws = (unsigned char*)d_ws; a.ph_lo = 0; a.ph_hi = NPHASE;
#if USE_CG
    void* kargs[] = {&a};
    hipError_t e = hipLaunchCooperativeKernel((const void*)hybrid_fwd, dim3(grid), dim3(NTHR), kargs, LDS_BYTES, stream);
    if (e != hipSuccess) fprintf(stderr, "cooperative launch failed: %s (grid %d)\n", hipGetErrorString(e), grid);
#else
    hipLaunchKernelGGL(hybrid_fwd, dim3(grid), dim3(NTHR), LDS_BYTES, stream, a);
    const hipError_t e = hipPeekAtLastError();
    if (e != hipSuccess) fprintf(stderr, "launch failed: %s (grid %d)\n", hipGetErrorString(e), grid);
#endif
}
#endif
```

```cpp
#ifndef CPU_EMU
#include <hip/hip_runtime.h>
#include <hip/hip_cooperative_groups.h>
#include <cstdio>
#include <cstdint>
#include <cmath>
namespace cg = cooperative_groups;
#endif

#ifndef BATCH
#define BATCH 4
#endif
#ifndef SEQ
#define SEQ 4096
#endif
#ifndef CTXL
#define CTXL 256
#endif
constexpr int DM = 1024, LTOK = CTXL + SEQ, NTOK = BATCH * LTOK, NR = BATCH + 1;
constexpr int NTHR = 512, NWAVES = 8;
static_assert(NTOK % 256 == 0 && SEQ % 256 == 0 && CTXL % 256 == 0 && LTOK % 32 == 0, "shape");
constexpr float DN_ALPHA = 1.6817928305074290f;
constexpr int SSD_IN = 5184, SSD_IN_PAD = 5376;

typedef unsigned short bf16_t;
typedef short bf16x8 __attribute__((ext_vector_type(8)));
typedef float f32x2 __attribute__((ext_vector_type(2)));
typedef float f32x4 __attribute__((ext_vector_type(4)));
typedef float f32x16 __attribute__((ext_vector_type(16)));
typedef unsigned u32x2 __attribute__((ext_vector_type(2)));
typedef unsigned u32x4 __attribute__((ext_vector_type(4)));

constexpr size_t MiB = 1u << 20;
constexpr size_t WS_CTL = 0, CTL_ZERO_BYTES = 64 * 1024;
constexpr size_t WS_MOD = 1 * MiB;
constexpr size_t WS_ROPE = WS_MOD + 768 * 1024;
constexpr size_t WS_S5C = 2 * MiB;
constexpr size_t S5C_ITEM = 12800;
constexpr size_t WS_WGLU = 6 * MiB;
constexpr size_t WS_WIN = 14 * MiB;
constexpr size_t WS_WOUT = 25 * MiB;
constexpr size_t WS_WDOWN = 29 * MiB;
constexpr size_t WS_WUP = 30 * MiB;
constexpr size_t WS_WO = 33 * MiB;
constexpr size_t WS_WSC = 35 * MiB;
constexpr size_t WS_UT = 52 * MiB;
constexpr size_t WS_VT = 116 * MiB;
constexpr size_t WS_US = 180 * MiB;
constexpr size_t WS_VS = 181 * MiB;
constexpr size_t WS_X = 308 * MiB;
constexpr size_t WS_H = 376 * MiB;
constexpr size_t WS_H2 = 410 * MiB;
constexpr size_t WS_OUT = 444 * MiB;
constexpr size_t WS_R = 512 * MiB;
constexpr size_t WS_SC = WS_R;
constexpr size_t WS_YF = WS_R, WS_YB = WS_R + 34 * MiB, WS_G = WS_R + 68 * MiB;
constexpr size_t WS_Z = WS_R, WS_XBC = WS_R + 68 * MiB, WS_XBCC = WS_R + 170 * MiB, WS_DT = WS_R + 272 * MiB, WS_DTS = WS_R + 277 * MiB, WS_ACUM = WS_R + 420 * MiB,
                 WS_YF2 = WS_R + 282 * MiB, WS_YB2 = WS_R + 350 * MiB, WS_G2 = WS_XBC;
constexpr size_t WS_CQKV = WS_R, WS_RS = WS_R + 17 * MiB, WS_Q = WS_R + 18 * MiB, WS_K = WS_R + 86 * MiB, WS_V = WS_R + 154 * MiB, WS_O = WS_R + 188 * MiB;
constexpr size_t WS_PL = WS_R + 68 * MiB;
constexpr size_t WS_PH = WS_R + 102 * MiB;
constexpr size_t WS_PS = WS_R + 136 * MiB;
constexpr size_t WS_PD = WS_R + 137 * MiB;
constexpr size_t WS_PW = WS_R + 205 * MiB;
constexpr size_t WS_PWS = WS_R + 214 * MiB;
constexpr size_t WS_PO = WS_R + 215 * MiB;
constexpr size_t WS_END = 1024 * MiB;
constexpr size_t WS_TS = 64 * 1024;
#ifndef PROBE
#define PROBE 0
#endif
#ifndef USE_CG
#define USE_CG 1
#endif
#ifndef DUPMASK
#define DUPMASK 0ull
#endif

__device__ __forceinline__ unsigned f2bf(float f) { unsigned u = __float_as_uint(f); return (u + 0x7fffu + ((u >> 16) & 1u)) >> 16; }
#ifdef CPU_EMU
__device__ __forceinline__ unsigned pk2(float lo, float hi) { return f2bf(lo) | (f2bf(hi) << 16); }
#else
typedef __bf16 bf16x2_hw __attribute__((ext_vector_type(2)));
__device__ __forceinline__ unsigned pk2(float lo, float hi) { const f32x2 v = {lo, hi}; const bf16x2_hw b = __builtin_convertvector(v, bf16x2_hw); return __builtin_bit_cast(unsigned, b); }
#endif
__device__ __forceinline__ float bflo(unsigned w) { return __uint_as_float(w << 16); }
__device__ __forceinline__ float bfhi(unsigned w) { return __uint_as_float(w & 0xffff0000u); }
__device__ __forceinline__ float bf2f(bf16_t s) { return __uint_as_float(((unsigned)s) << 16); }
__device__ __forceinline__ float gelu_tanh(float x) { const float u = 0.7978845608028654f * (x + 0.044715f * x * x * x); const float e = __expf(2.f * u); const float t = 1.f - 2.f / (e + 1.f); return 0.5f * x * (1.f + t); }
__device__ __forceinline__ float sigmoidf_(float x) { return 1.f / (1.f + __expf(-x)); }
__device__ __forceinline__ float siluf_(float x) { return x / (1.f + __expf(-x)); }
#ifdef CPU_EMU
__device__ __forceinline__ float wave_sum(float v) {
#pragma unroll
    for (int o = 1; o < 64; o <<= 1) v += __shfl_xor(v, o);
    return v;
}
__device__ __forceinline__ float wave_max(float v) {
#pragma unroll
    for (int o = 1; o < 64; o <<= 1) v = fmaxf(v, __shfl_xor(v, o));
    return v;
}
#else
template <int CTRL> __device__ __forceinline__ float dpp_f(float v) { return __builtin_bit_cast(float, __builtin_amdgcn_update_dpp(0, __builtin_bit_cast(int, v), CTRL, 0xF, 0xF, true)); }
__device__ __forceinline__ float wave_sum(float v) {
    v += dpp_f<0xB1>(v); v += dpp_f<0x4E>(v); v += dpp_f<0x141>(v); v += dpp_f<0x140>(v);
    { auto rr = __builtin_amdgcn_permlane16_swap(__float_as_uint(v), __float_as_uint(v), false, false); v = __uint_as_float(rr[0]) + __uint_as_float(rr[1]); }
    { auto rr = __builtin_amdgcn_permlane32_swap(__float_as_uint(v), __float_as_uint(v), false, false); v = __uint_as_float(rr[0]) + __uint_as_float(rr[1]); }
    return v;
}
__device__ __forceinline__ float wave_max(float v) {
    v = fmaxf(v, dpp_f<0xB1>(v)); v = fmaxf(v, dpp_f<0x4E>(v)); v = fmaxf(v, dpp_f<0x141>(v)); v = fmaxf(v, dpp_f<0x140>(v));
    { auto rr = __builtin_amdgcn_permlane16_swap(__float_as_uint(v), __float_as_uint(v), false, false); v = fmaxf(__uint_as_float(rr[0]), __uint_as_float(rr[1])); }
    { auto rr = __builtin_amdgcn_permlane32_swap(__float_as_uint(v), __float_as_uint(v), false, false); v = fmaxf(__uint_as_float(rr[0]), __uint_as_float(rr[1])); }
    return v;
}
#endif
__device__ __forceinline__ unsigned wave_umax(unsigned v) {
#pragma unroll
    for (int o = 1; o < 64; o <<= 1) { const unsigned t = __shfl_xor(v, o); v = t > v ? t : v; }
    return v;
}
#ifdef CPU_EMU
__device__ __forceinline__ void wave_sync() { emu::wave_barrier(); }
__device__ __forceinline__ f32x16 mfma32(bf16x8 a, bf16x8 b, f32x16 c) { return emu_mfma_32x32x16_bf16(a, b, c); }
__device__ __forceinline__ int rfl(int x) { return x; }
#else
__device__ __forceinline__ void wave_sync() { asm volatile("s_waitcnt lgkmcnt(0)" ::: "memory"); }
__device__ __forceinline__ f32x16 mfma32(bf16x8 a, bf16x8 b, f32x16 c) { return __builtin_amdgcn_mfma_f32_32x32x16_bf16(a, b, c, 0, 0, 0); }
__device__ __forceinline__ int rfl(int x) { return __builtin_amdgcn_readfirstlane(x); }
#endif
typedef short s16x4 __attribute__((ext_vector_type(4)));
typedef int i32x4 __attribute__((ext_vector_type(4)));
typedef int i32x2 __attribute__((ext_vector_type(2)));
typedef _Float16 h16x2 __attribute__((ext_vector_type(2)));
__device__ __forceinline__ h16x2 pk_h2(float a, float b) { h16x2 r; r[0] = (_Float16)a; r[1] = (_Float16)b; return r; }
#ifdef CPU_EMU
#define SCHED_FENCE() do {} while (0)
#else
#define SCHED_FENCE() __builtin_amdgcn_sched_barrier(0)
#endif
#ifdef CPU_EMU
__device__ __forceinline__ i32x4 mfma_i8(i32x4 a, i32x4 b, i32x4 c) { return emu_mfma_i32_16x16x64_i8(a, b, c); }
#else
__device__ __forceinline__ i32x4 mfma_i8(i32x4 a, i32x4 b, i32x4 c) { return __builtin_amdgcn_mfma_i32_16x16x64_i8(a, b, c, 0, 0, 0); }
#endif
#ifdef CPU_EMU
__device__ __forceinline__ s16x4 lds_tr(const unsigned char* p) { return emu_ds_read_tr16_b64(p); }
#else
__device__ __forceinline__ s16x4 lds_tr(const unsigned char* p) { return __builtin_bit_cast(s16x4, __builtin_amdgcn_ds_read_tr16_b64_v4i16((__attribute__((address_space(3))) s16x4*)p)); }
#endif
#ifdef CPU_EMU
__device__ __forceinline__ int hw_lane() { return (int)(threadIdx.x & 63); }
#else
__device__ __forceinline__ int hw_lane() { return (int)__builtin_amdgcn_mbcnt_hi(~0u, __builtin_amdgcn_mbcnt_lo(~0u, 0u)); }
#endif
__device__ __forceinline__ int crow(int r, int hi) { return (r & 3) + 8 * (r >> 2) + 4 * hi; }
__device__ __forceinline__ int seqpos(int dir, int s) { return dir == 0 ? s : (s < CTXL ? CTXL - 1 - s : LTOK + CTXL - 1 - s); }

struct Args { const float* in[37]; float* out; unsigned char* ws; int ph_lo, ph_hi; };
struct Frame { unsigned char* lds; int tid, lane, wave, G, bid; };

namespace pg8 {
constexpr int BM = 256, BK = 64, HALF = 128, HTB = HALF * BK * 2, STAGE_BYTES = 8 * HTB, NXCD = 8, WGM = 8;
__host__ __device__ __forceinline__ int lds_byte(int r, int c) { const int st = (r >> 4) * 2 + (c >> 5), rr = r & 15, cc = c & 31, ob = rr * 64 + cc * 2; return st * 1024 + (ob ^ (((ob >> 9) & 1) << 5)); }
__host__ __device__ __forceinline__ void stage_rc(int b, int& R, int& C) { const int st = b / 1024, sb = b % 1024, swz = sb ^ (((sb >> 9) & 1) << 5); R = (st >> 1) * 16 + swz / 64; C = (st & 1) * 32 + (swz % 64) / 2; }
__host__ __device__ __forceinline__ int perm32(int rho) { const int n = rho >> 4, i = rho & 15; return 8 * (i >> 2) + 4 * n + (i & 3); }
struct Unit { int pm, pn; };
struct Gemm { const bf16_t* A; const bf16_t* Bt; int M, N, K, lda, ldb; };
struct StaticOrder {
    int nM, nN, nwg, G, c; bool lat;
    __host__ __device__ void init(int M, int N, int G_, int c_, bool lat_ = false) { lat = lat_; nM = lat ? BATCH * (SEQ / 256) : M / BM; nN = N / BM; nwg = nM * nN; G = G_; c = c_; }
    __host__ __device__ bool next(int i, Unit& u) const {
        const long L = (long)i * G + c; if (L >= nwg) return false;
        int wgid = (int)L; { const int q = nwg / NXCD, r = nwg % NXCD, xcd = wgid % NXCD, off = wgid / NXCD; wgid = (xcd < r ? xcd * (q + 1) : r * (q + 1) + (xcd - r) * q) + off; }
        const int nig = WGM * nN, gid = wgid / nig, fm = gid * WGM, gsz = (nM - fm) < WGM ? (nM - fm) : WGM;
        u.pm = fm + ((wgid % nig) % gsz); u.pn = (wgid % nig) / gsz;
        if (lat) u.pm = (u.pm / (SEQ / 256)) * (LTOK / 256) + CTXL / 256 + u.pm % (SEQ / 256);
        return true;
    }
};
#ifdef CPU_EMU
template <class Epi, class Sched, bool ALIGN_EPI = false, bool SP2 = false>
__device__ __forceinline__ void gemm_phase(unsigned char* lds, const Gemm g, const Sched& S, const Epi& E, int wave_s) {
    const int tid = threadIdx.x, wid = tid >> 6, lane = tid & 63, wr = wid >> 2, wc = wid & 3, fr = lane & 15, fq = lane >> 4;
    Unit u;
    for (int ui = 0; S.next(ui, u); ++ui) {
        f32x4 acc[2][2][4][2];
        for (int ai = 0; ai < 2; ++ai) for (int bj = 0; bj < 2; ++bj) for (int m = 0; m < 4; ++m) for (int n = 0; n < 2; ++n) for (int e = 0; e < 4; ++e) {
            const int row = u.pm * 256 + 128 * ai + 64 * wr + 16 * m + fr;
            const int col = u.pn * 256 + 128 * bj + 32 * wc + (Epi::PERM ? 8 * fq + 4 * n + e : 16 * n + 4 * fq + e);
            const bf16_t* a = g.A + (size_t)row * g.lda; const bf16_t* b = g.Bt + (size_t)col * g.ldb; float s = 0.f;
            for (int k = 0; k < g.K; ++k) s += bf2f(a[k]) * bf2f(b[k]);
            acc[ai][bj][m][n][e] = s;
        }
        E(acc, u, wr, wc, fr, fq);
    }
    __syncthreads();
}
#else
#define PG8_LAS __attribute__((address_space(3)))
template <class Epi, class Sched, bool ALIGN_EPI = false, bool SP2 = false>
__device__ __forceinline__ void gemm_phase(PG8_LAS unsigned char* lds, const Gemm g, const Sched& S, const Epi& E, int wave_s) {
    int lane_ = hw_lane(); asm volatile("" : "+v"(lane_));
    const int wid = wave_s, lane = lane_, tid = wid * 64 + lane, wr = wid >> 2, wc = wid & 3, fr = lane & 15, fq = lane >> 4;
    const int K = g.K, nt = K / BK;
    unsigned voffA[2], voffB[2];
#pragma unroll
    for (int i = 0; i < 2; ++i) { int R, C; stage_rc(tid * 16 + i * 8192, R, C); const int Rb = Epi::PERM ? ((R & ~31) + perm32(R & 31)) : R;
        voffA[i] = (unsigned)(R * g.lda + C) * 2u; voffB[i] = (unsigned)(Rb * g.ldb + C) * 2u; }
    const size_t kstep = (size_t)(BK * 2);
    const size_t hstepA = (size_t)HALF * g.lda * 2, hstepB = (size_t)HALF * g.ldb * 2;
    const size_t tstepA = 2 * hstepA, tstepB = 2 * hstepB;
    const unsigned ldsw = (unsigned)wid * 1024u;
    const int aoff = lds_byte(wr * 64 + fr, fq * 8), boff = lds_byte(wc * 32 + fr, fq * 8);
#define PG8_SA(b, h) (((b) * 2 + (h)) * HTB)
#define PG8_SB(b, h) ((4 + (b) * 2 + (h)) * HTB)
#define PG8_STAGE(bufoff, gbase, voff) do { _Pragma("unroll") for (int _i = 0; _i < 2; ++_i) \
        __builtin_amdgcn_global_load_lds((const unsigned*)((const char*)(gbase) + (voff)[_i]), (PG8_LAS unsigned*)(lds + (bufoff) + ldsw + _i * 8192), 16, 0, 0); } while (0)
#define PG8_LDA(dst, b, h) do { _Pragma("unroll") for (int m = 0; m < 4; ++m) _Pragma("unroll") for (int k = 0; k < 2; ++k) dst[m][k] = *(const PG8_LAS bf16x8*)(lds + PG8_SA(b, h) + aoff + m * 2048 + k * 1024); } while (0)
#define PG8_LDB(dst, b, h) do { _Pragma("unroll") for (int n = 0; n < 2; ++n) _Pragma("unroll") for (int k = 0; k < 2; ++k) dst[n][k] = *(const PG8_LAS bf16x8*)(lds + PG8_SB(b, h) + boff + n * 2048 + k * 1024); } while (0)
#define PG8_MMA(ai, bj, At, Bt) do { __builtin_amdgcn_s_setprio(1); _Pragma("unroll") for (int m = 0; m < 4; ++m) _Pragma("unroll") for (int n = 0; n < 2; ++n) _Pragma("unroll") for (int k = 0; k < 2; ++k) \
        acc[ai][bj][m][n] = __builtin_amdgcn_mfma_f32_16x16x32_bf16(Bt[n][k], At[m][k], acc[ai][bj][m][n], 0, 0, 0); __builtin_amdgcn_s_setprio(0); } while (0)
#define PG8_WAIT_V(n) asm volatile("s_waitcnt vmcnt(" #n ")" ::: "memory")
#define PG8_WAIT_L(n) asm volatile("s_waitcnt lgkmcnt(" #n ")" ::: "memory")
#define PG8_BAR __builtin_amdgcn_s_barrier()
#define PG8_SCHED __builtin_amdgcn_sched_barrier(0)
    Unit cur, nxt; int ui = 0;
    if (!S.next(0, cur)) return;
    f32x4 acc[2][2][4][2];
#pragma unroll
    for (int a = 0; a < 2; ++a)
#pragma unroll
        for (int b = 0; b < 2; ++b)
#pragma unroll
            for (int m = 0; m < 4; ++m)
#pragma unroll
                for (int n = 0; n < 2; ++n) acc[a][b][m][n] = (f32x4){0.f, 0.f, 0.f, 0.f};
    bf16x8 At[4][2], B0[2][2], B1[2][2];
    const char* cA = (const char*)g.A + (size_t)cur.pm * tstepA; const char* cB = (const char*)g.Bt + (size_t)cur.pn * tstepB;
    if constexpr (SP2) {
        PG8_STAGE(PG8_SB(0, 0), cB, voffB); PG8_STAGE(PG8_SB(0, 1), cB + hstepB, voffB); PG8_STAGE(PG8_SA(0, 0), cA, voffA); PG8_STAGE(PG8_SA(0, 1), cA + hstepA, voffA);
        if (wr == 1) PG8_BAR;
        PG8_WAIT_V(2); PG8_BAR;
        PG8_STAGE(PG8_SB(1, 0), cB + kstep, voffB); PG8_STAGE(PG8_SA(1, 0), cA + kstep, voffA); PG8_STAGE(PG8_SB(1, 1), cB + hstepB + kstep, voffB);
        PG8_WAIT_V(6); PG8_BAR;
    } else {
        PG8_STAGE(PG8_SB(0, 0), cB, voffB); PG8_STAGE(PG8_SA(0, 0), cA, voffA); PG8_STAGE(PG8_SB(0, 1), cB + hstepB, voffB); PG8_STAGE(PG8_SA(0, 1), cA + hstepA, voffA);
        if (wr == 1) PG8_BAR;
        PG8_WAIT_V(4); PG8_BAR;
        PG8_STAGE(PG8_SB(1, 0), cB + kstep, voffB); PG8_STAGE(PG8_SA(1, 0), cA + kstep, voffA); PG8_STAGE(PG8_SB(1, 1), cB + hstepB + kstep, voffB);
        PG8_WAIT_V(6); PG8_BAR;
    }
    for (;;) {
        const bool has_next = S.next(ui + 1, nxt);
        const char* nA = has_next ? (const char*)g.A + (size_t)nxt.pm * tstepA : cA; const char* nB = has_next ? (const char*)g.Bt + (size_t)nxt.pn * tstepB : cB;
        for (int t = 0; t < nt; t += 2) {
            const bool last = (t == nt - 2);
            const char* a1 = cA + (size_t)(t + 1) * kstep;
            const char* a2 = last ? nA : cA + (size_t)(t + 2) * kstep; const char* b2 = last ? nB : cB + (size_t)(t + 2) * kstep;
            const char* a3 = a2 + kstep; const char* b3 = b2 + kstep;
            if constexpr (SP2) {
            PG8_LDB(B0, 0, 0); PG8_LDB(B1, 0, 1); PG8_SCHED; PG8_LDA(At, 0, 0); PG8_STAGE(PG8_SA(1, 1), a1 + hstepA, voffA);
            PG8_WAIT_V(8); PG8_WAIT_L(0); PG8_BAR; PG8_MMA(0, 0, At, B0); PG8_MMA(0, 1, At, B1); PG8_BAR; PG8_SCHED;
            PG8_LDA(At, 0, 1); PG8_STAGE(PG8_SB(0, 0), b2, voffB); PG8_STAGE(PG8_SB(0, 1), b2 + hstepB, voffB); PG8_STAGE(PG8_SA(0, 0), a2, voffA);
            PG8_WAIT_V(8); PG8_WAIT_L(0); PG8_BAR; PG8_MMA(1, 0, At, B0); PG8_MMA(1, 1, At, B1); PG8_BAR; PG8_SCHED;
            PG8_LDB(B0, 1, 0); PG8_LDB(B1, 1, 1); PG8_SCHED; PG8_LDA(At, 1, 0); PG8_STAGE(PG8_SA(0, 1), a2 + hstepA, voffA);
            PG8_WAIT_V(8); PG8_WAIT_L(0); PG8_BAR; PG8_MMA(0, 0, At, B0); PG8_MMA(0, 1, At, B1); PG8_BAR; PG8_SCHED;
            PG8_LDA(At, 1, 1); PG8_STAGE(PG8_SB(1, 0), b3, voffB); PG8_STAGE(PG8_SB(1, 1), b3 + hstepB, voffB); PG8_STAGE(PG8_SA(1, 0), a3, voffA);
            PG8_WAIT_V(8); PG8_WAIT_L(0); PG8_BAR; PG8_MMA(1, 0, At, B0); PG8_MMA(1, 1, At, B1); PG8_BAR; PG8_SCHED;
            } else {
            PG8_LDB(B0, 0, 0); PG8_SCHED; PG8_LDA(At, 0, 0); PG8_STAGE(PG8_SA(1, 1), a1 + hstepA, voffA);
            PG8_WAIT_L(8); PG8_BAR; PG8_WAIT_L(0); PG8_MMA(0, 0, At, B0); PG8_BAR; PG8_SCHED;
            PG8_LDB(B1, 0, 1); PG8_STAGE(PG8_SB(0, 0), b2, voffB);
            PG8_BAR; PG8_WAIT_L(0); PG8_MMA(0, 1, At, B1); PG8_BAR;
            PG8_LDA(At, 0, 1); PG8_STAGE(PG8_SA(0, 0), a2, voffA);
            PG8_BAR; PG8_WAIT_L(0); PG8_MMA(1, 0, At, B0); PG8_BAR; PG8_SCHED;
            PG8_STAGE(PG8_SB(0, 1), b2 + hstepB, voffB);
            PG8_WAIT_V(6); PG8_BAR; PG8_MMA(1, 1, At, B1); PG8_BAR;
            PG8_LDB(B0, 1, 0); PG8_SCHED; PG8_LDA(At, 1, 0); PG8_STAGE(PG8_SA(0, 1), a2 + hstepA, voffA);
            PG8_WAIT_L(8); PG8_BAR; PG8_WAIT_L(0); PG8_MMA(0, 0, At, B0); PG8_BAR; PG8_SCHED;
            PG8_LDB(B1, 1, 1); PG8_STAGE(PG8_SB(1, 0), b3, voffB);
            PG8_BAR; PG8_WAIT_L(0); PG8_MMA(0, 1, At, B1); PG8_BAR;
            PG8_LDA(At, 1, 1); PG8_STAGE(PG8_SA(1, 0), a3, voffA);
            PG8_BAR; PG8_WAIT_L(0); PG8_MMA(1, 0, At, B0); PG8_BAR; PG8_SCHED;
            PG8_STAGE(PG8_SB(1, 1), b3 + hstepB, voffB);
            PG8_WAIT_V(6); PG8_BAR; PG8_MMA(1, 1, At, B1); PG8_BAR;
            }
        }
        if constexpr (ALIGN_EPI) { if (wr == 0) PG8_BAR; }
        E(acc, cur, wr, wc, fr, fq);
        if (!has_next) break;
#pragma unroll
        for (int a = 0; a < 2; ++a)
#pragma unroll
            for (int b = 0; b < 2; ++b)
#pragma unroll
                for (int m = 0; m < 4; ++m)
#pragma unroll
                    for (int n = 0; n < 2; ++n) acc[a][b][m][n] = (f32x4){0.f, 0.f, 0.f, 0.f};
        cur = nxt; cA = nA; cB = nB; ++ui;
        if constexpr (ALIGN_EPI) { if (wr == 1) PG8_BAR; }
    }
    PG8_WAIT_V(0);
    if constexpr (!ALIGN_EPI) { if (wr == 0) PG8_BAR; }
    PG8_BAR;
#undef PG8_SA
#undef PG8_SB
#undef PG8_STAGE
#undef PG8_LDA
#undef PG8_LDB
#undef PG8_MMA
#undef PG8_WAIT_V
#undef PG8_WAIT_L
#undef PG8_BAR
#undef PG8_SCHED
}
#endif
}
#ifdef CPU_EMU
#define GEMM_LDS(F) ((F).lds)
#else
#define GEMM_LDS(F) ((PG8_LAS unsigned char*)(F).lds)
#endif
#ifndef PG8_SP2
#define PG8_SP2 true
#endif
#ifndef PG8_ALIGN
#define PG8_ALIGN true
#endif

typedef const f32x4 (&AccRef)[2][2][4][2];
struct Lane4 { int wr, wc, fr, fq; };
__device__ __forceinline__ Lane4 epi_lane(int wr, int wc) {
    int t = hw_lane();
#ifndef CPU_EMU
    asm volatile("" : "+v"(t));
#endif
    Lane4 L; L.wr = wr; L.wc = wc; L.fr = t & 15; L.fq = (t >> 4) & 3; return L;
}
struct EpiF32 {
    static constexpr bool PERM = false;
    float* O; int ldc;
    __device__ __forceinline__ void operator()(AccRef acc, const pg8::Unit& u, int wr_, int wc_, int, int) const {
        const Lane4 L = epi_lane(wr_, wc_); const int wr = L.wr, wc = L.wc, fr = L.fr, fq = L.fq;
        const int col0 = u.pn * 256 + wc * 32 + 4 * fq;
#pragma unroll
        for (int ai = 0; ai < 2; ++ai)
#pragma unroll
            for (int m = 0; m < 4; ++m) { float* rowp = O + (size_t)(u.pm * 256 + ai * 128 + wr * 64 + m * 16 + fr) * ldc + col0;
#pragma unroll
                for (int bj = 0; bj < 2; ++bj)
#pragma unroll
                    for (int n = 0; n < 2; ++n) *(f32x4*)(rowp + bj * 128 + n * 16) = acc[ai][bj][m][n]; }
    }
};
struct EpiGlu {
    static constexpr bool PERM = true;
    bf16_t* O;
    __device__ __forceinline__ void operator()(AccRef acc, const pg8::Unit& u, int wr_, int wc_, int, int) const {
        const Lane4 L = epi_lane(wr_, wc_); const int wr = L.wr, wc = L.wc, fr = L.fr, fq = L.fq;
        const int col0 = u.pn * 128 + wc * 32 + 8 * fq;
#pragma unroll
        for (int ai = 0; ai < 2; ++ai)
#pragma unroll
            for (int m = 0; m < 4; ++m) { bf16_t* rowp = O + (size_t)(u.pm * 256 + ai * 128 + wr * 64 + m * 16 + fr) * DM + col0; float o[8];
#pragma unroll
                for (int n = 0; n < 2; ++n) { const f32x4 v = acc[ai][0][m][n], g = acc[ai][1][m][n];
#pragma unroll
                    for (int e = 0; e < 4; ++e) o[4 * n + e] = v[e] * sigmoidf_(g[e]); }
                u32x4 w; w.x = pk2(o[0], o[1]); w.y = pk2(o[2], o[3]); w.z = pk2(o[4], o[5]); w.w = pk2(o[6], o[7]); *(u32x4*)rowp = w; }
    }
};
__device__ __forceinline__ u32x4 pack8(const f32x4 a, const f32x4 b, float s) {
    u32x4 w; w.x = pk2(a[0] * s, a[1] * s); w.y = pk2(a[2] * s, a[3] * s); w.z = pk2(b[0] * s, b[1] * s); w.w = pk2(b[2] * s, b[3] * s); return w;
}
struct EpiB16 {
    static constexpr bool PERM = true;
    bf16_t* O; int ldc;
    __device__ __forceinline__ void operator()(AccRef acc, const pg8::Unit& u, int wr_, int wc_, int, int) const {
        const Lane4 L = epi_lane(wr_, wc_); const int wr = L.wr, wc = L.wc, fr = L.fr, fq = L.fq;
        const int col0 = u.pn * 256 + wc * 32 + 8 * fq;
#pragma unroll
        for (int ai = 0; ai < 2; ++ai)
#pragma unroll
            for (int m = 0; m < 4; ++m) { bf16_t* rowp = O + (size_t)(u.pm * 256 + ai * 128 + wr * 64 + m * 16 + fr) * ldc + col0;
#pragma unroll
                for (int bj = 0; bj < 2; ++bj) *(u32x4*)(rowp + bj * 128) = pack8(acc[ai][bj][m][0], acc[ai][bj][m][1], 1.f); }
    }
};
typedef _Float16 f16x2_hw __attribute__((ext_vector_type(2)));
#ifdef CPU_EMU
__device__ __forceinline__ unsigned pkh2(float lo, float hi) { const f16x2_hw v = {(_Float16)lo, (_Float16)hi}; unsigned r; memcpy(&r, &v, 4); return r; }
__device__ __forceinline__ float hlo(unsigned w) { f16x2_hw v; memcpy(&v, &w, 4); return (float)v[0]; }
__device__ __forceinline__ float hhi(unsigned w) { f16x2_hw v; memcpy(&v, &w, 4); return (float)v[1]; }
#else
__device__ __forceinline__ unsigned pkh2(float lo, float hi) { const f32x2 v = {lo, hi}; const f16x2_hw b = __builtin_convertvector(v, f16x2_hw); return __builtin_bit_cast(unsigned, b); }
__device__ __forceinline__ float hlo(unsigned w) { return (float)__builtin_bit_cast(f16x2_hw, w)[0]; }
__device__ __forceinline__ float hhi(unsigned w) { return (float)__builtin_bit_cast(f16x2_hw, w)[1]; }
#endif
struct EpiH16 {
    static constexpr bool PERM = true;
    unsigned short* O; int ldc;
    __device__ __forceinline__ void operator()(AccRef acc, const pg8::Unit& u, int wr_, int wc_, int, int) const {
        const Lane4 L = epi_lane(wr_, wc_); const int wr = L.wr, wc = L.wc, fr = L.fr, fq = L.fq;
        const int col0 = u.pn * 256 + wc * 32 + 8 * fq;
#pragma unroll
        for (int ai = 0; ai < 2; ++ai)
#pragma unroll
            for (int m = 0; m < 4; ++m) { unsigned short* rowp = O + (size_t)(u.pm * 256 + ai * 128 + wr * 64 + m * 16 + fr) * ldc + col0;
#pragma unroll
                for (int bj = 0; bj < 2; ++bj) { const f32x4 a = acc[ai][bj][m][0], b = acc[ai][bj][m][1]; u32x4 w; w.x = pkh2(a[0], a[1]); w.y = pkh2(a[2], a[3]); w.z = pkh2(b[0], b[1]); w.w = pkh2(b[2], b[3]);
                    *(u32x4*)(rowp + bj * 128) = w; } }
    }
};
struct EpiSsdIn {
    static constexpr bool PERM = true;
    bf16_t* Z; bf16_t* XBC; float* DT;
    __device__ __forceinline__ void operator()(AccRef acc, const pg8::Unit& u, int wr_, int wc_, int, int) const {
        const Lane4 L = epi_lane(wr_, wc_); const int wr = L.wr, wc = L.wc, fr = L.fr, fq = L.fq;
        const int cw = wc * 32 + 8 * fq;
#pragma unroll
        for (int ai = 0; ai < 2; ++ai)
#pragma unroll
            for (int m = 0; m < 4; ++m) { const size_t row = (size_t)(u.pm * 256 + ai * 128 + wr * 64 + m * 16 + fr);
#pragma unroll
                for (int bj = 0; bj < 2; ++bj) { const int col = u.pn * 256 + bj * 128 + cw;
                    if (u.pn < 8) *(u32x4*)(Z + row * 2048 + col) = pack8(acc[ai][bj][m][0], acc[ai][bj][m][1], 1.f);
                    else if (u.pn < 20) *(u32x4*)(XBC + row * 3072 + (col - 2048)) = pack8(acc[ai][bj][m][0], acc[ai][bj][m][1], 1.f);
                    else if (col - 5120 < 64) { float* p = DT + row * 64 + (col - 5120); *(f32x4*)p = acc[ai][bj][m][0]; *(f32x4*)(p + 4) = acc[ai][bj][m][1]; } } }
    }
};
struct EpiMlaDown {
    static constexpr bool PERM = true;
    bf16_t* C; float* RS;
    __device__ __forceinline__ void operator()(AccRef acc, const pg8::Unit& u, int wr_, int wc_, int, int) const {
        const Lane4 L = epi_lane(wr_, wc_); const int wr = L.wr, wc = L.wc, fr = L.fr, fq = L.fq;
        const int cw = wc * 32 + 8 * fq;
#pragma unroll
        for (int ai = 0; ai < 2; ++ai)
#pragma unroll
            for (int m = 0; m < 4; ++m) { const size_t row = (size_t)(u.pm * 256 + ai * 128 + wr * 64 + m * 16 + fr); float ss = 0.f;
#pragma unroll
                for (int bj = 0; bj < 2; ++bj) { const int col = u.pn * 256 + bj * 128 + cw; const f32x4 a = acc[ai][bj][m][0], b = acc[ai][bj][m][1];
                    *(u32x4*)(C + row * 512 + col) = pack8(a, b, 1.f);
                    if (u.pn == 0 || bj == 0) ss += (a[0] * a[0] + a[1] * a[1]) + (a[2] * a[2] + a[3] * a[3]) + (b[0] * b[0] + b[1] * b[1]) + (b[2] * b[2] + b[3] * b[3]); }
                ss += __shfl_xor(ss, 16); ss += __shfl_xor(ss, 32);
                if (fq == 0) RS[row * 8 + u.pn * 4 + wc] = ss; }
    }
};
struct EpiMlaUp {
    static constexpr bool PERM = true;
    bf16_t* Q; bf16_t* Kb; bf16_t* Vb; const float* RS;
    __device__ __forceinline__ void operator()(AccRef acc, const pg8::Unit& u, int wr_, int wc_, int, int) const {
        const Lane4 L = epi_lane(wr_, wc_); const int wr = L.wr, wc = L.wc, fr = L.fr, fq = L.fq;
        const bool isq = u.pn < 8;
        if (isq && wc == 3) return;
#pragma unroll
        for (int ai = 0; ai < 2; ++ai)
#pragma unroll
            for (int m = 0; m < 4; ++m) { const int tok = u.pm * 256 + ai * 128 + wr * 64 + m * 16 + fr; const int b = tok / LTOK, p = tok - b * LTOK;
                const f32x4 rs = *(const f32x4*)(RS + ((unsigned)tok * 8u + (isq ? 0u : 4u)));
                const float rn = 1.0f / sqrtf(((rs[0] + rs[1]) + (rs[2] + rs[3])) * (isq ? (1.f / 256.f) : (1.f / 128.f)) + 1e-6f);
#pragma unroll
                for (int bj = 0; bj < 2; ++bj) { bf16_t* dst;
                    if (isq) dst = Q + ((unsigned)((b * 16 + u.pn * 2 + bj) * LTOK + p) * 128u + (unsigned)(wc * 32 + 8 * fq));
                    else { const int col = (u.pn & 3) * 256 + bj * 128 + wc * 32 + 8 * fq; const int head = col >> 6, d = col & 63; const unsigned rowi = (unsigned)((b * 16 + head) * LTOK + p);
                        dst = u.pn < 12 ? Kb + (rowi * 128u + (unsigned)d) : Vb + (rowi * 64u + (unsigned)d); }
                    *(u32x4*)dst = pack8(acc[ai][bj][m][0], acc[ai][bj][m][1], rn); }
                asm volatile("" ::: "memory"); }
    }
};

namespace att {
constexpr int NW = 8, QBLK = 32, KVBLK = 64, LDQ = 128, LDK = 128, LDV = 64, LDO = 1024;
constexpr float SCALE = 0.10206207261596575f;
constexpr float THR = 8.f;
constexpr size_t SHM_V = KVBLK * 128 * 2, SHM_K = KVBLK * 128 * 2, SHM_ATTN = 2 * SHM_V + 2 * SHM_K + NW * 64 * 4;
#ifdef CPU_EMU
__device__ __forceinline__ void attn_body(const bf16_t* Qb, const bf16_t* Kh, const bf16_t* Vh, bf16_t* Ob, int seq, unsigned char* lds, int tq0, const float* ROPE, int wave_s) {
    const int tid = threadIdx.x, wid = tid >> 6, lane = tid & 63, r32 = lane & 31, hi = lane >> 5;
    if (hi == 0) {
        const bf16_t* qg = Qb + (size_t)(wid * 32 + r32) * LDQ; float m = -1e30f; float q[96];
        for (int d = 0; d < 96; ++d) q[d] = bf2f(qg[d]);
        if (tq0 >= 0) { const int t = tq0 + wid * 32 + r32;
            for (int i = 0; i < 16; ++i) { const int pos = i < 8 ? (t >> 6) : (t & 63); const float c = ROPE[(pos * 8 + (i & 7)) * 2], sn = ROPE[(pos * 8 + (i & 7)) * 2 + 1];
                const float x1 = q[64 + 2 * i], x2 = q[64 + 2 * i + 1]; q[64 + 2 * i] = x1 * c - x2 * sn; q[64 + 2 * i + 1] = x2 * c + x1 * sn; }
            for (int d = 64; d < 96; ++d) q[d] = bf2f((bf16_t)f2bf(q[d])); }
        std::vector<float> sc(seq);
        for (int k = 0; k < seq; ++k) { float s = 0.f; for (int d = 0; d < 96; ++d) s += q[d] * bf2f(Kh[(size_t)k * LDK + d]); sc[k] = s * SCALE; m = fmaxf(m, sc[k]); }
        float l = 0.f; float o[64]; for (int d = 0; d < 64; ++d) o[d] = 0.f;
        for (int k = 0; k < seq; ++k) { const float pr = expf(sc[k] - m); l += pr; const float prb = bf2f((bf16_t)f2bf(pr)); for (int d = 0; d < 64; ++d) o[d] += prb * bf2f(Vh[(size_t)k * LDV + d]); }
        for (int d = 0; d < 64; ++d) Ob[(size_t)(wid * 32 + r32) * LDO + d] = (bf16_t)f2bf(o[d] / l);
    }
    __syncthreads();
}
#else
using s16x4 = __attribute__((ext_vector_type(4))) short;
#define KSWZ(row, colB) ((row) * 256 + ((colB) ^ (((row) & 7) << 4)))
#define SBAR() __builtin_amdgcn_sched_barrier(0)
__device__ __forceinline__ unsigned cvtpk(float lo, float hi) { unsigned r; asm volatile("v_cvt_pk_bf16_f32 %0, %1, %2" : "=v"(r) : "v"(lo), "v"(hi)); return r; }
__device__ __forceinline__ void partialSM(f32x16& p0, f32x16& p1, float& m_reg, float& mn, float& alpha) {
  constexpr float C = SCALE * 1.4426950408889634f;
  float pmax = p0[0]; for (int r = 1; r < 16; ++r) pmax = fmaxf(pmax, p0[r]); for (int r = 0; r < 16; ++r) pmax = fmaxf(pmax, p1[r]);
  { auto rr = __builtin_amdgcn_permlane32_swap(__float_as_uint(pmax), __float_as_uint(pmax), false, false);
    pmax = fmaxf(__uint_as_float(rr[0]), __uint_as_float(rr[1])); }
  if (__builtin_expect(__all(pmax - m_reg <= THR / SCALE), 1)) { mn = m_reg; alpha = 1.f; }
  else { mn = fmaxf(m_reg, pmax); alpha = __builtin_amdgcn_exp2f((m_reg - mn) * C); m_reg = mn; }
  float mnC = -mn * C;
  for (int r = 0; r < 16; ++r) p0[r] = fmaf(p0[r], C, mnC); for (int r = 0; r < 16; ++r) p1[r] = fmaf(p1[r], C, mnC);
  for (int r = 0; r < 16; ++r) p0[r] = __builtin_amdgcn_exp2f(p0[r]);
}
__device__ __forceinline__ void finishSM(f32x16& p0, f32x16& p1, float alpha, float& l_reg, bf16x8& pa0, bf16x8& pa1, bf16x8& pa2, bf16x8& pa3) {
  for (int r = 0; r < 16; ++r) p1[r] = __builtin_amdgcn_exp2f(p1[r]);
  float ps = 0; for (int r = 0; r < 16; ++r) ps += p0[r]; for (int r = 0; r < 16; ++r) ps += p1[r];
  { auto rr = __builtin_amdgcn_permlane32_swap(__float_as_uint(ps), __float_as_uint(ps), false, false);
    ps = __uint_as_float(rr[0]) + __uint_as_float(rr[1]); }
  l_reg = l_reg * alpha + ps;
#define PK4(P, BASE, OUT) do { unsigned a0 = cvtpk(P[BASE + 0], P[BASE + 1]), a1 = cvtpk(P[BASE + 2], P[BASE + 3]);   \
    unsigned b0 = cvtpk(P[BASE + 4], P[BASE + 5]), b1 = cvtpk(P[BASE + 6], P[BASE + 7]);                              \
    auto r0 = __builtin_amdgcn_permlane32_swap(a0, b0, false, false); auto r1 = __builtin_amdgcn_permlane32_swap(a1, b1, false, false); \
    u32x4 w = {r0[0], r1[0], r0[1], r1[1]}; OUT = *reinterpret_cast<bf16x8*>(&w); } while (0)
  PK4(p0, 0, pa0); PK4(p0, 8, pa1); PK4(p1, 0, pa2); PK4(p1, 8, pa3);
#undef PK4
}
__device__ __forceinline__ void qkt(f32x16& p0, f32x16& p1, const bf16_t* Ks, const bf16x8* qr, int r32, int hi) {
  p0 = f32x16{}; p1 = f32x16{};
#pragma unroll
  for (int d0 = 0; d0 < 6; ++d0) { int cb = (d0 * 16 + hi * 8) * 2;
    bf16x8 b0 = *reinterpret_cast<const bf16x8*>((const char*)Ks + KSWZ(r32, cb));
    bf16x8 b1 = *reinterpret_cast<const bf16x8*>((const char*)Ks + KSWZ(32 + r32, cb));
    p0 = __builtin_amdgcn_mfma_f32_32x32x16_bf16(b0, qr[d0], p0, 0, 0, 0);
    p1 = __builtin_amdgcn_mfma_f32_32x32x16_bf16(b1, qr[d0], p1, 0, 0, 0); }
}
__device__ __forceinline__ int v_st(int k, int c) { const int kk = (k & ~0xC) | ((k & 4) << 1) | ((k & 8) >> 1); return ((kk >> 3) * 4 + (c >> 5)) * 512 + ((kk & 7) * 32 + (c & 31)) * 2; }
__device__ __forceinline__ int v_rd_base(int lane) { return ((lane & 3) << 3) | (((lane >> 2) & 3) << 6) | (((lane >> 4) & 1) << 5) | (((lane >> 5) & 1) << 8); }
constexpr int v_rd_off(int d0, int ks, int half) { return d0 * 512 + ks * 4096 + half * 2048; }
template <int OFF> __device__ __forceinline__ s16x4 tr_read(int vb) {
  s16x4 r; asm volatile("ds_read_b64_tr_b16 %0, %1 offset:%2" : "=&v"(r) : "v"(vb), "i"(OFF) : "memory"); return r;
}
template <int D0> __device__ __forceinline__ void pv_one(f32x16& od, int vb, bf16x8 pa0, bf16x8 pa1, bf16x8 pa2, bf16x8 pa3) {
  const s16x4 l0 = tr_read<v_rd_off(D0, 0, 0)>(vb), h0 = tr_read<v_rd_off(D0, 0, 1)>(vb), l1 = tr_read<v_rd_off(D0, 1, 0)>(vb), h1 = tr_read<v_rd_off(D0, 1, 1)>(vb);
  const s16x4 l2 = tr_read<v_rd_off(D0, 2, 0)>(vb), h2 = tr_read<v_rd_off(D0, 2, 1)>(vb), l3 = tr_read<v_rd_off(D0, 3, 0)>(vb), h3 = tr_read<v_rd_off(D0, 3, 1)>(vb);
  asm volatile("s_waitcnt lgkmcnt(0)" ::: "memory"); SBAR();
#define PK(L, H) (bf16x8){L[0], L[1], L[2], L[3], H[0], H[1], H[2], H[3]}
  od = __builtin_amdgcn_mfma_f32_32x32x16_bf16(pa0, PK(l0, h0), od, 0, 0, 0);
  od = __builtin_amdgcn_mfma_f32_32x32x16_bf16(pa1, PK(l1, h1), od, 0, 0, 0);
  od = __builtin_amdgcn_mfma_f32_32x32x16_bf16(pa2, PK(l2, h2), od, 0, 0, 0);
  od = __builtin_amdgcn_mfma_f32_32x32x16_bf16(pa3, PK(l3, h3), od, 0, 0, 0);
#undef PK
}
__device__ __forceinline__ void pv_d0(f32x16* o, int vb, bf16x8 pa0, bf16x8 pa1, bf16x8 pa2, bf16x8 pa3) {
  pv_one<0>(o[0], vb, pa0, pa1, pa2, pa3); pv_one<1>(o[1], vb, pa0, pa1, pa2, pa3);
}
__device__ __forceinline__ void attn_body(const bf16_t* __restrict__ Qb, const bf16_t* __restrict__ Kh, const bf16_t* __restrict__ Vh, bf16_t* __restrict__ Ob, int seq, char* lds, int tq0, const float* __restrict__ ROPE, int wave_s) {
  const int wid = wave_s, lane = hw_lane(), tid = wid * 64 + lane, r32 = lane & 31, hi = lane >> 5;
  bf16_t* V_lds = (bf16_t*)lds; bf16_t* K_lds = (bf16_t*)(lds + 2 * SHM_V);
  float* ws = (float*)(lds + 2 * SHM_V + 2 * SHM_K) + wid * 64; float* li_l = ws; float* al_l = ws + 32;
  float m_reg = -1e30f, l_reg = 0; f32x16 o[2] = {}; bf16x8 qr[6];
  const bf16_t* Qw = Qb + (long)(wid * QBLK + r32) * LDQ + hi * 8;
#pragma unroll
  for (int d0 = 0; d0 < 6; ++d0) qr[d0] = *reinterpret_cast<const bf16x8*>(Qw + d0 * 16);
  if (tq0 >= 0) {
    const int t = tq0 + wid * QBLK + r32;
#pragma unroll
    for (int dd = 0; dd < 2; ++dd) { const int pos = dd == 0 ? (t >> 6) : (t & 63);
      const f32x4 r0 = *(const f32x4*)(ROPE + pos * 16 + 8 * hi), r1 = *(const f32x4*)(ROPE + pos * 16 + 8 * hi + 4);
      const u32x4 w = *reinterpret_cast<const u32x4*>(&qr[4 + dd]); u32x4 o;
      { const float x1 = bflo(w.x), x2 = bfhi(w.x); o.x = pk2(x1 * r0[0] - x2 * r0[1], x2 * r0[0] + x1 * r0[1]); }
      { const float x1 = bflo(w.y), x2 = bfhi(w.y); o.y = pk2(x1 * r0[2] - x2 * r0[3], x2 * r0[2] + x1 * r0[3]); }
      { const float x1 = bflo(w.z), x2 = bfhi(w.z); o.z = pk2(x1 * r1[0] - x2 * r1[1], x2 * r1[0] + x1 * r1[1]); }
      { const float x1 = bflo(w.w), x2 = bfhi(w.w); o.w = pk2(x1 * r1[2] - x2 * r1[3], x2 * r1[2] + x1 * r1[3]); }
      qr[4 + dd] = *reinterpret_cast<const bf16x8*>(&o); }
  }
  const int sr = tid >> 4, sc = (tid & 15) * 8;
  const int vk = tid >> 3, vc = (tid & 7) * 8, vst0 = v_st(vk, vc);
  const int vb0 = (int)(uintptr_t)V_lds + v_rd_base(lane);
  struct { bf16x8 vs0, ks0, ks1; } sr_[2];
#define SLOAD(i, k0) do { sr_[i].vs0 = *reinterpret_cast<const bf16x8*>(&Vh[(long)((k0) + vk) * LDV + vc]); \
    sr_[i].ks0 = *reinterpret_cast<const bf16x8*>(&Kh[(long)((k0) + sr) * LDK + sc]); sr_[i].ks1 = *reinterpret_cast<const bf16x8*>(&Kh[(long)((k0) + 32 + sr) * LDK + sc]); } while (0)
#define SWRITE(b, i) do { *(bf16x8*)((char*)V_lds + (b) * SHM_V + vst0) = sr_[i].vs0; int kc = sc * 2;               \
    *(bf16x8*)((char*)K_lds + (b) * SHM_K + KSWZ(sr, kc)) = sr_[i].ks0;                       \
    *(bf16x8*)((char*)K_lds + (b) * SHM_K + KSWZ(32 + sr, kc)) = sr_[i].ks1; } while (0)
#define SWAIT() asm volatile("s_waitcnt vmcnt(3)" ::: "memory")
#define RESC(a) do { if (__any((a) < 1.f)) { if (hi == 0) al_l[r32] = (a); asm volatile("s_waitcnt lgkmcnt(0)" ::: "memory"); \
    for (int d = 0; d < 2; ++d) for (int r = 0; r < 16; ++r) o[d][r] *= al_l[crow(r, hi)]; } } while (0)
  f32x16 pA0, pA1, pB0, pB1; float mnA, mnB, alA, alB; bf16x8 pa0, pa1, pa2, pa3; const int NT = seq / KVBLK;
  constexpr int SE = 0, SO = 1;
  SLOAD(SE, 0); asm volatile("s_waitcnt vmcnt(0)" ::: "memory"); SWRITE(0, SE); __syncthreads();
  qkt(pA0, pA1, K_lds, qr, r32, hi); partialSM(pA0, pA1, m_reg, mnA, alA);
  SLOAD(SO, KVBLK); if (2 < NT) SLOAD(SE, 2 * KVBLK);
  SWAIT(); SWRITE(1, SO); __syncthreads();
  for (int j = 1; j + 1 < NT; j += 2) {
    SBAR(); qkt(pB0, pB1, (bf16_t*)((char*)K_lds + SHM_K), qr, r32, hi);
    finishSM(pA0, pA1, alA, l_reg, pa0, pa1, pa2, pa3); SBAR();
    SLOAD(SO, (j + 2) * KVBLK); SBAR();
    pv_d0(o, vb0, pa0, pa1, pa2, pa3); partialSM(pB0, pB1, m_reg, mnB, alB);
    __syncthreads(); SWAIT(); SWRITE(0, SE);
    RESC(alB); __syncthreads();
    SBAR(); qkt(pA0, pA1, K_lds, qr, r32, hi);
    finishSM(pB0, pB1, alB, l_reg, pa0, pa1, pa2, pa3); SBAR();
    if (j + 3 < NT) SLOAD(SE, (j + 3) * KVBLK); SBAR();
    pv_d0(o, vb0 + (int)SHM_V, pa0, pa1, pa2, pa3); partialSM(pA0, pA1, m_reg, mnA, alA);
    __syncthreads(); SWAIT(); SWRITE(1, SO);
    RESC(alA); __syncthreads();
  }
  SBAR(); qkt(pB0, pB1, (bf16_t*)((char*)K_lds + SHM_K), qr, r32, hi);
  finishSM(pA0, pA1, alA, l_reg, pa0, pa1, pa2, pa3); SBAR();
  pv_d0(o, vb0, pa0, pa1, pa2, pa3); partialSM(pB0, pB1, m_reg, mnB, alB);
  __syncthreads(); RESC(alB);
  finishSM(pB0, pB1, alB, l_reg, pa0, pa1, pa2, pa3); SBAR();
  pv_d0(o, vb0 + (int)SHM_V, pa0, pa1, pa2, pa3);
  if (hi == 0) li_l[r32] = l_reg; asm volatile("s_waitcnt lgkmcnt(0)" ::: "memory");
  float rli[16];
#pragma unroll
  for (int r = 0; r < 16; ++r) rli[r] = __builtin_amdgcn_rcpf(li_l[crow(r, hi)]);
  bf16_t* Ow = Ob + (long)(wid * QBLK) * LDO;
#pragma unroll
  for (int r = 0; r < 16; ++r) { int orow = crow(r, hi);
    for (int d0 = 0; d0 < 2; ++d0) Ow[(long)orow * LDO + d0 * 32 + r32] = (bf16_t)f2bf(o[d0][r] * rli[r]); }
  __syncthreads();
#undef SLOAD
#undef SWRITE
#undef SWAIT
#undef RESC
}
#undef KSWZ
#undef SBAR
#endif
}

template <class RowMap>
__device__ __forceinline__ void tr_item(const float* W, int ldw, int k0, int n0, bf16_t* WT, int ldt, int koff, const float* kscale, RowMap rm, float* scr, int lane) {
#pragma unroll 8
    for (int i = 0; i < 32; ++i) { const int kk = 2 * i + (lane >> 5); scr[kk * 33 + (lane & 31)] = W[(size_t)(k0 + kk) * ldw + n0 + (lane & 31)]; }
    wave_sync();
    const int c = lane & 7;
    float ks[8];
#pragma unroll
    for (int e = 0; e < 8; ++e) ks[e] = kscale ? kscale[k0 + 8 * c + e] : 1.f;
#pragma unroll
    for (int j = 0; j < 4; ++j) { const int n = (lane >> 3) + 8 * j; const float* s = scr + (8 * c) * 33 + n;
        u32x4 o; o.x = pk2(s[0 * 33] * ks[0], s[1 * 33] * ks[1]); o.y = pk2(s[2 * 33] * ks[2], s[3 * 33] * ks[3]); o.z = pk2(s[4 * 33] * ks[4], s[5 * 33] * ks[5]); o.w = pk2(s[6 * 33] * ks[6], s[7 * 33] * ks[7]);
        const int row = rm(n0 + n);
        if (row >= 0) *(u32x4*)(WT + (size_t)row * ldt + koff + k0 + 8 * c) = o; }
    wave_sync();
}
struct RmId { int off; __device__ __forceinline__ int operator()(int n) const { return off + n; } };
struct RmGlu { int off; __device__ __forceinline__ int operator()(int n) const { return ((n >> 7) << 8) + off + (n & 127); } };
struct RmUq { __device__ __forceinline__ int operator()(int n) const { const int h = n / 96, d = n - h * 96; int sd = d;
        if (d >= 64) { const int rho = d - 64; const int half = rho >> 4, w = rho & 15; const int i = half * 8 + (w & 7); sd = 64 + 2 * i + (w >> 3); }
        return h * 128 + sd; } };
__device__ __forceinline__ void s5_disc(const Args& A, int it, int p, float& are_bar, float& aim_bar, float& cre, float& cim) {
    const float are = A.in[8][(size_t)it * 64 + p], aim = A.in[9][(size_t)it * 64 + p]; const float dt = expf(A.in[10][it]);
    const float zr = are * dt, zi = aim * dt; const float ez = expf(zr), cs = cosf(zi), sn = sinf(zi), sh = sinf(0.5f * zi);
    are_bar = ez * cs; aim_bar = ez * sn;
    const float nr = expm1f(zr) * cs - 2.f * sh * sh, ni = ez * sn;
    const float den = are * are + aim * aim;
    cre = (nr * are + ni * aim) / den; cim = (ni * are - nr * aim) / den;
}
__device__ __forceinline__ void ph_prep(const Args& A, Frame& F) {
    const int tid = F.tid, lane = F.lane, wave = F.wave, G = F.G, bid = F.bid;
    unsigned char* ws = A.ws;
    { float* ca = (float*)F.lds; float* red = ca + NR * 1024; float* MOD = (float*)(ws + WS_MOD);
      for (int i = tid; i < NR * 1024; i += NTHR) { const int r = i >> 10, k = i & 1023; const float c = r < BATCH ? A.in[1][r * 1024 + k] : A.in[3][k]; ca[i] = siluf_(c); }
      __syncthreads();
      for (int it = bid; it < 4 * 96; it += G) { const int l = it / 96, cb = (it % 96) * 64; float acc[NR];
#pragma unroll
          for (int r = 0; r < NR; ++r) acc[r] = 0.f;
          const float* wp = A.in[4] + ((size_t)l * 1024 + wave * 128) * 6144 + cb + lane;
#pragma unroll 8
          for (int k = 0; k < 128; ++k) { const float w = wp[(size_t)k * 6144];
#pragma unroll
              for (int r = 0; r < NR; ++r) acc[r] += ca[r * 1024 + wave * 128 + k] * w; }
#pragma unroll
          for (int r = 0; r < NR; ++r) red[(wave * NR + r) * 64 + lane] = acc[r];
          __syncthreads();
          if (tid < NR * 64) { const int r = tid >> 6, c = tid & 63; float s = A.in[5][l * 6144 + cb + c];
              for (int w = 0; w < 8; ++w) s += red[(w * NR + r) * 64 + c];
              MOD[((size_t)l * NR + r) * 6144 + cb + c] = s; }
          __syncthreads(); } }
    { float* ROPE = (float*)(ws + WS_ROPE);
      for (int i = bid * NTHR + tid; i < 64 * 8; i += G * NTHR) { const int pos = i >> 3, f = i & 7; const float freq = powf(10000.f, -(float)f / 8.f); const float ang = (float)pos * freq;
          ROPE[2 * i] = cosf(ang); ROPE[2 * i + 1] = sinf(ang); } }
    { float* scr = (float*)(F.lds + wave * 16384);
      const int gw = bid * NWAVES + wave, NGW = G * NWAVES;
      bf16_t* WGLU = (bf16_t*)(ws + WS_WGLU); bf16_t* WIN = (bf16_t*)(ws + WS_WIN); bf16_t* WOUT = (bf16_t*)(ws + WS_WOUT); bf16_t* WDOWN = (bf16_t*)(ws + WS_WDOWN);
      bf16_t* WUP = (bf16_t*)(ws + WS_WUP); bf16_t* WO = (bf16_t*)(ws + WS_WO);
      constexpr int I_GLU = 16 * 32, I_IN = 16 * 162, I_OUT = 32 * 32, I_DOWN = 16 * 13, I_UQ = 4 * 48, I_UK = 2 * 32, I_WO = 16 * 32;
      constexpr int NIT = 4 * I_GLU + I_IN + I_OUT + I_DOWN + I_UQ + 2 * I_UK + I_WO;
      for (int it = gw; it < NIT; it += NGW) { int r = it;
          if (r < 4 * I_GLU) { const int which = r / I_GLU, q = r % I_GLU, j = which >> 1, isgate = which & 1;
              const float* W = (isgate ? A.in[16] : A.in[17]) + (size_t)j * 1024 * 1024;
              tr_item(W, 1024, (q / 32) * 64, (q % 32) * 32, WGLU + (size_t)j * 2048 * 1024, 1024, 0, nullptr, RmGlu{isgate * 128}, scr, lane); continue; } r -= 4 * I_GLU;
          if (r < I_IN) { tr_item(A.in[18], SSD_IN, (r / 162) * 64, (r % 162) * 32, WIN, 1024, 0, nullptr, RmId{0}, scr, lane); continue; } r -= I_IN;
          if (r < I_OUT) { tr_item(A.in[25], 1024, (r / 32) * 64, (r % 32) * 32, WOUT, 2048, 0, A.in[24], RmId{0}, scr, lane); continue; } r -= I_OUT;
          if (r < I_DOWN) { tr_item(A.in[26], 416, (r / 13) * 64, (r % 13) * 32, WDOWN, 1024, 0, nullptr, RmId{0}, scr, lane); continue; } r -= I_DOWN;
          if (r < I_UQ) { tr_item(A.in[29], 1536, (r / 48) * 64, (r % 48) * 32, WUP, 384, 0, A.in[27], RmUq{}, scr, lane); continue; } r -= I_UQ;
          if (r < I_UK) { tr_item(A.in[30], 1024, (r / 32) * 64, (r % 32) * 32, WUP, 384, 256, A.in[28], RmId{2048}, scr, lane); continue; } r -= I_UK;
          if (r < I_UK) { tr_item(A.in[31], 1024, (r / 32) * 64, (r % 32) * 32, WUP, 384, 256, A.in[28], RmId{3072}, scr, lane); continue; } r -= I_UK;
          tr_item(A.in[32], 1024, (r / 32) * 64, (r % 32) * 32, WO, 1024, 0, nullptr, RmId{0}, scr, lane); }
      const u32x4 z4 = {0u, 0u, 0u, 0u};
      const long gt = (long)bid * NTHR + tid, GT = (long)G * NTHR;
      for (long i = gt; i < (long)(SSD_IN_PAD - SSD_IN) * 128; i += GT) *(u32x4*)(WIN + (size_t)SSD_IN * 1024 + i * 8) = z4;
      for (long i = gt; i < (long)(512 - 416) * 128; i += GT) *(u32x4*)(WDOWN + (size_t)416 * 1024 + i * 8) = z4;
      for (long i = gt; i < 4096L * 48; i += GT) { const int R = (int)(i / 48), k = (int)(i % 48) * 8;
          const bool zero = R < 2048 ? (k >= 256 || (R & 127) >= 96) : (k < 256);
          if (zero) *(u32x4*)(WUP + (size_t)R * 384 + k) = z4; }
      { unsigned char* UT = ws + WS_UT; unsigned char* VT = ws + WS_VT; float* US = (float*)(ws + WS_US); float* VS = (float*)(ws + WS_VS);
        for (int rw = gw; rw < 2 * 4 * 16384; rw += NGW) { const bool isu = rw < 4 * 16384; const int row = isu ? rw : rw - 4 * 16384;
            const float* src = (isu ? A.in[35] : A.in[36]) + (size_t)row * 1024;
            const f32x4 a = *(const f32x4*)(src + 8 * lane), b = *(const f32x4*)(src + 8 * lane + 4), c = *(const f32x4*)(src + 512 + 8 * lane), d = *(const f32x4*)(src + 512 + 8 * lane + 4);
            float v[16];
#pragma unroll
            for (int e = 0; e < 4; ++e) { v[e] = a[e]; v[4 + e] = b[e]; v[8 + e] = c[e]; v[12 + e] = d[e]; }
            float mx = 0.f;
#pragma unroll
            for (int e = 0; e < 16; ++e) mx = fmaxf(mx, fabsf(v[e]));
            mx = wave_max(mx);
            const float inv = mx > 0.f ? 127.f / mx : 0.f;
            unsigned q[16];
#pragma unroll
            for (int e = 0; e < 16; ++e) q[e] = (unsigned)(int)(rintf(v[e] * inv) + 128.f);
            u32x4 o;
            o.x = q[0] | (q[1] << 8) | (q[2] << 16) | (q[3] << 24); o.y = q[4] | (q[5] << 8) | (q[6] << 16) | (q[7] << 24);
            o.z = q[8] | (q[9] << 8) | (q[10] << 16) | (q[11] << 24); o.w = q[12] | (q[13] << 8) | (q[14] << 16) | (q[15] << 24);
            o.x ^= 0x80808080u; o.y ^= 0x80808080u; o.z ^= 0x80808080u; o.w ^= 0x80808080u;
            *(u32x4*)((isu ? UT : VT) + (size_t)(row >> 14) * 16384 * 1024 + (size_t)(lane >> 3) * 16384 * 128 + (size_t)(row & 16383) * 128 + 16 * (lane & 7)) = o;
            float qs = 0.f;
#pragma unroll
            for (int e = 0; e < 16; ++e) qs += (float)q[e];
            qs = wave_sum(qs);
            if (lane == 0) { if (isu) { US[2 * row] = mx * (1.f / 127.f); US[2 * row + 1] = qs; } else VS[row] = mx * (1.f / 127.f); } } }
      for (int it = gw; it < 2 * 2 * 64; it += NGW) { unsigned char* base = ws + WS_S5C + (size_t)it * S5C_ITEM;
          float ar, ai, cr, ci; s5_disc(A, it, lane, ar, ai, cr, ci);
          ((f32x2*)base)[lane] = (f32x2){ar, ai};
          const int r = lane & 31, h = lane >> 5;
          const float* bre = A.in[11] + (size_t)it * 64 * 16; const float* bim = A.in[12] + (size_t)it * 64 * 16;
          const float* cre = A.in[13] + (size_t)it * 16 * 64; const float* cim = A.in[14] + (size_t)it * 16 * 64;
#pragma unroll
          for (int blk = 0; blk < 4; ++blk) { const int pst = (blk & 1) * 32 + r; float ar2, ai2, kr, ki; s5_disc(A, it, pst, ar2, ai2, kr, ki); float v[8];
#pragma unroll
              for (int j = 0; j < 8; ++j) { const int c = 8 * h + j; const float br = bre[pst * 16 + c], bi = bim[pst * 16 + c]; v[j] = blk < 2 ? (kr * br - ki * bi) : (kr * bi + ki * br); }
              u32x4 o; o.x = pk2(v[0], v[1]); o.y = pk2(v[2], v[3]); o.z = pk2(v[4], v[5]); o.w = pk2(v[6], v[7]);
              ((u32x4*)(base + 512))[blk * 64 + lane] = o; }
#pragma unroll
          for (int ks = 0; ks < 8; ++ks) { float v[8];
#pragma unroll
              for (int j = 0; j < 8; ++j) { const int k = 16 * ks + 8 * h + j, p = k >> 1, comp = k & 1; v[j] = r < 16 ? (comp == 0 ? cre[r * 64 + p] : -cim[r * 64 + p]) : 0.f; }
              u32x4 o; o.x = pk2(v[0], v[1]); o.y = pk2(v[2], v[3]); o.z = pk2(v[4], v[5]); o.w = pk2(v[6], v[7]);
              ((u32x4*)(base + 512 + 4096))[ks * 64 + lane] = o; } }
    }
    __syncthreads();
    { bf16_t* WSC = (bf16_t*)(ws + WS_WSC); const int gw = bid * NWAVES + wave, NGW = G * NWAVES; const int r = lane & 31, hh = lane >> 5;
      for (int it = gw; it < 4 * 16 * 32; it += NGW) { const int l = it >> 9, hj = (it >> 5) & 15, kb = it & 31, k0 = kb * 32;
          const float* wq = A.in[33] + ((size_t)l * 1024 + k0 + r) * 2048 + hj * 128; const float* sk = A.in[34] + ((size_t)l * 16 + hj) * 128 * 128;
          f32x16 acc[4];
#pragma unroll
          for (int ib = 0; ib < 4; ++ib) acc[ib] = f32x16{};
#pragma unroll 2
          for (int t = 0; t < 8; ++t) { const int d0 = 16 * t + 8 * hh;
              const f32x4 a0 = *(const f32x4*)(wq + d0), a1 = *(const f32x4*)(wq + d0 + 4);
              u32x4 ah, al; { float hi_[8], lo_[8];
#pragma unroll
                  for (int e = 0; e < 4; ++e) { hi_[e] = bflo(pk2(a0[e], 0.f)); lo_[e] = a0[e] - hi_[e]; hi_[4 + e] = bflo(pk2(a1[e], 0.f)); lo_[4 + e] = a1[e] - hi_[4 + e]; }
                  ah.x = pk2(hi_[0], hi_[1]); ah.y = pk2(hi_[2], hi_[3]); ah.z = pk2(hi_[4], hi_[5]); ah.w = pk2(hi_[6], hi_[7]);
                  al.x = pk2(lo_[0], lo_[1]); al.y = pk2(lo_[2], lo_[3]); al.z = pk2(lo_[4], lo_[5]); al.w = pk2(lo_[6], lo_[7]); }
              const bf16x8 Ah = __builtin_bit_cast(bf16x8, ah), Al = __builtin_bit_cast(bf16x8, al);
#pragma unroll
              for (int ib = 0; ib < 4; ++ib) { const float* sp = sk + (size_t)(32 * ib + r) * 128 + d0; const f32x4 b0 = *(const f32x4*)sp, b1 = *(const f32x4*)(sp + 4);
                  u32x4 bh, bl; { float hi_[8], lo_[8];
#pragma unroll
                      for (int e = 0; e < 4; ++e) { hi_[e] = bflo(pk2(b0[e], 0.f)); lo_[e] = b0[e] - hi_[e]; hi_[4 + e] = bflo(pk2(b1[e], 0.f)); lo_[4 + e] = b1[e] - hi_[4 + e]; }
                      bh.x = pk2(hi_[0], hi_[1]); bh.y = pk2(hi_[2], hi_[3]); bh.z = pk2(hi_[4], hi_[5]); bh.w = pk2(hi_[6], hi_[7]);
                      bl.x = pk2(lo_[0], lo_[1]); bl.y = pk2(lo_[2], lo_[3]); bl.z = pk2(lo_[4], lo_[5]); bl.w = pk2(lo_[6], lo_[7]); }
                  const bf16x8 Bh = __builtin_bit_cast(bf16x8, bh), Bl = __builtin_bit_cast(bf16x8, bl);
                  acc[ib] = mfma32(Ah, Bh, acc[ib]); acc[ib] = mfma32(Ah, Bl, acc[ib]); acc[ib] = mfma32(Al, Bh, acc[ib]); } }
#pragma unroll
          for (int ib = 0; ib < 4; ++ib) { bf16_t* dst = WSC + ((size_t)l * 2048 + hj * 128 + 32 * ib + r) * 1024 + k0;
#pragma unroll
              for (int g4 = 0; g4 < 4; ++g4) { u32x2 w; w.x = pk2(acc[ib][4 * g4], acc[ib][4 * g4 + 1]); w.y = pk2(acc[ib][4 * g4 + 2], acc[ib][4 * g4 + 3]); *(u32x2*)(dst + 8 * g4 + 4 * hh) = w; } } } }
}

struct Row16 { float v[16]; };
__device__ __forceinline__ Row16 ld_row_f32(const float* p, int lane) { Row16 r; const f32x4 a = *(const f32x4*)(p + 8 * lane), b = *(const f32x4*)(p + 8 * lane + 4), c = *(const f32x4*)(p + 512 + 8 * lane), d = *(const f32x4*)(p + 512 + 8 * lane + 4);
#pragma unroll
    for (int e = 0; e < 4; ++e) { r.v[e] = a[e]; r.v[4 + e] = b[e]; r.v[8 + e] = c[e]; r.v[12 + e] = d[e]; } return r; }
__device__ __forceinline__ void st_row_f32(float* p, int lane, const Row16& r) {
    *(f32x4*)(p + 8 * lane) = (f32x4){r.v[0], r.v[1], r.v[2], r.v[3]}; *(f32x4*)(p + 8 * lane + 4) = (f32x4){r.v[4], r.v[5], r.v[6], r.v[7]};
    *(f32x4*)(p + 512 + 8 * lane) = (f32x4){r.v[8], r.v[9], r.v[10], r.v[11]}; *(f32x4*)(p + 512 + 8 * lane + 4) = (f32x4){r.v[12], r.v[13], r.v[14], r.v[15]}; }
__device__ __forceinline__ Row16 ld_row_bf16(const bf16_t* p, int lane) { Row16 r; const u32x4 a = *(const u32x4*)(p + 8 * lane), b = *(const u32x4*)(p + 512 + 8 * lane);
    r.v[0] = bflo(a.x); r.v[1] = bfhi(a.x); r.v[2] = bflo(a.y); r.v[3] = bfhi(a.y); r.v[4] = bflo(a.z); r.v[5] = bfhi(a.z); r.v[6] = bflo(a.w); r.v[7] = bfhi(a.w);
    r.v[8] = bflo(b.x); r.v[9] = bfhi(b.x); r.v[10] = bflo(b.y); r.v[11] = bfhi(b.y); r.v[12] = bflo(b.z); r.v[13] = bfhi(b.z); r.v[14] = bflo(b.w); r.v[15] = bfhi(b.w); return r; }
__device__ __forceinline__ void st_row_bf16(bf16_t* p, int lane, const Row16& r) {
    u32x4 a, b; a.x = pk2(r.v[0], r.v[1]); a.y = pk2(r.v[2], r.v[3]); a.z = pk2(r.v[4], r.v[5]); a.w = pk2(r.v[6], r.v[7]);
    b.x = pk2(r.v[8], r.v[9]); b.y = pk2(r.v[10], r.v[11]); b.z = pk2(r.v[12], r.v[13]); b.w = pk2(r.v[14], r.v[15]);
    *(u32x4*)(p + 8 * lane) = a; *(u32x4*)(p + 512 + 8 * lane) = b; }
__device__ __forceinline__ Row16 layer_norm_row(const Row16& v, const float* g, const float* b, int lane) {
    float s = 0.f;
#pragma unroll
    for (int e = 0; e < 16; ++e) s += v.v[e];
    const float mean = wave_sum(s) * (1.f / 1024.f); float q = 0.f;
#pragma unroll
    for (int e = 0; e < 16; ++e) { const float d = v.v[e] - mean; q += d * d; }
    const float rstd = 1.0f / sqrtf(wave_sum(q) * (1.f / 1024.f) + 1e-5f);
    const Row16 gg = ld_row_f32(g, lane), bb = ld_row_f32(b, lane); Row16 o;
#pragma unroll
    for (int e = 0; e < 16; ++e) o.v[e] = (v.v[e] - mean) * rstd * gg.v[e] + bb.v[e];
    return o;
}
__device__ __forceinline__ const float* mod_row(const Args& A, int layer, int tok) { const int b = tok / LTOK, p = tok - b * LTOK; return (const float*)(A.ws + WS_MOD) + ((size_t)layer * NR + (p < CTXL ? BATCH : b)) * 6144; }

__device__ __forceinline__ void ph_init(const Args& A, Frame& F) {
    bf16_t* X = (bf16_t*)(A.ws + WS_X); bf16_t* H = (bf16_t*)(A.ws + WS_H);
    for (int tok = F.bid * NWAVES + F.wave; tok < NTOK; tok += F.G * NWAVES) { const int b = tok / LTOK, p = tok - b * LTOK;
        const float* src = p < CTXL ? A.in[2] + ((size_t)b * CTXL + p) * DM : A.in[0] + ((size_t)b * SEQ + (p - CTXL)) * DM;
        const Row16 x = ld_row_f32(src, F.lane); st_row_bf16(X + (size_t)tok * DM, F.lane, x);
        const float* mod = mod_row(A, 0, tok); const Row16 sh = ld_row_f32(mod, F.lane), sc = ld_row_f32(mod + 1024, F.lane); Row16 h;
#pragma unroll
        for (int e = 0; e < 16; ++e) h.v[e] = x.v[e] * (1.f + sc.v[e]) + sh.v[e];
        st_row_bf16(H + (size_t)tok * DM, F.lane, h); }
}
struct LnStat { float mean, rstd; };
__device__ __forceinline__ LnStat ln_stats(const Row16& v) {
    float s = 0.f;
#pragma unroll
    for (int e = 0; e < 16; ++e) s += v.v[e];
    const float mean = wave_sum(s) * (1.f / 1024.f); float q = 0.f;
#pragma unroll
    for (int e = 0; e < 16; ++e) { const float d = v.v[e] - mean; q += d * d; }
    LnStat r; r.mean = mean; r.rstd = 1.0f / sqrtf(wave_sum(q) * (1.f / 1024.f) + 1e-5f); return r;
}
__device__ __forceinline__ void ph_rowop(const Args& A, Frame& F, int layer, bool dry = false) {
    bf16_t* X = (bf16_t*)(A.ws + WS_X); const bf16_t* OUT = (const bf16_t*)(A.ws + WS_OUT); bf16_t* H2 = (bf16_t*)(A.ws + WS_H2);
    const int ntk = layer == 3 ? BATCH * SEQ : NTOK; const int gw = F.bid * NWAVES + F.wave, NGW = F.G * NWAVES;
    const int t_beg = (int)(((long)gw * ntk) / NGW), t_end = (int)(((long)(gw + 1) * ntk) / NGW);
    const Row16 lg = ld_row_f32(A.in[6] + (size_t)(layer * 2) * DM, F.lane), lb = ld_row_f32(A.in[7] + (size_t)(layer * 2) * DM, F.lane);
    Row16 g1, sh, sc; int cls = -1;
    auto tokof = [&](int ti) { return layer == 3 ? (ti / SEQ) * LTOK + CTXL + (ti % SEQ) : ti; };
    auto finish = [&](int tok, const Row16& x, const Row16& o) {
        Row16 v;
#pragma unroll
        for (int e = 0; e < 16; ++e) v.v[e] = DN_ALPHA * x.v[e] + g1.v[e] * o.v[e];
        const LnStat st = ln_stats(v); Row16 x1, h;
#pragma unroll
        for (int e = 0; e < 16; ++e) { x1.v[e] = (v.v[e] - st.mean) * st.rstd * lg.v[e] + lb.v[e]; h.v[e] = x1.v[e] * (1.f + sc.v[e]) + sh.v[e]; }
        if (dry) { if (x1.v[0] == 12345.678f) st_row_bf16(H2 + (size_t)tok * DM, F.lane, x1); return; }
        st_row_bf16(X + (size_t)tok * DM, F.lane, x1); st_row_bf16(H2 + (size_t)tok * DM, F.lane, h); };
    for (int ti = t_beg; ti < t_end; ti += 2) { const int tokA = tokof(ti); const bool two = ti + 1 < t_end; const int tokB = two ? tokof(ti + 1) : tokA;
        const int clsA = (tokA / LTOK) * 2 + ((tokA % LTOK) < CTXL), clsB = (tokB / LTOK) * 2 + ((tokB % LTOK) < CTXL);
        const Row16 xA = ld_row_bf16(X + (size_t)tokA * DM, F.lane), oA = ld_row_bf16(OUT + (size_t)tokA * DM, F.lane);
        const Row16 xB = ld_row_bf16(X + (size_t)tokB * DM, F.lane), oB = ld_row_bf16(OUT + (size_t)tokB * DM, F.lane);
        if (clsA != cls) { const float* mod = mod_row(A, layer, tokA); g1 = ld_row_f32(mod + 2048, F.lane); sh = ld_row_f32(mod + 3072, F.lane); sc = ld_row_f32(mod + 4096, F.lane); cls = clsA; }
        finish(tokA, xA, oA);
        if (two) { if (clsB != cls) { const float* mod = mod_row(A, layer, tokB); g1 = ld_row_f32(mod + 2048, F.lane); sh = ld_row_f32(mod + 3072, F.lane); sc = ld_row_f32(mod + 4096, F.lane); cls = clsB; }
            finish(tokB, xB, oB); } }
}

__device__ __forceinline__ void ph_s5_scan(const Args& A, Frame& F, int j) {
    const int lane = F.lane, wave = F.wave, r = lane & 31, h = lane >> 5;
    constexpr int RS = 272, NSEG = 4, CPS = (LTOK / 32) / NSEG;
    static_assert((LTOK / 32) % NSEG == 0, "segments");
    unsigned char* Sb = F.lds + wave * (32 * RS);
    f32x2* XCH = (f32x2*)(F.lds + 8 * 32 * RS);
    const bf16_t* H = (const bf16_t*)(A.ws + WS_H);
    const int il = wave >> 2, seg = wave & 3;
    for (int it0 = 2 * F.bid; it0 < BATCH * 128; it0 += 2 * F.G) { const int item = it0 + il; const bool act = item < BATCH * 128;
        const int g = item & 63, dir = (item >> 6) & 1, b = item >> 7;
        const unsigned char* cb = A.ws + WS_S5C + (size_t)((j * 2 + dir) * 64 + g) * S5C_ITEM;
        f32x2 ab = {0.f, 0.f}; bf16x8 Bf[4], Cf[8];
        if (act) { ab = ((const f32x2*)cb)[lane];
#pragma unroll
            for (int q = 0; q < 4; ++q) Bf[q] = ((const bf16x8*)(cb + 512))[q * 64 + lane]; }
        const float are = ab.x, aim = ab.y;
        bf16_t* Y = (bf16_t*)(A.ws + (dir ? WS_YB : WS_YF));
        float sre = 0.f, sim = 0.f;
        const int sbeg = seg * CPS * 32;
#define S5_LOADU(s0) (*(const bf16x8*)(H + ((size_t)b * LTOK + seqpos(dir, (s0) + r)) * DM + g * 16 + 8 * h))
#define S5_BU(ua) do { f32x16 a0 = {}, a1 = {}, a2 = {}, a3 = {}; a0 = mfma32(ua, Bf[0], a0); a2 = mfma32(ua, Bf[2], a2); a1 = mfma32(ua, Bf[1], a1); a3 = mfma32(ua, Bf[3], a3); \
            _Pragma("unroll") for (int q = 0; q < 16; ++q) { *(unsigned*)(Sb + crow(q, h) * RS + r * 4) = pk2(a0[q], a2[q]); *(unsigned*)(Sb + crow(q, h) * RS + (32 + r) * 4) = pk2(a1[q], a3[q]); } } while (0)
        if (act && seg < NSEG - 1) {
            const f32x2 abx = ((const f32x2*)cb)[32 + r]; const float ar0 = ((const f32x2*)cb)[r].x, ai0 = ((const f32x2*)cb)[r].y, ar1 = abx.x, ai1 = abx.y;
            float w0r[16], w0i[16], w1r[16], w1i[16];
            { float p0r = 1.f, p0i = 0.f, p1r = 1.f, p1i = 0.f;
#pragma unroll
              for (int q = 0; q < 16; ++q) { w0r[q] = 0.f; w0i[q] = 0.f; w1r[q] = 0.f; w1i[q] = 0.f; }
#pragma unroll
              for (int k = 0; k < 32; ++k) {
#pragma unroll
                  for (int q = 0; q < 16; ++q) { const int k0 = 31 - ((q & 3) + 8 * (q >> 2));
                      if (k0 == k) { w0r[q] = h ? w0r[q] : p0r; w0i[q] = h ? w0i[q] : p0i; w1r[q] = h ? w1r[q] : p1r; w1i[q] = h ? w1i[q] : p1i; }
                      if (k0 - 4 == k) { w0r[q] = h ? p0r : w0r[q]; w0i[q] = h ? p0i : w0i[q]; w1r[q] = h ? p1r : w1r[q]; w1i[q] = h ? p1i : w1i[q]; } }
                  { const float t_ = p0r * ar0 - p0i * ai0; p0i = p0r * ai0 + p0i * ar0; p0r = t_; } { const float t_ = p1r * ar1 - p1i * ai1; p1i = p1r * ai1 + p1i * ar1; p1r = t_; } }
              float s0r = 0.f, s0i = 0.f, s1r = 0.f, s1i = 0.f; bf16x8 un = S5_LOADU(sbeg);
              for (int c = 0; c < CPS; ++c) { const int s0 = sbeg + 32 * c; const bf16x8 ua = un; if (c + 1 < CPS) un = S5_LOADU(s0 + 32);
                  f32x16 a0 = {}, a1 = {}, a2 = {}, a3 = {}; a0 = mfma32(ua, Bf[0], a0); a2 = mfma32(ua, Bf[2], a2); a1 = mfma32(ua, Bf[1], a1); a3 = mfma32(ua, Bf[3], a3);
                  float q0r = 0.f, q0i = 0.f, q1r = 0.f, q1i = 0.f;
#pragma unroll
                  for (int q = 0; q < 16; ++q) { q0r += w0r[q] * a0[q] - w0i[q] * a2[q]; q0i += w0r[q] * a2[q] + w0i[q] * a0[q]; q1r += w1r[q] * a1[q] - w1i[q] * a3[q]; q1i += w1r[q] * a3[q] + w1i[q] * a1[q]; }
                  { const float t_ = p0r * s0r - p0i * s0i + q0r; s0i = p0r * s0i + p0i * s0r + q0i; s0r = t_; } { const float t_ = p1r * s1r - p1i * s1i + q1r; s1i = p1r * s1i + p1i * s1r + q1i; s1r = t_; } }
              s0r += __shfl_xor(s0r, 32); s0i += __shfl_xor(s0i, 32); s1r += __shfl_xor(s1r, 32); s1i += __shfl_xor(s1i, 32);
              XCH[(il * NSEG + seg) * 64 + lane] = h == 0 ? (f32x2){s0r, s0i} : (f32x2){s1r, s1i}; } }
        __syncthreads();
        { float pr = are, pi = aim, ar_ = 1.f, ai_ = 0.f;
          for (int e = CPS * 32; e > 0; e >>= 1) { if (e & 1) { const float t_ = ar_ * pr - ai_ * pi; ai_ = ar_ * pi + ai_ * pr; ar_ = t_; } const float t2 = pr * pr - pi * pi; pi = 2.f * pr * pi; pr = t2; }
          sre = 0.f; sim = 0.f;
          for (int k = 0; k < seg; ++k) { const f32x2 f = XCH[(il * NSEG + k) * 64 + lane]; const float nre = ar_ * sre - ai_ * sim + f.x, nim = ar_ * sim + ai_ * sre + f.y; sre = nre; sim = nim; } }
        if (act) {
            int lane2 = lane;
#ifndef CPU_EMU
            asm volatile("" : "+v"(lane2));
#endif
            const int r = lane2 & 31, h = lane2 >> 5, lane = lane2; (void)lane;
#pragma unroll
            for (int q = 0; q < 8; ++q) Cf[q] = ((const bf16x8*)(cb + 512 + 4096))[q * 64 + lane];
            bf16x8 un = S5_LOADU(sbeg);
            for (int c = 0; c < CPS; ++c) { const int s0 = sbeg + 32 * c; const bf16x8 ua = un; if (c + 1 < CPS) un = S5_LOADU(s0 + 32);
                S5_BU(ua); wave_sync();
#pragma unroll 8
                for (int t = 0; t < 32; ++t) { unsigned* wp = (unsigned*)(Sb + t * RS + lane * 4); const unsigned w = *wp; const float bre = bflo(w), bim = bfhi(w);
                    const float nre = are * sre - aim * sim + bre, nim = are * sim + aim * sre + bim; sre = nre; sim = nim; *wp = pk2(sre, sim); }
                wave_sync();
                f32x16 y = {};
#pragma unroll
                for (int ks = 0; ks < 8; ++ks) { const bf16x8 sa = *(const bf16x8*)(Sb + r * RS + (16 * ks + 8 * h) * 2); y = mfma32(Cf[ks], sa, y); }
                { bf16_t* yp = Y + ((size_t)b * LTOK + seqpos(dir, s0 + r)) * DM + g * 16 + 4 * h;
                  u32x2 w0, w1; w0.x = pk2(y[0], y[1]); w0.y = pk2(y[2], y[3]); w1.x = pk2(y[4], y[5]); w1.y = pk2(y[6], y[7]);
                  *(u32x2*)yp = w0; *(u32x2*)(yp + 8) = w1; }
                wave_sync(); } }
        __syncthreads();
#undef S5_LOADU
#undef S5_BU
    }
}
__device__ __forceinline__ void ph_s5_combine(const Args& A, Frame& F, int j) {
    const bf16_t* H = (const bf16_t*)(A.ws + WS_H); const bf16_t* YF = (const bf16_t*)(A.ws + WS_YF); const bf16_t* YB = (const bf16_t*)(A.ws + WS_YB); bf16_t* Gb = (bf16_t*)(A.ws + WS_G);
    const Row16 d = ld_row_f32(A.in[15] + (size_t)j * DM, F.lane); const int NGW = F.G * NWAVES;
    for (int tok = F.bid * NWAVES + F.wave; tok < NTOK; tok += 2 * NGW) { const int tokB = tok + NGW; const bool two = tokB < NTOK; const size_t oA = (size_t)tok * DM, oB = (size_t)(two ? tokB : tok) * DM;
        const Row16 hA = ld_row_bf16(H + oA, F.lane), fA = ld_row_bf16(YF + oA, F.lane), bA = ld_row_bf16(YB + oA, F.lane);
        const Row16 hB = ld_row_bf16(H + oB, F.lane), fB = ld_row_bf16(YF + oB, F.lane), bB = ld_row_bf16(YB + oB, F.lane); Row16 o;
#pragma unroll
        for (int e = 0; e < 16; ++e) o.v[e] = gelu_tanh(d.v[e] * hA.v[e] + fA.v[e] + bA.v[e]);
        st_row_bf16(Gb + oA, F.lane, o);
        if (two) {
#pragma unroll
            for (int e = 0; e < 16; ++e) o.v[e] = gelu_tanh(d.v[e] * hB.v[e] + fB.v[e] + bB.v[e]);
            st_row_bf16(Gb + oB, F.lane, o); } }
}

__device__ __forceinline__ void ph_ssd_conv(const Args& A, Frame& F) {
    const bf16_t* XBC = (const bf16_t*)(A.ws + WS_XBC); bf16_t* XC = (bf16_t*)(A.ws + WS_XBCC); const float* DT = (const float*)(A.ws + WS_DT); float* DTS = (float*)(A.ws + WS_DTS);
    const float* cw = A.in[19]; const float* cbias = A.in[20]; const float* dtb = A.in[21];
    const long gt = (long)F.bid * NTHR + F.tid, GT = (long)F.G * NTHR;
    for (long i = gt; i < (long)NTOK * 384; i += GT) { const int tok = (int)(i / 384), ch = (int)(i % 384) * 8; const int p = tok % LTOK;
        const bool hp = (p != 0 && p != CTXL), hn = (p != CTXL - 1 && p != LTOK - 1);
        const u32x4 z4 = {0u, 0u, 0u, 0u};
        const u32x4 c0 = *(const u32x4*)(XBC + (size_t)tok * 3072 + ch);
        const u32x4 cm = hp ? *(const u32x4*)(XBC + (size_t)(tok - 1) * 3072 + ch) : z4;
        const u32x4 cp = hn ? *(const u32x4*)(XBC + (size_t)(tok + 1) * 3072 + ch) : z4;
        float o[8];
#pragma unroll
        for (int e = 0; e < 4; ++e) { const unsigned wm = cm[e], w0 = c0[e], wp = cp[e]; const int c = ch + 2 * e;
            o[2 * e] = siluf_(cbias[c] + cw[c] * bflo(wm) + cw[3072 + c] * bflo(w0) + cw[6144 + c] * bflo(wp));
            o[2 * e + 1] = siluf_(cbias[c + 1] + cw[c + 1] * bfhi(wm) + cw[3072 + c + 1] * bfhi(w0) + cw[6144 + c + 1] * bfhi(wp)); }
        u32x4 w; w.x = pk2(o[0], o[1]); w.y = pk2(o[2], o[3]); w.z = pk2(o[4], o[5]); w.w = pk2(o[6], o[7]);
        *(u32x4*)(XC + (size_t)tok * 3072 + ch) = w; }
    { float* ACUM = (float*)(A.ws + WS_ACUM);
      for (long i = gt; i < (long)(NTOK / 64) * 64; i += GT) { const int blk = (int)(i >> 6), j = (int)(i & 63); const int dir = j >> 5; const float Aj = -__expf(A.in[22][j]); const float bj = dtb[j]; float ac = 0.f;
          for (int k = 0; k < 64; ++k) { const size_t tk = (size_t)blk * 64 + (dir ? 63 - k : k); const float x = DT[tk * 64 + j] + bj; const float dt = x > 20.f ? x : log1pf(__expf(x));
              DTS[tk * 64 + j] = dt; ac += dt * Aj; ACUM[tk * 64 + j] = ac; } } }
}
__device__ __forceinline__ int ssd_tokbase(int dir, int c) { return dir == 0 ? 64 * c : (c < CTXL / 64 ? CTXL - 64 * (c + 1) : LTOK + CTXL - 64 * (c + 1)); }
__device__ __forceinline__ bf16x8 tr_frag(const unsigned char* T, int rs, int s0, int c0, int lane) {
    const int i = lane & 15, hh = lane >> 5, rb = 16 * ((lane >> 4) & 1); const unsigned char* p = T + (s0 + 8 * hh + (i >> 2)) * rs + (c0 + rb + 4 * (i & 3)) * 2;
    const s16x4 lo = lds_tr(p), hi = lds_tr(p + 4 * rs); return (bf16x8){lo[0], lo[1], lo[2], lo[3], hi[0], hi[1], hi[2], hi[3]};
}
__device__ __forceinline__ void ph_ssd_scan(const Args& A, Frame& F) {
    const int tid = F.tid, lane = F.lane, wave = F.wave, r = lane & 31, hi = lane >> 5;
    constexpr int RS_BC = 272, RS_X = 144, O_CN = 0, O_BN = 17408, O_XN = 34816, O_XS = 44032, O_ML = 53248, O_SP = 62464, O_VEC = 79872;
    constexpr int O_CN2 = 80896, O_BN2 = 98304, O_XN2 = 115712, O_XS2 = 132096, O_VEC2 = 141312;
    unsigned char* L = F.lds;
    const bf16_t* XC = (const bf16_t*)(A.ws + WS_XBCC); const float* DTS = (const float*)(A.ws + WS_DTS); const float* ACUM = (const float*)(A.ws + WS_ACUM);
    constexpr int NCH = LTOK / 64;
    for (int item = F.bid; item < BATCH * 64; item += F.G) { const int hh = item & 31, dir = (item >> 5) & 1, b = item >> 6, grp = hh >> 3, jj = dir * 32 + hh;
        bf16_t* Y = (bf16_t*)(A.ws + (dir ? WS_YB2 : WS_YF2));
        f32x16 st = {};
        for (int i = tid; i < 64 * 17; i += NTHR) *(u32x4*)(L + O_SP + i * 16) = (u32x4){0u, 0u, 0u, 0u};
        u32x4 rC[2], rB[2], rX; float rdt = 0.f, rac = 0.f, rws = 0.f;
#define SSD_LOAD(c) do { const size_t t0 = (size_t)b * LTOK + ssd_tokbase(dir, (c)); \
            _Pragma("unroll") for (int k = 0; k < 2; ++k) { const int id = tid + 512 * k, row = id >> 4, c8 = (id & 15) * 8; \
                rC[k] = *(const u32x4*)(XC + (t0 + row) * 3072 + 2560 + grp * 128 + c8); rB[k] = *(const u32x4*)(XC + (t0 + row) * 3072 + 2048 + grp * 128 + c8); } \
            { const int row = tid >> 3; rX = *(const u32x4*)(XC + (t0 + row) * 3072 + hh * 64 + (tid & 7) * 8); \
              const float dt_ = DTS[(t0 + row) * 64 + jj], ac_ = ACUM[(t0 + row) * 64 + jj], at_ = ACUM[(t0 + (dir ? 0 : 63)) * 64 + jj]; rws = dt_ * __expf(at_ - ac_); \
              if (tid < 64) { rdt = DTS[(t0 + tid) * 64 + jj]; rac = ACUM[(t0 + tid) * 64 + jj]; } } } while (0)
#define SSD_WRITE(oCN_, oBN_, oXN_, oXS_, oV_) do { float* dtv_ = (float*)(L + (oV_)); float* acv_ = dtv_ + 64; float* eac_ = acv_ + 64; _Pragma("unroll") for (int k = 0; k < 2; ++k) { const int id = tid + 512 * k, row = id >> 4, c8 = (id & 15) * 8; \
                *(u32x4*)(L + (oCN_) + row * RS_BC + c8 * 2) = rC[k]; *(u32x4*)(L + (oBN_) + row * RS_BC + c8 * 2) = rB[k]; } \
            { const int row = tid >> 3, c8 = (tid & 7) * 8; *(u32x4*)(L + (oXN_) + row * RS_X + c8 * 2) = rX; u32x4 xs_; \
              xs_.x = pk2(bflo(rX.x) * rws, bfhi(rX.x) * rws); xs_.y = pk2(bflo(rX.y) * rws, bfhi(rX.y) * rws); xs_.z = pk2(bflo(rX.z) * rws, bfhi(rX.z) * rws); xs_.w = pk2(bflo(rX.w) * rws, bfhi(rX.w) * rws); \
              *(u32x4*)(L + (oXS_) + row * RS_X + c8 * 2) = xs_; } \
            if (tid < 64) { dtv_[tid] = rdt; acv_[tid] = rac; eac_[tid] = __expf(rac); } } while (0)
        SSD_LOAD(0); __syncthreads(); SSD_WRITE(O_CN, O_BN, O_XN, O_XS, O_VEC); __syncthreads();
        for (int c = 0; c < NCH; ++c) { const bool par = (c & 1) != 0;
            const int oCN = par ? O_CN2 : O_CN, oBN = par ? O_BN2 : O_BN, oXN = par ? O_XN2 : O_XN, oXS = par ? O_XS2 : O_XS; const float* dtv = (const float*)(L + (par ? O_VEC2 : O_VEC)); const float* acv = dtv + 64; const float* eac = acv + 64;
            if (c + 1 < NCH) SSD_LOAD(c + 1);
            const size_t t0 = (size_t)b * LTOK + ssd_tokbase(dir, c);
            f32x16 yacc = {};
            int pb = 0, qb = 0;
            if (wave < 4) { pb = wave >> 1; qb = wave & 1;
#pragma unroll
                for (int t = 0; t < 8; ++t) { const bf16x8 af = *(const bf16x8*)(L + O_SP + (32 * pb + r) * RS_BC + (16 * t + 8 * hi) * 2), bfr = *(const bf16x8*)(L + oCN + (32 * qb + r) * RS_BC + (16 * t + 8 * hi) * 2);
                    yacc = mfma32(af, bfr, yacc); }
                const float eq = eac[32 * qb + r];
#pragma unroll
                for (int q = 0; q < 16; ++q) yacc[q] *= eq;
            } else if (wave < 7) { const int ti = wave - 4; const int sb = dir == 0 ? (ti == 2) : (ti >= 1), qb2 = dir == 0 ? (ti >= 1) : (ti == 2);
                f32x16 m = {};
#pragma unroll
                for (int t = 0; t < 8; ++t) { const bf16x8 af = *(const bf16x8*)(L + oBN + (32 * sb + r) * RS_BC + (16 * t + 8 * hi) * 2), bfr = *(const bf16x8*)(L + oCN + (32 * qb2 + r) * RS_BC + (16 * t + 8 * hi) * 2);
                    m = mfma32(af, bfr, m); }
                const int qi = 32 * qb2 + r; const float aq = acv[qi];
#pragma unroll
                for (int g4 = 0; g4 < 4; ++g4) { float v[4];
#pragma unroll
                    for (int e = 0; e < 4; ++e) { const int si = 32 * sb + 8 * g4 + 4 * hi + e; const bool ok = dir == 0 ? (si <= qi) : (si >= qi);
                        v[e] = ok ? m[4 * g4 + e] * dtv[si] * __expf(aq - acv[si]) : 0.f; }
                    u32x2 w; w.x = pk2(v[0], v[1]); w.y = pk2(v[2], v[3]); *(u32x2*)(L + O_ML + qi * RS_X + (32 * sb + 8 * g4 + 4 * hi) * 2) = w; }
            }
            __syncthreads();
            if (wave < 4) {
#pragma unroll
                for (int sb = 0; sb < 2; ++sb) { const bool use = dir == 0 ? (sb <= qb) : (sb >= qb);
                    if (use) {
#pragma unroll
                        for (int kk = 0; kk < 2; ++kk) { const int s0 = 32 * sb + 16 * kk;
                            const bf16x8 af = tr_frag(L + oXN, RS_X, s0, 32 * pb, lane);
                            const bf16x8 bfr = *(const bf16x8*)(L + O_ML + (32 * qb + r) * RS_X + (s0 + 8 * hi) * 2);
                            yacc = mfma32(af, bfr, yacc); } } }
                bf16_t* yp = Y + (t0 + 32 * qb + r) * 2048 + hh * 64 + 32 * pb;
#pragma unroll
                for (int g4 = 0; g4 < 4; ++g4) { u32x2 w; w.x = pk2(yacc[4 * g4], yacc[4 * g4 + 1]); w.y = pk2(yacc[4 * g4 + 2], yacc[4 * g4 + 3]); *(u32x2*)(yp + 8 * g4 + 4 * hi) = w; }
            }
            { const int nb = wave >> 1, pb2 = wave & 1; const float dec = __expf(acv[dir ? 0 : 63]);
#pragma unroll
              for (int q = 0; q < 16; ++q) st[q] *= dec;
#pragma unroll
              for (int t = 0; t < 4; ++t) { const bf16x8 af = tr_frag(L + oBN, RS_BC, 16 * t, 32 * nb, lane), bfr = tr_frag(L + oXS, RS_X, 16 * t, 32 * pb2, lane); st = mfma32(af, bfr, st); }
            }
            { const int nb = wave >> 1, pb2 = wave & 1;
#pragma unroll
              for (int g4 = 0; g4 < 4; ++g4) { u32x2 w; w.x = pk2(st[4 * g4], st[4 * g4 + 1]); w.y = pk2(st[4 * g4 + 2], st[4 * g4 + 3]); *(u32x2*)(L + O_SP + (32 * pb2 + r) * RS_BC + (32 * nb + 8 * g4 + 4 * hi) * 2) = w; } }
            if (c + 1 < NCH) { if (par) SSD_WRITE(O_CN, O_BN, O_XN, O_XS, O_VEC); else SSD_WRITE(O_CN2, O_BN2, O_XN2, O_XS2, O_VEC2); }
            __syncthreads();
        }
#undef SSD_LOAD
#undef SSD_WRITE
    }
}
__device__ __forceinline__ void ph_ssd_gate(const Args& A, Frame& F) {
    const bf16_t* YF = (const bf16_t*)(A.ws + WS_YF2); const bf16_t* YB = (const bf16_t*)(A.ws + WS_YB2); const bf16_t* XC = (const bf16_t*)(A.ws + WS_XBCC); const bf16_t* Z = (const bf16_t*)(A.ws + WS_Z);
    bf16_t* G2 = (bf16_t*)(A.ws + WS_G2); const float* Dh = A.in[23]; const int NGW = F.G * NWAVES;
    float dh[4];
#pragma unroll
    for (int j = 0; j < 4; ++j) dh[j] = Dh[(512 * j + 8 * F.lane) >> 6];
    for (int tok = F.bid * NWAVES + F.wave; tok < NTOK; tok += 2 * NGW) { const int tokB = tok + NGW; const bool two = tokB < NTOK; const int tk[2] = {tok, two ? tokB : tok};
        u32x4 a[2][4], bq[2][4], x[2][4], z[2][4];
#pragma unroll
        for (int t = 0; t < 2; ++t)
#pragma unroll
            for (int j = 0; j < 4; ++j) { const int d0 = 512 * j + 8 * F.lane;
                a[t][j] = *(const u32x4*)(YF + (size_t)tk[t] * 2048 + d0); bq[t][j] = *(const u32x4*)(YB + (size_t)tk[t] * 2048 + d0); x[t][j] = *(const u32x4*)(XC + (size_t)tk[t] * 3072 + d0); z[t][j] = *(const u32x4*)(Z + (size_t)tk[t] * 2048 + d0); }
#pragma unroll
        for (int t = 0; t < 2; ++t) { if (t == 1 && !two) break; float v[32]; float ss = 0.f;
#pragma unroll
            for (int j = 0; j < 4; ++j)
#pragma unroll
                for (int e = 0; e < 4; ++e) { const float v0 = (bflo(a[t][j][e]) + bflo(bq[t][j][e]) + dh[j] * bflo(x[t][j][e])) * siluf_(bflo(z[t][j][e])), v1 = (bfhi(a[t][j][e]) + bfhi(bq[t][j][e]) + dh[j] * bfhi(x[t][j][e])) * siluf_(bfhi(z[t][j][e]));
                    v[8 * j + 2 * e] = v0; v[8 * j + 2 * e + 1] = v1; ss += v0 * v0 + v1 * v1; }
            const float rn = 1.0f / sqrtf(wave_sum(ss) * (1.f / 2048.f) + 1e-6f);
#pragma unroll
            for (int j = 0; j < 4; ++j) { u32x4 w; w.x = pk2(v[8 * j] * rn, v[8 * j + 1] * rn); w.y = pk2(v[8 * j + 2] * rn, v[8 * j + 3] * rn); w.z = pk2(v[8 * j + 4] * rn, v[8 * j + 5] * rn); w.w = pk2(v[8 * j + 6] * rn, v[8 * j + 7] * rn);
                *(u32x4*)(G2 + (size_t)tk[t] * 2048 + 512 * j + 8 * F.lane) = w; } } }
}

__device__ __forceinline__ void mla_kr(const Args& A, Frame& F) {
    const bf16_t* C = (const bf16_t*)(A.ws + WS_CQKV); bf16_t* Kb = (bf16_t*)(A.ws + WS_K); const float* ROPE = (const float*)(A.ws + WS_ROPE);
    const long gt = (long)F.bid * NTHR + F.tid, GT = (long)F.G * NTHR;
    for (long idx = gt; idx < (long)NTOK * 16; idx += GT) { const int tok = (int)(idx >> 4), i = (int)(idx & 15); const int b = tok / LTOK, p = tok - b * LTOK;
        const int o1 = (i < 8) ? i : 16 + (i - 8); float x1 = bf2f(C[(size_t)tok * 512 + 384 + o1]), x2 = bf2f(C[(size_t)tok * 512 + 384 + o1 + 8]);
        if (p >= CTXL) { const int t = p - CTXL; const int pos = (i < 8) ? (t >> 6) : (t & 63); const float c = ROPE[(pos * 8 + (i & 7)) * 2], s = ROPE[(pos * 8 + (i & 7)) * 2 + 1];
            const float y1 = x1 * c - x2 * s, y2 = x2 * c + x1 * s; x1 = y1; x2 = y2; }
        const unsigned w = pk2(x1, x2);
#pragma unroll 4
        for (int hd = 0; hd < 16; ++hd) *(unsigned*)(Kb + ((size_t)(b * 16 + hd) * LTOK + p) * 128 + 64 + 2 * i) = w; }
}
__device__ __forceinline__ void ph_attn(const Args& A, Frame& F) {
    const bf16_t* Q = (const bf16_t*)(A.ws + WS_Q); const bf16_t* Kb = (const bf16_t*)(A.ws + WS_K); const bf16_t* Vb = (const bf16_t*)(A.ws + WS_V); bf16_t* O = (bf16_t*)(A.ws + WS_O);
    constexpr int NLQ = SEQ / 256, NCQ = CTXL / 256, NLU = BATCH * 16 * NLQ, NU = NLU + BATCH * 16 * NCQ;
    const int vb = (F.G % 8 == 0) ? (F.bid % 8) * (F.G / 8) + F.bid / 8 : F.bid;
    for (int u = vb; u < NU; u += F.G) { int bh, p0, seq;
        if (u < NLU) { bh = u / NLQ; p0 = CTXL + (u % NLQ) * 256; seq = LTOK; } else { const int v = u - NLU; bh = v / NCQ; p0 = (v % NCQ) * 256; seq = CTXL; }
        const int b = bh >> 4, hd = bh & 15;
        att::attn_body(Q + ((size_t)bh * LTOK + p0) * 128, Kb + (size_t)bh * LTOK * 128, Vb + (size_t)bh * LTOK * 64, O + ((size_t)b * LTOK + p0) * DM + hd * 64, seq,
#ifdef CPU_EMU
                       F.lds,
#else
                       (char*)F.lds,
#endif
                       p0 >= CTXL ? p0 - CTXL : -1, (const float*)(A.ws + WS_ROPE), F.wave); }
}

__device__ __forceinline__ float ub0(unsigned w) { return (float)(w & 0xffu); }
__device__ __forceinline__ float ub1(unsigned w) { return (float)((w >> 8) & 0xffu); }
__device__ __forceinline__ float ub2(unsigned w) { return (float)((w >> 16) & 0xffu); }
__device__ __forceinline__ float ub3(unsigned w) { return (float)(w >> 24); }
#ifdef CPU_EMU
__device__ __forceinline__ unsigned udot4(unsigned a, unsigned b, unsigned c) { for (int i = 0; i < 4; ++i) c += ((a >> (8 * i)) & 255u) * ((b >> (8 * i)) & 255u); return c; }
#else
__device__ __forceinline__ unsigned udot4(unsigned a, unsigned b, unsigned c) { return __builtin_amdgcn_udot4(a, b, c, false); }
#endif
#ifdef CPU_EMU
__device__ __forceinline__ unsigned med3u(unsigned a, unsigned b, unsigned c) { const unsigned mn = a < b ? a : b, mx = a < b ? b : a; const unsigned t = mx < c ? mx : c; return mn > t ? mn : t; }
__device__ __forceinline__ unsigned lane_xor1(unsigned x) { return __shfl_xor(x, 1); }
#else
__device__ __forceinline__ unsigned med3u(unsigned a, unsigned b, unsigned c) { unsigned r; asm("v_med3_u32 %0, %1, %2, %3" : "=v"(r) : "v"(a), "v"(b), "v"(c)); return r; }
__device__ __forceinline__ unsigned lane_xor1(unsigned x) { return (unsigned)__builtin_amdgcn_update_dpp(0, (int)x, 0xB1, 0xF, 0xF, true); }
#endif
#define TOP16_INSERT(t, x) do { _Pragma("unroll") for (int k_ = 15; k_ >= 1; --k_) t[k_] = med3u(t[k_ - 1], t[k_], (x)); t[0] = t[0] > (x) ? t[0] : (x); } while (0)
__device__ __forceinline__ int peer_tok(int layer, int ti) { return layer == 3 ? (ti / SEQ) * LTOK + CTXL + (ti % SEQ) : ti; }
#ifdef CPU_EMU
__device__ __forceinline__ int ror8_i(int v) { return __shfl_xor(v, 8); }
__device__ __forceinline__ void lane_pair16(int x, int& lo, int& hi) { const int o = __shfl_xor(x, 16); const bool up = (threadIdx.x >> 4) & 1; lo = up ? o : x; hi = up ? x : o; }
__device__ __forceinline__ void lane_pair32(int x, int& lo, int& hi) { const int o = __shfl_xor(x, 32); const bool up = (threadIdx.x >> 5) & 1; lo = up ? o : x; hi = up ? x : o; }
#else
__device__ __forceinline__ int ror8_i(int v) { return __builtin_amdgcn_update_dpp(0, v, 0x128, 0xF, 0xF, true); }
__device__ __forceinline__ void lane_pair16(int x, int& lo, int& hi) { auto rr = __builtin_amdgcn_permlane16_swap((unsigned)x, (unsigned)x, false, false); lo = (int)rr[0]; hi = (int)rr[1]; }
__device__ __forceinline__ void lane_pair32(int x, int& lo, int& hi) { auto rr = __builtin_amdgcn_permlane32_swap((unsigned)x, (unsigned)x, false, false); lo = (int)rr[0]; hi = (int)rr[1]; }
#endif
#ifdef CPU_EMU
__device__ __forceinline__ unsigned bperm(unsigned s0, unsigned s1, unsigned sel) { const unsigned long long v = ((unsigned long long)s0 << 32) | s1; unsigned r = 0; for (int i = 0; i < 4; ++i) { const unsigned k = (sel >> (8 * i)) & 255u; const unsigned byte = k < 8u ? (unsigned)((v >> (8 * k)) & 255ull) : (k == 12u ? 0u : 255u); r |= byte << (8 * i); } return r; }
#else
__device__ __forceinline__ unsigned bperm(unsigned s0, unsigned s1, unsigned sel) { return __builtin_amdgcn_perm(s0, s1, sel); }
#endif
#ifdef CPU_EMU
__device__ __forceinline__ int sdot4(unsigned a, unsigned b, int c) { for (int i = 0; i < 4; ++i) c += (int)(signed char)(a >> (8 * i)) * (int)(signed char)(b >> (8 * i)); return c; }
__device__ __forceinline__ float sum_bits012(float v) { v += __shfl_xor(v, 1); v += __shfl_xor(v, 2); v += __shfl_xor(v, 4); return v; }
#else
__device__ __forceinline__ int sdot4(unsigned a, unsigned b, int c) { return __builtin_amdgcn_sdot4((int)a, (int)b, c, false); }
__device__ __forceinline__ float sum_bits012(float v) { v += dpp_f<0xB1>(v); v += dpp_f<0x4E>(v); v += dpp_f<0x141>(v); return v; }
#endif
#ifdef CPU_EMU
__device__ __forceinline__ float sum_bits345(float v) { v += __shfl_xor(v, 8); v += __shfl_xor(v, 16); v += __shfl_xor(v, 32); return v; }
#else
__device__ __forceinline__ float sum_bits345(float v) {
    v += dpp_f<0x128>(v);
    { auto rr = __builtin_amdgcn_permlane16_swap(__float_as_uint(v), __float_as_uint(v), false, false); v = __uint_as_float(rr[0]) + __uint_as_float(rr[1]); }
    { auto rr = __builtin_amdgcn_permlane32_swap(__float_as_uint(v), __float_as_uint(v), false, false); v = __uint_as_float(rr[0]) + __uint_as_float(rr[1]); }
    return v;
}
#endif
#ifdef CPU_EMU
__device__ __forceinline__ float merge_bit3(float a, float b) { const bool hi = (threadIdx.x >> 3) & 1; const float k = hi ? b : a, t = hi ? a : b; return k + __shfl_xor(t, 8); }
__device__ __forceinline__ float merge_bit4(float a, float b) { const bool hi = (threadIdx.x >> 4) & 1; const float k = hi ? b : a, t = hi ? a : b; return k + __shfl_xor(t, 16); }
__device__ __forceinline__ float merge_bit5(float a, float b) { const bool hi = (threadIdx.x >> 5) & 1; const float k = hi ? b : a, t = hi ? a : b; return k + __shfl_xor(t, 32); }
#else
__device__ __forceinline__ float merge_bit3(float a, float b) {
    const int x = __builtin_amdgcn_update_dpp(__builtin_bit_cast(int, b), __builtin_bit_cast(int, a), 0x128, 0xF, 0x3, false);
    const int y = __builtin_amdgcn_update_dpp(__builtin_bit_cast(int, a), __builtin_bit_cast(int, b), 0x128, 0xF, 0xC, false);
    return __builtin_bit_cast(float, x) + __builtin_bit_cast(float, y); }
__device__ __forceinline__ float merge_bit4(float a, float b) { auto rr = __builtin_amdgcn_permlane16_swap(__float_as_uint(a), __float_as_uint(b), false, false); return __uint_as_float(rr[0]) + __uint_as_float(rr[1]); }
__device__ __forceinline__ float merge_bit5(float a, float b) { auto rr = __builtin_amdgcn_permlane32_swap(__float_as_uint(a), __float_as_uint(b), false, false); return __uint_as_float(rr[0]) + __uint_as_float(rr[1]); }
#endif
#ifdef CPU_EMU
template <int K> __device__ __forceinline__ unsigned quad_bcast(unsigned v) { return __shfl(v, (int)((threadIdx.x & 63 & ~3) | K)); }
#else
template <int K> __device__ __forceinline__ unsigned quad_bcast(unsigned v) { return (unsigned)__builtin_amdgcn_update_dpp(0, (int)v, K * 0x55, 0xF, 0xF, true); }
#endif
#define EL_LOAD(ELQ, TOK) do { ELQ = *(const u32x4*)(PL + (size_t)(TOK) * 512 + 16 * e8 + 4 * (lane & 3)); } while (0)
#define EL_GET(ELQ, i) ((i) >> 2) == 0 ? quad_bcast<0>(ELQ[(i) & 3]) : ((i) >> 2) == 1 ? quad_bcast<1>(ELQ[(i) & 3]) : ((i) >> 2) == 2 ? quad_bcast<2>(ELQ[(i) & 3]) : quad_bcast<3>(ELQ[(i) & 3])
#ifdef CPU_EMU
__device__ __forceinline__ float fmerge_bit2(float a, float b) { const bool hi = (threadIdx.x >> 2) & 1; const float k = hi ? b : a, t = hi ? a : b; return k + __shfl_xor(t, 7); }
__device__ __forceinline__ float fmerge_bit1(float a, float b, int lane) { const bool hi = (lane >> 1) & 1; const float k = hi ? b : a, t = hi ? a : b; return k + __shfl_xor(t, 2); }
__device__ __forceinline__ float fmerge_bit0(float a, float b, int lane) { const bool hi = lane & 1; const float k = hi ? b : a, t = hi ? a : b; return k + __shfl_xor(t, 1); }
#else
__device__ __forceinline__ float fmerge_bit2(float a, float b) {
    const int x = __builtin_amdgcn_update_dpp(__builtin_bit_cast(int, b), __builtin_bit_cast(int, a), 0x141, 0xF, 0x5, false), y = __builtin_amdgcn_update_dpp(__builtin_bit_cast(int, a), __builtin_bit_cast(int, b), 0x141, 0xF, 0xA, false);
    return __builtin_bit_cast(float, x) + __builtin_bit_cast(float, y); }
__device__ __forceinline__ float fmerge_bit1(float a, float b, int lane) { const bool hi = (lane >> 1) & 1; const float k = hi ? b : a, t = hi ? a : b; return k + dpp_f<0x4E>(t); }
__device__ __forceinline__ float fmerge_bit0(float a, float b, int lane) { const bool hi = lane & 1; const float k = hi ? b : a, t = hi ? a : b; return k + dpp_f<0xB1>(t); }
#endif
#ifdef CPU_EMU
__device__ __forceinline__ int imerge_bit2(int a, int b) { const bool hi = (threadIdx.x >> 2) & 1; const int k = hi ? b : a, t = hi ? a : b; return k + __shfl_xor(t, 7); }
__device__ __forceinline__ int imerge_bit1(int a, int b, int lane) { const bool hi = (lane >> 1) & 1; const int k = hi ? b : a, t = hi ? a : b; return k + __shfl_xor(t, 2); }
__device__ __forceinline__ int imerge_bit0(int a, int b, int lane) { const bool hi = lane & 1; const int k = hi ? b : a, t = hi ? a : b; return k + __shfl_xor(t, 1); }
#else
__device__ __forceinline__ int imerge_bit2(int a, int b) {
    const int x = __builtin_amdgcn_update_dpp(b, a, 0x141, 0xF, 0x5, false), y = __builtin_amdgcn_update_dpp(a, b, 0x141, 0xF, 0xA, false); return x + y; }
__device__ __forceinline__ int imerge_bit1(int a, int b, int lane) { const bool hi = (lane >> 1) & 1; const int k = hi ? b : a, t = hi ? a : b; return k + __builtin_amdgcn_update_dpp(0, t, 0x4E, 0xF, 0xF, true); }
__device__ __forceinline__ int imerge_bit0(int a, int b, int lane) { const bool hi = lane & 1; const int k = hi ? b : a, t = hi ? a : b; return k + __builtin_amdgcn_update_dpp(0, t, 0xB1, 0xF, 0xF, true); }
#endif
__device__ __forceinline__ void ph_peer_a(const Args& A, Frame& F, int layer) {
    const int lane = F.lane;
    float* wsc = (float*)(F.lds + F.wave * 10240);
    const unsigned short* SC = (const unsigned short*)(A.ws + WS_SC); const bf16_t* H2 = (const bf16_t*)(A.ws + WS_H2);
    const float* US = (const float*)(A.ws + WS_US) + (size_t)layer * 16384 * 2; const float* VS = (const float*)(A.ws + WS_VS) + (size_t)layer * 16384;
    unsigned* PL = (unsigned*)(A.ws + WS_PL); unsigned char* PH = A.ws + WS_PH;
    const int ntk = layer == 3 ? BATCH * SEQ : NTOK; const int gw = F.bid * NWAVES + F.wave, NGW = F.G * NWAVES;
    const int t_beg = (int)(((long)gw * ntk) / NGW), t_end = (int)(((long)(gw + 1) * ntk) / NGW);
    for (int tg = t_beg; tg < t_end; tg += 4) {
        { const int tq = lane >> 4, li = lane & 15; const int ti = (tg + tq < t_end) ? tg + tq : t_end - 1;
          const int tokL = peer_tok(layer, ti);
          const unsigned short* src = SC + (size_t)tokL * 2048 + li * 128;
          unsigned t1[16];
#pragma unroll
          for (int k = 0; k < 16; ++k) t1[k] = 0u;
#pragma unroll 1
          for (int i = 0; i < 128; i += 8) { const u32x4 v = *(const u32x4*)(src + i);
#pragma unroll
              for (int e = 0; e < 8; ++e) { const float sv_ = (e & 1) ? hhi(v[e >> 1]) : hlo(v[e >> 1]); const float fv = fminf(fmaxf(sv_, -63.99f), 63.99f); const unsigned key = ((unsigned)((fv + 64.f) * 262144.f) << 7) | (unsigned)(i + e); TOP16_INSERT(t1, key); } }
          float v1[16], v2[16]; unsigned i1[16], i2[16];
#pragma unroll
          for (int k = 0; k < 16; ++k) { const unsigned p = lane_xor1(t1[k]); v1[k] = (float)(t1[k] >> 7) * (1.f / 262144.f) - 64.f; i1[k] = (t1[k] & 127u) << 7; v2[k] = (float)(p >> 7) * (1.f / 262144.f) - 64.f; i2[k] = p & 127u; }
          unsigned c[16];
#pragma unroll
          for (int k = 0; k < 16; ++k) c[k] = 0u;
#pragma unroll
          for (int ia = 0; ia < 16; ++ia)
#pragma unroll
              for (int ib = 0; ib < 16 / (ia + 1); ++ib) { const float sm = fminf(fmaxf(v1[ia] + v2[ib], -127.9f), 127.9f); const unsigned key = ((unsigned)((sm + 128.f) * 1024.f) << 14) | i1[ia] | i2[ib]; TOP16_INSERT(c, key); }
          if ((li & 1) == 0 && tg + tq < t_end) { float* Lb = wsc + tq * 640; int* EL = (int*)Lb; float* GL = Lb + 128; float* SUL = Lb + 256; float* SVL = Lb + 384; const int hd = li >> 1;
              const float mx = (float)(c[0] >> 14) * (1.f / 1024.f); float ex[16]; float sum = 0.f;
#pragma unroll
              for (int k = 0; k < 16; ++k) { ex[k] = __expf((float)(c[k] >> 14) * (1.f / 1024.f) - mx); sum += ex[k]; }
              const float inv = 1.f / sum;
#pragma unroll
              for (int k = 0; k < 16; ++k) { const int e = (int)(c[k] & 16383u); EL[hd * 16 + k] = e; GL[hd * 16 + k] = ex[k] * inv; SUL[hd * 16 + k] = US[2 * e]; SVL[hd * 16 + k] = VS[e]; } }
          wave_sync(); }
        for (int tq = 0; tq < 4 && tg + tq < t_end; ++tq) { const int tok = peer_tok(layer, tg + tq); const unsigned* Lb = (const unsigned*)(wsc + tq * 640);
            const Row16 hv = ld_row_bf16(H2 + (size_t)tok * DM, lane);
#pragma unroll
            for (int a = 0; a < 4; ++a)
#pragma unroll
                for (int r = 0; r < 2; ++r) { const int p = 64 * r + lane; PL[(size_t)tok * 512 + a * 128 + p] = Lb[a * 128 + (p & 7) * 16 + (p >> 3)]; }
            float amax = 0.f;
#pragma unroll
            for (int e = 0; e < 16; ++e) amax = fmaxf(amax, fabsf(hv.v[e]));
            const float shc = amax * (1.f / 127.f), inv1 = amax > 0.f ? 127.f / amax : 0.f;
            u32x4 h1w;
#pragma unroll
            for (int k = 0; k < 4; ++k) { unsigned w1 = 0u;
#pragma unroll
                for (int e = 0; e < 4; ++e) w1 |= ((unsigned)(int)rintf(hv.v[4 * k + e] * inv1) & 255u) << (8 * e);
                h1w[k] = w1; }
            *(u32x4*)(PH + (size_t)tok * 2048 + 16 * lane) = h1w; *(float*)(PH + (size_t)tok * 2048 + 1024 + 4 * lane) = shc; }
        wave_sync();
    }
}
struct PeerSlice { int s0, sstep, t_beg, t_end; };
__device__ __forceinline__ PeerSlice peer_slice(const Args& A, const Frame& F, int layer) {
    int m = F.G < 8 ? F.G : 8, r = F.bid % m, rank = F.bid / m, nrank = (F.G - 1 - r) / m + 1;
#ifndef CPU_EMU
    if (A.ph_hi - A.ph_lo > 1) { const unsigned* bar = (const unsigned*)(A.ws + WS_CTL) + 1024; bool ok = true; unsigned tot = 0u;
#pragma unroll
        for (int j = 0; j < 16; ++j) { const unsigned cj = __hip_atomic_load(&bar[256 + 64 * j], __ATOMIC_RELAXED, __HIP_MEMORY_SCOPE_AGENT); tot += cj; ok = ok && ((j < 8) == (cj > 0u)); }
        const volatile __attribute__((address_space(3))) unsigned* st = (const volatile __attribute__((address_space(3))) unsigned*)((__attribute__((address_space(3))) unsigned char*)F.lds + 131072) + 8;
        if (ok && tot == (unsigned)F.G) { const int x = rfl((int)st[3]); m = 8; r = x; rank = rfl((int)st[2]); nrank = rfl((int)__hip_atomic_load(&bar[256 + 64 * x], __ATOMIC_RELAXED, __HIP_MEMORY_SCOPE_AGENT)); } }
#endif
    const int ntk = layer == 3 ? BATCH * SEQ : NTOK, wi = rank * NWAVES + F.wave, nws = nrank * NWAVES;
    PeerSlice P; P.s0 = r; P.sstep = m; P.t_beg = (int)(((long)wi * ntk) / nws); P.t_end = (int)(((long)(wi + 1) * ntk) / nws); return P;
}
__device__ __forceinline__ void ph_peer_u(const Args& A, Frame& F, int layer) {
    const int lane = F.lane, e8 = lane >> 3, c = lane & 7; const PeerSlice P = peer_slice(A, F, layer);
    const unsigned* PL = (const unsigned*)(A.ws + WS_PL); const unsigned char* PH = A.ws + WS_PH; float* PD = (float*)(A.ws + WS_PD);
    const int kx = (lane & 1) * 4 + ((lane >> 1) & 1) * 2 + ((lane >> 2) & 1);
#define PU_LISTS(EL, H1, HS, TOK) do { H1 = *(const u32x4*)(PH + (size_t)(TOK) * 2048 + hoff); HS = *(const float*)(PH + (size_t)(TOK) * 2048 + 1024 + soff); \
        EL_LOAD(EL, TOK); } while (0)
#define PU_ROWS(Q, EL) do { _Pragma("unroll") for (int i = 0; i < 16; ++i) { const unsigned e_ = EL_GET(EL, i); Q[i] = *(const u32x4*)(UTs + (e_ * 128u + c16)); } } while (0)
#define PU_COMP(Q, C1, HS, TOK) do { float d[16]; \
        _Pragma("unroll") for (int i = 0; i < 16; ++i) { int d1 = 0; \
            _Pragma("unroll") for (int j = 0; j < 4; ++j) d1 = sdot4(Q[i][j], C1[j], d1); \
            d[i] = (float)d1 * HS; } \
        float m_[8], n_[4]; \
        _Pragma("unroll") for (int j = 0; j < 8; ++j) m_[j] = fmerge_bit2(d[2 * j], d[2 * j + 1]); \
        _Pragma("unroll") for (int j = 0; j < 4; ++j) n_[j] = fmerge_bit1(m_[2 * j], m_[2 * j + 1], lane); \
        const float p0_ = fmerge_bit0(n_[0], n_[1], lane), p1_ = fmerge_bit0(n_[2], n_[3], lane); \
        *(h16x2*)((_Float16*)PD + ((size_t)(TOK) * 8 + s) * 128 + 16 * e8 + 2 * kx) = pk_h2(p0_ * (1.f / 64.f), p1_ * (1.f / 64.f)); } while (0)
    for (int s = P.s0; s < 8; s += P.sstep) {
        const unsigned char* UTs = A.ws + WS_UT + (size_t)layer * 16384 * 1024 + (size_t)s * 16384 * 128; const unsigned c16 = 16u * (unsigned)c;
        const unsigned hoff = (unsigned)(128 * s + 16 * c), soff = (unsigned)(4 * (8 * s + c));
        if (P.t_beg >= P.t_end) continue;
        u32x4 ela, elb, ha1, hb1, qa[16], qb[16]; float ha2 = 0.f, hb2 = 0.f;
        int toka = peer_tok(layer, P.t_beg), tokb = toka;
        PU_LISTS(ela, ha1, ha2, toka); PU_ROWS(qa, ela);
        if (P.t_beg + 1 < P.t_end) { tokb = peer_tok(layer, P.t_beg + 1); PU_LISTS(elb, hb1, hb2, tokb); }
#pragma unroll 1
        for (int ti = P.t_beg; ti < P.t_end; ti += 2) {
            { if (ti + 1 < P.t_end) PU_ROWS(qb, elb);
              const int tc = toka; const u32x4 c1 = ha1; const float c2 = ha2;
              if (ti + 2 < P.t_end) { toka = peer_tok(layer, ti + 2); PU_LISTS(ela, ha1, ha2, toka); }
              PU_COMP(qa, c1, c2, tc); }
            if (ti + 1 >= P.t_end) break;
            { if (ti + 2 < P.t_end) PU_ROWS(qa, ela);
              const int tc = tokb; const u32x4 c1 = hb1; const float c2 = hb2;
              if (ti + 3 < P.t_end) { tokb = peer_tok(layer, ti + 3); PU_LISTS(elb, hb1, hb2, tokb); }
              PU_COMP(qb, c1, c2, tc); }
        }
    }
#undef PU_LISTS
#undef PU_ROWS
#undef PU_COMP
}
__device__ __forceinline__ void ph_peer_w(const Args& A, Frame& F, int layer) {
    const int lane = F.lane; const unsigned* PL = (const unsigned*)(A.ws + WS_PL); const float* PD = (const float*)(A.ws + WS_PD);
    unsigned char* PWB = A.ws + WS_PW; float* PWS = (float*)(A.ws + WS_PWS);
    const int ntk = layer == 3 ? BATCH * SEQ : NTOK; const int gw = F.bid * NWAVES + F.wave, NGW = F.G * NWAVES;
    const int t_beg = (int)(((long)gw * ntk) / NGW), t_end = (int)(((long)(gw + 1) * ntk) / NGW);
#pragma unroll 2
    for (int ti = t_beg; ti < t_end; ++ti) { const int tok = peer_tok(layer, ti); const _Float16* pd = (const _Float16*)PD + (size_t)tok * 1024 + (lane & 48) + 2 * (lane & 7) + ((lane >> 3) & 1);     const float* pl = (const float*)(PL + (size_t)tok * 512) + lane;
        float d0 = 0.f, d1 = 0.f;
#pragma unroll
        for (int s = 0; s < 8; ++s) { d0 += (float)pd[s * 128]; d1 += (float)pd[s * 128 + 64]; }
        d0 *= 64.f; d1 *= 64.f;
        const float w0 = pl[128] * gelu_tanh(d0 * pl[256]) * pl[384], w1 = pl[128 + 64] * gelu_tanh(d1 * pl[256 + 64]) * pl[384 + 64];
        const float wmax = wave_max(fmaxf(fabsf(w0), fabsf(w1))); const float wsc = wmax * (1.f / 16256.f), winv = wmax > 0.f ? 16256.f / wmax : 0.f;
        const int q0 = (int)rintf(w0 * winv), q1 = (int)rintf(w1 * winv); const int h0 = q0 >> 7, h1 = q1 >> 7;
        unsigned char* pw = PWB + (size_t)tok * 256 + lane;
        pw[0] = (unsigned char)(h0 & 255); pw[64] = (unsigned char)(h1 & 255); pw[128] = (unsigned char)(q0 - h0 * 128); pw[192] = (unsigned char)(q1 - h1 * 128);
        if (lane == 0) PWS[tok] = wsc; }
}
__device__ __forceinline__ void ph_peer_v(const Args& A, Frame& F, int layer) {
    const int lane = F.lane, e8 = lane >> 3, c = lane & 7; const PeerSlice P = peer_slice(A, F, layer);
    const unsigned* PL = (const unsigned*)(A.ws + WS_PL); const unsigned char* PWB = A.ws + WS_PW; const float* PWS = (const float*)(A.ws + WS_PWS); _Float16* PO = (_Float16*)(A.ws + WS_PO);
    const unsigned c16 = 16u * (unsigned)c;
    const int am = lane & 15, aterm = am & 1, acb = ((am >> 1) & 1) + 2 * (am >> 3), apar = (am >> 2) & 1;
    const unsigned aoff = (unsigned)(aterm * 128 + 16 * (2 * (lane >> 4) + apar));
    unsigned asel[4];
#pragma unroll
    for (int sl = 0; sl < 4; ++sl) asel[sl] = 0x0C0C0C0Cu ^ ((0x0Cu ^ (unsigned)sl) << (8 * acb));
    for (int s = P.s0; s < 8; s += P.sstep) {
        const unsigned char* VTs = A.ws + WS_VT + (size_t)layer * 16384 * 1024 + (size_t)s * 16384 * 128;
        if (P.t_beg >= P.t_end) continue;
        int tok = peer_tok(layer, P.t_beg);
        u32x4 el; EL_LOAD(el, tok);
        u32x4 wa = *(const u32x4*)(PWB + (size_t)tok * 256 + aoff); float wsc = PWS[tok];
#pragma unroll 1
        for (int ti = P.t_beg; ti < P.t_end; ++ti) {
            u32x4 q[16];
#pragma unroll
            for (int i = 0; i < 16; ++i) { const unsigned e_ = EL_GET(el, i); q[i] = *(const u32x4*)(VTs + (e_ * 128u + c16)); }
            const int tokc = tok; const u32x4 wc = wa; const float wsc_c = wsc;
            if (ti + 1 < P.t_end) { tok = peer_tok(layer, ti + 1); EL_LOAD(el, tok);
                wa = *(const u32x4*)(PWB + (size_t)tok * 256 + aoff); wsc = PWS[tok]; }
            i32x4 acc[4];
#pragma unroll
            for (int d = 0; d < 4; ++d) acc[d] = (i32x4){0, 0, 0, 0};
#pragma unroll
            for (int j = 0; j < 4; ++j) { i32x4 aj;
#pragma unroll
                for (int sl = 0; sl < 4; ++sl) aj[sl] = (int)bperm(0u, wc[j], asel[sl]);
#pragma unroll
                for (int d = 0; d < 4; ++d) { const i32x4 bj = {(int)q[4 * j][d], (int)q[4 * j + 1][d], (int)q[4 * j + 2][d], (int)q[4 * j + 3][d]}; acc[d] = mfma_i8(aj, bj, acc[d]); } }
            int o[8];
#pragma unroll
            for (int d = 0; d < 4; ++d)
#pragma unroll
                for (int cl = 0; cl < 2; ++cl) { const int w_ = acc[d][2 * cl] * 128 + acc[d][2 * cl + 1]; int x0, x1; lane_pair16(w_, x0, x1); o[2 * d + cl] = x0 + ror8_i(x1); }
            if ((lane & 0x18) == 0) { _Float16* dst = PO + (size_t)tokc * 1024 + 128 * s + 16 * c + 2 * (lane >> 5);
#pragma unroll
                for (int d = 0; d < 4; ++d) *(h16x2*)(dst + 4 * d) = pk_h2((float)o[2 * d] * wsc_c, (float)o[2 * d + 1] * wsc_c); }
        }
    }
}
__device__ __forceinline__ void ph_peer_e(const Args& A, Frame& F, int layer, bool dry = false) {
    const int lane = F.lane; bf16_t* X = (bf16_t*)(A.ws + WS_X); bf16_t* H = (bf16_t*)(A.ws + WS_H); const float* PO = (const float*)(A.ws + WS_PO); const float* PWS = (const float*)(A.ws + WS_PWS);
    const int ntk = layer == 3 ? BATCH * SEQ : NTOK; const int gw = F.bid * NWAVES + F.wave, NGW = F.G * NWAVES;
    const int t_beg = (int)(((long)gw * ntk) / NGW), t_end = (int)(((long)(gw + 1) * ntk) / NGW);
    const Row16 lg = ld_row_f32(A.in[6] + (size_t)(layer * 2 + 1) * DM, lane), lb = ld_row_f32(A.in[7] + (size_t)(layer * 2 + 1) * DM, lane);
    Row16 g2, sh, scl; int cls = -1;
    auto setcls = [&](int tok) { const int c_ = (tok / LTOK) * 2 + ((tok % LTOK) < CTXL); if (c_ != cls) { cls = c_; g2 = ld_row_f32(mod_row(A, layer, tok) + 5120, lane);
            if (layer < 3) { const float* modn = mod_row(A, layer + 1, tok); sh = ld_row_f32(modn, lane); scl = ld_row_f32(modn + 1024, lane); } } };
    auto ldpo = [&](int tok) { const _Float16* po = (const _Float16*)PO + (size_t)tok * 1024 + 16 * lane; const u32x4 o0 = *(const u32x4*)po, o1 = *(const u32x4*)(po + 8); Row16 out;
#pragma unroll
        for (int e = 0; e < 4; ++e) { out.v[2 * e] = hlo(o0[e]); out.v[2 * e + 1] = hhi(o0[e]); out.v[8 + 2 * e] = hlo(o1[e]); out.v[8 + 2 * e + 1] = hhi(o1[e]); }
        return out; };
    auto finish = [&](int tok, const Row16& x1, const Row16& out) { const int b = tok / LTOK, p = tok - b * LTOK; Row16 v;
#pragma unroll
        for (int e = 0; e < 16; ++e) v.v[e] = DN_ALPHA * x1.v[e] + g2.v[e] * out.v[e];
        const LnStat st = ln_stats(v); Row16 x2;
#pragma unroll
        for (int e = 0; e < 16; ++e) x2.v[e] = (v.v[e] - st.mean) * st.rstd * lg.v[e] + lb.v[e];
        if (dry) { if (x2.v[0] == 12345.678f) st_row_f32((float*)(A.ws + WS_OUT) + (size_t)tok * DM, lane, x2); return; }
        if (layer < 3) { st_row_bf16(X + (size_t)tok * DM, lane, x2); Row16 hn;
#pragma unroll
            for (int e = 0; e < 16; ++e) hn.v[e] = x2.v[e] * (1.f + scl.v[e]) + sh.v[e];
            st_row_bf16(H + (size_t)tok * DM, lane, hn);
        } else { st_row_f32(A.out + ((size_t)b * SEQ + (p - CTXL)) * DM, lane, x2); } };
    for (int ti = t_beg; ti < t_end; ti += 2) { const int tokA = peer_tok(layer, ti); const bool two = ti + 1 < t_end; const int tokB = two ? peer_tok(layer, ti + 1) : tokA;
        const Row16 oA = ldpo(tokA), xA = ld_row_bf16(X + (size_t)tokA * DM, lane), oB = ldpo(tokB), xB = ld_row_bf16(X + (size_t)tokB * DM, lane);
        setcls(tokA); finish(tokA, xA, oA);
        if (two) { setcls(tokB); finish(tokB, xB, oB); } }
}

constexpr int NPHASE = 45;
constexpr int PH_ORDER[NPHASE] = {0, 1, 2, 3, 4, 5, 6, 29, 30, 31, 32, 7, 8, 9, 10, 11, 12, 13, 14, 33, 34, 35, 36, 15, 16, 17, 18, 19, 20, 21, 37, 38, 39, 40, 22, 23, 24, 25, 26, 27, 41, 42, 43, 44, 28};
__device__ __forceinline__ void gemm_f32(const Args& A, Frame& F, const bf16_t* Am, int lda, const bf16_t* Bt, int ldb, int N, int K, float* O, int ldc, bool lat = false) {
    pg8::Gemm g{Am, Bt, NTOK, N, K, lda, ldb}; pg8::StaticOrder S; S.init(NTOK, N, F.G, F.bid, lat); EpiF32 E{O, ldc};
    pg8::gemm_phase<EpiF32, pg8::StaticOrder, PG8_ALIGN, PG8_SP2>(GEMM_LDS(F), g, S, E, F.wave);
}
__device__ __forceinline__ void gemm_b16(const Args& A, Frame& F, const bf16_t* Am, int lda, const bf16_t* Bt, int ldb, int N, int K, bf16_t* O, int ldc) {
    pg8::Gemm g{Am, Bt, NTOK, N, K, lda, ldb}; pg8::StaticOrder S; S.init(NTOK, N, F.G, F.bid); EpiB16 E{O, ldc};
    pg8::gemm_phase<EpiB16, pg8::StaticOrder, PG8_ALIGN, PG8_SP2>(GEMM_LDS(F), g, S, E, F.wave);
}
__device__ __forceinline__ void run_phase(const Args& A, Frame& F, int ph, bool dry = false) {
    unsigned char* ws = A.ws;
    switch (ph) {
    case 0: ph_prep(A, F); break;
    case 1: ph_init(A, F); break;
    case 2: case 23: ph_s5_scan(A, F, ph == 2 ? 0 : 1); break;
    case 3: case 24: ph_s5_combine(A, F, ph == 3 ? 0 : 1); break;
    case 4: case 25: { const int j = ph == 4 ? 0 : 1;
        pg8::Gemm g{(const bf16_t*)(ws + WS_G), (const bf16_t*)(ws + WS_WGLU) + (size_t)j * 2048 * 1024, NTOK, 2048, 1024, 1024, 1024}; pg8::StaticOrder S; S.init(NTOK, 2048, F.G, F.bid, j == 1); EpiGlu E{(bf16_t*)(ws + WS_OUT)};
        pg8::gemm_phase<EpiGlu, pg8::StaticOrder, PG8_ALIGN, PG8_SP2>(GEMM_LDS(F), g, S, E, F.wave); } break;
    case 5: ph_rowop(A, F, 0, dry); break;
    case 13: ph_rowop(A, F, 1, dry); break;
    case 20: ph_rowop(A, F, 2, dry); break;
    case 26: ph_rowop(A, F, 3, dry); break;
    case 6: case 14: case 21: case 27: { const int layer = ph == 6 ? 0 : ph == 14 ? 1 : ph == 21 ? 2 : 3;
        pg8::Gemm g{(const bf16_t*)(ws + WS_H2), (const bf16_t*)(ws + WS_WSC) + (size_t)layer * 2048 * 1024, NTOK, 2048, 1024, 1024, 1024}; pg8::StaticOrder S; S.init(NTOK, 2048, F.G, F.bid, layer == 3);
        EpiH16 E{(unsigned short*)(ws + WS_SC), 2048};
        pg8::gemm_phase<EpiH16, pg8::StaticOrder, PG8_ALIGN, PG8_SP2>(GEMM_LDS(F), g, S, E, F.wave); } break;
    case 7: ph_peer_e(A, F, 0, dry); break;
    case 15: ph_peer_e(A, F, 1, dry); break;
    case 22: ph_peer_e(A, F, 2, dry); break;
    case 28: ph_peer_e(A, F, 3, dry); break;
    case 29: case 33: case 37: case 41: ph_peer_a(A, F, (ph - 29) >> 2); break;
    case 30: case 34: case 38: case 42: ph_peer_u(A, F, (ph - 29) >> 2); break;
    case 31: case 35: case 39: case 43: ph_peer_w(A, F, (ph - 29) >> 2); break;
    case 32: case 36: case 40: case 44: ph_peer_v(A, F, (ph - 29) >> 2); break;
    case 8: { pg8::Gemm g{(const bf16_t*)(ws + WS_H), (const bf16_t*)(ws + WS_WIN), NTOK, SSD_IN_PAD, 1024, 1024, 1024}; pg8::StaticOrder S; S.init(NTOK, SSD_IN_PAD, F.G, F.bid);
        EpiSsdIn E{(bf16_t*)(ws + WS_Z), (bf16_t*)(ws + WS_XBC), (float*)(ws + WS_DT)};
        pg8::gemm_phase<EpiSsdIn, pg8::StaticOrder, PG8_ALIGN, PG8_SP2>(GEMM_LDS(F), g, S, E, F.wave); } break;
    case 9: ph_ssd_conv(A, F); break;
    case 10: ph_ssd_scan(A, F); break;
    case 11: ph_ssd_gate(A, F); break;
    case 12: gemm_b16(A, F, (const bf16_t*)(ws + WS_G2), 2048, (const bf16_t*)(ws + WS_WOUT), 2048, 1024, 2048, (bf16_t*)(ws + WS_OUT), 1024); break;
    case 16: { pg8::Gemm g{(const bf16_t*)(ws + WS_H), (const bf16_t*)(ws + WS_WDOWN), NTOK, 512, 1024, 1024, 1024}; pg8::StaticOrder S; S.init(NTOK, 512, F.G, F.bid);
        EpiMlaDown E{(bf16_t*)(ws + WS_CQKV), (float*)(ws + WS_RS)};
        pg8::gemm_phase<EpiMlaDown, pg8::StaticOrder, PG8_ALIGN, PG8_SP2>(GEMM_LDS(F), g, S, E, F.wave); } break;
    case 17: { mla_kr(A, F); __syncthreads();
        pg8::Gemm g{(const bf16_t*)(ws + WS_CQKV), (const bf16_t*)(ws + WS_WUP), NTOK, 4096, 384, 512, 384}; pg8::StaticOrder S; S.init(NTOK, 4096, F.G, F.bid);
        EpiMlaUp E{(bf16_t*)(ws + WS_Q), (bf16_t*)(ws + WS_K), (bf16_t*)(ws + WS_V), (const float*)(ws + WS_RS)};
        pg8::gemm_phase<EpiMlaUp, pg8::StaticOrder, PG8_ALIGN, PG8_SP2>(GEMM_LDS(F), g, S, E, F.wave); } break;
    case 18: ph_attn(A, F); break;
    case 19: gemm_b16(A, F, (const bf16_t*)(ws + WS_O), 1024, (const bf16_t*)(ws + WS_WO), 1024, 1024, 1024, (bf16_t*)(ws + WS_OUT), 1024); break;
    default: break;
    }
}

#ifndef CPU_EMU
#define LAS __attribute__((address_space(3)))
#define XB_TMO      128
#define XB_XCNT(j)  (256  + 64 * (j))
#define XB_XSUB(j)  (1280 + 64 * (j))
#define XB_XGEN(j)  (2304 + 64 * (j))
#define XB_TOP      3328
#define XB_TOPGEN   3392
#define XCD_BAR_WORDS 3456
#define XB_SPIN_CAP (1u << 22)
__device__ __forceinline__ unsigned xb_ld(unsigned* p)              { return __hip_atomic_load(p, __ATOMIC_RELAXED, __HIP_MEMORY_SCOPE_AGENT); }
__device__ __forceinline__ unsigned xb_add(unsigned* p, unsigned v) { return __hip_atomic_fetch_add(p, v, __ATOMIC_RELAXED, __HIP_MEMORY_SCOPE_AGENT); }
__device__ __forceinline__ unsigned xb_xcc_id() { return (unsigned)__builtin_amdgcn_s_getreg((3 << 11) | 20) & 0xFu; }
#define XB_SPIN(cond, bar) do { unsigned _sp = 0; while (cond) { __builtin_amdgcn_s_sleep(1); \
    if ((++_sp & 255u) == 0u) { if (xb_ld(&(bar)[XB_TMO])) break; if (_sp > XB_SPIN_CAP) { atomicAdd(&(bar)[XB_TMO], 1u); break; } } } } while (0)
struct XcdBarrier { unsigned* bar; unsigned x; volatile LAS unsigned* st; };
__device__ __forceinline__ XcdBarrier xcd_barrier_post(unsigned* bar, volatile LAS unsigned* st) {
    XcdBarrier b; b.bar = bar; b.x = xb_xcc_id(); b.st = st;
    if (threadIdx.x == 0) { st[2] = xb_add(&bar[XB_XCNT(b.x)], 1u); st[3] = b.x; }
    return b;
}
__device__ __forceinline__ void xcd_barrier_complete(unsigned* bar, unsigned x, unsigned& nloc, unsigned& nx) {
    const unsigned G = gridDim.x * gridDim.y * gridDim.z;
    unsigned sum, cnt, mine, sp = 0u;
    for (;;) {
        sum = 0u; cnt = 0u; mine = 0u;
#pragma unroll
        for (unsigned j = 0; j < 16; ++j) { const unsigned c = xb_ld(&bar[XB_XCNT(j)]); sum += c; cnt += (c > 0u) ? 1u : 0u; mine = (j == x) ? c : mine; }
        if (sum == G) break;
        __builtin_amdgcn_s_sleep(1);
        if ((++sp & 255u) == 0u) { if (xb_ld(&bar[XB_TMO])) break; if (sp > XB_SPIN_CAP) { atomicAdd(&bar[XB_TMO], 1u); break; } }
    }
    nloc = mine > 0u ? mine : 1u; nx = cnt > 0u ? cnt : 1u;
}
__device__ __forceinline__ void xcd_barrier(const XcdBarrier& b, int wave_s) {
    asm volatile("s_waitcnt vmcnt(0)" ::: "memory");
    __syncthreads();
    if (wave_s == 0 && hw_lane() == 0) {
        unsigned* bar = b.bar;
        __builtin_amdgcn_s_waitcnt(0);
        unsigned nloc = b.st[0], nx = b.st[1];
        if (nloc == 0u) { xcd_barrier_complete(bar, b.x, nloc, nx); b.st[0] = nloc; b.st[1] = nx; }
        const unsigned old = xb_add(&bar[XB_XSUB(b.x)], 1u);
        const unsigned gen = old / nloc;
        if (old + 1u == (gen + 1u) * nloc) {
            __builtin_amdgcn_fence(__ATOMIC_RELEASE, "agent");
            asm volatile("s_waitcnt vmcnt(0)" ::: "memory");
            const unsigned og = xb_add(&bar[XB_TOP], 1u);
            const unsigned tg = og / nx;
            if (og + 1u == (tg + 1u) * nx) xb_add(&bar[XB_TOPGEN], 1u);
            else XB_SPIN(xb_ld(&bar[XB_TOPGEN]) == tg, bar);
            __builtin_amdgcn_fence(__ATOMIC_ACQUIRE, "agent");
            xb_add(&bar[XB_XGEN(b.x)], 1u);
            asm volatile("s_waitcnt vmcnt(0)" ::: "memory");
        } else {
            XB_SPIN(xb_ld(&bar[XB_XGEN(b.x)]) == gen, bar);
            __builtin_amdgcn_fence(__ATOMIC_ACQUIRE, "agent");
            asm volatile("s_waitcnt vmcnt(0)" ::: "memory");
        }
    }
    __syncthreads();
}

constexpr int LDS_BYTES = 147456;
constexpr int LDSCTL_OFF = 131072;
__device__ __forceinline__ Frame mk_frame(unsigned char* lds, int wave_s) {
    int l = hw_lane(); asm volatile("" : "+v"(l));
    Frame F; F.lds = lds; F.lane = l; F.wave = wave_s; F.tid = wave_s * 64 + l; F.G = gridDim.x; F.bid = blockIdx.x; return F;
}
__device__ __forceinline__ void grid_bar(unsigned char* ws, unsigned char* lds, int wave_s) {
    XcdBarrier bar; bar.bar = (unsigned*)(ws + WS_CTL) + 1024; bar.x = xb_xcc_id(); bar.st = (volatile LAS unsigned*)((LAS unsigned char*)lds + LDSCTL_OFF) + 8;
    xcd_barrier(bar, wave_s);
}
__global__ void __launch_bounds__(NTHR, 2) hybrid_fwd(Args args) {
    extern __shared__ __attribute__((aligned(16))) unsigned char lds[];
    const int wave_s = __builtin_amdgcn_readfirstlane((int)threadIdx.x >> 6);
    { volatile LAS unsigned* MISC = (volatile LAS unsigned*)((LAS unsigned char*)lds + LDSCTL_OFF);
      if (wave_s == 0) MISC[hw_lane()] = 0u;
      __syncthreads();
      if (args.ph_hi - args.ph_lo > 1) (void)xcd_barrier_post((unsigned*)(args.ws + WS_CTL) + 1024, MISC + 8); }
    const int lo = args.ph_lo, hi = args.ph_hi;
    if (PROBE && blockIdx.x == 0 && wave_s == 0 && hw_lane() == 0) { ((unsigned long long*)(args.ws + WS_TS))[0] = __builtin_amdgcn_s_memrealtime(); ((unsigned long long*)(args.ws + WS_TS))[40] = 0ull; ((unsigned long long*)(args.ws + WS_TS))[41] = 0ull; }
#define PHASE(k, id) if (lo <= (k) && (k) < hi) { if ((DUPMASK >> (k)) & 1ull) { Frame F = mk_frame(lds, wave_s); run_phase(args, F, (id), true); grid_bar(args.ws, lds, wave_s); } { Frame F = mk_frame(lds, wave_s); run_phase(args, F, (id)); } if ((k) + 1 < hi) { if (USE_CG && (k) == 0) cg::this_grid().sync(); grid_bar(args.ws, lds, wave_s); } }
    PHASE(0, 0) PHASE(1, 1) PHASE(2, 2) PHASE(3, 3) PHASE(4, 4) PHASE(5, 5) PHASE(6, 6) PHASE(7, 29) PHASE(8, 30) PHASE(9, 31) PHASE(10, 32) PHASE(11, 7)
    PHASE(12, 8) PHASE(13, 9) PHASE(14, 10) PHASE(15, 11) PHASE(16, 12) PHASE(17, 13) PHASE(18, 14) PHASE(19, 33) PHASE(20, 34) PHASE(21, 35) PHASE(22, 36) PHASE(23, 15)
    PHASE(24, 16) PHASE(25, 17) PHASE(26, 18) PHASE(27, 19) PHASE(28, 20) PHASE(29, 21) PHASE(30, 37) PHASE(31, 38) PHASE(32, 39) PHASE(33, 40) PHASE(34, 22)
    PHASE(35, 23) PHASE(36, 24) PHASE(37, 25) PHASE(38, 26) PHASE(39, 27) PHASE(40, 41) PHASE(41, 42) PHASE(42, 43) PHASE(43, 44) PHASE(44, 28)
#undef PHASE
}

extern "C" void kernel_launch(void* const* d_in, const int* in_sizes, int n_in, void* d_out, int out_size, void* d_ws, size_t ws_size, hipStream_t stream) {
    static int grid = 0;
    if (grid == 0) {
        if (n_in != 37 || ws_size < WS_END) { fprintf(stderr, "kernel_launch: unexpected n_in %d / ws %zu\n", n_in, ws_size); grid = -1; return; }
        int dev = 0, cus = 0, per_cu = 0;
        hipGetDevice(&dev); hipDeviceGetAttribute(&cus, hipDeviceAttributeMultiprocessorCount, dev);
        hipFuncSetAttribute((const void*)hybrid_fwd, hipFuncAttributeMaxDynamicSharedMemorySize, LDS_BYTES);
        hipOccupancyMaxActiveBlocksPerMultiprocessor(&per_cu, (const void*)hybrid_fwd, NTHR, LDS_BYTES);
        (void)hipGetLastError();
        if (per_cu < 1) { fprintf(stderr, "kernel_launch: occupancy query says %d blocks/CU\n", per_cu); per_cu = 1; }
        grid = cus;
    }
    if (grid < 0) return;
    hipMemsetAsync((char*)d_ws + WS_CTL, 0, CTL_ZERO_BYTES, stream);
    Args a{};
    for (int i = 0; i < 37; ++i) a.in[i] = (const float*)d_in[i];
    a.out = (float*)d_out; a.ws = (unsigned char*)d_ws; a.ph_lo = 0; a.ph_hi = NPHASE;
#if USE_CG
    void* kargs[] = {&a};
    hipError_t e = hipLaunchCooperativeKernel((const void*)hybrid_fwd, dim3(grid), dim3(NTHR), kargs, LDS_BYTES, stream);
    if (e != hipSuccess) fprintf(stderr, "cooperative launch failed: %s (grid %d)\n", hipGetErrorString(e), grid);
#else
    hipLaunchKernelGGL(hybrid_fwd, dim3(grid), dim3(NTHR), LDS_BYTES, stream, a);
    const hipError_t e = hipPeekAtLastError();
    if (e != hipSuccess) fprintf(stderr, "launch failed: %s (grid %d)\n", hipGetErrorString(e), grid);
#endif
}
#endif
```

```cpp
#ifndef CPU_EMU
#include <hip/hip_runtime.h>
#include <hip/hip_cooperative_groups.h>
#include <cstdio>
#include <cstdint>
#include <cmath>
namespace cg = cooperative_groups;
#endif

#ifndef BATCH
#define BATCH 4
#endif
#ifndef SEQ
#define SEQ 4096
#endif
#ifndef CTXL
#define CTXL 256
#endif
constexpr int DM = 1024, LTOK = CTXL + SEQ, NTOK = BATCH * LTOK, NR = BATCH + 1;
constexpr int NTHR = 512, NWAVES = 8;
static_assert(NTOK % 256 == 0 && SEQ % 256 == 0 && CTXL % 256 == 0 && LTOK % 32 == 0, "shape");
constexpr float DN_ALPHA = 1.6817928305074290f;
constexpr int SSD_IN = 5184, SSD_IN_PAD = 5376;

typedef unsigned short bf16_t;
typedef short bf16x8 __attribute__((ext_vector_type(8)));
typedef float f32x2 __attribute__((ext_vector_type(2)));
typedef float f32x4 __attribute__((ext_vector_type(4)));
typedef float f32x16 __attribute__((ext_vector_type(16)));
typedef unsigned u32x2 __attribute__((ext_vector_type(2)));
typedef unsigned u32x4 __attribute__((ext_vector_type(4)));

constexpr size_t MiB = 1u << 20;
constexpr size_t WS_CTL = 0, CTL_ZERO_BYTES = 64 * 1024;
constexpr size_t WS_MOD = 1 * MiB;
constexpr size_t WS_ROPE = WS_MOD + 768 * 1024;
constexpr size_t WS_S5C = 2 * MiB;
constexpr size_t S5C_ITEM = 12800;
constexpr size_t WS_WGLU = 6 * MiB;
constexpr size_t WS_WIN = 14 * MiB;
constexpr size_t WS_WOUT = 25 * MiB;
constexpr size_t WS_WDOWN = 29 * MiB;
constexpr size_t WS_WUP = 30 * MiB;
constexpr size_t WS_WO = 33 * MiB;
constexpr size_t WS_WSC = 35 * MiB;
constexpr size_t WS_UT = 52 * MiB;
constexpr size_t WS_VT = 116 * MiB;
constexpr size_t WS_US = 180 * MiB;
constexpr size_t WS_VS = 181 * MiB;
constexpr size_t WS_X = 308 * MiB;
constexpr size_t WS_H = 376 * MiB;
constexpr size_t WS_H2 = 410 * MiB;
constexpr size_t WS_OUT = 444 * MiB;
constexpr size_t WS_R = 512 * MiB;
constexpr size_t WS_SC = WS_R;
constexpr size_t WS_YF = WS_R, WS_YB = WS_R + 34 * MiB, WS_G = WS_R + 68 * MiB;
constexpr size_t WS_Z = WS_R, WS_XBC = WS_R + 68 * MiB, WS_XBCC = WS_R + 170 * MiB, WS_DT = WS_R + 272 * MiB, WS_DTS = WS_R + 277 * MiB, WS_ACUM = WS_R + 420 * MiB,
                 WS_YF2 = WS_R + 282 * MiB, WS_YB2 = WS_R + 350 * MiB, WS_G2 = WS_XBC;
constexpr size_t WS_CQKV = WS_R, WS_RS = WS_R + 17 * MiB, WS_Q = WS_R + 18 * MiB, WS_K = WS_R + 86 * MiB, WS_V = WS_R + 154 * MiB, WS_O = WS_R + 188 * MiB;
constexpr size_t WS_PL = WS_R + 68 * MiB;
constexpr size_t WS_PH = WS_R + 102 * MiB;
constexpr size_t WS_PS = WS_R + 136 * MiB;
constexpr size_t WS_PD = WS_R + 137 * MiB;
constexpr size_t WS_PW = WS_R + 205 * MiB;
constexpr size_t WS_PWS = WS_R + 214 * MiB;
constexpr size_t WS_PO = WS_R + 215 * MiB;
constexpr size_t WS_END = 1024 * MiB;
constexpr size_t WS_TS = 64 * 1024;
#ifndef PROBE
#define PROBE 0
#endif
#ifndef USE_CG
#define USE_CG 1
#endif
#ifndef DUPMASK
#define DUPMASK 0ull
#endif

__device__ __forceinline__ unsigned f2bf(float f) { unsigned u = __float_as_uint(f); return (u + 0x7fffu + ((u >> 16) & 1u)) >> 16; }
#ifdef CPU_EMU
__device__ __forceinline__ unsigned pk2(float lo, float hi) { return f2bf(lo) | (f2bf(hi) << 16); }
#else
typedef __bf16 bf16x2_hw __attribute__((ext_vector_type(2)));
__device__ __forceinline__ unsigned pk2(float lo, float hi) { const f32x2 v = {lo, hi}; const bf16x2_hw b = __builtin_convertvector(v, bf16x2_hw); return __builtin_bit_cast(unsigned, b); }
#endif
__device__ __forceinline__ float bflo(unsigned w) { return __uint_as_float(w << 16); }
__device__ __forceinline__ float bfhi(unsigned w) { return __uint_as_float(w & 0xffff0000u); }
__device__ __forceinline__ float bf2f(bf16_t s) { return __uint_as_float(((unsigned)s) << 16); }
__device__ __forceinline__ float gelu_tanh(float x) { const float u = 0.7978845608028654f * (x + 0.044715f * x * x * x); const float e = __expf(2.f * u); const float t = 1.f - 2.f / (e + 1.f); return 0.5f * x * (1.f + t); }
__device__ __forceinline__ float sigmoidf_(float x) { return 1.f / (1.f + __expf(-x)); }
__device__ __forceinline__ float siluf_(float x) { return x / (1.f + __expf(-x)); }
#ifdef CPU_EMU
__device__ __forceinline__ float wave_sum(float v) {
#pragma unroll
    for (int o = 1; o < 64; o <<= 1) v += __shfl_xor(v, o);
    return v;
}
__device__ __forceinline__ float wave_max(float v) {
#pragma unroll
    for (int o = 1; o < 64; o <<= 1) v = fmaxf(v, __shfl_xor(v, o));
    return v;
}
#else
template <int CTRL> __device__ __forceinline__ float dpp_f(float v) { return __builtin_bit_cast(float, __builtin_amdgcn_update_dpp(0, __builtin_bit_cast(int, v), CTRL, 0xF, 0xF, true)); }
__device__ __forceinline__ float wave_sum(float v) {
    v += dpp_f<0xB1>(v); v += dpp_f<0x4E>(v); v += dpp_f<0x141>(v); v += dpp_f<0x140>(v);
    { auto rr = __builtin_amdgcn_permlane16_swap(__float_as_uint(v), __float_as_uint(v), false, false); v = __uint_as_float(rr[0]) + __uint_as_float(rr[1]); }
    { auto rr = __builtin_amdgcn_permlane32_swap(__float_as_uint(v), __float_as_uint(v), false, false); v = __uint_as_float(rr[0]) + __uint_as_float(rr[1]); }
    return v;
}
__device__ __forceinline__ float wave_max(float v) {
    v = fmaxf(v, dpp_f<0xB1>(v)); v = fmaxf(v, dpp_f<0x4E>(v)); v = fmaxf(v, dpp_f<0x141>(v)); v = fmaxf(v, dpp_f<0x140>(v));
    { auto rr = __builtin_amdgcn_permlane16_swap(__float_as_uint(v), __float_as_uint(v), false, false); v = fmaxf(__uint_as_float(rr[0]), __uint_as_float(rr[1])); }
    { auto rr = __builtin_amdgcn_permlane32_swap(__float_as_uint(v), __float_as_uint(v), false, false); v = fmaxf(__uint_as_float(rr[0]), __uint_as_float(rr[1])); }
    return v;
}
#endif
__device__ __forceinline__ unsigned wave_umax(unsigned v) {
#pragma unroll
    for (int o = 1; o < 64; o <<= 1) { const unsigned t = __shfl_xor(v, o); v = t > v ? t : v; }
    return v;
}
#ifdef CPU_EMU
__device__ __forceinline__ void wave_sync() { emu::wave_barrier(); }
__device__ __forceinline__ f32x16 mfma32(bf16x8 a, bf16x8 b, f32x16 c) { return emu_mfma_32x32x16_bf16(a, b, c); }
__device__ __forceinline__ int rfl(int x) { return x; }
#else
__device__ __forceinline__ void wave_sync() { asm volatile("s_waitcnt lgkmcnt(0)" ::: "memory"); }
__device__ __forceinline__ f32x16 mfma32(bf16x8 a, bf16x8 b, f32x16 c) { return __builtin_amdgcn_mfma_f32_32x32x16_bf16(a, b, c, 0, 0, 0); }
__device__ __forceinline__ int rfl(int x) { return __builtin_amdgcn_readfirstlane(x); }
#endif
typedef short s16x4 __attribute__((ext_vector_type(4)));
typedef int i32x4 __attribute__((ext_vector_type(4)));
typedef int i32x2 __attribute__((ext_vector_type(2)));
typedef _Float16 h16x2 __attribute__((ext_vector_type(2)));
__device__ __forceinline__ h16x2 pk_h2(float a, float b) { h16x2 r; r[0] = (_Float16)a; r[1] = (_Float16)b; return r; }
#ifdef CPU_EMU
#define SCHED_FENCE() do {} while (0)
#else
#define SCHED_FENCE() __builtin_amdgcn_sched_barrier(0)
#endif
#ifdef CPU_EMU
__device__ __forceinline__ i32x4 mfma_i8(i32x4 a, i32x4 b, i32x4 c) { return emu_mfma_i32_16x16x64_i8(a, b, c); }
#else
__device__ __forceinline__ i32x4 mfma_i8(i32x4 a, i32x4 b, i32x4 c) { return __builtin_amdgcn_mfma_i32_16x16x64_i8(a, b, c, 0, 0, 0); }
#endif
#ifdef CPU_EMU
__device__ __forceinline__ s16x4 lds_tr(const unsigned char* p) { return emu_ds_read_tr16_b64(p); }
#else
__device__ __forceinline__ s16x4 lds_tr(const unsigned char* p) { return __builtin_bit_cast(s16x4, __builtin_amdgcn_ds_read_tr16_b64_v4i16((__attribute__((address_space(3))) s16x4*)p)); }
#endif
#ifdef CPU_EMU
__device__ __forceinline__ int hw_lane() { return (int)(threadIdx.x & 63); }
#else
__device__ __forceinline__ int hw_lane() { return (int)__builtin_amdgcn_mbcnt_hi(~0u, __builtin_amdgcn_mbcnt_lo(~0u, 0u)); }
#endif
__device__ __forceinline__ int crow(int r, int hi) { return (r & 3) + 8 * (r >> 2) + 4 * hi; }
__device__ __forceinline__ int seqpos(int dir, int s) { return dir == 0 ? s : (s < CTXL ? CTXL - 1 - s : LTOK + CTXL - 1 - s); }

struct Args { const float* in[37]; float* out; unsigned char* ws; int ph_lo, ph_hi; };
struct Frame { unsigned char* lds; int tid, lane, wave, G, bid; };

namespace pg8 {
constexpr int BM = 256, BK = 64, HALF = 128, HTB = HALF * BK * 2, STAGE_BYTES = 8 * HTB, NXCD = 8, WGM = 8;
__host__ __device__ __forceinline__ int lds_byte(int r, int c) { const int st = (r >> 4) * 2 + (c >> 5), rr = r & 15, cc = c & 31, ob = rr * 64 + cc * 2; return st * 1024 + (ob ^ (((ob >> 9) & 1) << 5)); }
__host__ __device__ __forceinline__ void stage_rc(int b, int& R, int& C) { const int st = b / 1024, sb = b % 1024, swz = sb ^ (((sb >> 9) & 1) << 5); R = (st >> 1) * 16 + swz / 64; C = (st & 1) * 32 + (swz % 64) / 2; }
__host__ __device__ __forceinline__ int perm32(int rho) { const int n = rho >> 4, i = rho & 15; return 8 * (i >> 2) + 4 * n + (i & 3); }
struct Unit { int pm, pn; };
struct Gemm { const bf16_t* A; const bf16_t* Bt; int M, N, K, lda, ldb; };
struct StaticOrder {
    int nM, nN, nwg, G, c; bool lat;
    __host__ __device__ void init(int M, int N, int G_, int c_, bool lat_ = false) { lat = lat_; nM = lat ? BATCH * (SEQ / 256) : M / BM; nN = N / BM; nwg = nM * nN; G = G_; c = c_; }
    __host__ __device__ bool next(int i, Unit& u) const {
        const long L = (long)i * G + c; if (L >= nwg) return false;
        int wgid = (int)L; { const int q = nwg / NXCD, r = nwg % NXCD, xcd = wgid % NXCD, off = wgid / NXCD; wgid = (xcd < r ? xcd * (q + 1) : r * (q + 1) + (xcd - r) * q) + off; }
        const int nig = WGM * nN, gid = wgid / nig, fm = gid * WGM, gsz = (nM - fm) < WGM ? (nM - fm) : WGM;
        u.pm = fm + ((wgid % nig) % gsz); u.pn = (wgid % nig) / gsz;
        if (lat) u.pm = (u.pm / (SEQ / 256)) * (LTOK / 256) + CTXL / 256 + u.pm % (SEQ / 256);
        return true;
    }
};
#ifdef CPU_EMU
template <class Epi, class Sched, bool ALIGN_EPI = false, bool SP2 = false>
__device__ __forceinline__ void gemm_phase(unsigned char* lds, const Gemm g, const Sched& S, const Epi& E, int wave_s) {
    const int tid = threadIdx.x, wid = tid >> 6, lane = tid & 63, wr = wid >> 2, wc = wid & 3, fr = lane & 15, fq = lane >> 4;
    Unit u;
    for (int ui = 0; S.next(ui, u); ++ui) {
        f32x4 acc[2][2][4][2];
        for (int ai = 0; ai < 2; ++ai) for (int bj = 0; bj < 2; ++bj) for (int m = 0; m < 4; ++m) for (int n = 0; n < 2; ++n) for (int e = 0; e < 4; ++e) {
            const int row = u.pm * 256 + 128 * ai + 64 * wr + 16 * m + fr;
            const int col = u.pn * 256 + 128 * bj + 32 * wc + (Epi::PERM ? 8 * fq + 4 * n + e : 16 * n + 4 * fq + e);
            const bf16_t* a = g.A + (size_t)row * g.lda; const bf16_t* b = g.Bt + (size_t)col * g.ldb; float s = 0.f;
            for (int k = 0; k < g.K; ++k) s += bf2f(a[k]) * bf2f(b[k]);
            acc[ai][bj][m][n][e] = s;
        }
        E(acc, u, wr, wc, fr, fq);
    }
    __syncthreads();
}
#else
#define PG8_LAS __attribute__((address_space(3)))
template <class Epi, class Sched, bool ALIGN_EPI = false, bool SP2 = false>
__device__ __forceinline__ void gemm_phase(PG8_LAS unsigned char* lds, const Gemm g, const Sched& S, const Epi& E, int wave_s) {
    int lane_ = hw_lane(); asm volatile("" : "+v"(lane_));
    const int wid = wave_s, lane = lane_, tid = wid * 64 + lane, wr = wid >> 2, wc = wid & 3, fr = lane & 15, fq = lane >> 4;
    const int K = g.K, nt = K / BK;
    unsigned voffA[2], voffB[2];
#pragma unroll
    for (int i = 0; i < 2; ++i) { int R, C; stage_rc(tid * 16 + i * 8192, R, C); const int Rb = Epi::PERM ? ((R & ~31) + perm32(R & 31)) : R;
        voffA[i] = (unsigned)(R * g.lda + C) * 2u; voffB[i] = (unsigned)(Rb * g.ldb + C) * 2u; }
    const size_t kstep = (size_t)(BK * 2);
    const size_t hstepA = (size_t)HALF * g.lda * 2, hstepB = (size_t)HALF * g.ldb * 2;
    const size_t tstepA = 2 * hstepA, tstepB = 2 * hstepB;
    const unsigned ldsw = (unsigned)wid * 1024u;
    const int aoff = lds_byte(wr * 64 + fr, fq * 8), boff = lds_byte(wc * 32 + fr, fq * 8);
#define PG8_SA(b, h) (((b) * 2 + (h)) * HTB)
#define PG8_SB(b, h) ((4 + (b) * 2 + (h)) * HTB)
#define PG8_STAGE(bufoff, gbase, voff) do { _Pragma("unroll") for (int _i = 0; _i < 2; ++_i) \
        __builtin_amdgcn_global_load_lds((const unsigned*)((const char*)(gbase) + (voff)[_i]), (PG8_LAS unsigned*)(lds + (bufoff) + ldsw + _i * 8192), 16, 0, 0); } while (0)
#define PG8_LDA(dst, b, h) do { _Pragma("unroll") for (int m = 0; m < 4; ++m) _Pragma("unroll") for (int k = 0; k < 2; ++k) dst[m][k] = *(const PG8_LAS bf16x8*)(lds + PG8_SA(b, h) + aoff + m * 2048 + k * 1024); } while (0)
#define PG8_LDB(dst, b, h) do { _Pragma("unroll") for (int n = 0; n < 2; ++n) _Pragma("unroll") for (int k = 0; k < 2; ++k) dst[n][k] = *(const PG8_LAS bf16x8*)(lds + PG8_SB(b, h) + boff + n * 2048 + k * 1024); } while (0)
#define PG8_MMA(ai, bj, At, Bt) do { __builtin_amdgcn_s_setprio(1); _Pragma("unroll") for (int m = 0; m < 4; ++m) _Pragma("unroll") for (int n = 0; n < 2; ++n) _Pragma("unroll") for (int k = 0; k < 2; ++k) \
        acc[ai][bj][m][n] = __builtin_amdgcn_mfma_f32_16x16x32_bf16(Bt[n][k], At[m][k], acc[ai][bj][m][n], 0, 0, 0); __builtin_amdgcn_s_setprio(0); } while (0)
#define PG8_WAIT_V(n) asm volatile("s_waitcnt vmcnt(" #n ")" ::: "memory")
#define PG8_WAIT_L(n) asm volatile("s_waitcnt lgkmcnt(" #n ")" ::: "memory")
#define PG8_BAR __builtin_amdgcn_s_barrier()
#define PG8_SCHED __builtin_amdgcn_sched_barrier(0)
    Unit cur, nxt; int ui = 0;
    if (!S.next(0, cur)) return;
    f32x4 acc[2][2][4][2];
#pragma unroll
    for (int a = 0; a < 2; ++a)
#pragma unroll
        for (int b = 0; b < 2; ++b)
#pragma unroll
            for (int m = 0; m < 4; ++m)
#pragma unroll
                for (int n = 0; n < 2; ++n) acc[a][b][m][n] = (f32x4){0.f, 0.f, 0.f, 0.f};
    bf16x8 At[4][2], B0[2][2], B1[2][2];
    const char* cA = (const char*)g.A + (size_t)cur.pm * tstepA; const char* cB = (const char*)g.Bt + (size_t)cur.pn * tstepB;
    if constexpr (SP2) {
        PG8_STAGE(PG8_SB(0, 0), cB, voffB); PG8_STAGE(PG8_SB(0, 1), cB + hstepB, voffB); PG8_STAGE(PG8_SA(0, 0), cA, voffA); PG8_STAGE(PG8_SA(0, 1), cA + hstepA, voffA);
        if (wr == 1) PG8_BAR;
        PG8_WAIT_V(2); PG8_BAR;
        PG8_STAGE(PG8_SB(1, 0), cB + kstep, voffB); PG8_STAGE(PG8_SA(1, 0), cA + kstep, voffA); PG8_STAGE(PG8_SB(1, 1), cB + hstepB + kstep, voffB);
        PG8_WAIT_V(6); PG8_BAR;
    } else {
        PG8_STAGE(PG8_SB(0, 0), cB, voffB); PG8_STAGE(PG8_SA(0, 0), cA, voffA); PG8_STAGE(PG8_SB(0, 1), cB + hstepB, voffB); PG8_STAGE(PG8_SA(0, 1), cA + hstepA, voffA);
        if (wr == 1) PG8_BAR;
        PG8_WAIT_V(4); PG8_BAR;
        PG8_STAGE(PG8_SB(1, 0), cB + kstep, voffB); PG8_STAGE(PG8_SA(1, 0), cA + kstep, voffA); PG8_STAGE(PG8_SB(1, 1), cB + hstepB + kstep, voffB);
        PG8_WAIT_V(6); PG8_BAR;
    }
    for (;;) {
        const bool has_next = S.next(ui + 1, nxt);
        const char* nA = has_next ? (const char*)g.A + (size_t)nxt.pm * tstepA : cA; const char* nB = has_next ? (const char*)g.Bt + (size_t)nxt.pn * tstepB : cB;
        for (int t = 0; t < nt; t += 2) {
            const bool last = (t == nt - 2);
            const char* a1 = cA + (size_t)(t + 1) * kstep;
            const char* a2 = last ? nA : cA + (size_t)(t + 2) * kstep; const char* b2 = last ? nB : cB + (size_t)(t + 2) * kstep;
            const char* a3 = a2 + kstep; const char* b3 = b2 + kstep;
            if constexpr (SP2) {
            PG8_LDB(B0, 0, 0); PG8_LDB(B1, 0, 1); PG8_SCHED; PG8_LDA(At, 0, 0); PG8_STAGE(PG8_SA(1, 1), a1 + hstepA, voffA);
            PG8_WAIT_V(8); PG8_WAIT_L(0); PG8_BAR; PG8_MMA(0, 0, At, B0); PG8_MMA(0, 1, At, B1); PG8_BAR; PG8_SCHED;
            PG8_LDA(At, 0, 1); PG8_STAGE(PG8_SB(0, 0), b2, voffB); PG8_STAGE(PG8_SB(0, 1), b2 + hstepB, voffB); PG8_STAGE(PG8_SA(0, 0), a2, voffA);
            PG8_WAIT_V(8); PG8_WAIT_L(0); PG8_BAR; PG8_MMA(1, 0, At, B0); PG8_MMA(1, 1, At, B1); PG8_BAR; PG8_SCHED;
            PG8_LDB(B0, 1, 0); PG8_LDB(B1, 1, 1); PG8_SCHED; PG8_LDA(At, 1, 0); PG8_STAGE(PG8_SA(0, 1), a2 + hstepA, voffA);
            PG8_WAIT_V(8); PG8_WAIT_L(0); PG8_BAR; PG8_MMA(0, 0, At, B0); PG8_MMA(0, 1, At, B1); PG8_BAR; PG8_SCHED;
            PG8_LDA(At, 1, 1); PG8_STAGE(PG8_SB(1, 0), b3, voffB); PG8_STAGE(PG8_SB(1, 1), b3 + hstepB, voffB); PG8_STAGE(PG8_SA(1, 0), a3, voffA);
            PG8_WAIT_V(8); PG8_WAIT_L(0); PG8_BAR; PG8_MMA(1, 0, At, B0); PG8_MMA(1, 1, At, B1); PG8_BAR; PG8_SCHED;
            } else {
            PG8_LDB(B0, 0, 0); PG8_SCHED; PG8_LDA(At, 0, 0); PG8_STAGE(PG8_SA(1, 1), a1 + hstepA, voffA);
            PG8_WAIT_L(8); PG8_BAR; PG8_WAIT_L(0); PG8_MMA(0, 0, At, B0); PG8_BAR; PG8_SCHED;
            PG8_LDB(B1, 0, 1); PG8_STAGE(PG8_SB(0, 0), b2, voffB);
            PG8_BAR; PG8_WAIT_L(0); PG8_MMA(0, 1, At, B1); PG8_BAR;
            PG8_LDA(At, 0, 1); PG8_STAGE(PG8_SA(0, 0), a2, voffA);
            PG8_BAR; PG8_WAIT_L(0); PG8_MMA(1, 0, At, B0); PG8_BAR; PG8_SCHED;
            PG8_STAGE(PG8_SB(0, 1), b2 + hstepB, voffB);
            PG8_WAIT_V(6); PG8_BAR; PG8_MMA(1, 1, At, B1); PG8_BAR;
            PG8_LDB(B0, 1, 0); PG8_SCHED; PG8_LDA(At, 1, 0); PG8_STAGE(PG8_SA(0, 1), a2 + hstepA, voffA);
            PG8_WAIT_L(8); PG8_BAR; PG8_WAIT_L(0); PG8_MMA(0, 0, At, B0); PG8_BAR; PG8_SCHED;
            PG8_LDB(B1, 1, 1); PG8_STAGE(PG8_SB(1, 0), b3, voffB);
            PG8_BAR; PG8_WAIT_L(0); PG8_MMA(0, 1, At, B1); PG8_BAR;
            PG8_LDA(At, 1, 1); PG8_STAGE(PG8_SA(1, 0), a3, voffA);
            PG8_BAR; PG8_WAIT_L(0); PG8_MMA(1, 0, At, B0); PG8_BAR; PG8_SCHED;
            PG8_STAGE(PG8_SB(1, 1), b3 + hstepB, voffB);
            PG8_WAIT_V(6); PG8_BAR; PG8_MMA(1, 1, At, B1); PG8_BAR;
            }
        }
        if constexpr (ALIGN_EPI) { if (wr == 0) PG8_BAR; }
        E(acc, cur, wr, wc, fr, fq);
        if (!has_next) break;
#pragma unroll
        for (int a = 0; a < 2; ++a)
#pragma unroll
            for (int b = 0; b < 2; ++b)
#pragma unroll
                for (int m = 0; m < 4; ++m)
#pragma unroll
                    for (int n = 0; n < 2; ++n) acc[a][b][m][n] = (f32x4){0.f, 0.f, 0.f, 0.f};
        cur = nxt; cA = nA; cB = nB; ++ui;
        if constexpr (ALIGN_EPI) { if (wr == 1) PG8_BAR; }
    }
    PG8_WAIT_V(0);
    if constexpr (!ALIGN_EPI) { if (wr == 0) PG8_BAR; }
    PG8_BAR;
#undef PG8_SA
#undef PG8_SB
#undef PG8_STAGE
#undef PG8_LDA
#undef PG8_LDB
#undef PG8_MMA
#undef PG8_WAIT_V
#undef PG8_WAIT_L
#undef PG8_BAR
#undef PG8_SCHED
}
#endif
}
#ifdef CPU_EMU
#define GEMM_LDS(F) ((F).lds)
#else
#define GEMM_LDS(F) ((PG8_LAS unsigned char*)(F).lds)
#endif
#ifndef PG8_SP2
#define PG8_SP2 true
#endif
#ifndef PG8_ALIGN
#define PG8_ALIGN true
#endif

typedef const f32x4 (&AccRef)[2][2][4][2];
struct Lane4 { int wr, wc, fr, fq; };
__device__ __forceinline__ Lane4 epi_lane(int wr, int wc) {
    int t = hw_lane();
#ifndef CPU_EMU
    asm volatile("" : "+v"(t));
#endif
    Lane4 L; L.wr = wr; L.wc = wc; L.fr = t & 15; L.fq = (t >> 4) & 3; return L;
}
struct EpiF32 {
    static constexpr bool PERM = false;
    float* O; int ldc;
    __device__ __forceinline__ void operator()(AccRef acc, const pg8::Unit& u, int wr_, int wc_, int, int) const {
        const Lane4 L = epi_lane(wr_, wc_); const int wr = L.wr, wc = L.wc, fr = L.fr, fq = L.fq;
        const int col0 = u.pn * 256 + wc * 32 + 4 * fq;
#pragma unroll
        for (int ai = 0; ai < 2; ++ai)
#pragma unroll
            for (int m = 0; m < 4; ++m) { float* rowp = O + (size_t)(u.pm * 256 + ai * 128 + wr * 64 + m * 16 + fr) * ldc + col0;
#pragma unroll
                for (int bj = 0; bj < 2; ++bj)
#pragma unroll
                    for (int n = 0; n < 2; ++n) *(f32x4*)(rowp + bj * 128 + n * 16) = acc[ai][bj][m][n]; }
    }
};
struct EpiGlu {
    static constexpr bool PERM = true;
    bf16_t* O;
    __device__ __forceinline__ void operator()(AccRef acc, const pg8::Unit& u, int wr_, int wc_, int, int) const {
        const Lane4 L = epi_lane(wr_, wc_); const int wr = L.wr, wc = L.wc, fr = L.fr, fq = L.fq;
        const int col0 = u.pn * 128 + wc * 32 + 8 * fq;
#pragma unroll
        for (int ai = 0; ai < 2; ++ai)
#pragma unroll
            for (int m = 0; m < 4; ++m) { bf16_t* rowp = O + (size_t)(u.pm * 256 + ai * 128 + wr * 64 + m * 16 + fr) * DM + col0; float o[8];
#pragma unroll
                for (int n = 0; n < 2; ++n) { const f32x4 v = acc[ai][0][m][n], g = acc[ai][1][m][n];
#pragma unroll
                    for (int e = 0; e < 4; ++e) o[4 * n + e] = v[e] * sigmoidf_(g[e]); }
                u32x4 w; w.x = pk2(o[0], o[1]); w.y = pk2(o[2], o[3]); w.z = pk2(o[4], o[5]); w.w = pk2(o[6], o[7]); *(u32x4*)rowp = w; }
    }
};
__device__ __forceinline__ u32x4 pack8(const f32x4 a, const f32x4 b, float s) {
    u32x4 w; w.x = pk2(a[0] * s, a[1] * s); w.y = pk2(a[2] * s, a[3] * s); w.z = pk2(b[0] * s, b[1] * s); w.w = pk2(b[2] * s, b[3] * s); return w;
}
struct EpiB16 {
    static constexpr bool PERM = true;
    bf16_t* O; int ldc;
    __device__ __forceinline__ void operator()(AccRef acc, const pg8::Unit& u, int wr_, int wc_, int, int) const {
        const Lane4 L = epi_lane(wr_, wc_); const int wr = L.wr, wc = L.wc, fr = L.fr, fq = L.fq;
        const int col0 = u.pn * 256 + wc * 32 + 8 * fq;
#pragma unroll
        for (int ai = 0; ai < 2; ++ai)
#pragma unroll
            for (int m = 0; m < 4; ++m) { bf16_t* rowp = O + (size_t)(u.pm * 256 + ai * 128 + wr * 64 + m * 16 + fr) * ldc + col0;
#pragma unroll
                for (int bj = 0; bj < 2; ++bj) *(u32x4*)(rowp + bj * 128) = pack8(acc[ai][bj][m][0], acc[ai][bj][m][1], 1.f); }
    }
};
typedef _Float16 f16x2_hw __attribute__((ext_vector_type(2)));
#ifdef CPU_EMU
__device__ __forceinline__ unsigned pkh2(float lo, float hi) { const f16x2_hw v = {(_Float16)lo, (_Float16)hi}; unsigned r; memcpy(&r, &v, 4); return r; }
__device__ __forceinline__ float hlo(unsigned w) { f16x2_hw v; memcpy(&v, &w, 4); return (float)v[0]; }
__device__ __forceinline__ float hhi(unsigned w) { f16x2_hw v; memcpy(&v, &w, 4); return (float)v[1]; }
#else
__device__ __forceinline__ unsigned pkh2(float lo, float hi) { const f32x2 v = {lo, hi}; const f16x2_hw b = __builtin_convertvector(v, f16x2_hw); return __builtin_bit_cast(unsigned, b); }
__device__ __forceinline__ float hlo(unsigned w) { return (float)__builtin_bit_cast(f16x2_hw, w)[0]; }
__device__ __forceinline__ float hhi(unsigned w) { return (float)__builtin_bit_cast(f16x2_hw, w)[1]; }
#endif
struct EpiH16 {
    static constexpr bool PERM = true;
    unsigned short* O; int ldc;
    __device__ __forceinline__ void operator()(AccRef acc, const pg8::Unit& u, int wr_, int wc_, int, int) const {
        const Lane4 L = epi_lane(wr_, wc_); const int wr = L.wr, wc = L.wc, fr = L.fr, fq = L.fq;
        const int col0 = u.pn * 256 + wc * 32 + 8 * fq;
#pragma unroll
        for (int ai = 0; ai < 2; ++ai)
#pragma unroll
            for (int m = 0; m < 4; ++m) { unsigned short* rowp = O + (size_t)(u.pm * 256 + ai * 128 + wr * 64 + m * 16 + fr) * ldc + col0;
#pragma unroll
                for (int bj = 0; bj < 2; ++bj) { const f32x4 a = acc[ai][bj][m][0], b = acc[ai][bj][m][1]; u32x4 w; w.x = pkh2(a[0], a[1]); w.y = pkh2(a[2], a[3]); w.z = pkh2(b[0], b[1]); w.w = pkh2(b[2], b[3]);
                    *(u32x4*)(rowp + bj * 128) = w; } }
    }
};
struct EpiSsdIn {
    static constexpr bool PERM = true;
    bf16_t* Z; bf16_t* XBC; float* DT;
    __device__ __forceinline__ void operator()(AccRef acc, const pg8::Unit& u, int wr_, int wc_, int, int) const {
        const Lane4 L = epi_lane(wr_, wc_); const int wr = L.wr, wc = L.wc, fr = L.fr, fq = L.fq;
        const int cw = wc * 32 + 8 * fq;
#pragma unroll
        for (int ai = 0; ai < 2; ++ai)
#pragma unroll
            for (int m = 0; m < 4; ++m) { const size_t row = (size_t)(u.pm * 256 + ai * 128 + wr * 64 + m * 16 + fr);
#pragma unroll
                for (int bj = 0; bj < 2; ++bj) { const int col = u.pn * 256 + bj * 128 + cw;
                    if (u.pn < 8) *(u32x4*)(Z + row * 2048 + col) = pack8(acc[ai][bj][m][0], acc[ai][bj][m][1], 1.f);
                    else if (u.pn < 20) *(u32x4*)(XBC + row * 3072 + (col - 2048)) = pack8(acc[ai][bj][m][0], acc[ai][bj][m][1], 1.f);
                    else if (col - 5120 < 64) { float* p = DT + row * 64 + (col - 5120); *(f32x4*)p = acc[ai][bj][m][0]; *(f32x4*)(p + 4) = acc[ai][bj][m][1]; } } }
    }
};
struct EpiMlaDown {
    static constexpr bool PERM = true;
    bf16_t* C; float* RS;
    __device__ __forceinline__ void operator()(AccRef acc, const pg8::Unit& u, int wr_, int wc_, int, int) const {
        const Lane4 L = epi_lane(wr_, wc_); const int wr = L.wr, wc = L.wc, fr = L.fr, fq = L.fq;
        const int cw = wc * 32 + 8 * fq;
#pragma unroll
        for (int ai = 0; ai < 2; ++ai)
#pragma unroll
            for (int m = 0; m < 4; ++m) { const size_t row = (size_t)(u.pm * 256 + ai * 128 + wr * 64 + m * 16 + fr); float ss = 0.f;
#pragma unroll
                for (int bj = 0; bj < 2; ++bj) { const int col = u.pn * 256 + bj * 128 + cw; const f32x4 a = acc[ai][bj][m][0], b = acc[ai][bj][m][1];
                    *(u32x4*)(C + row * 512 + col) = pack8(a, b, 1.f);
                    if (u.pn == 0 || bj == 0) ss += (a[0] * a[0] + a[1] * a[1]) + (a[2] * a[2] + a[3] * a[3]) + (b[0] * b[0] + b[1] * b[1]) + (b[2] * b[2] + b[3] * b[3]); }
                ss += __shfl_xor(ss, 16); ss += __shfl_xor(ss, 32);
                if (fq == 0) RS[row * 8 + u.pn * 4 + wc] = ss; }
    }
};
struct EpiMlaUp {
    static constexpr bool PERM = true;
    bf16_t* Q; bf16_t* Kb; bf16_t* Vb; const float* RS;
    __device__ __forceinline__ void operator()(AccRef acc, const pg8::Unit& u, int wr_, int wc_, int, int) const {
        const Lane4 L = epi_lane(wr_, wc_); const int wr = L.wr, wc = L.wc, fr = L.fr, fq = L.fq;
        const bool isq = u.pn < 8;
        if (isq && wc == 3) return;
#pragma unroll
        for (int ai = 0; ai < 2; ++ai)
#pragma unroll
            for (int m = 0; m < 4; ++m) { const int tok = u.pm * 256 + ai * 128 + wr * 64 + m * 16 + fr; const int b = tok / LTOK, p = tok - b * LTOK;
                const f32x4 rs = *(const f32x4*)(RS + ((unsigned)tok * 8u + (isq ? 0u : 4u)));
                const float rn = 1.0f / sqrtf(((rs[0] + rs[1]) + (rs[2] + rs[3])) * (isq ? (1.f / 256.f) : (1.f / 128.f)) + 1e-6f);
#pragma unroll
                for (int bj = 0; bj < 2; ++bj) { bf16_t* dst;
                    if (isq) dst = Q + ((unsigned)((b * 16 + u.pn * 2 + bj) * LTOK + p) * 128u + (unsigned)(wc * 32 + 8 * fq));
                    else { const int col = (u.pn & 3) * 256 + bj * 128 + wc * 32 + 8 * fq; const int head = col >> 6, d = col & 63; const unsigned rowi = (unsigned)((b * 16 + head) * LTOK + p);
                        dst = u.pn < 12 ? Kb + (rowi * 128u + (unsigned)d) : Vb + (rowi * 64u + (unsigned)d); }
                    *(u32x4*)dst = pack8(acc[ai][bj][m][0], acc[ai][bj][m][1], rn); }
                asm volatile("" ::: "memory"); }
    }
};

namespace att {
constexpr int NW = 8, QBLK = 32, KVBLK = 64, LDQ = 128, LDK = 128, LDV = 64, LDO = 1024;
constexpr float SCALE = 0.10206207261596575f;
constexpr float THR = 8.f;
constexpr size_t SHM_V = KVBLK * 128 * 2, SHM_K = KVBLK * 128 * 2, SHM_ATTN = 2 * SHM_V + 2 * SHM_K + NW * 64 * 4;
#ifdef CPU_EMU
__device__ __forceinline__ void attn_body(const bf16_t* Qb, const bf16_t* Kh, const bf16_t* Vh, bf16_t* Ob, int seq, unsigned char* lds, int tq0, const float* ROPE, int wave_s) {
    const int tid = threadIdx.x, wid = tid >> 6, lane = tid & 63, r32 = lane & 31, hi = lane >> 5;
    if (hi == 0) {
        const bf16_t* qg = Qb + (size_t)(wid * 32 + r32) * LDQ; float m = -1e30f; float q[96];
        for (int d = 0; d < 96; ++d) q[d] = bf2f(qg[d]);
        if (tq0 >= 0) { const int t = tq0 + wid * 32 + r32;
            for (int i = 0; i < 16; ++i) { const int pos = i < 8 ? (t >> 6) : (t & 63); const float c = ROPE[(pos * 8 + (i & 7)) * 2], sn = ROPE[(pos * 8 + (i & 7)) * 2 + 1];
                const float x1 = q[64 + 2 * i], x2 = q[64 + 2 * i + 1]; q[64 + 2 * i] = x1 * c - x2 * sn; q[64 + 2 * i + 1] = x2 * c + x1 * sn; }
            for (int d = 64; d < 96; ++d) q[d] = bf2f((bf16_t)f2bf(q[d])); }
        std::vector<float> sc(seq);
        for (int k = 0; k < seq; ++k) { float s = 0.f; for (int d = 0; d < 96; ++d) s += q[d] * bf2f(Kh[(size_t)k * LDK + d]); sc[k] = s * SCALE; m = fmaxf(m, sc[k]); }
        float l = 0.f; float o[64]; for (int d = 0; d < 64; ++d) o[d] = 0.f;
        for (int k = 0; k < seq; ++k) { const float pr = expf(sc[k] - m); l += pr; const float prb = bf2f((bf16_t)f2bf(pr)); for (int d = 0; d < 64; ++d) o[d] += prb * bf2f(Vh[(size_t)k * LDV + d]); }
        for (int d = 0; d < 64; ++d) Ob[(size_t)(wid * 32 + r32) * LDO + d] = (bf16_t)f2bf(o[d] / l);
    }
    __syncthreads();
}
#else
using s16x4 = __attribute__((ext_vector_type(4))) short;
#define KSWZ(row, colB) ((row) * 256 + ((colB) ^ (((row) & 7) << 4)))
#define SBAR() __builtin_amdgcn_sched_barrier(0)
__device__ __forceinline__ unsigned cvtpk(float lo, float hi) { unsigned r; asm volatile("v_cvt_pk_bf16_f32 %0, %1, %2" : "=v"(r) : "v"(lo), "v"(hi)); return r; }
__device__ __forceinline__ void partialSM(f32x16& p0, f32x16& p1, float& m_reg, float& mn, float& alpha) {
  constexpr float C = SCALE * 1.4426950408889634f;
  float pmax = p0[0]; for (int r = 1; r < 16; ++r) pmax = fmaxf(pmax, p0[r]); for (int r = 0; r < 16; ++r) pmax = fmaxf(pmax, p1[r]);
  { auto rr = __builtin_amdgcn_permlane32_swap(__float_as_uint(pmax), __float_as_uint(pmax), false, false);
    pmax = fmaxf(__uint_as_float(rr[0]), __uint_as_float(rr[1])); }
  if (__builtin_expect(__all(pmax - m_reg <= THR / SCALE), 1)) { mn = m_reg; alpha = 1.f; }
  else { mn = fmaxf(m_reg, pmax); alpha = __builtin_amdgcn_exp2f((m_reg - mn) * C); m_reg = mn; }
  float mnC = -mn * C;
  for (int r = 0; r < 16; ++r) p0[r] = fmaf(p0[r], C, mnC); for (int r = 0; r < 16; ++r) p1[r] = fmaf(p1[r], C, mnC);
  for (int r = 0; r < 16; ++r) p0[r] = __builtin_amdgcn_exp2f(p0[r]);
}
__device__ __forceinline__ void finishSM(f32x16& p0, f32x16& p1, float alpha, float& l_reg, bf16x8& pa0, bf16x8& pa1, bf16x8& pa2, bf16x8& pa3) {
  for (int r = 0; r < 16; ++r) p1[r] = __builtin_amdgcn_exp2f(p1[r]);
  float ps = 0; for (int r = 0; r < 16; ++r) ps += p0[r]; for (int r = 0; r < 16; ++r) ps += p1[r];
  { auto rr = __builtin_amdgcn_permlane32_swap(__float_as_uint(ps), __float_as_uint(ps), false, false);
    ps = __uint_as_float(rr[0]) + __uint_as_float(rr[1]); }
  l_reg = l_reg * alpha + ps;
#define PK4(P, BASE, OUT) do { unsigned a0 = cvtpk(P[BASE + 0], P[BASE + 1]), a1 = cvtpk(P[BASE + 2], P[BASE + 3]);   \
    unsigned b0 = cvtpk(P[BASE + 4], P[BASE + 5]), b1 = cvtpk(P[BASE + 6], P[BASE + 7]);                              \
    auto r0 = __builtin_amdgcn_permlane32_swap(a0, b0, false, false); auto r1 = __builtin_amdgcn_permlane32_swap(a1, b1, false, false); \
    u32x4 w = {r0[0], r1[0], r0[1], r1[1]}; OUT = *reinterpret_cast<bf16x8*>(&w); } while (0)
  PK4(p0, 0, pa0); PK4(p0, 8, pa1); PK4(p1, 0, pa2); PK4(p1, 8, pa3);
#undef PK4
}
__device__ __forceinline__ void qkt(f32x16& p0, f32x16& p1, const bf16_t* Ks, const bf16x8* qr, int r32, int hi) {
  p0 = f32x16{}; p1 = f32x16{};
#pragma unroll
  for (int d0 = 0; d0 < 6; ++d0) { int cb = (d0 * 16 + hi * 8) * 2;
    bf16x8 b0 = *reinterpret_cast<const bf16x8*>((const char*)Ks + KSWZ(r32, cb));
    bf16x8 b1 = *reinterpret_cast<const bf16x8*>((const char*)Ks + KSWZ(32 + r32, cb));
    p0 = __builtin_amdgcn_mfma_f32_32x32x16_bf16(b0, qr[d0], p0, 0, 0, 0);
    p1 = __builtin_amdgcn_mfma_f32_32x32x16_bf16(b1, qr[d0], p1, 0, 0, 0); }
}
__device__ __forceinline__ int v_st(int k, int c) { const int kk = (k & ~0xC) | ((k & 4) << 1) | ((k & 8) >> 1); return ((kk >> 3) * 4 + (c >> 5)) * 512 + ((kk & 7) * 32 + (c & 31)) * 2; }
__device__ __forceinline__ int v_rd_base(int lane) { return ((lane & 3) << 3) | (((lane >> 2) & 3) << 6) | (((lane >> 4) & 1) << 5) | (((lane >> 5) & 1) << 8); }
constexpr int v_rd_off(int d0, int ks, int half) { return d0 * 512 + ks * 4096 + half * 2048; }
template <int OFF> __device__ __forceinline__ s16x4 tr_read(int vb) {
  s16x4 r; asm volatile("ds_read_b64_tr_b16 %0, %1 offset:%2" : "=&v"(r) : "v"(vb), "i"(OFF) : "memory"); return r;
}
template <int D0> __device__ __forceinline__ void pv_one(f32x16& od, int vb, bf16x8 pa0, bf16x8 pa1, bf16x8 pa2, bf16x8 pa3) {
  const s16x4 l0 = tr_read<v_rd_off(D0, 0, 0)>(vb), h0 = tr_read<v_rd_off(D0, 0, 1)>(vb), l1 = tr_read<v_rd_off(D0, 1, 0)>(vb), h1 = tr_read<v_rd_off(D0, 1, 1)>(vb);
  const s16x4 l2 = tr_read<v_rd_off(D0, 2, 0)>(vb), h2 = tr_read<v_rd_off(D0, 2, 1)>(vb), l3 = tr_read<v_rd_off(D0, 3, 0)>(vb), h3 = tr_read<v_rd_off(D0, 3, 1)>(vb);
  asm volatile("s_waitcnt lgkmcnt(0)" ::: "memory"); SBAR();
#define PK(L, H) (bf16x8){L[0], L[1], L[2], L[3], H[0], H[1], H[2], H[3]}
  od = __builtin_amdgcn_mfma_f32_32x32x16_bf16(pa0, PK(l0, h0), od, 0, 0, 0);
  od = __builtin_amdgcn_mfma_f32_32x32x16_bf16(pa1, PK(l1, h1), od, 0, 0, 0);
  od = __builtin_amdgcn_mfma_f32_32x32x16_bf16(pa2, PK(l2, h2), od, 0, 0, 0);
  od = __builtin_amdgcn_mfma_f32_32x32x16_bf16(pa3, PK(l3, h3), od, 0, 0, 0);
#undef PK
}
__device__ __forceinline__ void pv_d0(f32x16* o, int vb, bf16x8 pa0, bf16x8 pa1, bf16x8 pa2, bf16x8 pa3) {
  pv_one<0>(o[0], vb, pa0, pa1, pa2, pa3); pv_one<1>(o[1], vb, pa0, pa1, pa2, pa3);
}
__device__ __forceinline__ void attn_body(const bf16_t* __restrict__ Qb, const bf16_t* __restrict__ Kh, const bf16_t* __restrict__ Vh, bf16_t* __restrict__ Ob, int seq, char* lds, int tq0, const float* __restrict__ ROPE, int wave_s) {
  const int wid = wave_s, lane = hw_lane(), tid = wid * 64 + lane, r32 = lane & 31, hi = lane >> 5;
  bf16_t* V_lds = (bf16_t*)lds; bf16_t* K_lds = (bf16_t*)(lds + 2 * SHM_V);
  float* ws = (float*)(lds + 2 * SHM_V + 2 * SHM_K) + wid * 64; float* li_l = ws; float* al_l = ws + 32;
  float m_reg = -1e30f, l_reg = 0; f32x16 o[2] = {}; bf16x8 qr[6];
  const bf16_t* Qw = Qb + (long)(wid * QBLK + r32) * LDQ + hi * 8;
#pragma unroll
  for (int d0 = 0; d0 < 6; ++d0) qr[d0] = *reinterpret_cast<const bf16x8*>(Qw + d0 * 16);
  if (tq0 >= 0) {
    const int t = tq0 + wid * QBLK + r32;
#pragma unroll
    for (int dd = 0; dd < 2; ++dd) { const int pos = dd == 0 ? (t >> 6) : (t & 63);
      const f32x4 r0 = *(const f32x4*)(ROPE + pos * 16 + 8 * hi), r1 = *(const f32x4*)(ROPE + pos * 16 + 8 * hi + 4);
      const u32x4 w = *reinterpret_cast<const u32x4*>(&qr[4 + dd]); u32x4 o;
      { const float x1 = bflo(w.x), x2 = bfhi(w.x); o.x = pk2(x1 * r0[0] - x2 * r0[1], x2 * r0[0] + x1 * r0[1]); }
      { const float x1 = bflo(w.y), x2 = bfhi(w.y); o.y = pk2(x1 * r0[2] - x2 * r0[3], x2 * r0[2] + x1 * r0[3]); }
      { const float x1 = bflo(w.z), x2 = bfhi(w.z); o.z = pk2(x1 * r1[0] - x2 * r1[1], x2 * r1[0] + x1 * r1[1]); }
      { const float x1 = bflo(w.w), x2 = bfhi(w.w); o.w = pk2(x1 * r1[2] - x2 * r1[3], x2 * r1[2] + x1 * r1[3]); }
      qr[4 + dd] = *reinterpret_cast<const bf16x8*>(&o); }
  }
  const int sr = tid >> 4, sc = (tid & 15) * 8;
  const int vk = tid >> 3, vc = (tid & 7) * 8, vst0 = v_st(vk, vc);
  const int vb0 = (int)(uintptr_t)V_lds + v_rd_base(lane);
  struct { bf16x8 vs0, ks0, ks1; } sr_[2];
#define SLOAD(i, k0) do { sr_[i].vs0 = *reinterpret_cast<const bf16x8*>(&Vh[(long)((k0) + vk) * LDV + vc]); \
    sr_[i].ks0 = *reinterpret_cast<const bf16x8*>(&Kh[(long)((k0) + sr) * LDK + sc]); sr_[i].ks1 = *reinterpret_cast<const bf16x8*>(&Kh[(long)((k0) + 32 + sr) * LDK + sc]); } while (0)
#define SWRITE(b, i) do { *(bf16x8*)((char*)V_lds + (b) * SHM_V + vst0) = sr_[i].vs0; int kc = sc * 2;               \
    *(bf16x8*)((char*)K_lds + (b) * SHM_K + KSWZ(sr, kc)) = sr_[i].ks0;                       \
    *(bf16x8*)((char*)K_lds + (b) * SHM_K + KSWZ(32 + sr, kc)) = sr_[i].ks1; } while (0)
#define SWAIT() asm volatile("s_waitcnt vmcnt(3)" ::: "memory")
#define RESC(a) do { if (__any((a) < 1.f)) { if (hi == 0) al_l[r32] = (a); asm volatile("s_waitcnt lgkmcnt(0)" ::: "memory"); \
    for (int d = 0; d < 2; ++d) for (int r = 0; r < 16; ++r) o[d][r] *= al_l[crow(r, hi)]; } } while (0)
  f32x16 pA0, pA1, pB0, pB1; float mnA, mnB, alA, alB; bf16x8 pa0, pa1, pa2, pa3; const int NT = seq / KVBLK;
  constexpr int SE = 0, SO = 1;
  SLOAD(SE, 0); asm volatile("s_waitcnt vmcnt(0)" ::: "memory"); SWRITE(0, SE); __syncthreads();
  qkt(pA0, pA1, K_lds, qr, r32, hi); partialSM(pA0, pA1, m_reg, mnA, alA);
  SLOAD(SO, KVBLK); if (2 < NT) SLOAD(SE, 2 * KVBLK);
  SWAIT(); SWRITE(1, SO); __syncthreads();
  for (int j = 1; j + 1 < NT; j += 2) {
    SBAR(); qkt(pB0, pB1, (bf16_t*)((char*)K_lds + SHM_K), qr, r32, hi);
    finishSM(pA0, pA1, alA, l_reg, pa0, pa1, pa2, pa3); SBAR();
    SLOAD(SO, (j + 2) * KVBLK); SBAR();
    pv_d0(o, vb0, pa0, pa1, pa2, pa3); partialSM(pB0, pB1, m_reg, mnB, alB);
    __syncthreads(); SWAIT(); SWRITE(0, SE);
    RESC(alB); __syncthreads();
    SBAR(); qkt(pA0, pA1, K_lds, qr, r32, hi);
    finishSM(pB0, pB1, alB, l_reg, pa0, pa1, pa2, pa3); SBAR();
    if (j + 3 < NT) SLOAD(SE, (j + 3) * KVBLK); SBAR();
    pv_d0(o, vb0 + (int)SHM_V, pa0, pa1, pa2, pa3); partialSM(pA0, pA1, m_reg, mnA, alA);
    __syncthreads(); SWAIT(); SWRITE(1, SO);
    RESC(alA); __syncthreads();
  }
  SBAR(); qkt(pB0, pB1, (bf16_t*)((char*)K_lds + SHM_K), qr, r32, hi);
  finishSM(pA0, pA1, alA, l_reg, pa0, pa1, pa2, pa3); SBAR();
  pv_d0(o, vb0, pa0, pa1, pa2, pa3); partialSM(pB0, pB1, m_reg, mnB, alB);
  __syncthreads(); RESC(alB);
  finishSM(pB0, pB1, alB, l_reg, pa0, pa1, pa2, pa3); SBAR();
  pv_d0(o, vb0 + (int)SHM_V, pa0, pa1, pa2, pa3);
  if (hi == 0) li_l[r32] = l_reg; asm volatile("s_waitcnt lgkmcnt(0)" ::: "memory");
  float rli[16];
#pragma unroll
  for (int r = 0; r < 16; ++r) rli[r] = __builtin_amdgcn_rcpf(li_l[crow(r, hi)]);
  bf16_t* Ow = Ob + (long)(wid * QBLK) * LDO;
#pragma unroll
  for (int r = 0; r < 16; ++r) { int orow = crow(r, hi);
    for (int d0 = 0; d0 < 2; ++d0) Ow[(long)orow * LDO + d0 * 32 + r32] = (bf16_t)f2bf(o[d0][r] * rli[r]); }
  __syncthreads();
#undef SLOAD
#undef SWRITE
#undef SWAIT
#undef RESC
}
#undef KSWZ
#undef SBAR
#endif
}

template <class RowMap>
__device__ __forceinline__ void tr_item(const float* W, int ldw, int k0, int n0, bf16_t* WT, int ldt, int koff, const float* kscale, RowMap rm, float* scr, int lane) {
#pragma unroll 8
    for (int i = 0; i < 32; ++i) { const int kk = 2 * i + (lane >> 5); scr[kk * 33 + (lane & 31)] = W[(size_t)(k0 + kk) * ldw + n0 + (lane & 31)]; }
    wave_sync();
    const int c = lane & 7;
    float ks[8];
#pragma unroll
    for (int e = 0; e < 8; ++e) ks[e] = kscale ? kscale[k0 + 8 * c + e] : 1.f;
#pragma unroll
    for (int j = 0; j < 4; ++j) { const int n = (lane >> 3) + 8 * j; const float* s = scr + (8 * c) * 33 + n;
        u32x4 o; o.x = pk2(s[0 * 33] * ks[0], s[1 * 33] * ks[1]); o.y = pk2(s[2 * 33] * ks[2], s[3 * 33] * ks[3]); o.z = pk2(s[4 * 33] * ks[4], s[5 * 33] * ks[5]); o.w = pk2(s[6 * 33] * ks[6], s[7 * 33] * ks[7]);
        const int row = rm(n0 + n);
        if (row >= 0) *(u32x4*)(WT + (size_t)row * ldt + koff + k0 + 8 * c) = o; }
    wave_sync();
}
struct RmId { int off; __device__ __forceinline__ int operator()(int n) const { return off + n; } };
struct RmGlu { int off; __device__ __forceinline__ int operator()(int n) const { return ((n >> 7) << 8) + off + (n & 127); } };
struct RmUq { __device__ __forceinline__ int operator()(int n) const { const int h = n / 96, d = n - h * 96; int sd = d;
        if (d >= 64) { const int rho = d - 64; const int half = rho >> 4, w = rho & 15; const int i = half * 8 + (w & 7); sd = 64 + 2 * i + (w >> 3); }
        return h * 128 + sd; } };
__device__ __forceinline__ void s5_disc(const Args& A, int it, int p, float& are_bar, float& aim_bar, float& cre, float& cim) {
    const float are = A.in[8][(size_t)it * 64 + p], aim = A.in[9][(size_t)it * 64 + p]; const float dt = expf(A.in[10][it]);
    const float zr = are * dt, zi = aim * dt; const float ez = expf(zr), cs = cosf(zi), sn = sinf(zi), sh = sinf(0.5f * zi);
    are_bar = ez * cs; aim_bar = ez * sn;
    const float nr = expm1f(zr) * cs - 2.f * sh * sh, ni = ez * sn;
    const float den = are * are + aim * aim;
    cre = (nr * are + ni * aim) / den; cim = (ni * are - nr * aim) / den;
}
__device__ __forceinline__ void ph_prep(const Args& A, Frame& F) {
    const int tid = F.tid, lane = F.lane, wave = F.wave, G = F.G, bid = F.bid;
    unsigned char* ws = A.ws;
    { float* ca = (float*)F.lds; float* red = ca + NR * 1024; float* MOD = (float*)(ws + WS_MOD);
      for (int i = tid; i < NR * 1024; i += NTHR) { const int r = i >> 10, k = i & 1023; const float c = r < BATCH ? A.in[1][r * 1024 + k] : A.in[3][k]; ca[i] = siluf_(c); }
      __syncthreads();
      for (int it = bid; it < 4 * 96; it += G) { const int l = it / 96, cb = (it % 96) * 64; float acc[NR];
#pragma unroll
          for (int r = 0; r < NR; ++r) acc[r] = 0.f;
          const float* wp = A.in[4] + ((size_t)l * 1024 + wave * 128) * 6144 + cb + lane;
#pragma unroll 8
          for (int k = 0; k < 128; ++k) { const float w = wp[(size_t)k * 6144];
#pragma unroll
              for (int r = 0; r < NR; ++r) acc[r] += ca[r * 1024 + wave * 128 + k] * w; }
#pragma unroll
          for (int r = 0; r < NR; ++r) red[(wave * NR + r) * 64 + lane] = acc[r];
          __syncthreads();
          if (tid < NR * 64) { const int r = tid >> 6, c = tid & 63; float s = A.in[5][l * 6144 + cb + c];
              for (int w = 0; w < 8; ++w) s += red[(w * NR + r) * 64 + c];
              MOD[((size_t)l * NR + r) * 6144 + cb + c] = s; }
          __syncthreads(); } }
    { float* ROPE = (float*)(ws + WS_ROPE);
      for (int i = bid * NTHR + tid; i < 64 * 8; i += G * NTHR) { const int pos = i >> 3, f = i & 7; const float freq = powf(10000.f, -(float)f / 8.f); const float ang = (float)pos * freq;
          ROPE[2 * i] = cosf(ang); ROPE[2 * i + 1] = sinf(ang); } }
    { float* scr = (float*)(F.lds + wave * 16384);
      const int gw = bid * NWAVES + wave, NGW = G * NWAVES;
      bf16_t* WGLU = (bf16_t*)(ws + WS_WGLU); bf16_t* WIN = (bf16_t*)(ws + WS_WIN); bf16_t* WOUT = (bf16_t*)(ws + WS_WOUT); bf16_t* WDOWN = (bf16_t*)(ws + WS_WDOWN);
      bf16_t* WUP = (bf16_t*)(ws + WS_WUP); bf16_t* WO = (bf16_t*)(ws + WS_WO);
      constexpr int I_GLU = 16 * 32, I_IN = 16 * 162, I_OUT = 32 * 32, I_DOWN = 16 * 13, I_UQ = 4 * 48, I_UK = 2 * 32, I_WO = 16 * 32;
      constexpr int NIT = 4 * I_GLU + I_IN + I_OUT + I_DOWN + I_UQ + 2 * I_UK + I_WO;
      for (int it = gw; it < NIT; it += NGW) { int r = it;
          if (r < 4 * I_GLU) { const int which = r / I_GLU, q = r % I_GLU, j = which >> 1, isgate = which & 1;
              const float* W = (isgate ? A.in[16] : A.in[17]) + (size_t)j * 1024 * 1024;
              tr_item(W, 1024, (q / 32) * 64, (q % 32) * 32, WGLU + (size_t)j * 2048 * 1024, 1024, 0, nullptr, RmGlu{isgate * 128}, scr, lane); continue; } r -= 4 * I_GLU;
          if (r < I_IN) { tr_item(A.in[18], SSD_IN, (r / 162) * 64, (r % 162) * 32, WIN, 1024, 0, nullptr, RmId{0}, scr, lane); continue; } r -= I_IN;
          if (r < I_OUT) { tr_item(A.in[25], 1024, (r / 32) * 64, (r % 32) * 32, WOUT, 2048, 0, A.in[24], RmId{0}, scr, lane); continue; } r -= I_OUT;
          if (r < I_DOWN) { tr_item(A.in[26], 416, (r / 13) * 64, (r % 13) * 32, WDOWN, 1024, 0, nullptr, RmId{0}, scr, lane); continue; } r -= I_DOWN;
          if (r < I_UQ) { tr_item(A.in[29], 1536, (r / 48) * 64, (r % 48) * 32, WUP, 384, 0, A.in[27], RmUq{}, scr, lane); continue; } r -= I_UQ;
          if (r < I_UK) { tr_item(A.in[30], 1024, (r / 32) * 64, (r % 32) * 32, WUP, 384, 256, A.in[28], RmId{2048}, scr, lane); continue; } r -= I_UK;
          if (r < I_UK) { tr_item(A.in[31], 1024, (r / 32) * 64, (r % 32) * 32, WUP, 384, 256, A.in[28], RmId{3072}, scr, lane); continue; } r -= I_UK;
          tr_item(A.in[32], 1024, (r / 32) * 64, (r % 32) * 32, WO, 1024, 0, nullptr, RmId{0}, scr, lane); }
      const u32x4 z4 = {0u, 0u, 0u, 0u};
      const long gt = (long)bid * NTHR + tid, GT = (long)G * NTHR;
      for (long i = gt; i < (long)(SSD_IN_PAD - SSD_IN) * 128; i += GT) *(u32x4*)(WIN + (size_t)SSD_IN * 1024 + i * 8) = z4;
      for (long i = gt; i < (long)(512 - 416) * 128; i += GT) *(u32x4*)(WDOWN + (size_t)416 * 1024 + i * 8) = z4;
      for (long i = gt; i < 4096L * 48; i += GT) { const int R = (int)(i / 48), k = (int)(i % 48) * 8;
          const bool zero = R < 2048 ? (k >= 256 || (R & 127) >= 96) : (k < 256);
          if (zero) *(u32x4*)(WUP + (size_t)R * 384 + k) = z4; }
      { unsigned char* UT = ws + WS_UT; unsigned char* VT = ws + WS_VT; float* US = (float*)(ws + WS_US); float* VS = (float*)(ws + WS_VS);
        for (int rw = gw; rw < 2 * 4 * 16384; rw += NGW) { const bool isu = rw < 4 * 16384; const int row = isu ? rw : rw - 4 * 16384;
            const float* src = (isu ? A.in[35] : A.in[36]) + (size_t)row * 1024;
            const f32x4 a = *(const f32x4*)(src + 8 * lane), b = *(const f32x4*)(src + 8 * lane + 4), c = *(const f32x4*)(src + 512 + 8 * lane), d = *(const f32x4*)(src + 512 + 8 * lane + 4);
            float v[16];
#pragma unroll
            for (int e = 0; e < 4; ++e) { v[e] = a[e]; v[4 + e] = b[e]; v[8 + e] = c[e]; v[12 + e] = d[e]; }
            float mx = 0.f;
#pragma unroll
            for (int e = 0; e < 16; ++e) mx = fmaxf(mx, fabsf(v[e]));
            mx = wave_max(mx);
            const float inv = mx > 0.f ? 127.f / mx : 0.f;
            unsigned q[16];
#pragma unroll
            for (int e = 0; e < 16; ++e) q[e] = (unsigned)(int)(rintf(v[e] * inv) + 128.f);
            u32x4 o;
            o.x = q[0] | (q[1] << 8) | (q[2] << 16) | (q[3] << 24); o.y = q[4] | (q[5] << 8) | (q[6] << 16) | (q[7] << 24);
            o.z = q[8] | (q[9] << 8) | (q[10] << 16) | (q[11] << 24); o.w = q[12] | (q[13] << 8) | (q[14] << 16) | (q[15] << 24);
            o.x ^= 0x80808080u; o.y ^= 0x80808080u; o.z ^= 0x80808080u; o.w ^= 0x80808080u;
            *(u32x4*)((isu ? UT : VT) + (size_t)(row >> 14) * 16384 * 1024 + (size_t)(lane >> 3) * 16384 * 128 + (size_t)(row & 16383) * 128 + 16 * (lane & 7)) = o;
            float qs = 0.f;
#pragma unroll
            for (int e = 0; e < 16; ++e) qs += (float)q[e];
            qs = wave_sum(qs);
            if (lane == 0) { if (isu) { US[2 * row] = mx * (1.f / 127.f); US[2 * row + 1] = qs; } else VS[row] = mx * (1.f / 127.f); } } }
      for (int it = gw; it < 2 * 2 * 64; it += NGW) { unsigned char* base = ws + WS_S5C + (size_t)it * S5C_ITEM;
          float ar, ai, cr, ci; s5_disc(A, it, lane, ar, ai, cr, ci);
          ((f32x2*)base)[lane] = (f32x2){ar, ai};
          const int r = lane & 31, h = lane >> 5;
          const float* bre = A.in[11] + (size_t)it * 64 * 16; const float* bim = A.in[12] + (size_t)it * 64 * 16;
          const float* cre = A.in[13] + (size_t)it * 16 * 64; const float* cim = A.in[14] + (size_t)it * 16 * 64;
#pragma unroll
          for (int blk = 0; blk < 4; ++blk) { const int pst = (blk & 1) * 32 + r; float ar2, ai2, kr, ki; s5_disc(A, it, pst, ar2, ai2, kr, ki); float v[8];
#pragma unroll
              for (int j = 0; j < 8; ++j) { const int c = 8 * h + j; const float br = bre[pst * 16 + c], bi = bim[pst * 16 + c]; v[j] = blk < 2 ? (kr * br - ki * bi) : (kr * bi + ki * br); }
              u32x4 o; o.x = pk2(v[0], v[1]); o.y = pk2(v[2], v[3]); o.z = pk2(v[4], v[5]); o.w = pk2(v[6], v[7]);
              ((u32x4*)(base + 512))[blk * 64 + lane] = o; }
#pragma unroll
          for (int ks = 0; ks < 8; ++ks) { float v[8];
#pragma unroll
              for (int j = 0; j < 8; ++j) { const int k = 16 * ks + 8 * h + j, p = k >> 1, comp = k & 1; v[j] = r < 16 ? (comp == 0 ? cre[r * 64 + p] : -cim[r * 64 + p]) : 0.f; }
              u32x4 o; o.x = pk2(v[0], v[1]); o.y = pk2(v[2], v[3]); o.z = pk2(v[4], v[5]); o.w = pk2(v[6], v[7]);
              ((u32x4*)(base + 512 + 4096))[ks * 64 + lane] = o; } }
    }
    __syncthreads();
    { bf16_t* WSC = (bf16_t*)(ws + WS_WSC); const int gw = bid * NWAVES + wave, NGW = G * NWAVES; const int r = lane & 31, hh = lane >> 5;
      for (int it = gw; it < 4 * 16 * 32; it += NGW) { const int l = it >> 9, hj = (it >> 5) & 15, kb = it & 31, k0 = kb * 32;
          const float* wq = A.in[33] + ((size_t)l * 1024 + k0 + r) * 2048 + hj * 128; const float* sk = A.in[34] + ((size_t)l * 16 + hj) * 128 * 128;
          f32x16 acc[4];
#pragma unroll
          for (int ib = 0; ib < 4; ++ib) acc[ib] = f32x16{};
#pragma unroll 2
          for (int t = 0; t < 8; ++t) { const int d0 = 16 * t + 8 * hh;
              const f32x4 a0 = *(const f32x4*)(wq + d0), a1 = *(const f32x4*)(wq + d0 + 4);
              u32x4 ah, al; { float hi_[8], lo_[8];
#pragma unroll
                  for (int e = 0; e < 4; ++e) { hi_[e] = bflo(pk2(a0[e], 0.f)); lo_[e] = a0[e] - hi_[e]; hi_[4 + e] = bflo(pk2(a1[e], 0.f)); lo_[4 + e] = a1[e] - hi_[4 + e]; }
                  ah.x = pk2(hi_[0], hi_[1]); ah.y = pk2(hi_[2], hi_[3]); ah.z = pk2(hi_[4], hi_[5]); ah.w = pk2(hi_[6], hi_[7]);
                  al.x = pk2(lo_[0], lo_[1]); al.y = pk2(lo_[2], lo_[3]); al.z = pk2(lo_[4], lo_[5]); al.w = pk2(lo_[6], lo_[7]); }
              const bf16x8 Ah = __builtin_bit_cast(bf16x8, ah), Al = __builtin_bit_cast(bf16x8, al);
#pragma unroll
              for (int ib = 0; ib < 4; ++ib) { const float* sp = sk + (size_t)(32 * ib + r) * 128 + d0; const f32x4 b0 = *(const f32x4*)sp, b1 = *(const f32x4*)(sp + 4);
                  u32x4 bh, bl; { float hi_[8], lo_[8];
#pragma unroll
                      for (int e = 0; e < 4; ++e) { hi_[e] = bflo(pk2(b0[e], 0.f)); lo_[e] = b0[e] - hi_[e]; hi_[4 + e] = bflo(pk2(b1[e], 0.f)); lo_[4 + e] = b1[e] - hi_[4 + e]; }
                      bh.x = pk2(hi_[0], hi_[1]); bh.y = pk2(hi_[2], hi_[3]); bh.z = pk2(hi_[4], hi_[5]); bh.w = pk2(hi_[6], hi_[7]);
                      bl.x = pk2(lo_[0], lo_[1]); bl.y = pk2(lo_[2], lo_[3]); bl.z = pk2(lo_[4], lo_[5]); bl.w = pk2(lo_[6], lo_[7]); }
                  const bf16x8 Bh = __builtin_bit_cast(bf16x8, bh), Bl = __builtin_bit_cast(bf16x8, bl);
                  acc[ib] = mfma32(Ah, Bh, acc[ib]); acc[ib] = mfma32(Ah, Bl, acc[ib]); acc[ib] = mfma32(Al, Bh, acc[ib]); } }
#pragma unroll
          for (int ib = 0; ib < 4; ++ib) { bf16_t* dst = WSC + ((size_t)l * 2048 + hj * 128 + 32 * ib + r) * 1024 + k0;
#pragma unroll
              for (int g4 = 0; g4 < 4; ++g4) { u32x2 w; w.x = pk2(acc[ib][4 * g4], acc[ib][4 * g4 + 1]); w.y = pk2(acc[ib][4 * g4 + 2], acc[ib][4 * g4 + 3]); *(u32x2*)(dst + 8 * g4 + 4 * hh) = w; } } } }
}

struct Row16 { float v[16]; };
__device__ __forceinline__ Row16 ld_row_f32(const float* p, int lane) { Row16 r; const f32x4 a = *(const f32x4*)(p + 8 * lane), b = *(const f32x4*)(p + 8 * lane + 4), c = *(const f32x4*)(p + 512 + 8 * lane), d = *(const f32x4*)(p + 512 + 8 * lane + 4);
#pragma unroll
    for (int e = 0; e < 4; ++e) { r.v[e] = a[e]; r.v[4 + e] = b[e]; r.v[8 + e] = c[e]; r.v[12 + e] = d[e]; } return r; }
__device__ __forceinline__ void st_row_f32(float* p, int lane, const Row16& r) {
    *(f32x4*)(p + 8 * lane) = (f32x4){r.v[0], r.v[1], r.v[2], r.v[3]}; *(f32x4*)(p + 8 * lane + 4) = (f32x4){r.v[4], r.v[5], r.v[6], r.v[7]};
    *(f32x4*)(p + 512 + 8 * lane) = (f32x4){r.v[8], r.v[9], r.v[10], r.v[11]}; *(f32x4*)(p + 512 + 8 * lane + 4) = (f32x4){r.v[12], r.v[13], r.v[14], r.v[15]}; }
__device__ __forceinline__ Row16 ld_row_bf16(const bf16_t* p, int lane) { Row16 r; const u32x4 a = *(const u32x4*)(p + 8 * lane), b = *(const u32x4*)(p + 512 + 8 * lane);
    r.v[0] = bflo(a.x); r.v[1] = bfhi(a.x); r.v[2] = bflo(a.y); r.v[3] = bfhi(a.y); r.v[4] = bflo(a.z); r.v[5] = bfhi(a.z); r.v[6] = bflo(a.w); r.v[7] = bfhi(a.w);
    r.v[8] = bflo(b.x); r.v[9] = bfhi(b.x); r.v[10] = bflo(b.y); r.v[11] = bfhi(b.y); r.v[12] = bflo(b.z); r.v[13] = bfhi(b.z); r.v[14] = bflo(b.w); r.v[15] = bfhi(b.w); return r; }
__device__ __forceinline__ void st_row_bf16(bf16_t* p, int lane, const Row16& r) {
    u32x4 a, b; a.x = pk2(r.v[0], r.v[1]); a.y = pk2(r.v[2], r.v[3]); a.z = pk2(r.v[4], r.v[5]); a.w = pk2(r.v[6], r.v[7]);
    b.x = pk2(r.v[8], r.v[9]); b.y = pk2(r.v[10], r.v[11]); b.z = pk2(r.v[12], r.v[13]); b.w = pk2(r.v[14], r.v[15]);
    *(u32x4*)(p + 8 * lane) = a; *(u32x4*)(p + 512 + 8 * lane) = b; }
__device__ __forceinline__ Row16 layer_norm_row(const Row16& v, const float* g, const float* b, int lane) {
    float s = 0.f;
#pragma unroll
    for (int e = 0; e < 16; ++e) s += v.v[e];
    const float mean = wave_sum(s) * (1.f / 1024.f); float q = 0.f;
#pragma unroll
    for (int e = 0; e < 16; ++e) { const float d = v.v[e] - mean; q += d * d; }
    const float rstd = 1.0f / sqrtf(wave_sum(q) * (1.f / 1024.f) + 1e-5f);
    const Row16 gg = ld_row_f32(g, lane), bb = ld_row_f32(b, lane); Row16 o;
#pragma unroll
    for (int e = 0; e < 16; ++e) o.v[e] = (v.v[e] - mean) * rstd * gg.v[e] + bb.v[e];
    return o;
}
__device__ __forceinline__ const float* mod_row(const Args& A, int layer, int tok) { const int b = tok / LTOK, p = tok - b * LTOK; return (const float*)(A.ws + WS_MOD) + ((size_t)layer * NR + (p < CTXL ? BATCH : b)) * 6144; }

__device__ __forceinline__ void ph_init(const Args& A, Frame& F) {
    bf16_t* X = (bf16_t*)(A.ws + WS_X); bf16_t* H = (bf16_t*)(A.ws + WS_H);
    for (int tok = F.bid * NWAVES + F.wave; tok < NTOK; tok += F.G * NWAVES) { const int b = tok / LTOK, p = tok - b * LTOK;
        const float* src = p < CTXL ? A.in[2] + ((size_t)b * CTXL + p) * DM : A.in[0] + ((size_t)b * SEQ + (p - CTXL)) * DM;
        const Row16 x = ld_row_f32(src, F.lane); st_row_bf16(X + (size_t)tok * DM, F.lane, x);
        const float* mod = mod_row(A, 0, tok); const Row16 sh = ld_row_f32(mod, F.lane), sc = ld_row_f32(mod + 1024, F.lane); Row16 h;
#pragma unroll
        for (int e = 0; e < 16; ++e) h.v[e] = x.v[e] * (1.f + sc.v[e]) + sh.v[e];
        st_row_bf16(H + (size_t)tok * DM, F.lane, h); }
}
struct LnStat { float mean, rstd; };
__device__ __forceinline__ LnStat ln_stats(const Row16& v) {
    float s = 0.f;
#pragma unroll
    for (int e = 0; e < 16; ++e) s += v.v[e];
    const float mean = wave_sum(s) * (1.f / 1024.f); float q = 0.f;
#pragma unroll
    for (int e = 0; e < 16; ++e) { const float d = v.v[e] - mean; q += d * d; }
    LnStat r; r.mean = mean; r.rstd = 1.0f / sqrtf(wave_sum(q) * (1.f / 1024.f) + 1e-5f); return r;
}
__device__ __forceinline__ void ph_rowop(const Args& A, Frame& F, int layer, bool dry = false) {
    bf16_t* X = (bf16_t*)(A.ws + WS_X); const bf16_t* OUT = (const bf16_t*)(A.ws + WS_OUT); bf16_t* H2 = (bf16_t*)(A.ws + WS_H2);
    const int ntk = layer == 3 ? BATCH * SEQ : NTOK; const int gw = F.bid * NWAVES + F.wave, NGW = F.G * NWAVES;
    const int t_beg = (int)(((long)gw * ntk) / NGW), t_end = (int)(((long)(gw + 1) * ntk) / NGW);
    const Row16 lg = ld_row_f32(A.in[6] + (size_t)(layer * 2) * DM, F.lane), lb = ld_row_f32(A.in[7] + (size_t)(layer * 2) * DM, F.lane);
    Row16 g1, sh, sc; int cls = -1;
    auto tokof = [&](int ti) { return layer == 3 ? (ti / SEQ) * LTOK + CTXL + (ti % SEQ) : ti; };
    auto finish = [&](int tok, const Row16& x, const Row16& o) {
        Row16 v;
#pragma unroll
        for (int e = 0; e < 16; ++e) v.v[e] = DN_ALPHA * x.v[e] + g1.v[e] * o.v[e];
        const LnStat st = ln_stats(v); Row16 x1, h;
#pragma unroll
        for (int e = 0; e < 16; ++e) { x1.v[e] = (v.v[e] - st.mean) * st.rstd * lg.v[e] + lb.v[e]; h.v[e] = x1.v[e] * (1.f + sc.v[e]) + sh.v[e]; }
        if (dry) { if (x1.v[0] == 12345.678f) st_row_bf16(H2 + (size_t)tok * DM, F.lane, x1); return; }
        st_row_bf16(X + (size_t)tok * DM, F.lane, x1); st_row_bf16(H2 + (size_t)tok * DM, F.lane, h); };
    for (int ti = t_beg; ti < t_end; ti += 2) { const int tokA = tokof(ti); const bool two = ti + 1 < t_end; const int tokB = two ? tokof(ti + 1) : tokA;
        const int clsA = (tokA / LTOK) * 2 + ((tokA % LTOK) < CTXL), clsB = (tokB / LTOK) * 2 + ((tokB % LTOK) < CTXL);
        const Row16 xA = ld_row_bf16(X + (size_t)tokA * DM, F.lane), oA = ld_row_bf16(OUT + (size_t)tokA * DM, F.lane);
        const Row16 xB = ld_row_bf16(X + (size_t)tokB * DM, F.lane), oB = ld_row_bf16(OUT + (size_t)tokB * DM, F.lane);
        if (clsA != cls) { const float* mod = mod_row(A, layer, tokA); g1 = ld_row_f32(mod + 2048, F.lane); sh = ld_row_f32(mod + 3072, F.lane); sc = ld_row_f32(mod + 4096, F.lane); cls = clsA; }
        finish(tokA, xA, oA);
        if (two) { if (clsB != cls) { const float* mod = mod_row(A, layer, tokB); g1 = ld_row_f32(mod + 2048, F.lane); sh = ld_row_f32(mod + 3072, F.lane); sc = ld_row_f32(mod + 4096, F.lane); cls = clsB; }
            finish(tokB, xB, oB); } }
}

__device__ __forceinline__ void ph_s5_scan(const Args& A, Frame& F, int j) {
    const int lane = F.lane, wave = F.wave, r = lane & 31, h = lane >> 5;
    constexpr int RS = 272, NSEG = 4, CPS = (LTOK / 32) / NSEG;
    static_assert((LTOK / 32) % NSEG == 0, "segments");
    unsigned char* Sb = F.lds + wave * (32 * RS);
    f32x2* XCH = (f32x2*)(F.lds + 8 * 32 * RS);
    const bf16_t* H = (const bf16_t*)(A.ws + WS_H);
    const int il = wave >> 2, seg = wave & 3;
    for (int it0 = 2 * F.bid; it0 < BATCH * 128; it0 += 2 * F.G) { const int item = it0 + il; const bool act = item < BATCH * 128;
        const int g = item & 63, dir = (item >> 6) & 1, b = item >> 7;
        const unsigned char* cb = A.ws + WS_S5C + (size_t)((j * 2 + dir) * 64 + g) * S5C_ITEM;
        f32x2 ab = {0.f, 0.f}; bf16x8 Bf[4], Cf[8];
        if (act) { ab = ((const f32x2*)cb)[lane];
#pragma unroll
            for (int q = 0; q < 4; ++q) Bf[q] = ((const bf16x8*)(cb + 512))[q * 64 + lane]; }
        const float are = ab.x, aim = ab.y;
        bf16_t* Y = (bf16_t*)(A.ws + (dir ? WS_YB : WS_YF));
        float sre = 0.f, sim = 0.f;
        const int sbeg = seg * CPS * 32;
#define S5_LOADU(s0) (*(const bf16x8*)(H + ((size_t)b * LTOK + seqpos(dir, (s0) + r)) * DM + g * 16 + 8 * h))
#define S5_BU(ua) do { f32x16 a0 = {}, a1 = {}, a2 = {}, a3 = {}; a0 = mfma32(ua, Bf[0], a0); a2 = mfma32(ua, Bf[2], a2); a1 = mfma32(ua, Bf[1], a1); a3 = mfma32(ua, Bf[3], a3); \
            _Pragma("unroll") for (int q = 0; q < 16; ++q) { *(unsigned*)(Sb + crow(q, h) * RS + r * 4) = pk2(a0[q], a2[q]); *(unsigned*)(Sb + crow(q, h) * RS + (32 + r) * 4) = pk2(a1[q], a3[q]); } } while (0)
        if (act && seg < NSEG - 1) {
            const f32x2 abx = ((const f32x2*)cb)[32 + r]; const float ar0 = ((const f32x2*)cb)[r].x, ai0 = ((const f32x2*)cb)[r].y, ar1 = abx.x, ai1 = abx.y;
            float w0r[16], w0i[16], w1r[16], w1i[16];
            { float p0r = 1.f, p0i = 0.f, p1r = 1.f, p1i = 0.f;
#pragma unroll
              for (int q = 0; q < 16; ++q) { w0r[q] = 0.f; w0i[q] = 0.f; w1r[q] = 0.f; w1i[q] = 0.f; }
#pragma unroll
              for (int k = 0; k < 32; ++k) {
#pragma unroll
                  for (int q = 0; q < 16; ++q) { const int k0 = 31 - ((q & 3) + 8 * (q >> 2));
                      if (k0 == k) { w0r[q] = h ? w0r[q] : p0r; w0i[q] = h ? w0i[q] : p0i; w1r[q] = h ? w1r[q] : p1r; w1i[q] = h ? w1i[q] : p1i; }
                      if (k0 - 4 == k) { w0r[q] = h ? p0r : w0r[q]; w0i[q] = h ? p0i : w0i[q]; w1r[q] = h ? p1r : w1r[q]; w1i[q] = h ? p1i : w1i[q]; } }
                  { const float t_ = p0r * ar0 - p0i * ai0; p0i = p0r * ai0 + p0i * ar0; p0r = t_; } { const float t_ = p1r * ar1 - p1i * ai1; p1i = p1r * ai1 + p1i * ar1; p1r = t_; } }
              float s0r = 0.f, s0i = 0.f, s1r = 0.f, s1i = 0.f; bf16x8 un = S5_LOADU(sbeg);
              for (int c = 0; c < CPS; ++c) { const int s0 = sbeg + 32 * c; const bf16x8 ua = un; if (c + 1 < CPS) un = S5_LOADU(s0 + 32);
                  f32x16 a0 = {}, a1 = {}, a2 = {}, a3 = {}; a0 = mfma32(ua, Bf[0], a0); a2 = mfma32(ua, Bf[2], a2); a1 = mfma32(ua, Bf[1], a1); a3 = mfma32(ua, Bf[3], a3);
                  float q0r = 0.f, q0i = 0.f, q1r = 0.f, q1i = 0.f;
#pragma unroll
                  for (int q = 0; q < 16; ++q) { q0r += w0r[q] * a0[q] - w0i[q] * a2[q]; q0i += w0r[q] * a2[q] + w0i[q] * a0[q]; q1r += w1r[q] * a1[q] - w1i[q] * a3[q]; q1i += w1r[q] * a3[q] + w1i[q] * a1[q]; }
                  { const float t_ = p0r * s0r - p0i * s0i + q0r; s0i = p0r * s0i + p0i * s0r + q0i; s0r = t_; } { const float t_ = p1r * s1r - p1i * s1i + q1r; s1i = p1r * s1i + p1i * s1r + q1i; s1r = t_; } }
              s0r += __shfl_xor(s0r, 32); s0i += __shfl_xor(s0i, 32); s1r += __shfl_xor(s1r, 32); s1i += __shfl_xor(s1i, 32);
              XCH[(il * NSEG + seg) * 64 + lane] = h == 0 ? (f32x2){s0r, s0i} : (f32x2){s1r, s1i}; } }
        __syncthreads();
        { float pr = are, pi = aim, ar_ = 1.f, ai_ = 0.f;
          for (int e = CPS * 32; e > 0; e >>= 1) { if (e & 1) { const float t_ = ar_ * pr - ai_ * pi; ai_ = ar_ * pi + ai_ * pr; ar_ = t_; } const float t2 = pr * pr - pi * pi; pi = 2.f * pr * pi; pr = t2; }
          sre = 0.f; sim = 0.f;
          for (int k = 0; k < seg; ++k) { const f32x2 f = XCH[(il * NSEG + k) * 64 + lane]; const float nre = ar_ * sre - ai_ * sim + f.x, nim = ar_ * sim + ai_ * sre + f.y; sre = nre; sim = nim; } }
        if (act) {
            int lane2 = lane;
#ifndef CPU_EMU
            asm volatile("" : "+v"(lane2));
#endif
            const int r = lane2 & 31, h = lane2 >> 5, lane = lane2; (void)lane;
#pragma unroll
            for (int q = 0; q < 8; ++q) Cf[q] = ((const bf16x8*)(cb + 512 + 4096))[q * 64 + lane];
            bf16x8 un = S5_LOADU(sbeg);
            for (int c = 0; c < CPS; ++c) { const int s0 = sbeg + 32 * c; const bf16x8 ua = un; if (c + 1 < CPS) un = S5_LOADU(s0 + 32);
                S5_BU(ua); wave_sync();
#pragma unroll 8
                for (int t = 0; t < 32; ++t) { unsigned* wp = (unsigned*)(Sb + t * RS + lane * 4); const unsigned w = *wp; const float bre = bflo(w), bim = bfhi(w);
                    const float nre = are * sre - aim * sim + bre, nim = are * sim + aim * sre + bim; sre = nre; sim = nim; *wp = pk2(sre, sim); }
                wave_sync();
                f32x16 y = {};
#pragma unroll
                for (int ks = 0; ks < 8; ++ks) { const bf16x8 sa = *(const bf16x8*)(Sb + r * RS + (16 * ks + 8 * h) * 2); y = mfma32(Cf[ks], sa, y); }
                { bf16_t* yp = Y + ((size_t)b * LTOK + seqpos(dir, s0 + r)) * DM + g * 16 + 4 * h;
                  u32x2 w0, w1; w0.x = pk2(y[0], y[1]); w0.y = pk2(y[2], y[3]); w1.x = pk2(y[4], y[5]); w1.y = pk2(y[6], y[7]);
                  *(u32x2*)yp = w0; *(u32x2*)(yp + 8) = w1; }
                wave_sync(); } }
        __syncthreads();
#undef S5_LOADU
#undef S5_BU
    }
}
__device__ __forceinline__ void ph_s5_combine(const Args& A, Frame& F, int j) {
    const bf16_t* H = (const bf16_t*)(A.ws + WS_H); const bf16_t* YF = (const bf16_t*)(A.ws + WS_YF); const bf16_t* YB = (const bf16_t*)(A.ws + WS_YB); bf16_t* Gb = (bf16_t*)(A.ws + WS_G);
    const Row16 d = ld_row_f32(A.in[15] + (size_t)j * DM, F.lane); const int NGW = F.G * NWAVES;
    for (int tok = F.bid * NWAVES + F.wave; tok < NTOK; tok += 2 * NGW) { const int tokB = tok + NGW; const bool two = tokB < NTOK; const size_t oA = (size_t)tok * DM, oB = (size_t)(two ? tokB : tok) * DM;
        const Row16 hA = ld_row_bf16(H + oA, F.lane), fA = ld_row_bf16(YF + oA, F.lane), bA = ld_row_bf16(YB + oA, F.lane);
        const Row16 hB = ld_row_bf16(H + oB, F.lane), fB = ld_row_bf16(YF + oB, F.lane), bB = ld_row_bf16(YB + oB, F.lane); Row16 o;
#pragma unroll
        for (int e = 0; e < 16; ++e) o.v[e] = gelu_tanh(d.v[e] * hA.v[e] + fA.v[e] + bA.v[e]);
        st_row_bf16(Gb + oA, F.lane, o);
        if (two) {
#pragma unroll
            for (int e = 0; e < 16; ++e) o.v[e] = gelu_tanh(d.v[e] * hB.v[e] + fB.v[e] + bB.v[e]);
            st_row_bf16(Gb + oB, F.lane, o); } }
}

__device__ __forceinline__ void ph_ssd_conv(const Args& A, Frame& F) {
    const bf16_t* XBC = (const bf16_t*)(A.ws + WS_XBC); bf16_t* XC = (bf16_t*)(A.ws + WS_XBCC); const float* DT = (const float*)(A.ws + WS_DT); float* DTS = (float*)(A.ws + WS_DTS);
    const float* cw = A.in[19]; const float* cbias = A.in[20]; const float* dtb = A.in[21];
    const long gt = (long)F.bid * NTHR + F.tid, GT = (long)F.G * NTHR;
    for (long i = gt; i < (long)NTOK * 384; i += GT) { const int tok = (int)(i / 384), ch = (int)(i % 384) * 8; const int p = tok % LTOK;
        const bool hp = (p != 0 && p != CTXL), hn = (p != CTXL - 1 && p != LTOK - 1);
        const u32x4 z4 = {0u, 0u, 0u, 0u};
        const u32x4 c0 = *(const u32x4*)(XBC + (size_t)tok * 3072 + ch);
        const u32x4 cm = hp ? *(const u32x4*)(XBC + (size_t)(tok - 1) * 3072 + ch) : z4;
        const u32x4 cp = hn ? *(const u32x4*)(XBC + (size_t)(tok + 1) * 3072 + ch) : z4;
        float o[8];
#pragma unroll
        for (int e = 0; e < 4; ++e) { const unsigned wm = cm[e], w0 = c0[e], wp = cp[e]; const int c = ch + 2 * e;
            o[2 * e] = siluf_(cbias[c] + cw[c] * bflo(wm) + cw[3072 + c] * bflo(w0) + cw[6144 + c] * bflo(wp));
            o[2 * e + 1] = siluf_(cbias[c + 1] + cw[c + 1] * bfhi(wm) + cw[3072 + c + 1] * bfhi(w0) + cw[6144 + c + 1] * bfhi(wp)); }
        u32x4 w; w.x = pk2(o[0], o[1]); w.y = pk2(o[2], o[3]); w.z = pk2(o[4], o[5]); w.w = pk2(o[6], o[7]);
        *(u32x4*)(XC + (size_t)tok * 3072 + ch) = w; }
    { float* ACUM = (float*)(A.ws + WS_ACUM);
      for (long i = gt; i < (long)(NTOK / 64) * 64; i += GT) { const int blk = (int)(i >> 6), j = (int)(i & 63); const int dir = j >> 5; const float Aj = -__expf(A.in[22][j]); const float bj = dtb[j]; float ac = 0.f;
          for (int k = 0; k < 64; ++k) { const size_t tk = (size_t)blk * 64 + (dir ? 63 - k : k); const float x = DT[tk * 64 + j] + bj; const float dt = x > 20.f ? x : log1pf(__expf(x));
              DTS[tk * 64 + j] = dt; ac += dt * Aj; ACUM[tk * 64 + j] = ac; } } }
}
__device__ __forceinline__ int ssd_tokbase(int dir, int c) { return dir == 0 ? 64 * c : (c < CTXL / 64 ? CTXL - 64 * (c + 1) : LTOK + CTXL - 64 * (c + 1)); }
__device__ __forceinline__ bf16x8 tr_frag(const unsigned char* T, int rs, int s0, int c0, int lane) {
    const int i = lane & 15, hh = lane >> 5, rb = 16 * ((lane >> 4) & 1); const unsigned char* p = T + (s0 + 8 * hh + (i >> 2)) * rs + (c0 + rb + 4 * (i & 3)) * 2;
    const s16x4 lo = lds_tr(p), hi = lds_tr(p + 4 * rs); return (bf16x8){lo[0], lo[1], lo[2], lo[3], hi[0], hi[1], hi[2], hi[3]};
}
__device__ __forceinline__ void ph_ssd_scan(const Args& A, Frame& F) {
    const int tid = F.tid, lane = F.lane, wave = F.wave, r = lane & 31, hi = lane >> 5;
    constexpr int RS_BC = 272, RS_X = 144, O_CN = 0, O_BN = 17408, O_XN = 34816, O_XS = 44032, O_ML = 53248, O_SP = 62464, O_VEC = 79872;
    constexpr int O_CN2 = 80896, O_BN2 = 98304, O_XN2 = 115712, O_XS2 = 132096, O_VEC2 = 141312;
    unsigned char* L = F.lds;
    const bf16_t* XC = (const bf16_t*)(A.ws + WS_XBCC); const float* DTS = (const float*)(A.ws + WS_DTS); const float* ACUM = (const float*)(A.ws + WS_ACUM);
    constexpr int NCH = LTOK / 64;
    for (int item = F.bid; item < BATCH * 64; item += F.G) { const int hh = item & 31, dir = (item >> 5) & 1, b = item >> 6, grp = hh >> 3, jj = dir * 32 + hh;
        bf16_t* Y = (bf16_t*)(A.ws + (dir ? WS_YB2 : WS_YF2));
        f32x16 st = {};
        for (int i = tid; i < 64 * 17; i += NTHR) *(u32x4*)(L + O_SP + i * 16) = (u32x4){0u, 0u, 0u, 0u};
        u32x4 rC[2], rB[2], rX; float rdt = 0.f, rac = 0.f, rws = 0.f;
#define SSD_LOAD(c) do { const size_t t0 = (size_t)b * LTOK + ssd_tokbase(dir, (c)); \
            _Pragma("unroll") for (int k = 0; k < 2; ++k) { const int id = tid + 512 * k, row = id >> 4, c8 = (id & 15) * 8; \
                rC[k] = *(const u32x4*)(XC + (t0 + row) * 3072 + 2560 + grp * 128 + c8); rB[k] = *(const u32x4*)(XC + (t0 + row) * 3072 + 2048 + grp * 128 + c8); } \
            { const int row = tid >> 3; rX = *(const u32x4*)(XC + (t0 + row) * 3072 + hh * 64 + (tid & 7) * 8); \
              const float dt_ = DTS[(t0 + row) * 64 + jj], ac_ = ACUM[(t0 + row) * 64 + jj], at_ = ACUM[(t0 + (dir ? 0 : 63)) * 64 + jj]; rws = dt_ * __expf(at_ - ac_); \
              if (tid < 64) { rdt = DTS[(t0 + tid) * 64 + jj]; rac = ACUM[(t0 + tid) * 64 + jj]; } } } while (0)
#define SSD_WRITE(oCN_, oBN_, oXN_, oXS_, oV_) do { float* dtv_ = (float*)(L + (oV_)); float* acv_ = dtv_ + 64; float* eac_ = acv_ + 64; _Pragma("unroll") for (int k = 0; k < 2; ++k) { const int id = tid + 512 * k, row = id >> 4, c8 = (id & 15) * 8; \
                *(u32x4*)(L + (oCN_) + row * RS_BC + c8 * 2) = rC[k]; *(u32x4*)(L + (oBN_) + row * RS_BC + c8 * 2) = rB[k]; } \
            { const int row = tid >> 3, c8 = (tid & 7) * 8; *(u32x4*)(L + (oXN_) + row * RS_X + c8 * 2) = rX; u32x4 xs_; \
              xs_.x = pk2(bflo(rX.x) * rws, bfhi(rX.x) * rws); xs_.y = pk2(bflo(rX.y) * rws, bfhi(rX.y) * rws); xs_.z = pk2(bflo(rX.z) * rws, bfhi(rX.z) * rws); xs_.w = pk2(bflo(rX.w) * rws, bfhi(rX.w) * rws); \
              *(u32x4*)(L + (oXS_) + row * RS_X + c8 * 2) = xs_; } \
            if (tid < 64) { dtv_[tid] = rdt; acv_[tid] = rac; eac_[tid] = __expf(rac); } } while (0)
        SSD_LOAD(0); __syncthreads(); SSD_WRITE(O_CN, O_BN, O_XN, O_XS, O_VEC); __syncthreads();
        for (int c = 0; c < NCH; ++c) { const bool par = (c & 1) != 0;
            const int oCN = par ? O_CN2 : O_CN, oBN = par ? O_BN2 : O_BN, oXN = par ? O_XN2 : O_XN, oXS = par ? O_XS2 : O_XS; const float* dtv = (const float*)(L + (par ? O_VEC2 : O_VEC)); const float* acv = dtv + 64; const float* eac = acv + 64;
            if (c + 1 < NCH) SSD_LOAD(c + 1);
            const size_t t0 = (size_t)b * LTOK + ssd_tokbase(dir, c);
            f32x16 yacc = {};
            int pb = 0, qb = 0;
            if (wave < 4) { pb = wave >> 1; qb = wave & 1;
#pragma unroll
                for (int t = 0; t < 8; ++t) { const bf16x8 af = *(const bf16x8*)(L + O_SP + (32 * pb + r) * RS_BC + (16 * t + 8 * hi) * 2), bfr = *(const bf16x8*)(L + oCN + (32 * qb + r) * RS_BC + (16 * t + 8 * hi) * 2);
                    yacc = mfma32(af, bfr, yacc); }
                const float eq = eac[32 * qb + r];
#pragma unroll
                for (int q = 0; q < 16; ++q) yacc[q] *= eq;
            } else if (wave < 7) { const int ti = wave - 4; const int sb = dir == 0 ? (ti == 2) : (ti >= 1), qb2 = dir == 0 ? (ti >= 1) : (ti == 2);
                f32x16 m = {};
#pragma unroll
                for (int t = 0; t < 8; ++t) { const bf16x8 af = *(const bf16x8*)(L + oBN + (32 * sb + r) * RS_BC + (16 * t + 8 * hi) * 2), bfr = *(const bf16x8*)(L + oCN + (32 * qb2 + r) * RS_BC + (16 * t + 8 * hi) * 2);
                    m = mfma32(af, bfr, m); }
                const int qi = 32 * qb2 + r; const float aq = acv[qi];
#pragma unroll
                for (int g4 = 0; g4 < 4; ++g4) { float v[4];
#pragma unroll
                    for (int e = 0; e < 4; ++e) { const int si = 32 * sb + 8 * g4 + 4 * hi + e; const bool ok = dir == 0 ? (si <= qi) : (si >= qi);
                        v[e] = ok ? m[4 * g4 + e] * dtv[si] * __expf(aq - acv[si]) : 0.f; }
                    u32x2 w; w.x = pk2(v[0], v[1]); w.y = pk2(v[2], v[3]); *(u32x2*)(L + O_ML + qi * RS_X + (32 * sb + 8 * g4 + 4 * hi) * 2) = w; }
            }
            __syncthreads();
            if (wave < 4) {
#pragma unroll
                for (int sb = 0; sb < 2; ++sb) { const bool use = dir == 0 ? (sb <= qb) : (sb >= qb);
                    if (use) {
#pragma unroll
                        for (int kk = 0; kk < 2; ++kk) { const int s0 = 32 * sb + 16 * kk;
                            const bf16x8 af = tr_frag(L + oXN, RS_X, s0, 32 * pb, lane);
                            const bf16x8 bfr = *(const bf16x8*)(L + O_ML + (32 * qb + r) * RS_X + (s0 + 8 * hi) * 2);
                            yacc = mfma32(af, bfr, yacc); } } }
                bf16_t* yp = Y + (t0 + 32 * qb + r) * 2048 + hh * 64 + 32 * pb;
#pragma unroll
                for (int g4 = 0; g4 < 4; ++g4) { u32x2 w; w.x = pk2(yacc[4 * g4], yacc[4 * g4 + 1]); w.y = pk2(yacc[4 * g4 + 2], yacc[4 * g4 + 3]); *(u32x2*)(yp + 8 * g4 + 4 * hi) = w; }
            }
            { const int nb = wave >> 1, pb2 = wave & 1; const float dec = __expf(acv[dir ? 0 : 63]);
#pragma unroll
              for (int q = 0; q < 16; ++q) st[q] *= dec;
#pragma unroll
              for (int t = 0; t < 4; ++t) { const bf16x8 af = tr_frag(L + oBN, RS_BC, 16 * t, 32 * nb, lane), bfr = tr_frag(L + oXS, RS_X, 16 * t, 32 * pb2, lane); st = mfma32(af, bfr, st); }
            }
            { const int nb = wave >> 1, pb2 = wave & 1;
#pragma unroll
              for (int g4 = 0; g4 < 4; ++g4) { u32x2 w; w.x = pk2(st[4 * g4], st[4 * g4 + 1]); w.y = pk2(st[4 * g4 + 2], st[4 * g4 + 3]); *(u32x2*)(L + O_SP + (32 * pb2 + r) * RS_BC + (32 * nb + 8 * g4 + 4 * hi) * 2) = w; } }
            if (c + 1 < NCH) { if (par) SSD_WRITE(O_CN, O_BN, O_XN, O_XS, O_VEC); else SSD_WRITE(O_CN2, O_BN2, O_XN2, O_XS2, O_VEC2); }
            __syncthreads();
        }
#undef SSD_LOAD
#undef SSD_WRITE
    }
}
__device__ __forceinline__ void ph_ssd_gate(const Args& A, Frame& F) {
    const bf16_t* YF = (const bf16_t*)(A.ws + WS_YF2); const bf16_t* YB = (const bf16_t*)(A.ws + WS_YB2); const bf16_t* XC = (const bf16_t*)(A.ws + WS_XBCC); const bf16_t* Z = (const bf16_t*)(A.ws + WS_Z);
    bf16_t* G2 = (bf16_t*)(A.ws + WS_G2); const float* Dh = A.in[23]; const int NGW = F.G * NWAVES;
    float dh[4];
#pragma unroll
    for (int j = 0; j < 4; ++j) dh[j] = Dh[(512 * j + 8 * F.lane) >> 6];
    for (int tok = F.bid * NWAVES + F.wave; tok < NTOK; tok += 2 * NGW) { const int tokB = tok + NGW; const bool two = tokB < NTOK; const int tk[2] = {tok, two ? tokB : tok};
        u32x4 a[2][4], bq[2][4], x[2][4], z[2][4];
#pragma unroll
        for (int t = 0; t < 2; ++t)
#pragma unroll
            for (int j = 0; j < 4; ++j) { const int d0 = 512 * j + 8 * F.lane;
                a[t][j] = *(const u32x4*)(YF + (size_t)tk[t] * 2048 + d0); bq[t][j] = *(const u32x4*)(YB + (size_t)tk[t] * 2048 + d0); x[t][j] = *(const u32x4*)(XC + (size_t)tk[t] * 3072 + d0); z[t][j] = *(const u32x4*)(Z + (size_t)tk[t] * 2048 + d0); }
#pragma unroll
        for (int t = 0; t < 2; ++t) { if (t == 1 && !two) break; float v[32]; float ss = 0.f;
#pragma unroll
            for (int j = 0; j < 4; ++j)
#pragma unroll
                for (int e = 0; e < 4; ++e) { const float v0 = (bflo(a[t][j][e]) + bflo(bq[t][j][e]) + dh[j] * bflo(x[t][j][e])) * siluf_(bflo(z[t][j][e])), v1 = (bfhi(a[t][j][e]) + bfhi(bq[t][j][e]) + dh[j] * bfhi(x[t][j][e])) * siluf_(bfhi(z[t][j][e]));
                    v[8 * j + 2 * e] = v0; v[8 * j + 2 * e + 1] = v1; ss += v0 * v0 + v1 * v1; }
            const float rn = 1.0f / sqrtf(wave_sum(ss) * (1.f / 2048.f) + 1e-6f);
#pragma unroll
            for (int j = 0; j < 4; ++j) { u32x4 w; w.x = pk2(v[8 * j] * rn, v[8 * j + 1] * rn); w.y = pk2(v[8 * j + 2] * rn, v[8 * j + 3] * rn); w.z = pk2(v[8 * j + 4] * rn, v[8 * j + 5] * rn); w.w = pk2(v[8 * j + 6] * rn, v[8 * j + 7] * rn);
                *(u32x4*)(G2 + (size_t)tk[t] * 2048 + 512 * j + 8 * F.lane) = w; } } }
}

__device__ __forceinline__ void mla_kr(const Args& A, Frame& F) {
    const bf16_t* C = (const bf16_t*)(A.ws + WS_CQKV); bf16_t* Kb = (bf16_t*)(A.ws + WS_K); const float* ROPE = (const float*)(A.ws + WS_ROPE);
    const long gt = (long)F.bid * NTHR + F.tid, GT = (long)F.G * NTHR;
    for (long idx = gt; idx < (long)NTOK * 16; idx += GT) { const int tok = (int)(idx >> 4), i = (int)(idx & 15); const int b = tok / LTOK, p = tok - b * LTOK;
        const int o1 = (i < 8) ? i : 16 + (i - 8); float x1 = bf2f(C[(size_t)tok * 512 + 384 + o1]), x2 = bf2f(C[(size_t)tok * 512 + 384 + o1 + 8]);
        if (p >= CTXL) { const int t = p - CTXL; const int pos = (i < 8) ? (t >> 6) : (t & 63); const float c = ROPE[(pos * 8 + (i & 7)) * 2], s = ROPE[(pos * 8 + (i & 7)) * 2 + 1];
            const float y1 = x1 * c - x2 * s, y2 = x2 * c + x1 * s; x1 = y1; x2 = y2; }
        const unsigned w = pk2(x1, x2);
#pragma unroll 4
        for (int hd = 0; hd < 16; ++hd) *(unsigned*)(Kb + ((size_t)(b * 16 + hd) * LTOK + p) * 128 + 64 + 2 * i) = w; }
}
__device__ __forceinline__ void ph_attn(const Args& A, Frame& F) {
    const bf16_t* Q = (const bf16_t*)(A.ws + WS_Q); const bf16_t* Kb = (const bf16_t*)(A.ws + WS_K); const bf16_t* Vb = (const bf16_t*)(A.ws + WS_V); bf16_t* O = (bf16_t*)(A.ws + WS_O);
    constexpr int NLQ = SEQ / 256, NCQ = CTXL / 256, NLU = BATCH * 16 * NLQ, NU = NLU + BATCH * 16 * NCQ;
    const int vb = (F.G % 8 == 0) ? (F.bid % 8) * (F.G / 8) + F.bid / 8 : F.bid;
    for (int u = vb; u < NU; u += F.G) { int bh, p0, seq;
        if (u < NLU) { bh = u / NLQ; p0 = CTXL + (u % NLQ) * 256; seq = LTOK; } else { const int v = u - NLU; bh = v / NCQ; p0 = (v % NCQ) * 256; seq = CTXL; }
        const int b = bh >> 4, hd = bh & 15;
        att::attn_body(Q + ((size_t)bh * LTOK + p0) * 128, Kb + (size_t)bh * LTOK * 128, Vb + (size_t)bh * LTOK * 64, O + ((size_t)b * LTOK + p0) * DM + hd * 64, seq,
#ifdef CPU_EMU
                       F.lds,
#else
                       (char*)F.lds,
#endif
                       p0 >= CTXL ? p0 - CTXL : -1, (const float*)(A.ws + WS_ROPE), F.wave); }
}

__device__ __forceinline__ float ub0(unsigned w) { return (float)(w & 0xffu); }
__device__ __forceinline__ float ub1(unsigned w) { return (float)((w >> 8) & 0xffu); }
__device__ __forceinline__ float ub2(unsigned w) { return (float)((w >> 16) & 0xffu); }
__device__ __forceinline__ float ub3(unsigned w) { return (float)(w >> 24); }
#ifdef CPU_EMU
__device__ __forceinline__ unsigned udot4(unsigned a, unsigned b, unsigned c) { for (int i = 0; i < 4; ++i) c += ((a >> (8 * i)) & 255u) * ((b >> (8 * i)) & 255u); return c; }
#else
__device__ __forceinline__ unsigned udot4(unsigned a, unsigned b, unsigned c) { return __builtin_amdgcn_udot4(a, b, c, false); }
#endif
#ifdef CPU_EMU
__device__ __forceinline__ unsigned med3u(unsigned a, unsigned b, unsigned c) { const unsigned mn = a < b ? a : b, mx = a < b ? b : a; const unsigned t = mx < c ? mx : c; return mn > t ? mn : t; }
__device__ __forceinline__ unsigned lane_xor1(unsigned x) { return __shfl_xor(x, 1); }
#else
__device__ __forceinline__ unsigned med3u(unsigned a, unsigned b, unsigned c) { unsigned r; asm("v_med3_u32 %0, %1, %2, %3" : "=v"(r) : "v"(a), "v"(b), "v"(c)); return r; }
__device__ __forceinline__ unsigned lane_xor1(unsigned x) { return (unsigned)__builtin_amdgcn_update_dpp(0, (int)x, 0xB1, 0xF, 0xF, true); }
#endif
#define TOP16_INSERT(t, x) do { _Pragma("unroll") for (int k_ = 15; k_ >= 1; --k_) t[k_] = med3u(t[k_ - 1], t[k_], (x)); t[0] = t[0] > (x) ? t[0] : (x); } while (0)
__device__ __forceinline__ int peer_tok(int layer, int ti) { return layer == 3 ? (ti / SEQ) * LTOK + CTXL + (ti % SEQ) : ti; }
#ifdef CPU_EMU
__device__ __forceinline__ int ror8_i(int v) { return __shfl_xor(v, 8); }
__device__ __forceinline__ void lane_pair16(int x, int& lo, int& hi) { const int o = __shfl_xor(x, 16); const bool up = (threadIdx.x >> 4) & 1; lo = up ? o : x; hi = up ? x : o; }
__device__ __forceinline__ void lane_pair32(int x, int& lo, int& hi) { const int o = __shfl_xor(x, 32); const bool up = (threadIdx.x >> 5) & 1; lo = up ? o : x; hi = up ? x : o; }
#else
__device__ __forceinline__ int ror8_i(int v) { return __builtin_amdgcn_update_dpp(0, v, 0x128, 0xF, 0xF, true); }
__device__ __forceinline__ void lane_pair16(int x, int& lo, int& hi) { auto rr = __builtin_amdgcn_permlane16_swap((unsigned)x, (unsigned)x, false, false); lo = (int)rr[0]; hi = (int)rr[1]; }
__device__ __forceinline__ void lane_pair32(int x, int& lo, int& hi) { auto rr = __builtin_amdgcn_permlane32_swap((unsigned)x, (unsigned)x, false, false); lo = (int)rr[0]; hi = (int)rr[1]; }
#endif
#ifdef CPU_EMU
__device__ __forceinline__ unsigned bperm(unsigned s0, unsigned s1, unsigned sel) { const unsigned long long v = ((unsigned long long)s0 << 32) | s1; unsigned r = 0; for (int i = 0; i < 4; ++i) { const unsigned k = (sel >> (8 * i)) & 255u; const unsigned byte = k < 8u ? (unsigned)((v >> (8 * k)) & 255ull) : (k == 12u ? 0u : 255u); r |= byte << (8 * i); } return r; }
#else
__device__ __forceinline__ unsigned bperm(unsigned s0, unsigned s1, unsigned sel) { return __builtin_amdgcn_perm(s0, s1, sel); }
#endif
#ifdef CPU_EMU
__device__ __forceinline__ int sdot4(unsigned a, unsigned b, int c) { for (int i = 0; i < 4; ++i) c += (int)(signed char)(a >> (8 * i)) * (int)(signed char)(b >> (8 * i)); return c; }
__device__ __forceinline__ float sum_bits012(float v) { v += __shfl_xor(v, 1); v += __shfl_xor(v, 2); v += __shfl_xor(v, 4); return v; }
#else
__device__ __forceinline__ int sdot4(unsigned a, unsigned b, int c) { return __builtin_amdgcn_sdot4((int)a, (int)b, c, false); }
__device__ __forceinline__ float sum_bits012(float v) { v += dpp_f<0xB1>(v); v += dpp_f<0x4E>(v); v += dpp_f<0x141>(v); return v; }
#endif
#ifdef CPU_EMU
__device__ __forceinline__ float sum_bits345(float v) { v += __shfl_xor(v, 8); v += __shfl_xor(v, 16); v += __shfl_xor(v, 32); return v; }
#else
__device__ __forceinline__ float sum_bits345(float v) {
    v += dpp_f<0x128>(v);
    { auto rr = __builtin_amdgcn_permlane16_swap(__float_as_uint(v), __float_as_uint(v), false, false); v = __uint_as_float(rr[0]) + __uint_as_float(rr[1]); }
    { auto rr = __builtin_amdgcn_permlane32_swap(__float_as_uint(v), __float_as_uint(v), false, false); v = __uint_as_float(rr[0]) + __uint_as_float(rr[1]); }
    return v;
}
#endif
#ifdef CPU_EMU
__device__ __forceinline__ float merge_bit3(float a, float b) { const bool hi = (threadIdx.x >> 3) & 1; const float k = hi ? b : a, t = hi ? a : b; return k + __shfl_xor(t, 8); }
__device__ __forceinline__ float merge_bit4(float a, float b) { const bool hi = (threadIdx.x >> 4) & 1; const float k = hi ? b : a, t = hi ? a : b; return k + __shfl_xor(t, 16); }
__device__ __forceinline__ float merge_bit5(float a, float b) { const bool hi = (threadIdx.x >> 5) & 1; const float k = hi ? b : a, t = hi ? a : b; return k + __shfl_xor(t, 32); }
#else
__device__ __forceinline__ float merge_bit3(float a, float b) {
    const int x = __builtin_amdgcn_update_dpp(__builtin_bit_cast(int, b), __builtin_bit_cast(int, a), 0x128, 0xF, 0x3, false);
    const int y = __builtin_amdgcn_update_dpp(__builtin_bit_cast(int, a), __builtin_bit_cast(int, b), 0x128, 0xF, 0xC, false);
    return __builtin_bit_cast(float, x) + __builtin_bit_cast(float, y); }
__device__ __forceinline__ float merge_bit4(float a, float b) { auto rr = __builtin_amdgcn_permlane16_swap(__float_as_uint(a), __float_as_uint(b), false, false); return __uint_as_float(rr[0]) + __uint_as_float(rr[1]); }
__device__ __forceinline__ float merge_bit5(float a, float b) { auto rr = __builtin_amdgcn_permlane32_swap(__float_as_uint(a), __float_as_uint(b), false, false); return __uint_as_float(rr[0]) + __uint_as_float(rr[1]); }
#endif
#ifdef CPU_EMU
template <int K> __device__ __forceinline__ unsigned quad_bcast(unsigned v) { return __shfl(v, (int)((threadIdx.x & 63 & ~3) | K)); }
#else
template <int K> __device__ __forceinline__ unsigned quad_bcast(unsigned v) { return (unsigned)__builtin_amdgcn_update_dpp(0, (int)v, K * 0x55, 0xF, 0xF, true); }
#endif
#define EL_LOAD(ELQ, TOK) do { ELQ = *(const u32x4*)(PL + (size_t)(TOK) * 512 + 16 * e8 + 4 * (lane & 3)); } while (0)
#define EL_GET(ELQ, i) ((i) >> 2) == 0 ? quad_bcast<0>(ELQ[(i) & 3]) : ((i) >> 2) == 1 ? quad_bcast<1>(ELQ[(i) & 3]) : ((i) >> 2) == 2 ? quad_bcast<2>(ELQ[(i) & 3]) : quad_bcast<3>(ELQ[(i) & 3])
#ifdef CPU_EMU
__device__ __forceinline__ float fmerge_bit2(float a, float b) { const bool hi = (threadIdx.x >> 2) & 1; const float k = hi ? b : a, t = hi ? a : b; return k + __shfl_xor(t, 7); }
__device__ __forceinline__ float fmerge_bit1(float a, float b, int lane) { const bool hi = (lane >> 1) & 1; const float k = hi ? b : a, t = hi ? a : b; return k + __shfl_xor(t, 2); }
__device__ __forceinline__ float fmerge_bit0(float a, float b, int lane) { const bool hi = lane & 1; const float k = hi ? b : a, t = hi ? a : b; return k + __shfl_xor(t, 1); }
#else
__device__ __forceinline__ float fmerge_bit2(float a, float b) {
    const int x = __builtin_amdgcn_update_dpp(__builtin_bit_cast(int, b), __builtin_bit_cast(int, a), 0x141, 0xF, 0x5, false), y = __builtin_amdgcn_update_dpp(__builtin_bit_cast(int, a), __builtin_bit_cast(int, b), 0x141, 0xF, 0xA, false);
    return __builtin_bit_cast(float, x) + __builtin_bit_cast(float, y); }
__device__ __forceinline__ float fmerge_bit1(float a, float b, int lane) { const bool hi = (lane >> 1) & 1; const float k = hi ? b : a, t = hi ? a : b; return k + dpp_f<0x4E>(t); }
__device__ __forceinline__ float fmerge_bit0(float a, float b, int lane) { const bool hi = lane & 1; const float k = hi ? b : a, t = hi ? a : b; return k + dpp_f<0xB1>(t); }
#endif
#ifdef CPU_EMU
__device__ __forceinline__ int imerge_bit2(int a, int b) { const bool hi = (threadIdx.x >> 2) & 1; const int k = hi ? b : a, t = hi ? a : b; return k + __shfl_xor(t, 7); }
__device__ __forceinline__ int imerge_bit1(int a, int b, int lane) { const bool hi = (lane >> 1) & 1; const int k = hi ? b : a, t = hi ? a : b; return k + __shfl_xor(t, 2); }
__device__ __forceinline__ int imerge_bit0(int a, int b, int lane) { const bool hi = lane & 1; const int k = hi ? b : a, t = hi ? a : b; return k + __shfl_xor(t, 1); }
#else
__device__ __forceinline__ int imerge_bit2(int a, int b) {
    const int x = __builtin_amdgcn_update_dpp(b, a, 0x141, 0xF, 0x5, false), y = __builtin_amdgcn_update_dpp(a, b, 0x141, 0xF, 0xA, false); return x + y; }
__device__ __forceinline__ int imerge_bit1(int a, int b, int lane) { const bool hi = (lane >> 1) & 1; const int k = hi ? b : a, t = hi ? a : b; return k + __builtin_amdgcn_update_dpp(0, t, 0x4E, 0xF, 0xF, true); }
__device__ __forceinline__ int imerge_bit0(int a, int b, int lane) { const bool hi = lane & 1; const int k = hi ? b : a, t = hi ? a : b; return k + __builtin_amdgcn_update_dpp(0, t, 0xB1, 0xF, 0xF, true); }
#endif
__device__ __forceinline__ void ph_peer_a(const Args& A, Frame& F, int layer) {
    const int lane = F.lane;
    float* wsc = (float*)(F.lds + F.wave * 10240);
    const unsigned short* SC = (const unsigned short*)(A.ws + WS_SC); const bf16_t* H2 = (const bf16_t*)(A.ws + WS_H2);
    const float* US = (const float*)(A.ws + WS_US) + (size_t)layer * 16384 * 2; const float* VS = (const float*)(A.ws + WS_VS) + (size_t)layer * 16384;
    unsigned* PL = (unsigned*)(A.ws + WS_PL); unsigned char* PH = A.ws + WS_PH;
    const int ntk = layer == 3 ? BATCH * SEQ : NTOK; const int gw = F.bid * NWAVES + F.wave, NGW = F.G * NWAVES;
    const int t_beg = (int)(((long)gw * ntk) / NGW), t_end = (int)(((long)(gw + 1) * ntk) / NGW);
    for (int tg = t_beg; tg < t_end; tg += 4) {
        { const int tq = lane >> 4, li = lane & 15; const int ti = (tg + tq < t_end) ? tg + tq : t_end - 1;
          const int tokL = peer_tok(layer, ti);
          const unsigned short* src = SC + (size_t)tokL * 2048 + li * 128;
          unsigned t1[16];
#pragma unroll
          for (int k = 0; k < 16; ++k) t1[k] = 0u;
#pragma unroll 1
          for (int i = 0; i < 128; i += 8) { const u32x4 v = *(const u32x4*)(src + i);
#pragma unroll
              for (int e = 0; e < 8; ++e) { const float sv_ = (e & 1) ? hhi(v[e >> 1]) : hlo(v[e >> 1]); const float fv = fminf(fmaxf(sv_, -63.99f), 63.99f); const unsigned key = ((unsigned)((fv + 64.f) * 262144.f) << 7) | (unsigned)(i + e); TOP16_INSERT(t1, key); } }
          float v1[16], v2[16]; unsigned i1[16], i2[16];
#pragma unroll
          for (int k = 0; k < 16; ++k) { const unsigned p = lane_xor1(t1[k]); v1[k] = (float)(t1[k] >> 7) * (1.f / 262144.f) - 64.f; i1[k] = (t1[k] & 127u) << 7; v2[k] = (float)(p >> 7) * (1.f / 262144.f) - 64.f; i2[k] = p & 127u; }
          unsigned c[16];
#pragma unroll
          for (int k = 0; k < 16; ++k) c[k] = 0u;
#pragma unroll
          for (int ia = 0; ia < 16; ++ia)
#pragma unroll
              for (int ib = 0; ib < 16 / (ia + 1); ++ib) { const float sm = fminf(fmaxf(v1[ia] + v2[ib], -127.9f), 127.9f); const unsigned key = ((unsigned)((sm + 128.f) * 1024.f) << 14) | i1[ia] | i2[ib]; TOP16_INSERT(c, key); }
          if ((li & 1) == 0 && tg + tq < t_end) { float* Lb = wsc + tq * 640; int* EL = (int*)Lb; float* GL = Lb + 128; float* SUL = Lb + 256; const int hd = li >> 1;
              const float mx = (float)(c[0] >> 14) * (1.f / 1024.f); float ex[16]; float sum = 0.f;
#pragma unroll
              for (int k = 0; k < 16; ++k) { ex[k] = __expf((float)(c[k] >> 14) * (1.f / 1024.f) - mx); sum += ex[k]; }
              const float inv = 1.f / sum;
#pragma unroll
              for (int k = 0; k < 16; ++k) { const int e = (int)(c[k] & 16383u); EL[hd * 16 + k] = e; GL[hd * 16 + k] = ex[k] * inv * VS[e]; SUL[hd * 16 + k] = US[2 * e]; } }
          wave_sync(); }
        for (int tq = 0; tq < 4 && tg + tq < t_end; ++tq) { const int tok = peer_tok(layer, tg + tq); const unsigned* Lb = (const unsigned*)(wsc + tq * 640);
            const Row16 hv = ld_row_bf16(H2 + (size_t)tok * DM, lane);
#pragma unroll
            for (int a = 0; a < 3; ++a)
#pragma unroll
                for (int r = 0; r < 2; ++r) { const int p = 64 * r + lane; PL[(size_t)tok * 512 + a * 128 + p] = Lb[a * 128 + (p & 7) * 16 + (p >> 3)]; }
            float amax = 0.f;
#pragma unroll
            for (int e = 0; e < 16; ++e) amax = fmaxf(amax, fabsf(hv.v[e]));
            const float shc = amax * (1.f / 127.f), inv1 = amax > 0.f ? 127.f / amax : 0.f;
            u32x4 h1w;
#pragma unroll
            for (int k = 0; k < 4; ++k) { unsigned w1 = 0u;
#pragma unroll
                for (int e = 0; e < 4; ++e) w1 |= ((unsigned)(int)rintf(hv.v[4 * k + e] * inv1) & 255u) << (8 * e);
                h1w[k] = w1; }
            *(u32x4*)(PH + (size_t)tok * 2048 + 16 * lane) = h1w; *(float*)(PH + (size_t)tok * 2048 + 1024 + 4 * lane) = shc; }
        wave_sync();
    }
}
struct PeerSlice { int s0, sstep, t_beg, t_end; };
__device__ __forceinline__ PeerSlice peer_slice(const Args& A, const Frame& F, int layer) {
    int m = F.G < 8 ? F.G : 8, r = F.bid % m, rank = F.bid / m, nrank = (F.G - 1 - r) / m + 1;
#ifndef CPU_EMU
    if (A.ph_hi - A.ph_lo > 1) { const unsigned* bar = (const unsigned*)(A.ws + WS_CTL) + 1024; bool ok = true; unsigned tot = 0u;
#pragma unroll
        for (int j = 0; j < 16; ++j) { const unsigned cj = __hip_atomic_load(&bar[256 + 64 * j], __ATOMIC_RELAXED, __HIP_MEMORY_SCOPE_AGENT); tot += cj; ok = ok && ((j < 8) == (cj > 0u)); }
        const volatile __attribute__((address_space(3))) unsigned* st = (const volatile __attribute__((address_space(3))) unsigned*)((__attribute__((address_space(3))) unsigned char*)F.lds + 131072) + 8;
        if (ok && tot == (unsigned)F.G) { const int x = rfl((int)st[3]); m = 8; r = x; rank = rfl((int)st[2]); nrank = rfl((int)__hip_atomic_load(&bar[256 + 64 * x], __ATOMIC_RELAXED, __HIP_MEMORY_SCOPE_AGENT)); } }
#endif
    const int ntk = layer == 3 ? BATCH * SEQ : NTOK, wi = rank * NWAVES + F.wave, nws = nrank * NWAVES;
    PeerSlice P; P.s0 = r; P.sstep = m; P.t_beg = (int)(((long)wi * ntk) / nws); P.t_end = (int)(((long)(wi + 1) * ntk) / nws); return P;
}
__device__ __forceinline__ void ph_peer_u(const Args& A, Frame& F, int layer) {
    const int lane = F.lane, e8 = lane >> 3, c = lane & 7; const PeerSlice P = peer_slice(A, F, layer);
    const unsigned* PL = (const unsigned*)(A.ws + WS_PL); const unsigned char* PH = A.ws + WS_PH; float* PD = (float*)(A.ws + WS_PD);
    const int kx = (lane & 1) * 4 + ((lane >> 1) & 1) * 2 + ((lane >> 2) & 1);
#define PU_LISTS(EL, H1, HS, TOK) do { H1 = *(const u32x4*)(PH + (size_t)(TOK) * 2048 + hoff); HS = *(const float*)(PH + (size_t)(TOK) * 2048 + 1024 + soff); \
        EL_LOAD(EL, TOK); } while (0)
#define PU_ROWS(Q, EL) do { _Pragma("unroll") for (int i = 0; i < 16; ++i) { const unsigned e_ = EL_GET(EL, i); Q[i] = *(const u32x4*)(UTs + (e_ * 128u + c16)); } } while (0)
#define PU_COMP(Q, C1, HS, TOK) do { float d[16]; \
        _Pragma("unroll") for (int i = 0; i < 16; ++i) { int d1 = 0; \
            _Pragma("unroll") for (int j = 0; j < 4; ++j) d1 = sdot4(Q[i][j], C1[j], d1); \
            d[i] = (float)d1 * HS; } \
        float m_[8], n_[4]; \
        _Pragma("unroll") for (int j = 0; j < 8; ++j) m_[j] = fmerge_bit2(d[2 * j], d[2 * j + 1]); \
        _Pragma("unroll") for (int j = 0; j < 4; ++j) n_[j] = fmerge_bit1(m_[2 * j], m_[2 * j + 1], lane); \
        const float p0_ = fmerge_bit0(n_[0], n_[1], lane), p1_ = fmerge_bit0(n_[2], n_[3], lane); \
        *(h16x2*)((_Float16*)PD + ((size_t)(TOK) * 8 + s) * 128 + 16 * e8 + 2 * kx) = pk_h2(p0_ * (1.f / 64.f), p1_ * (1.f / 64.f)); } while (0)
    for (int s = P.s0; s < 8; s += P.sstep) {
        const unsigned char* UTs = A.ws + WS_UT + (size_t)layer * 16384 * 1024 + (size_t)s * 16384 * 128; const unsigned c16 = 16u * (unsigned)c;
        const unsigned hoff = (unsigned)(128 * s + 16 * c), soff = (unsigned)(4 * (8 * s + c));
        if (P.t_beg >= P.t_end) continue;
        u32x4 ela, elb, ha1, hb1, qa[16], qb[16]; float ha2 = 0.f, hb2 = 0.f;
        int toka = peer_tok(layer, P.t_beg), tokb = toka;
        PU_LISTS(ela, ha1, ha2, toka); PU_ROWS(qa, ela);
        if (P.t_beg + 1 < P.t_end) { tokb = peer_tok(layer, P.t_beg + 1); PU_LISTS(elb, hb1, hb2, tokb); }
#pragma unroll 1
        for (int ti = P.t_beg; ti < P.t_end; ti += 2) {
            { if (ti + 1 < P.t_end) PU_ROWS(qb, elb);
              const int tc = toka; const u32x4 c1 = ha1; const float c2 = ha2;
              if (ti + 2 < P.t_end) { toka = peer_tok(layer, ti + 2); PU_LISTS(ela, ha1, ha2, toka); }
              PU_COMP(qa, c1, c2, tc); }
            if (ti + 1 >= P.t_end) break;
            { if (ti + 2 < P.t_end) PU_ROWS(qa, ela);
              const int tc = tokb; const u32x4 c1 = hb1; const float c2 = hb2;
              if (ti + 3 < P.t_end) { tokb = peer_tok(layer, ti + 3); PU_LISTS(elb, hb1, hb2, tokb); }
              PU_COMP(qb, c1, c2, tc); }
        }
    }
#undef PU_LISTS
#undef PU_ROWS
#undef PU_COMP
}
__device__ __forceinline__ void ph_peer_w(const Args& A, Frame& F, int layer) {
    const int lane = F.lane; const unsigned* PL = (const unsigned*)(A.ws + WS_PL); const float* PD = (const float*)(A.ws + WS_PD);
    unsigned char* PWB = A.ws + WS_PW; float* PWS = (float*)(A.ws + WS_PWS);
    const int ntk = layer == 3 ? BATCH * SEQ : NTOK; const int gw = F.bid * NWAVES + F.wave, NGW = F.G * NWAVES;
    const int t_beg = (int)(((long)gw * ntk) / NGW), t_end = (int)(((long)(gw + 1) * ntk) / NGW);
#pragma unroll 2
    for (int ti = t_beg; ti < t_end; ++ti) { const int tok = peer_tok(layer, ti); const int p0 = 16 * (lane >> 3) + (lane & 7);
        const _Float16* pd = (const _Float16*)PD + (size_t)tok * 1024 + 16 * (lane >> 3) + 2 * (lane & 7); const float* pl = (const float*)(PL + (size_t)tok * 512) + p0;
        float d0 = 0.f, d1 = 0.f;
#pragma unroll
        for (int s = 0; s < 8; ++s) { const unsigned w2 = *(const unsigned*)(pd + s * 128); d0 += hlo(w2); d1 += hhi(w2); }
        d0 *= 64.f; d1 *= 64.f;
        const float w0 = pl[128] * gelu_tanh(d0 * pl[256]), w1 = pl[128 + 8] * gelu_tanh(d1 * pl[256 + 8]);
        const float wmax = wave_max(fmaxf(fabsf(w0), fabsf(w1))); const float wsc = wmax * (1.f / 16256.f), winv = wmax > 0.f ? 16256.f / wmax : 0.f;
        const int q0 = (int)rintf(w0 * winv), q1 = (int)rintf(w1 * winv); const int h0 = q0 >> 7, h1 = q1 >> 7;
        unsigned char* pw = PWB + (size_t)tok * 256 + p0;
        pw[0] = (unsigned char)(h0 & 255); pw[8] = (unsigned char)(h1 & 255); pw[128] = (unsigned char)(q0 - h0 * 128); pw[136] = (unsigned char)(q1 - h1 * 128);
        if (lane == 0) PWS[tok] = wsc; }
}
__device__ __forceinline__ void ph_peer_v(const Args& A, Frame& F, int layer) {
    const int lane = F.lane, e8 = lane >> 3, c = lane & 7; const PeerSlice P = peer_slice(A, F, layer);
    const unsigned* PL = (const unsigned*)(A.ws + WS_PL); const unsigned char* PWB = A.ws + WS_PW; const float* PWS = (const float*)(A.ws + WS_PWS); _Float16* PO = (_Float16*)(A.ws + WS_PO);
    const unsigned c16 = 16u * (unsigned)c;
    const int am = lane & 15, aterm = am & 1, acb = ((am >> 1) & 1) + 2 * (am >> 3), apar = (am >> 2) & 1;
    const unsigned aoff = (unsigned)(aterm * 128 + 16 * (2 * (lane >> 4) + apar));
    unsigned asel[4];
#pragma unroll
    for (int sl = 0; sl < 4; ++sl) asel[sl] = 0x0C0C0C0Cu ^ ((0x0Cu ^ (unsigned)sl) << (8 * acb));
    for (int s = P.s0; s < 8; s += P.sstep) {
        const unsigned char* VTs = A.ws + WS_VT + (size_t)layer * 16384 * 1024 + (size_t)s * 16384 * 128;
        if (P.t_beg >= P.t_end) continue;
        int tok = peer_tok(layer, P.t_beg);
        u32x4 el; EL_LOAD(el, tok);
        u32x4 wa = *(const u32x4*)(PWB + (size_t)tok * 256 + aoff); float wsc = PWS[tok];
#pragma unroll 1
        for (int ti = P.t_beg; ti < P.t_end; ++ti) {
            u32x4 q[16];
#pragma unroll
            for (int i = 0; i < 16; ++i) { const unsigned e_ = EL_GET(el, i); q[i] = *(const u32x4*)(VTs + (e_ * 128u + c16)); }
            const int tokc = tok; const u32x4 wc = wa; const float wsc_c = wsc;
            if (ti + 1 < P.t_end) { tok = peer_tok(layer, ti + 1); EL_LOAD(el, tok);
                wa = *(const u32x4*)(PWB + (size_t)tok * 256 + aoff); wsc = PWS[tok]; }
            i32x4 acc[4];
#pragma unroll
            for (int d = 0; d < 4; ++d) acc[d] = (i32x4){0, 0, 0, 0};
#pragma unroll
            for (int j = 0; j < 4; ++j) { i32x4 aj;
#pragma unroll
                for (int sl = 0; sl < 4; ++sl) aj[sl] = (int)bperm(0u, wc[j], asel[sl]);
#pragma unroll
                for (int d = 0; d < 4; ++d) { const i32x4 bj = {(int)q[4 * j][d], (int)q[4 * j + 1][d], (int)q[4 * j + 2][d], (int)q[4 * j + 3][d]}; acc[d] = mfma_i8(aj, bj, acc[d]); } }
            int o[8];
#pragma unroll
            for (int d = 0; d < 4; ++d)
#pragma unroll
                for (int cl = 0; cl < 2; ++cl) { const int w_ = acc[d][2 * cl] * 128 + acc[d][2 * cl + 1]; int x0, x1; lane_pair16(w_, x0, x1); o[2 * d + cl] = x0 + ror8_i(x1); }
            if ((lane & 0x18) == 0) { _Float16* dst = PO + (size_t)tokc * 1024 + 128 * s + 16 * c + 2 * (lane >> 5);
#pragma unroll
                for (int d = 0; d < 4; ++d) *(h16x2*)(dst + 4 * d) = pk_h2((float)o[2 * d] * wsc_c, (float)o[2 * d + 1] * wsc_c); }
        }
    }
}
__device__ __forceinline__ void ph_peer_e(const Args& A, Frame& F, int layer, bool dry = false) {
    const int lane = F.lane; bf16_t* X = (bf16_t*)(A.ws + WS_X); bf16_t* H = (bf16_t*)(A.ws + WS_H); const float* PO = (const float*)(A.ws + WS_PO); const float* PWS = (const float*)(A.ws + WS_PWS);
    const int ntk = layer == 3 ? BATCH * SEQ : NTOK; const int gw = F.bid * NWAVES + F.wave, NGW = F.G * NWAVES;
    const int t_beg = (int)(((long)gw * ntk) / NGW), t_end = (int)(((long)(gw + 1) * ntk) / NGW);
    const Row16 lg = ld_row_f32(A.in[6] + (size_t)(layer * 2 + 1) * DM, lane), lb = ld_row_f32(A.in[7] + (size_t)(layer * 2 + 1) * DM, lane);
    Row16 g2, sh, scl; int cls = -1;
    auto setcls = [&](int tok) { const int c_ = (tok / LTOK) * 2 + ((tok % LTOK) < CTXL); if (c_ != cls) { cls = c_; g2 = ld_row_f32(mod_row(A, layer, tok) + 5120, lane);
            if (layer < 3) { const float* modn = mod_row(A, layer + 1, tok); sh = ld_row_f32(modn, lane); scl = ld_row_f32(modn + 1024, lane); } } };
    auto ldpo = [&](int tok) { const _Float16* po = (const _Float16*)PO + (size_t)tok * 1024 + 16 * lane; const u32x4 o0 = *(const u32x4*)po, o1 = *(const u32x4*)(po + 8); Row16 out;
#pragma unroll
        for (int e = 0; e < 4; ++e) { out.v[2 * e] = hlo(o0[e]); out.v[2 * e + 1] = hhi(o0[e]); out.v[8 + 2 * e] = hlo(o1[e]); out.v[8 + 2 * e + 1] = hhi(o1[e]); }
        return out; };
    auto finish = [&](int tok, const Row16& x1, const Row16& out) { const int b = tok / LTOK, p = tok - b * LTOK; Row16 v;
#pragma unroll
        for (int e = 0; e < 16; ++e) v.v[e] = DN_ALPHA * x1.v[e] + g2.v[e] * out.v[e];
        const LnStat st = ln_stats(v); Row16 x2;
#pragma unroll
        for (int e = 0; e < 16; ++e) x2.v[e] = (v.v[e] - st.mean) * st.rstd * lg.v[e] + lb.v[e];
        if (dry) { if (x2.v[0] == 12345.678f) st_row_f32((float*)(A.ws + WS_OUT) + (size_t)tok * DM, lane, x2); return; }
        if (layer < 3) { st_row_bf16(X + (size_t)tok * DM, lane, x2); Row16 hn;
#pragma unroll
            for (int e = 0; e < 16; ++e) hn.v[e] = x2.v[e] * (1.f + scl.v[e]) + sh.v[e];
            st_row_bf16(H + (size_t)tok * DM, lane, hn);
        } else { st_row_f32(A.out + ((size_t)b * SEQ + (p - CTXL)) * DM, lane, x2); } };
    for (int ti = t_beg; ti < t_end; ti += 2) { const int tokA = peer_tok(layer, ti); const bool two = ti + 1 < t_end; const int tokB = two ? peer_tok(layer, ti + 1) : tokA;
        const Row16 oA = ldpo(tokA), xA = ld_row_bf16(X + (size_t)tokA * DM, lane), oB = ldpo(tokB), xB = ld_row_bf16(X + (size_t)tokB * DM, lane);
        setcls(tokA); finish(tokA, xA, oA);
        if (two) { setcls(tokB); finish(tokB, xB, oB); } }
}

constexpr int NPHASE = 45;
constexpr int PH_ORDER[NPHASE] = {0, 1, 2, 3, 4, 5, 6, 29, 30, 31, 32, 7, 8, 9, 10, 11, 12, 13, 14, 33, 34, 35, 36, 15, 16, 17, 18, 19, 20, 21, 37, 38, 39, 40, 22, 23, 24, 25, 26, 27, 41, 42, 43, 44, 28};
__device__ __forceinline__ void gemm_f32(const Args& A, Frame& F, const bf16_t* Am, int lda, const bf16_t* Bt, int ldb, int N, int K, float* O, int ldc, bool lat = false) {
    pg8::Gemm g{Am, Bt, NTOK, N, K, lda, ldb}; pg8::StaticOrder S; S.init(NTOK, N, F.G, F.bid, lat); EpiF32 E{O, ldc};
    pg8::gemm_phase<EpiF32, pg8::StaticOrder, PG8_ALIGN, PG8_SP2>(GEMM_LDS(F), g, S, E, F.wave);
}
__device__ __forceinline__ void gemm_b16(const Args& A, Frame& F, const bf16_t* Am, int lda, const bf16_t* Bt, int ldb, int N, int K, bf16_t* O, int ldc) {
    pg8::Gemm g{Am, Bt, NTOK, N, K, lda, ldb}; pg8::StaticOrder S; S.init(NTOK, N, F.G, F.bid); EpiB16 E{O, ldc};
    pg8::gemm_phase<EpiB16, pg8::StaticOrder, PG8_ALIGN, PG8_SP2>(GEMM_LDS(F), g, S, E, F.wave);
}
__device__ __forceinline__ void run_phase(const Args& A, Frame& F, int ph, bool dry = false) {
    unsigned char* ws = A.ws;
    switch (ph) {
    case 0: ph_prep(A, F); break;
    case 1: ph_init(A, F); break;
    case 2: case 23: ph_s5_scan(A, F, ph == 2 ? 0 : 1); break;
    case 3: case 24: ph_s5_combine(A, F, ph == 3 ? 0 : 1); break;
    case 4: case 25: { const int j = ph == 4 ? 0 : 1;
        pg8::Gemm g{(const bf16_t*)(ws + WS_G), (const bf16_t*)(ws + WS_WGLU) + (size_t)j * 2048 * 1024, NTOK, 2048, 1024, 1024, 1024}; pg8::StaticOrder S; S.init(NTOK, 2048, F.G, F.bid, j == 1); EpiGlu E{(bf16_t*)(ws + WS_OUT)};
        pg8::gemm_phase<EpiGlu, pg8::StaticOrder, PG8_ALIGN, PG8_SP2>(GEMM_LDS(F), g, S, E, F.wave); } break;
    case 5: ph_rowop(A, F, 0, dry); break;
    case 13: ph_rowop(A, F, 1, dry); break;
    case 20: ph_rowop(A, F, 2, dry); break;
    case 26: ph_rowop(A, F, 3, dry); break;
    case 6: case 14: case 21: case 27: { const int layer = ph == 6 ? 0 : ph == 14 ? 1 : ph == 21 ? 2 : 3;
        pg8::Gemm g{(const bf16_t*)(ws + WS_H2), (const bf16_t*)(ws + WS_WSC) + (size_t)layer * 2048 * 1024, NTOK, 2048, 1024, 1024, 1024}; pg8::StaticOrder S; S.init(NTOK, 2048, F.G, F.bid, layer == 3);
        EpiH16 E{(unsigned short*)(ws + WS_SC), 2048};
        pg8::gemm_phase<EpiH16, pg8::StaticOrder, PG8_ALIGN, PG8_SP2>(GEMM_LDS(F), g, S, E, F.wave); } break;
    case 7: ph_peer_e(A, F, 0, dry); break;
    case 15: ph_peer_e(A, F, 1, dry); break;
    case 22: ph_peer_e(A, F, 2, dry); break;
    case 28: ph_peer_e(A, F, 3, dry); break;
    case 29: case 33: case 37: case 41: ph_peer_a(A, F, (ph - 29) >> 2); break;
    case 30: case 34: case 38: case 42: ph_peer_u(A, F, (ph - 29) >> 2); break;
    case 31: case 35: case 39: case 43: ph_peer_w(A, F, (ph - 29) >> 2); break;
    case 32: case 36: case 40: case 44: ph_peer_v(A, F, (ph - 29) >> 2); break;
    case 8: { pg8::Gemm g{(const bf16_t*)(ws + WS_H), (const bf16_t*)(ws + WS_WIN), NTOK, SSD_IN_PAD, 1024, 1024, 1024}; pg8::StaticOrder S; S.init(NTOK, SSD_IN_PAD, F.G, F.bid);
        EpiSsdIn E{(bf16_t*)(ws + WS_Z), (bf16_t*)(ws + WS_XBC), (float*)(ws + WS_DT)};
        pg8::gemm_phase<EpiSsdIn, pg8::StaticOrder, PG8_ALIGN, PG8_SP2>(GEMM_LDS(F), g, S, E, F.wave); } break;
    case 9: ph_ssd_conv(A, F); break;
    case 10: ph_ssd_scan(A, F); break;
    case 11: ph_ssd_gate(A, F); break;
    case 12: gemm_b16(A, F, (const bf16_t*)(ws + WS_G2), 2048, (const bf16_t*)(ws + WS_WOUT), 2048, 1024, 2048, (bf16_t*)(ws + WS_OUT), 1024); break;
    case 16: { pg8::Gemm g{(const bf16_t*)(ws + WS_H), (const bf16_t*)(ws + WS_WDOWN), NTOK, 512, 1024, 1024, 1024}; pg8::StaticOrder S; S.init(NTOK, 512, F.G, F.bid);
        EpiMlaDown E{(bf16_t*)(ws + WS_CQKV), (float*)(ws + WS_RS)};
        pg8::gemm_phase<EpiMlaDown, pg8::StaticOrder, PG8_ALIGN, PG8_SP2>(GEMM_LDS(F), g, S, E, F.wave); } break;
    case 17: { mla_kr(A, F); __syncthreads();
        pg8::Gemm g{(const bf16_t*)(ws + WS_CQKV), (const bf16_t*)(ws + WS_WUP), NTOK, 4096, 384, 512, 384}; pg8::StaticOrder S; S.init(NTOK, 4096, F.G, F.bid);
        EpiMlaUp E{(bf16_t*)(ws + WS_Q), (bf16_t*)(ws + WS_K), (bf16_t*)(ws + WS_V), (const float*)(ws + WS_RS)};
        pg8::gemm_phase<EpiMlaUp, pg8::StaticOrder, PG8_ALIGN, PG8_SP2>(GEMM_LDS(F), g, S, E, F.wave); } break;
    case 18: ph_attn(A, F); break;
    case 19: gemm_b16(A, F, (const bf16_t*)(ws + WS_O), 1024, (const bf16_t*)(ws + WS_WO), 1024, 1024, 1024, (bf16_t*)(ws + WS_OUT), 1024); break;
    default: break;
    }
}

#ifndef CPU_EMU
#define LAS __attribute__((address_space(3)))
#define XB_TMO      128
#define XB_XCNT(j)  (256  + 64 * (j))
#define XB_XSUB(j)  (1280 + 64 * (j))
#define XB_XGEN(j)  (2304 + 64 * (j))
#define XB_TOP      3328
#define XB_TOPGEN   3392
#define XCD_BAR_WORDS 3456
#define XB_SPIN_CAP (1u << 22)
__device__ __forceinline__ unsigned xb_ld(unsigned* p)              { return __hip_atomic_load(p, __ATOMIC_RELAXED, __HIP_MEMORY_SCOPE_AGENT); }
__device__ __forceinline__ unsigned xb_add(unsigned* p, unsigned v) { return __hip_atomic_fetch_add(p, v, __ATOMIC_RELAXED, __HIP_MEMORY_SCOPE_AGENT); }
__device__ __forceinline__ unsigned xb_xcc_id() { return (unsigned)__builtin_amdgcn_s_getreg((3 << 11) | 20) & 0xFu; }
#define XB_SPIN(cond, bar) do { unsigned _sp = 0; while (cond) { __builtin_amdgcn_s_sleep(1); \
    if ((++_sp & 255u) == 0u) { if (xb_ld(&(bar)[XB_TMO])) break; if (_sp > XB_SPIN_CAP) { atomicAdd(&(bar)[XB_TMO], 1u); break; } } } } while (0)
struct XcdBarrier { unsigned* bar; unsigned x; volatile LAS unsigned* st; };
__device__ __forceinline__ XcdBarrier xcd_barrier_post(unsigned* bar, volatile LAS unsigned* st) {
    XcdBarrier b; b.bar = bar; b.x = xb_xcc_id(); b.st = st;
    if (threadIdx.x == 0) { st[2] = xb_add(&bar[XB_XCNT(b.x)], 1u); st[3] = b.x; }
    return b;
}
__device__ __forceinline__ void xcd_barrier_complete(unsigned* bar, unsigned x, unsigned& nloc, unsigned& nx) {
    const unsigned G = gridDim.x * gridDim.y * gridDim.z;
    unsigned sum, cnt, mine, sp = 0u;
    for (;;) {
        sum = 0u; cnt = 0u; mine = 0u;
#pragma unroll
        for (unsigned j = 0; j < 16; ++j) { const unsigned c = xb_ld(&bar[XB_XCNT(j)]); sum += c; cnt += (c > 0u) ? 1u : 0u; mine = (j == x) ? c : mine; }
        if (sum == G) break;
        __builtin_amdgcn_s_sleep(1);
        if ((++sp & 255u) == 0u) { if (xb_ld(&bar[XB_TMO])) break; if (sp > XB_SPIN_CAP) { atomicAdd(&bar[XB_TMO], 1u); break; } }
    }
    nloc = mine > 0u ? mine : 1u; nx = cnt > 0u ? cnt : 1u;
}
__device__ __forceinline__ void xcd_barrier(const XcdBarrier& b, int wave_s) {
    asm volatile("s_waitcnt vmcnt(0)" ::: "memory");
    __syncthreads();
    if (wave_s == 0 && hw_lane() == 0) {
        unsigned* bar = b.bar;
        __builtin_amdgcn_s_waitcnt(0);
        unsigned nloc = b.st[0], nx = b.st[1];
        if (nloc == 0u) { xcd_barrier_complete(bar, b.x, nloc, nx); b.st[0] = nloc; b.st[1] = nx; }
        const unsigned old = xb_add(&bar[XB_XSUB(b.x)], 1u);
        const unsigned gen = old / nloc;
        if (old + 1u == (gen + 1u) * nloc) {
            __builtin_amdgcn_fence(__ATOMIC_RELEASE, "agent");
            asm volatile("s_waitcnt vmcnt(0)" ::: "memory");
            const unsigned og = xb_add(&bar[XB_TOP], 1u);
            const unsigned tg = og / nx;
            if (og + 1u == (tg + 1u) * nx) xb_add(&bar[XB_TOPGEN], 1u);
            else XB_SPIN(xb_ld(&bar[XB_TOPGEN]) == tg, bar);
            __builtin_amdgcn_fence(__ATOMIC_ACQUIRE, "agent");
            xb_add(&bar[XB_XGEN(b.x)], 1u);
            asm volatile("s_waitcnt vmcnt(0)" ::: "memory");
        } else {
            XB_SPIN(xb_ld(&bar[XB_XGEN(b.x)]) == gen, bar);
            __builtin_amdgcn_fence(__ATOMIC_ACQUIRE, "agent");
            asm volatile("s_waitcnt vmcnt(0)" ::: "memory");
        }
    }
    __syncthreads();
}

constexpr int LDS_BYTES = 147456;
constexpr int LDSCTL_OFF = 131072;
__device__ __forceinline__ Frame mk_frame(unsigned char* lds, int wave_s) {
    int l = hw_lane(); asm volatile("" : "+v"(l));
    Frame F; F.lds = lds; F.lane = l; F.wave = wave_s; F.tid = wave_s * 64 + l; F.G = gridDim.x; F.bid = blockIdx.x; return F;
}
__device__ __forceinline__ void grid_bar(unsigned char* ws, unsigned char* lds, int wave_s) {
    XcdBarrier bar; bar.bar = (unsigned*)(ws + WS_CTL) + 1024; bar.x = xb_xcc_id(); bar.st = (volatile LAS unsigned*)((LAS unsigned char*)lds + LDSCTL_OFF) + 8;
    xcd_barrier(bar, wave_s);
}
__global__ void __launch_bounds__(NTHR, 2) hybrid_fwd(Args args) {
    extern __shared__ __attribute__((aligned(16))) unsigned char lds[];
    const int wave_s = __builtin_amdgcn_readfirstlane((int)threadIdx.x >> 6);
    { volatile LAS unsigned* MISC = (volatile LAS unsigned*)((LAS unsigned char*)lds + LDSCTL_OFF);
      if (wave_s == 0) MISC[hw_lane()] = 0u;
      __syncthreads();
      if (args.ph_hi - args.ph_lo > 1) (void)xcd_barrier_post((unsigned*)(args.ws + WS_CTL) + 1024, MISC + 8); }
    const int lo = args.ph_lo, hi = args.ph_hi;
    if (PROBE && blockIdx.x == 0 && wave_s == 0 && hw_lane() == 0) { ((unsigned long long*)(args.ws + WS_TS))[0] = __builtin_amdgcn_s_memrealtime(); ((unsigned long long*)(args.ws + WS_TS))[40] = 0ull; ((unsigned long long*)(args.ws + WS_TS))[41] = 0ull; }
#define PHASE(k, id) if (lo <= (k) && (k) < hi) { if ((DUPMASK >> (k)) & 1ull) { Frame F = mk_frame(lds, wave_s); run_phase(args, F, (id), true); grid_bar(args.ws, lds, wave_s); } { Frame F = mk_frame(lds, wave_s); run_phase(args, F, (id)); } if ((k) + 1 < hi) { if (USE_CG && (k) == 0) cg::this_grid().sync(); grid_bar(args.ws, lds, wave_s); } }
    PHASE(0, 0) PHASE(1, 1) PHASE(2, 2) PHASE(3, 3) PHASE(4, 4) PHASE(5, 5) PHASE(6, 6) PHASE(7, 29) PHASE(8, 30) PHASE(9, 31) PHASE(10, 32) PHASE(11, 7)
    PHASE(12, 8) PHASE(13, 9) PHASE(14, 10) PHASE(15, 11) PHASE(16, 12) PHASE(17, 13) PHASE(18, 14) PHASE(19, 33) PHASE(20, 34) PHASE(21, 35) PHASE(22, 36) PHASE(23, 15)
    PHASE(24, 16) PHASE(25, 17) PHASE(26, 18) PHASE(27, 19) PHASE(28, 20) PHASE(29, 21) PHASE(30, 37) PHASE(31, 38) PHASE(32, 39) PHASE(33, 40) PHASE(34, 22)
    PHASE(35, 23) PHASE(36, 24) PHASE(37, 25) PHASE(38, 26) PHASE(39, 27) PHASE(40, 41) PHASE(41, 42) PHASE(42, 43) PHASE(43, 44) PHASE(44, 28)
#undef PHASE
}

extern "C" void kernel_launch(void* const* d_in, const int* in_sizes, int n_in, void* d_out, int out_size, void* d_ws, size_t ws_size, hipStream_t stream) {
    static int grid = 0;
    if (grid == 0) {
        if (n_in != 37 || ws_size < WS_END) { fprintf(stderr, "kernel_launch: unexpected n_in %d / ws %zu\n", n_in, ws_size); grid = -1; return; }
        int dev = 0, cus = 0, per_cu = 0;
        hipGetDevice(&dev); hipDeviceGetAttribute(&cus, hipDeviceAttributeMultiprocessorCount, dev);
        hipFuncSetAttribute((const void*)hybrid_fwd, hipFuncAttributeMaxDynamicSharedMemorySize, LDS_BYTES);
        hipOccupancyMaxActiveBlocksPerMultiprocessor(&per_cu, (const void*)hybrid_fwd, NTHR, LDS_BYTES);
        (void)hipGetLastError();
        if (per_cu < 1) { fprintf(stderr, "kernel_launch: occupancy query says %d blocks/CU\n", per_cu); per_cu = 1; }
        grid = cus;
    }
    if (grid < 0) return;
    hipMemsetAsync((char*)d_ws + WS_CTL, 0, CTL_ZERO_BYTES, stream);
    Args a{};
    for (int i = 0; i < 37; ++i) a.in[i] = (const float*)d_in[i];
    a.out = (float*)d_out; a.ws = (unsigned char*)d_ws; a.ph_lo = 0; a.ph_hi = NPHASE;
#if USE_CG
    void* kargs[] = {&a};
    hipError_t e = hipLaunchCooperativeKernel((const void*)hybrid_fwd, dim3(grid), dim3(NTHR), kargs, LDS_BYTES, stream);
    if (e != hipSuccess) fprintf(stderr, "cooperative launch failed: %s (grid %d)\n", hipGetErrorString(e), grid);
#else
    hipLaunchKernelGGL(hybrid_fwd, dim3(grid), dim3(NTHR), LDS_BYTES, stream, a);
    const hipError_t e = hipPeekAtLastError();
    if (e != hipSuccess) fprintf(stderr, "launch failed: %s (grid %d)\n", hipGetErrorString(e), grid);
#endif
}
#endif
```

```cpp
#ifndef CPU_EMU
#include <hip/hip_runtime.h>
#include <hip/hip_cooperative_groups.h>
#include <cstdio>
#include <cstdint>
#include <cmath>
namespace cg = cooperative_groups;
#endif

#ifndef BATCH
#define BATCH 4
#endif
#ifndef SEQ
#define SEQ 4096
#endif
#ifndef CTXL
#define CTXL 256
#endif
constexpr int DM = 1024, LTOK = CTXL + SEQ, NTOK = BATCH * LTOK, NR = BATCH + 1;
constexpr int NTHR = 512, NWAVES = 8;
static_assert(NTOK % 256 == 0 && SEQ % 256 == 0 && CTXL % 256 == 0 && LTOK % 32 == 0, "shape");
constexpr float DN_ALPHA = 1.6817928305074290f;
constexpr int SSD_IN = 5184, SSD_IN_PAD = 5376;

typedef unsigned short bf16_t;
typedef short bf16x8 __attribute__((ext_vector_type(8)));
typedef float f32x2 __attribute__((ext_vector_type(2)));
typedef float f32x4 __attribute__((ext_vector_type(4)));
typedef float f32x16 __attribute__((ext_vector_type(16)));
typedef unsigned u32x2 __attribute__((ext_vector_type(2)));
typedef unsigned u32x4 __attribute__((ext_vector_type(4)));

constexpr size_t MiB = 1u << 20;
constexpr size_t WS_CTL = 0, CTL_ZERO_BYTES = 64 * 1024;
constexpr size_t WS_MOD = 1 * MiB;
constexpr size_t WS_ROPE = WS_MOD + 768 * 1024;
constexpr size_t WS_S5C = 2 * MiB;
constexpr size_t S5C_ITEM = 12800;
constexpr size_t WS_WGLU = 6 * MiB;
constexpr size_t WS_WIN = 14 * MiB;
constexpr size_t WS_WOUT = 25 * MiB;
constexpr size_t WS_WDOWN = 29 * MiB;
constexpr size_t WS_WUP = 30 * MiB;
constexpr size_t WS_WO = 33 * MiB;
constexpr size_t WS_WSC = 35 * MiB;
constexpr size_t WS_UT = 52 * MiB;
constexpr size_t WS_VT = 116 * MiB;
constexpr size_t WS_US = 180 * MiB;
constexpr size_t WS_VS = 181 * MiB;
constexpr size_t WS_X = 308 * MiB;
constexpr size_t WS_H = 376 * MiB;
constexpr size_t WS_H2 = 410 * MiB;
constexpr size_t WS_OUT = 444 * MiB;
constexpr size_t WS_R = 512 * MiB;
constexpr size_t WS_SC = WS_R;
constexpr size_t WS_YF = WS_R, WS_YB = WS_R + 34 * MiB, WS_G = WS_R + 68 * MiB;
constexpr size_t WS_Z = WS_R, WS_XBC = WS_R + 68 * MiB, WS_XBCC = WS_R + 170 * MiB, WS_DT = WS_R + 272 * MiB, WS_DTS = WS_R + 277 * MiB, WS_ACUM = WS_R + 420 * MiB,
                 WS_YF2 = WS_R + 282 * MiB, WS_YB2 = WS_R + 350 * MiB, WS_G2 = WS_XBC;
constexpr size_t WS_CQKV = WS_R, WS_RS = WS_R + 17 * MiB, WS_Q = WS_R + 18 * MiB, WS_K = WS_R + 86 * MiB, WS_V = WS_R + 154 * MiB, WS_O = WS_R + 188 * MiB;
constexpr size_t WS_PL = WS_R + 68 * MiB;
constexpr size_t WS_PH = WS_R + 102 * MiB;
constexpr size_t WS_PS = WS_R + 136 * MiB;
constexpr size_t WS_PD = WS_R + 137 * MiB;
constexpr size_t WS_PW = WS_R + 205 * MiB;
constexpr size_t WS_PWS = WS_R + 214 * MiB;
constexpr size_t WS_PO = WS_R + 215 * MiB;
constexpr size_t WS_END = 1024 * MiB;
constexpr size_t WS_TS = 64 * 1024;
#ifndef PROBE
#define PROBE 0
#endif
#ifndef USE_CG
#define USE_CG 1
#endif
#ifndef DUPMASK
#define DUPMASK 0ull
#endif

__device__ __forceinline__ unsigned f2bf(float f) { unsigned u = __float_as_uint(f); return (u + 0x7fffu + ((u >> 16) & 1u)) >> 16; }
#ifdef CPU_EMU
__device__ __forceinline__ unsigned pk2(float lo, float hi) { return f2bf(lo) | (f2bf(hi) << 16); }
#else
typedef __bf16 bf16x2_hw __attribute__((ext_vector_type(2)));
__device__ __forceinline__ unsigned pk2(float lo, float hi) { const f32x2 v = {lo, hi}; const bf16x2_hw b = __builtin_convertvector(v, bf16x2_hw); return __builtin_bit_cast(unsigned, b); }
#endif
__device__ __forceinline__ float bflo(unsigned w) { return __uint_as_float(w << 16); }
__device__ __forceinline__ float bfhi(unsigned w) { return __uint_as_float(w & 0xffff0000u); }
__device__ __forceinline__ float bf2f(bf16_t s) { return __uint_as_float(((unsigned)s) << 16); }
__device__ __forceinline__ float gelu_tanh(float x) { const float u = 0.7978845608028654f * (x + 0.044715f * x * x * x); const float e = __expf(2.f * u); const float t = 1.f - 2.f / (e + 1.f); return 0.5f * x * (1.f + t); }
__device__ __forceinline__ float sigmoidf_(float x) { return 1.f / (1.f + __expf(-x)); }
__device__ __forceinline__ float siluf_(float x) { return x / (1.f + __expf(-x)); }
#ifdef CPU_EMU
__device__ __forceinline__ float wave_sum(float v) {
#pragma unroll
    for (int o = 1; o < 64; o <<= 1) v += __shfl_xor(v, o);
    return v;
}
__device__ __forceinline__ float wave_max(float v) {
#pragma unroll
    for (int o = 1; o < 64; o <<= 1) v = fmaxf(v, __shfl_xor(v, o));
    return v;
}
#else
template <int CTRL> __device__ __forceinline__ float dpp_f(float v) { return __builtin_bit_cast(float, __builtin_amdgcn_update_dpp(0, __builtin_bit_cast(int, v), CTRL, 0xF, 0xF, true)); }
__device__ __forceinline__ float wave_sum(float v) {
    v += dpp_f<0xB1>(v); v += dpp_f<0x4E>(v); v += dpp_f<0x141>(v); v += dpp_f<0x140>(v);
    { auto rr = __builtin_amdgcn_permlane16_swap(__float_as_uint(v), __float_as_uint(v), false, false); v = __uint_as_float(rr[0]) + __uint_as_float(rr[1]); }
    { auto rr = __builtin_amdgcn_permlane32_swap(__float_as_uint(v), __float_as_uint(v), false, false); v = __uint_as_float(rr[0]) + __uint_as_float(rr[1]); }
    return v;
}
__device__ __forceinline__ float wave_max(float v) {
    v = fmaxf(v, dpp_f<0xB1>(v)); v = fmaxf(v, dpp_f<0x4E>(v)); v = fmaxf(v, dpp_f<0x141>(v)); v = fmaxf(v, dpp_f<0x140>(v));
    { auto rr = __builtin_amdgcn_permlane16_swap(__float_as_uint(v), __float_as_uint(v), false, false); v = fmaxf(__uint_as_float(rr[0]), __uint_as_float(rr[1])); }
    { auto rr = __builtin_amdgcn_permlane32_swap(__float_as_uint(v), __float_as_uint(v), false, false); v = fmaxf(__uint_as_float(rr[0]), __uint_as_float(rr[1])); }
    return v;
}
#endif
__device__ __forceinline__ unsigned wave_umax(unsigned v) {
#pragma unroll
    for (int o = 1; o < 64; o <<= 1) { const unsigned t = __shfl_xor(v, o); v = t > v ? t : v; }
    return v;
}
#ifdef CPU_EMU
__device__ __forceinline__ void wave_sync() { emu::wave_barrier(); }
__device__ __forceinline__ f32x16 mfma32(bf16x8 a, bf16x8 b, f32x16 c) { return emu_mfma_32x32x16_bf16(a, b, c); }
__device__ __forceinline__ int rfl(int x) { return x; }
#else
__device__ __forceinline__ void wave_sync() { asm volatile("s_waitcnt lgkmcnt(0)" ::: "memory"); }
__device__ __forceinline__ f32x16 mfma32(bf16x8 a, bf16x8 b, f32x16 c) { return __builtin_amdgcn_mfma_f32_32x32x16_bf16(a, b, c, 0, 0, 0); }
__device__ __forceinline__ int rfl(int x) { return __builtin_amdgcn_readfirstlane(x); }
#endif
typedef short s16x4 __attribute__((ext_vector_type(4)));
typedef int i32x4 __attribute__((ext_vector_type(4)));
typedef int i32x2 __attribute__((ext_vector_type(2)));
typedef _Float16 h16x2 __attribute__((ext_vector_type(2)));
__device__ __forceinline__ h16x2 pk_h2(float a, float b) { h16x2 r; r[0] = (_Float16)a; r[1] = (_Float16)b; return r; }
#ifdef CPU_EMU
#define SCHED_FENCE() do {} while (0)
#else
#define SCHED_FENCE() __builtin_amdgcn_sched_barrier(0)
#endif
#ifdef CPU_EMU
__device__ __forceinline__ i32x4 mfma_i8(i32x4 a, i32x4 b, i32x4 c) { return emu_mfma_i32_16x16x64_i8(a, b, c); }
#else
__device__ __forceinline__ i32x4 mfma_i8(i32x4 a, i32x4 b, i32x4 c) { return __builtin_amdgcn_mfma_i32_16x16x64_i8(a, b, c, 0, 0, 0); }
#endif
#ifdef CPU_EMU
__device__ __forceinline__ s16x4 lds_tr(const unsigned char* p) { return emu_ds_read_tr16_b64(p); }
#else
__device__ __forceinline__ s16x4 lds_tr(const unsigned char* p) { return __builtin_bit_cast(s16x4, __builtin_amdgcn_ds_read_tr16_b64_v4i16((__attribute__((address_space(3))) s16x4*)p)); }
#endif
#ifdef CPU_EMU
__device__ __forceinline__ int hw_lane() { return (int)(threadIdx.x & 63); }
#else
__device__ __forceinline__ int hw_lane() { return (int)__builtin_amdgcn_mbcnt_hi(~0u, __builtin_amdgcn_mbcnt_lo(~0u, 0u)); }
#endif
__device__ __forceinline__ int crow(int r, int hi) { return (r & 3) + 8 * (r >> 2) + 4 * hi; }
__device__ __forceinline__ int seqpos(int dir, int s) { return dir == 0 ? s : (s < CTXL ? CTXL - 1 - s : LTOK + CTXL - 1 - s); }

struct Args { const float* in[37]; float* out; unsigned char* ws; int ph_lo, ph_hi; };
struct Frame { unsigned char* lds; int tid, lane, wave, G, bid; };

namespace pg8 {
constexpr int BM = 256, BK = 64, HALF = 128, HTB = HALF * BK * 2, STAGE_BYTES = 8 * HTB, NXCD = 8, WGM = 8;
__host__ __device__ __forceinline__ int lds_byte(int r, int c) { const int st = (r >> 4) * 2 + (c >> 5), rr = r & 15, cc = c & 31, ob = rr * 64 + cc * 2; return st * 1024 + (ob ^ (((ob >> 9) & 1) << 5)); }
__host__ __device__ __forceinline__ void stage_rc(int b, int& R, int& C) { const int st = b / 1024, sb = b % 1024, swz = sb ^ (((sb >> 9) & 1) << 5); R = (st >> 1) * 16 + swz / 64; C = (st & 1) * 32 + (swz % 64) / 2; }
__host__ __device__ __forceinline__ int perm32(int rho) { const int n = rho >> 4, i = rho & 15; return 8 * (i >> 2) + 4 * n + (i & 3); }
struct Unit { int pm, pn; };
struct Gemm { const bf16_t* A; const bf16_t* Bt; int M, N, K, lda, ldb; };
struct StaticOrder {
    int nM, nN, nwg, G, c; bool lat;
    __host__ __device__ void init(int M, int N, int G_, int c_, bool lat_ = false) { lat = lat_; nM = lat ? BATCH * (SEQ / 256) : M / BM; nN = N / BM; nwg = nM * nN; G = G_; c = c_; }
    __host__ __device__ bool next(int i, Unit& u) const {
        const long L = (long)i * G + c; if (L >= nwg) return false;
        int wgid = (int)L; { const int q = nwg / NXCD, r = nwg % NXCD, xcd = wgid % NXCD, off = wgid / NXCD; wgid = (xcd < r ? xcd * (q + 1) : r * (q + 1) + (xcd - r) * q) + off; }
        const int nig = WGM * nN, gid = wgid / nig, fm = gid * WGM, gsz = (nM - fm) < WGM ? (nM - fm) : WGM;
        u.pm = fm + ((wgid % nig) % gsz); u.pn = (wgid % nig) / gsz;
        if (lat) u.pm = (u.pm / (SEQ / 256)) * (LTOK / 256) + CTXL / 256 + u.pm % (SEQ / 256);
        return true;
    }
};
#ifdef CPU_EMU
template <class Epi, class Sched, bool ALIGN_EPI = false, bool SP2 = false>
__device__ __forceinline__ void gemm_phase(unsigned char* lds, const Gemm g, const Sched& S, const Epi& E, int wave_s) {
    const int tid = threadIdx.x, wid = tid >> 6, lane = tid & 63, wr = wid >> 2, wc = wid & 3, fr = lane & 15, fq = lane >> 4;
    Unit u;
    for (int ui = 0; S.next(ui, u); ++ui) {
        f32x4 acc[2][2][4][2];
        for (int ai = 0; ai < 2; ++ai) for (int bj = 0; bj < 2; ++bj) for (int m = 0; m < 4; ++m) for (int n = 0; n < 2; ++n) for (int e = 0; e < 4; ++e) {
            const int row = u.pm * 256 + 128 * ai + 64 * wr + 16 * m + fr;
            const int col = u.pn * 256 + 128 * bj + 32 * wc + (Epi::PERM ? 8 * fq + 4 * n + e : 16 * n + 4 * fq + e);
            const bf16_t* a = g.A + (size_t)row * g.lda; const bf16_t* b = g.Bt + (size_t)col * g.ldb; float s = 0.f;
            for (int k = 0; k < g.K; ++k) s += bf2f(a[k]) * bf2f(b[k]);
            acc[ai][bj][m][n][e] = s;
        }
        E(acc, u, wr, wc, fr, fq);
    }
    __syncthreads();
}
#else
#define PG8_LAS __attribute__((address_space(3)))
template <class Epi, class Sched, bool ALIGN_EPI = false, bool SP2 = false>
__device__ __forceinline__ void gemm_phase(PG8_LAS unsigned char* lds, const Gemm g, const Sched& S, const Epi& E, int wave_s) {
    int lane_ = hw_lane(); asm volatile("" : "+v"(lane_));
    const int wid = wave_s, lane = lane_, tid = wid * 64 + lane, wr = wid >> 2, wc = wid & 3, fr = lane & 15, fq = lane >> 4;
    const int K = g.K, nt = K / BK;
    unsigned voffA[2], voffB[2];
#pragma unroll
    for (int i = 0; i < 2; ++i) { int R, C; stage_rc(tid * 16 + i * 8192, R, C); const int Rb = Epi::PERM ? ((R & ~31) + perm32(R & 31)) : R;
        voffA[i] = (unsigned)(R * g.lda + C) * 2u; voffB[i] = (unsigned)(Rb * g.ldb + C) * 2u; }
    const size_t kstep = (size_t)(BK * 2);
    const size_t hstepA = (size_t)HALF * g.lda * 2, hstepB = (size_t)HALF * g.ldb * 2;
    const size_t tstepA = 2 * hstepA, tstepB = 2 * hstepB;
    const unsigned ldsw = (unsigned)wid * 1024u;
    const int aoff = lds_byte(wr * 64 + fr, fq * 8), boff = lds_byte(wc * 32 + fr, fq * 8);
#define PG8_SA(b, h) (((b) * 2 + (h)) * HTB)
#define PG8_SB(b, h) ((4 + (b) * 2 + (h)) * HTB)
#define PG8_STAGE(bufoff, gbase, voff) do { _Pragma("unroll") for (int _i = 0; _i < 2; ++_i) \
        __builtin_amdgcn_global_load_lds((const unsigned*)((const char*)(gbase) + (voff)[_i]), (PG8_LAS unsigned*)(lds + (bufoff) + ldsw + _i * 8192), 16, 0, 0); } while (0)
#define PG8_LDA(dst, b, h) do { _Pragma("unroll") for (int m = 0; m < 4; ++m) _Pragma("unroll") for (int k = 0; k < 2; ++k) dst[m][k] = *(const PG8_LAS bf16x8*)(lds + PG8_SA(b, h) + aoff + m * 2048 + k * 1024); } while (0)
#define PG8_LDB(dst, b, h) do { _Pragma("unroll") for (int n = 0; n < 2; ++n) _Pragma("unroll") for (int k = 0; k < 2; ++k) dst[n][k] = *(const PG8_LAS bf16x8*)(lds + PG8_SB(b, h) + boff + n * 2048 + k * 1024); } while (0)
#define PG8_MMA(ai, bj, At, Bt) do { __builtin_amdgcn_s_setprio(1); _Pragma("unroll") for (int m = 0; m < 4; ++m) _Pragma("unroll") for (int n = 0; n < 2; ++n) _Pragma("unroll") for (int k = 0; k < 2; ++k) \
        acc[ai][bj][m][n] = __builtin_amdgcn_mfma_f32_16x16x32_bf16(Bt[n][k], At[m][k], acc[ai][bj][m][n], 0, 0, 0); __builtin_amdgcn_s_setprio(0); } while (0)
#define PG8_WAIT_V(n) asm volatile("s_waitcnt vmcnt(" #n ")" ::: "memory")
#define PG8_WAIT_L(n) asm volatile("s_waitcnt lgkmcnt(" #n ")" ::: "memory")
#define PG8_BAR __builtin_amdgcn_s_barrier()
#define PG8_SCHED __builtin_amdgcn_sched_barrier(0)
    Unit cur, nxt; int ui = 0;
    if (!S.next(0, cur)) return;
    f32x4 acc[2][2][4][2];
#pragma unroll
    for (int a = 0; a < 2; ++a)
#pragma unroll
        for (int b = 0; b < 2; ++b)
#pragma unroll
            for (int m = 0; m < 4; ++m)
#pragma unroll
                for (int n = 0; n < 2; ++n) acc[a][b][m][n] = (f32x4){0.f, 0.f, 0.f, 0.f};
    bf16x8 At[4][2], B0[2][2], B1[2][2];
    const char* cA = (const char*)g.A + (size_t)cur.pm * tstepA; const char* cB = (const char*)g.Bt + (size_t)cur.pn * tstepB;
    if constexpr (SP2) {
        PG8_STAGE(PG8_SB(0, 0), cB, voffB); PG8_STAGE(PG8_SB(0, 1), cB + hstepB, voffB); PG8_STAGE(PG8_SA(0, 0), cA, voffA); PG8_STAGE(PG8_SA(0, 1), cA + hstepA, voffA);
        if (wr == 1) PG8_BAR;
        PG8_WAIT_V(2); PG8_BAR;
        PG8_STAGE(PG8_SB(1, 0), cB + kstep, voffB); PG8_STAGE(PG8_SA(1, 0), cA + kstep, voffA); PG8_STAGE(PG8_SB(1, 1), cB + hstepB + kstep, voffB);
        PG8_WAIT_V(6); PG8_BAR;
    } else {
        PG8_STAGE(PG8_SB(0, 0), cB, voffB); PG8_STAGE(PG8_SA(0, 0), cA, voffA); PG8_STAGE(PG8_SB(0, 1), cB + hstepB, voffB); PG8_STAGE(PG8_SA(0, 1), cA + hstepA, voffA);
        if (wr == 1) PG8_BAR;
        PG8_WAIT_V(4); PG8_BAR;
        PG8_STAGE(PG8_SB(1, 0), cB + kstep, voffB); PG8_STAGE(PG8_SA(1, 0), cA + kstep, voffA); PG8_STAGE(PG8_SB(1, 1), cB + hstepB + kstep, voffB);
        PG8_WAIT_V(6); PG8_BAR;
    }
    for (;;) {
        const bool has_next = S.next(ui + 1, nxt);
        const char* nA = has_next ? (const char*)g.A + (size_t)nxt.pm * tstepA : cA; const char* nB = has_next ? (const char*)g.Bt + (size_t)nxt.pn * tstepB : cB;
        for (int t = 0; t < nt; t += 2) {
            const bool last = (t == nt - 2);
            const char* a1 = cA + (size_t)(t + 1) * kstep;
            const char* a2 = last ? nA : cA + (size_t)(t + 2) * kstep; const char* b2 = last ? nB : cB + (size_t)(t + 2) * kstep;
            const char* a3 = a2 + kstep; const char* b3 = b2 + kstep;
            if constexpr (SP2) {
            PG8_LDB(B0, 0, 0); PG8_LDB(B1, 0, 1); PG8_SCHED; PG8_LDA(At, 0, 0); PG8_STAGE(PG8_SA(1, 1), a1 + hstepA, voffA);
            PG8_WAIT_V(8); PG8_WAIT_L(0); PG8_BAR; PG8_MMA(0, 0, At, B0); PG8_MMA(0, 1, At, B1); PG8_BAR; PG8_SCHED;
            PG8_LDA(At, 0, 1); PG8_STAGE(PG8_SB(0, 0), b2, voffB); PG8_STAGE(PG8_SB(0, 1), b2 + hstepB, voffB); PG8_STAGE(PG8_SA(0, 0), a2, voffA);
            PG8_WAIT_V(8); PG8_WAIT_L(0); PG8_BAR; PG8_MMA(1, 0, At, B0); PG8_MMA(1, 1, At, B1); PG8_BAR; PG8_SCHED;
            PG8_LDB(B0, 1, 0); PG8_LDB(B1, 1, 1); PG8_SCHED; PG8_LDA(At, 1, 0); PG8_STAGE(PG8_SA(0, 1), a2 + hstepA, voffA);
            PG8_WAIT_V(8); PG8_WAIT_L(0); PG8_BAR; PG8_MMA(0, 0, At, B0); PG8_MMA(0, 1, At, B1); PG8_BAR; PG8_SCHED;
            PG8_LDA(At, 1, 1); PG8_STAGE(PG8_SB(1, 0), b3, voffB); PG8_STAGE(PG8_SB(1, 1), b3 + hstepB, voffB); PG8_STAGE(PG8_SA(1, 0), a3, voffA);
            PG8_WAIT_V(8); PG8_WAIT_L(0); PG8_BAR; PG8_MMA(1, 0, At, B0); PG8_MMA(1, 1, At, B1); PG8_BAR; PG8_SCHED;
            } else {
            PG8_LDB(B0, 0, 0); PG8_SCHED; PG8_LDA(At, 0, 0); PG8_STAGE(PG8_SA(1, 1), a1 + hstepA, voffA);
            PG8_WAIT_L(8); PG8_BAR; PG8_WAIT_L(0); PG8_MMA(0, 0, At, B0); PG8_BAR; PG8_SCHED;
            PG8_LDB(B1, 0, 1); PG8_STAGE(PG8_SB(0, 0), b2, voffB);
            PG8_BAR; PG8_WAIT_L(0); PG8_MMA(0, 1, At, B1); PG8_BAR;
            PG8_LDA(At, 0, 1); PG8_STAGE(PG8_SA(0, 0), a2, voffA);
            PG8_BAR; PG8_WAIT_L(0); PG8_MMA(1, 0, At, B0); PG8_BAR; PG8_SCHED;
            PG8_STAGE(PG8_SB(0, 1), b2 + hstepB, voffB);
            PG8_WAIT_V(6); PG8_BAR; PG8_MMA(1, 1, At, B1); PG8_BAR;
            PG8_LDB(B0, 1, 0); PG8_SCHED; PG8_LDA(At, 1, 0); PG8_STAGE(PG8_SA(0, 1), a2 + hstepA, voffA);
            PG8_WAIT_L(8); PG8_BAR; PG8_WAIT_L(0); PG8_MMA(0, 0, At, B0); PG8_BAR; PG8_SCHED;
            PG8_LDB(B1, 1, 1); PG8_STAGE(PG8_SB(1, 0), b3, voffB);
            PG8_BAR; PG8_WAIT_L(0); PG8_MMA(0, 1, At, B1); PG8_BAR;
            PG8_LDA(At, 1, 1); PG8_STAGE(PG8_SA(1, 0), a3, voffA);
            PG8_BAR; PG8_WAIT_L(0); PG8_MMA(1, 0, At, B0); PG8_BAR; PG8_SCHED;
            PG8_STAGE(PG8_SB(1, 1), b3 + hstepB, voffB);
            PG8_WAIT_V(6); PG8_BAR; PG8_MMA(1, 1, At, B1); PG8_BAR;
            }
        }
        if constexpr (ALIGN_EPI) { if (wr == 0) PG8_BAR; }
        E(acc, cur, wr, wc, fr, fq);
        if (!has_next) break;
#pragma unroll
        for (int a = 0; a < 2; ++a)
#pragma unroll
            for (int b = 0; b < 2; ++b)
#pragma unroll
                for (int m = 0; m < 4; ++m)
#pragma unroll
                    for (int n = 0; n < 2; ++n) acc[a][b][m][n] = (f32x4){0.f, 0.f, 0.f, 0.f};
        cur = nxt; cA = nA; cB = nB; ++ui;
        if constexpr (ALIGN_EPI) { if (wr == 1) PG8_BAR; }
    }
    PG8_WAIT_V(0);
    if constexpr (!ALIGN_EPI) { if (wr == 0) PG8_BAR; }
    PG8_BAR;
#undef PG8_SA
#undef PG8_SB
#undef PG8_STAGE
#undef PG8_LDA
#undef PG8_LDB
#undef PG8_MMA
#undef PG8_WAIT_V
#undef PG8_WAIT_L
#undef PG8_BAR
#undef PG8_SCHED
}
#endif
}
#ifdef CPU_EMU
#define GEMM_LDS(F) ((F).lds)
#else
#define GEMM_LDS(F) ((PG8_LAS unsigned char*)(F).lds)
#endif
#ifndef PG8_SP2
#define PG8_SP2 true
#endif
#ifndef PG8_ALIGN
#define PG8_ALIGN true
#endif

typedef const f32x4 (&AccRef)[2][2][4][2];
struct Lane4 { int wr, wc, fr, fq; };
__device__ __forceinline__ Lane4 epi_lane(int wr, int wc) {
    int t = hw_lane();
#ifndef CPU_EMU
    asm volatile("" : "+v"(t));
#endif
    Lane4 L; L.wr = wr; L.wc = wc; L.fr = t & 15; L.fq = (t >> 4) & 3; return L;
}
struct EpiF32 {
    static constexpr bool PERM = false;
    float* O; int ldc;
    __device__ __forceinline__ void operator()(AccRef acc, const pg8::Unit& u, int wr_, int wc_, int, int) const {
        const Lane4 L = epi_lane(wr_, wc_); const int wr = L.wr, wc = L.wc, fr = L.fr, fq = L.fq;
        const int col0 = u.pn * 256 + wc * 32 + 4 * fq;
#pragma unroll
        for (int ai = 0; ai < 2; ++ai)
#pragma unroll
            for (int m = 0; m < 4; ++m) { float* rowp = O + (size_t)(u.pm * 256 + ai * 128 + wr * 64 + m * 16 + fr) * ldc + col0;
#pragma unroll
                for (int bj = 0; bj < 2; ++bj)
#pragma unroll
                    for (int n = 0; n < 2; ++n) *(f32x4*)(rowp + bj * 128 + n * 16) = acc[ai][bj][m][n]; }
    }
};
struct EpiGlu {
    static constexpr bool PERM = true;
    bf16_t* O;
    __device__ __forceinline__ void operator()(AccRef acc, const pg8::Unit& u, int wr_, int wc_, int, int) const {
        const Lane4 L = epi_lane(wr_, wc_); const int wr = L.wr, wc = L.wc, fr = L.fr, fq = L.fq;
        const int col0 = u.pn * 128 + wc * 32 + 8 * fq;
#pragma unroll
        for (int ai = 0; ai < 2; ++ai)
#pragma unroll
            for (int m = 0; m < 4; ++m) { bf16_t* rowp = O + (size_t)(u.pm * 256 + ai * 128 + wr * 64 + m * 16 + fr) * DM + col0; float o[8];
#pragma unroll
                for (int n = 0; n < 2; ++n) { const f32x4 v = acc[ai][0][m][n], g = acc[ai][1][m][n];
#pragma unroll
                    for (int e = 0; e < 4; ++e) o[4 * n + e] = v[e] * sigmoidf_(g[e]); }
                u32x4 w; w.x = pk2(o[0], o[1]); w.y = pk2(o[2], o[3]); w.z = pk2(o[4], o[5]); w.w = pk2(o[6], o[7]); *(u32x4*)rowp = w; }
    }
};
__device__ __forceinline__ u32x4 pack8(const f32x4 a, const f32x4 b, float s) {
    u32x4 w; w.x = pk2(a[0] * s, a[1] * s); w.y = pk2(a[2] * s, a[3] * s); w.z = pk2(b[0] * s, b[1] * s); w.w = pk2(b[2] * s, b[3] * s); return w;
}
struct EpiB16 {
    static constexpr bool PERM = true;
    bf16_t* O; int ldc;
    __device__ __forceinline__ void operator()(AccRef acc, const pg8::Unit& u, int wr_, int wc_, int, int) const {
        const Lane4 L = epi_lane(wr_, wc_); const int wr = L.wr, wc = L.wc, fr = L.fr, fq = L.fq;
        const int col0 = u.pn * 256 + wc * 32 + 8 * fq;
#pragma unroll
        for (int ai = 0; ai < 2; ++ai)
#pragma unroll
            for (int m = 0; m < 4; ++m) { bf16_t* rowp = O + (size_t)(u.pm * 256 + ai * 128 + wr * 64 + m * 16 + fr) * ldc + col0;
#pragma unroll
                for (int bj = 0; bj < 2; ++bj) *(u32x4*)(rowp + bj * 128) = pack8(acc[ai][bj][m][0], acc[ai][bj][m][1], 1.f); }
    }
};
typedef _Float16 f16x2_hw __attribute__((ext_vector_type(2)));
#ifdef CPU_EMU
__device__ __forceinline__ unsigned pkh2(float lo, float hi) { const f16x2_hw v = {(_Float16)lo, (_Float16)hi}; unsigned r; memcpy(&r, &v, 4); return r; }
__device__ __forceinline__ float hlo(unsigned w) { f16x2_hw v; memcpy(&v, &w, 4); return (float)v[0]; }
__device__ __forceinline__ float hhi(unsigned w) { f16x2_hw v; memcpy(&v, &w, 4); return (float)v[1]; }
#else
__device__ __forceinline__ unsigned pkh2(float lo, float hi) { const f32x2 v = {lo, hi}; const f16x2_hw b = __builtin_convertvector(v, f16x2_hw); return __builtin_bit_cast(unsigned, b); }
__device__ __forceinline__ float hlo(unsigned w) { return (float)__builtin_bit_cast(f16x2_hw, w)[0]; }
__device__ __forceinline__ float hhi(unsigned w) { return (float)__builtin_bit_cast(f16x2_hw, w)[1]; }
#endif
struct EpiH16 {
    static constexpr bool PERM = true;
    unsigned short* O; int ldc;
    __device__ __forceinline__ void operator()(AccRef acc, const pg8::Unit& u, int wr_, int wc_, int, int) const {
        const Lane4 L = epi_lane(wr_, wc_); const int wr = L.wr, wc = L.wc, fr = L.fr, fq = L.fq;
        const int col0 = u.pn * 256 + wc * 32 + 8 * fq;
#pragma unroll
        for (int ai = 0; ai < 2; ++ai)
#pragma unroll
            for (int m = 0; m < 4; ++m) { unsigned short* rowp = O + (size_t)(u.pm * 256 + ai * 128 + wr * 64 + m * 16 + fr) * ldc + col0;
#pragma unroll
                for (int bj = 0; bj < 2; ++bj) { const f32x4 a = acc[ai][bj][m][0], b = acc[ai][bj][m][1]; u32x4 w; w.x = pkh2(a[0], a[1]); w.y = pkh2(a[2], a[3]); w.z = pkh2(b[0], b[1]); w.w = pkh2(b[2], b[3]);
                    *(u32x4*)(rowp + bj * 128) = w; } }
    }
};
struct EpiSsdIn {
    static constexpr bool PERM = true;
    bf16_t* Z; bf16_t* XBC; float* DT;
    __device__ __forceinline__ void operator()(AccRef acc, const pg8::Unit& u, int wr_, int wc_, int, int) const {
        const Lane4 L = epi_lane(wr_, wc_); const int wr = L.wr, wc = L.wc, fr = L.fr, fq = L.fq;
        const int cw = wc * 32 + 8 * fq;
#pragma unroll
        for (int ai = 0; ai < 2; ++ai)
#pragma unroll
            for (int m = 0; m < 4; ++m) { const size_t row = (size_t)(u.pm * 256 + ai * 128 + wr * 64 + m * 16 + fr);
#pragma unroll
                for (int bj = 0; bj < 2; ++bj) { const int col = u.pn * 256 + bj * 128 + cw;
                    if (u.pn < 8) *(u32x4*)(Z + row * 2048 + col) = pack8(acc[ai][bj][m][0], acc[ai][bj][m][1], 1.f);
                    else if (u.pn < 20) *(u32x4*)(XBC + row * 3072 + (col - 2048)) = pack8(acc[ai][bj][m][0], acc[ai][bj][m][1], 1.f);
                    else if (col - 5120 < 64) { float* p = DT + row * 64 + (col - 5120); *(f32x4*)p = acc[ai][bj][m][0]; *(f32x4*)(p + 4) = acc[ai][bj][m][1]; } } }
    }
};
struct EpiMlaDown {
    static constexpr bool PERM = true;
    bf16_t* C; float* RS;
    __device__ __forceinline__ void operator()(AccRef acc, const pg8::Unit& u, int wr_, int wc_, int, int) const {
        const Lane4 L = epi_lane(wr_, wc_); const int wr = L.wr, wc = L.wc, fr = L.fr, fq = L.fq;
        const int cw = wc * 32 + 8 * fq;
#pragma unroll
        for (int ai = 0; ai < 2; ++ai)
#pragma unroll
            for (int m = 0; m < 4; ++m) { const size_t row = (size_t)(u.pm * 256 + ai * 128 + wr * 64 + m * 16 + fr); float ss = 0.f;
#pragma unroll
                for (int bj = 0; bj < 2; ++bj) { const int col = u.pn * 256 + bj * 128 + cw; const f32x4 a = acc[ai][bj][m][0], b = acc[ai][bj][m][1];
                    *(u32x4*)(C + row * 512 + col) = pack8(a, b, 1.f);
                    if (u.pn == 0 || bj == 0) ss += (a[0] * a[0] + a[1] * a[1]) + (a[2] * a[2] + a[3] * a[3]) + (b[0] * b[0] + b[1] * b[1]) + (b[2] * b[2] + b[3] * b[3]); }
                ss += __shfl_xor(ss, 16); ss += __shfl_xor(ss, 32);
                if (fq == 0) RS[row * 8 + u.pn * 4 + wc] = ss; }
    }
};
struct EpiMlaUp {
    static constexpr bool PERM = true;
    bf16_t* Q; bf16_t* Kb; bf16_t* Vb; const float* RS;
    __device__ __forceinline__ void operator()(AccRef acc, const pg8::Unit& u, int wr_, int wc_, int, int) const {
        const Lane4 L = epi_lane(wr_, wc_); const int wr = L.wr, wc = L.wc, fr = L.fr, fq = L.fq;
        const bool isq = u.pn < 8;
        if (isq && wc == 3) return;
#pragma unroll
        for (int ai = 0; ai < 2; ++ai)
#pragma unroll
            for (int m = 0; m < 4; ++m) { const int tok = u.pm * 256 + ai * 128 + wr * 64 + m * 16 + fr; const int b = tok / LTOK, p = tok - b * LTOK;
                const f32x4 rs = *(const f32x4*)(RS + ((unsigned)tok * 8u + (isq ? 0u : 4u)));
                const float rn = 1.0f / sqrtf(((rs[0] + rs[1]) + (rs[2] + rs[3])) * (isq ? (1.f / 256.f) : (1.f / 128.f)) + 1e-6f);
#pragma unroll
                for (int bj = 0; bj < 2; ++bj) { bf16_t* dst;
                    if (isq) dst = Q + ((unsigned)((b * 16 + u.pn * 2 + bj) * LTOK + p) * 128u + (unsigned)(wc * 32 + 8 * fq));
                    else { const int col = (u.pn & 3) * 256 + bj * 128 + wc * 32 + 8 * fq; const int head = col >> 6, d = col & 63; const unsigned rowi = (unsigned)((b * 16 + head) * LTOK + p);
                        dst = u.pn < 12 ? Kb + (rowi * 128u + (unsigned)d) : Vb + (rowi * 64u + (unsigned)d); }
                    *(u32x4*)dst = pack8(acc[ai][bj][m][0], acc[ai][bj][m][1], rn); }
                asm volatile("" ::: "memory"); }
    }
};

namespace att {
constexpr int NW = 8, QBLK = 32, KVBLK = 64, LDQ = 128, LDK = 128, LDV = 64, LDO = 1024;
constexpr float SCALE = 0.10206207261596575f;
constexpr float THR = 8.f;
constexpr size_t SHM_V = KVBLK * 128 * 2, SHM_K = KVBLK * 128 * 2, SHM_ATTN = 2 * SHM_V + 2 * SHM_K + NW * 64 * 4;
#ifdef CPU_EMU
__device__ __forceinline__ void attn_body(const bf16_t* Qb, const bf16_t* Kh, const bf16_t* Vh, bf16_t* Ob, int seq, unsigned char* lds, int tq0, const float* ROPE, int wave_s) {
    const int tid = threadIdx.x, wid = tid >> 6, lane = tid & 63, r32 = lane & 31, hi = lane >> 5;
    if (hi == 0) {
        const bf16_t* qg = Qb + (size_t)(wid * 32 + r32) * LDQ; float m = -1e30f; float q[96];
        for (int d = 0; d < 96; ++d) q[d] = bf2f(qg[d]);
        if (tq0 >= 0) { const int t = tq0 + wid * 32 + r32;
            for (int i = 0; i < 16; ++i) { const int pos = i < 8 ? (t >> 6) : (t & 63); const float c = ROPE[(pos * 8 + (i & 7)) * 2], sn = ROPE[(pos * 8 + (i & 7)) * 2 + 1];
                const float x1 = q[64 + 2 * i], x2 = q[64 + 2 * i + 1]; q[64 + 2 * i] = x1 * c - x2 * sn; q[64 + 2 * i + 1] = x2 * c + x1 * sn; }
            for (int d = 64; d < 96; ++d) q[d] = bf2f((bf16_t)f2bf(q[d])); }
        std::vector<float> sc(seq);
        for (int k = 0; k < seq; ++k) { float s = 0.f; for (int d = 0; d < 96; ++d) s += q[d] * bf2f(Kh[(size_t)k * LDK + d]); sc[k] = s * SCALE; m = fmaxf(m, sc[k]); }
        float l = 0.f; float o[64]; for (int d = 0; d < 64; ++d) o[d] = 0.f;
        for (int k = 0; k < seq; ++k) { const float pr = expf(sc[k] - m); l += pr; const float prb = bf2f((bf16_t)f2bf(pr)); for (int d = 0; d < 64; ++d) o[d] += prb * bf2f(Vh[(size_t)k * LDV + d]); }
        for (int d = 0; d < 64; ++d) Ob[(size_t)(wid * 32 + r32) * LDO + d] = (bf16_t)f2bf(o[d] / l);
    }
    __syncthreads();
}
#else
using s16x4 = __attribute__((ext_vector_type(4))) short;
#define KSWZ(row, colB) ((row) * 256 + ((colB) ^ (((row) & 7) << 4)))
#define SBAR() __builtin_amdgcn_sched_barrier(0)
__device__ __forceinline__ unsigned cvtpk(float lo, float hi) { unsigned r; asm volatile("v_cvt_pk_bf16_f32 %0, %1, %2" : "=v"(r) : "v"(lo), "v"(hi)); return r; }
__device__ __forceinline__ void partialSM(f32x16& p0, f32x16& p1, float& m_reg, float& mn, float& alpha) {
  constexpr float C = SCALE * 1.4426950408889634f;
  float pmax = p0[0]; for (int r = 1; r < 16; ++r) pmax = fmaxf(pmax, p0[r]); for (int r = 0; r < 16; ++r) pmax = fmaxf(pmax, p1[r]);
  { auto rr = __builtin_amdgcn_permlane32_swap(__float_as_uint(pmax), __float_as_uint(pmax), false, false);
    pmax = fmaxf(__uint_as_float(rr[0]), __uint_as_float(rr[1])); }
  if (__builtin_expect(__all(pmax - m_reg <= THR / SCALE), 1)) { mn = m_reg; alpha = 1.f; }
  else { mn = fmaxf(m_reg, pmax); alpha = __builtin_amdgcn_exp2f((m_reg - mn) * C); m_reg = mn; }
  float mnC = -mn * C;
  for (int r = 0; r < 16; ++r) p0[r] = fmaf(p0[r], C, mnC); for (int r = 0; r < 16; ++r) p1[r] = fmaf(p1[r], C, mnC);
  for (int r = 0; r < 16; ++r) p0[r] = __builtin_amdgcn_exp2f(p0[r]);
}
__device__ __forceinline__ void finishSM(f32x16& p0, f32x16& p1, float alpha, float& l_reg, bf16x8& pa0, bf16x8& pa1, bf16x8& pa2, bf16x8& pa3) {
  for (int r = 0; r < 16; ++r) p1[r] = __builtin_amdgcn_exp2f(p1[r]);
  float ps = 0; for (int r = 0; r < 16; ++r) ps += p0[r]; for (int r = 0; r < 16; ++r) ps += p1[r];
  { auto rr = __builtin_amdgcn_permlane32_swap(__float_as_uint(ps), __float_as_uint(ps), false, false);
    ps = __uint_as_float(rr[0]) + __uint_as_float(rr[1]); }
  l_reg = l_reg * alpha + ps;
#define PK4(P, BASE, OUT) do { unsigned a0 = cvtpk(P[BASE + 0], P[BASE + 1]), a1 = cvtpk(P[BASE + 2], P[BASE + 3]);   \
    unsigned b0 = cvtpk(P[BASE + 4], P[BASE + 5]), b1 = cvtpk(P[BASE + 6], P[BASE + 7]);                              \
    auto r0 = __builtin_amdgcn_permlane32_swap(a0, b0, false, false); auto r1 = __builtin_amdgcn_permlane32_swap(a1, b1, false, false); \
    u32x4 w = {r0[0], r1[0], r0[1], r1[1]}; OUT = *reinterpret_cast<bf16x8*>(&w); } while (0)
  PK4(p0, 0, pa0); PK4(p0, 8, pa1); PK4(p1, 0, pa2); PK4(p1, 8, pa3);
#undef PK4
}
__device__ __forceinline__ void qkt(f32x16& p0, f32x16& p1, const bf16_t* Ks, const bf16x8* qr, int r32, int hi) {
  p0 = f32x16{}; p1 = f32x16{};
#pragma unroll
  for (int d0 = 0; d0 < 6; ++d0) { int cb = (d0 * 16 + hi * 8) * 2;
    bf16x8 b0 = *reinterpret_cast<const bf16x8*>((const char*)Ks + KSWZ(r32, cb));
    bf16x8 b1 = *reinterpret_cast<const bf16x8*>((const char*)Ks + KSWZ(32 + r32, cb));
    p0 = __builtin_amdgcn_mfma_f32_32x32x16_bf16(b0, qr[d0], p0, 0, 0, 0);
    p1 = __builtin_amdgcn_mfma_f32_32x32x16_bf16(b1, qr[d0], p1, 0, 0, 0); }
}
__device__ __forceinline__ int v_st(int k, int c) { const int kk = (k & ~0xC) | ((k & 4) << 1) | ((k & 8) >> 1); return ((kk >> 3) * 4 + (c >> 5)) * 512 + ((kk & 7) * 32 + (c & 31)) * 2; }
__device__ __forceinline__ int v_rd_base(int lane) { return ((lane & 3) << 3) | (((lane >> 2) & 3) << 6) | (((lane >> 4) & 1) << 5) | (((lane >> 5) & 1) << 8); }
constexpr int v_rd_off(int d0, int ks, int half) { return d0 * 512 + ks * 4096 + half * 2048; }
template <int OFF> __device__ __forceinline__ s16x4 tr_read(int vb) {
  s16x4 r; asm volatile("ds_read_b64_tr_b16 %0, %1 offset:%2" : "=&v"(r) : "v"(vb), "i"(OFF) : "memory"); return r;
}
template <int D0> __device__ __forceinline__ void pv_one(f32x16& od, int vb, bf16x8 pa0, bf16x8 pa1, bf16x8 pa2, bf16x8 pa3) {
  const s16x4 l0 = tr_read<v_rd_off(D0, 0, 0)>(vb), h0 = tr_read<v_rd_off(D0, 0, 1)>(vb), l1 = tr_read<v_rd_off(D0, 1, 0)>(vb), h1 = tr_read<v_rd_off(D0, 1, 1)>(vb);
  const s16x4 l2 = tr_read<v_rd_off(D0, 2, 0)>(vb), h2 = tr_read<v_rd_off(D0, 2, 1)>(vb), l3 = tr_read<v_rd_off(D0, 3, 0)>(vb), h3 = tr_read<v_rd_off(D0, 3, 1)>(vb);
  asm volatile("s_waitcnt lgkmcnt(0)" ::: "memory"); SBAR();
#define PK(L, H) (bf16x8){L[0], L[1], L[2], L[3], H[0], H[1], H[2], H[3]}
  od = __builtin_amdgcn_mfma_f32_32x32x16_bf16(pa0, PK(l0, h0), od, 0, 0, 0);
  od = __builtin_amdgcn_mfma_f32_32x32x16_bf16(pa1, PK(l1, h1), od, 0, 0, 0);
  od = __builtin_amdgcn_mfma_f32_32x32x16_bf16(pa2, PK(l2, h2), od, 0, 0, 0);
  od = __builtin_amdgcn_mfma_f32_32x32x16_bf16(pa3, PK(l3, h3), od, 0, 0, 0);
#undef PK
}
__device__ __forceinline__ void pv_d0(f32x16* o, int vb, bf16x8 pa0, bf16x8 pa1, bf16x8 pa2, bf16x8 pa3) {
  pv_one<0>(o[0], vb, pa0, pa1, pa2, pa3); pv_one<1>(o[1], vb, pa0, pa1, pa2, pa3);
}
__device__ __forceinline__ void attn_body(const bf16_t* __restrict__ Qb, const bf16_t* __restrict__ Kh, const bf16_t* __restrict__ Vh, bf16_t* __restrict__ Ob, int seq, char* lds, int tq0, const float* __restrict__ ROPE, int wave_s) {
  const int wid = wave_s, lane = hw_lane(), tid = wid * 64 + lane, r32 = lane & 31, hi = lane >> 5;
  bf16_t* V_lds = (bf16_t*)lds; bf16_t* K_lds = (bf16_t*)(lds + 2 * SHM_V);
  float* ws = (float*)(lds + 2 * SHM_V + 2 * SHM_K) + wid * 64; float* li_l = ws; float* al_l = ws + 32;
  float m_reg = -1e30f, l_reg = 0; f32x16 o[2] = {}; bf16x8 qr[6];
  const bf16_t* Qw = Qb + (long)(wid * QBLK + r32) * LDQ + hi * 8;
#pragma unroll
  for (int d0 = 0; d0 < 6; ++d0) qr[d0] = *reinterpret_cast<const bf16x8*>(Qw + d0 * 16);
  if (tq0 >= 0) {
    const int t = tq0 + wid * QBLK + r32;
#pragma unroll
    for (int dd = 0; dd < 2; ++dd) { const int pos = dd == 0 ? (t >> 6) : (t & 63);
      const f32x4 r0 = *(const f32x4*)(ROPE + pos * 16 + 8 * hi), r1 = *(const f32x4*)(ROPE + pos * 16 + 8 * hi + 4);
      const u32x4 w = *reinterpret_cast<const u32x4*>(&qr[4 + dd]); u32x4 o;
      { const float x1 = bflo(w.x), x2 = bfhi(w.x); o.x = pk2(x1 * r0[0] - x2 * r0[1], x2 * r0[0] + x1 * r0[1]); }
      { const float x1 = bflo(w.y), x2 = bfhi(w.y); o.y = pk2(x1 * r0[2] - x2 * r0[3], x2 * r0[2] + x1 * r0[3]); }
      { const float x1 = bflo(w.z), x2 = bfhi(w.z); o.z = pk2(x1 * r1[0] - x2 * r1[1], x2 * r1[0] + x1 * r1[1]); }
      { const float x1 = bflo(w.w), x2 = bfhi(w.w); o.w = pk2(x1 * r1[2] - x2 * r1[3], x2 * r1[2] + x1 * r1[3]); }
      qr[4 + dd] = *reinterpret_cast<const bf16x8*>(&o); }
  }
  const int sr = tid >> 4, sc = (tid & 15) * 8;
  const int vk = tid >> 3, vc = (tid & 7) * 8, vst0 = v_st(vk, vc);
  const int vb0 = (int)(uintptr_t)V_lds + v_rd_base(lane);
  struct { bf16x8 vs0, ks0, ks1; } sr_[2];
#define SLOAD(i, k0) do { sr_[i].vs0 = *reinterpret_cast<const bf16x8*>(&Vh[(long)((k0) + vk) * LDV + vc]); \
    sr_[i].ks0 = *reinterpret_cast<const bf16x8*>(&Kh[(long)((k0) + sr) * LDK + sc]); sr_[i].ks1 = *reinterpret_cast<const bf16x8*>(&Kh[(long)((k0) + 32 + sr) * LDK + sc]); } while (0)
#define SWRITE(b, i) do { *(bf16x8*)((char*)V_lds + (b) * SHM_V + vst0) = sr_[i].vs0; int kc = sc * 2;               \
    *(bf16x8*)((char*)K_lds + (b) * SHM_K + KSWZ(sr, kc)) = sr_[i].ks0;                       \
    *(bf16x8*)((char*)K_lds + (b) * SHM_K + KSWZ(32 + sr, kc)) = sr_[i].ks1; } while (0)
#define SWAIT() asm volatile("s_waitcnt vmcnt(3)" ::: "memory")
#define RESC(a) do { if (__any((a) < 1.f)) { if (hi == 0) al_l[r32] = (a); asm volatile("s_waitcnt lgkmcnt(0)" ::: "memory"); \
    for (int d = 0; d < 2; ++d) for (int r = 0; r < 16; ++r) o[d][r] *= al_l[crow(r, hi)]; } } while (0)
  f32x16 pA0, pA1, pB0, pB1; float mnA, mnB, alA, alB; bf16x8 pa0, pa1, pa2, pa3; const int NT = seq / KVBLK;
  constexpr int SE = 0, SO = 1;
  SLOAD(SE, 0); asm volatile("s_waitcnt vmcnt(0)" ::: "memory"); SWRITE(0, SE); __syncthreads();
  qkt(pA0, pA1, K_lds, qr, r32, hi); partialSM(pA0, pA1, m_reg, mnA, alA);
  SLOAD(SO, KVBLK); if (2 < NT) SLOAD(SE, 2 * KVBLK);
  SWAIT(); SWRITE(1, SO); __syncthreads();
  for (int j = 1; j + 1 < NT; j += 2) {
    SBAR(); qkt(pB0, pB1, (bf16_t*)((char*)K_lds + SHM_K), qr, r32, hi);
    finishSM(pA0, pA1, alA, l_reg, pa0, pa1, pa2, pa3); SBAR();
    SLOAD(SO, (j + 2) * KVBLK); SBAR();
    pv_d0(o, vb0, pa0, pa1, pa2, pa3); partialSM(pB0, pB1, m_reg, mnB, alB);
    __syncthreads(); SWAIT(); SWRITE(0, SE);
    RESC(alB); __syncthreads();
    SBAR(); qkt(pA0, pA1, K_lds, qr, r32, hi);
    finishSM(pB0, pB1, alB, l_reg, pa0, pa1, pa2, pa3); SBAR();
    if (j + 3 < NT) SLOAD(SE, (j + 3) * KVBLK); SBAR();
    pv_d0(o, vb0 + (int)SHM_V, pa0, pa1, pa2, pa3); partialSM(pA0, pA1, m_reg, mnA, alA);
    __syncthreads(); SWAIT(); SWRITE(1, SO);
    RESC(alA); __syncthreads();
  }
  SBAR(); qkt(pB0, pB1, (bf16_t*)((char*)K_lds + SHM_K), qr, r32, hi);
  finishSM(pA0, pA1, alA, l_reg, pa0, pa1, pa2, pa3); SBAR();
  pv_d0(o, vb0, pa0, pa1, pa2, pa3); partialSM(pB0, pB1, m_reg, mnB, alB);
  __syncthreads(); RESC(alB);
  finishSM(pB0, pB1, alB, l_reg, pa0, pa1, pa2, pa3); SBAR();
  pv_d0(o, vb0 + (int)SHM_V, pa0, pa1, pa2, pa3);
  if (hi == 0) li_l[r32] = l_reg; asm volatile("s_waitcnt lgkmcnt(0)" ::: "memory");
  float rli[16];
#pragma unroll
  for (int r = 0; r < 16; ++r) rli[r] = __builtin_amdgcn_rcpf(li_l[crow(r, hi)]);
  bf16_t* Ow = Ob + (long)(wid * QBLK) * LDO;
#pragma unroll
  for (int r = 0; r < 16; ++r) { int orow = crow(r, hi);
    for (int d0 = 0; d0 < 2; ++d0) Ow[(long)orow * LDO + d0 * 32 + r32] = (bf16_t)f2bf(o[d0][r] * rli[r]); }
  __syncthreads();
#undef SLOAD
#undef SWRITE
#undef SWAIT
#undef RESC
}
#undef KSWZ
#undef SBAR
#endif
}

template <class RowMap>
__device__ __forceinline__ void tr_item(const float* W, int ldw, int k0, int n0, bf16_t* WT, int ldt, int koff, const float* kscale, RowMap rm, float* scr, int lane) {
#pragma unroll 8
    for (int i = 0; i < 32; ++i) { const int kk = 2 * i + (lane >> 5); scr[kk * 33 + (lane & 31)] = W[(size_t)(k0 + kk) * ldw + n0 + (lane & 31)]; }
    wave_sync();
    const int c = lane & 7;
    float ks[8];
#pragma unroll
    for (int e = 0; e < 8; ++e) ks[e] = kscale ? kscale[k0 + 8 * c + e] : 1.f;
#pragma unroll
    for (int j = 0; j < 4; ++j) { const int n = (lane >> 3) + 8 * j; const float* s = scr + (8 * c) * 33 + n;
        u32x4 o; o.x = pk2(s[0 * 33] * ks[0], s[1 * 33] * ks[1]); o.y = pk2(s[2 * 33] * ks[2], s[3 * 33] * ks[3]); o.z = pk2(s[4 * 33] * ks[4], s[5 * 33] * ks[5]); o.w = pk2(s[6 * 33] * ks[6], s[7 * 33] * ks[7]);
        const int row = rm(n0 + n);
        if (row >= 0) *(u32x4*)(WT + (size_t)row * ldt + koff + k0 + 8 * c) = o; }
    wave_sync();
}
struct RmId { int off; __device__ __forceinline__ int operator()(int n) const { return off + n; } };
struct RmGlu { int off; __device__ __forceinline__ int operator()(int n) const { return ((n >> 7) << 8) + off + (n & 127); } };
struct RmUq { __device__ __forceinline__ int operator()(int n) const { const int h = n / 96, d = n - h * 96; int sd = d;
        if (d >= 64) { const int rho = d - 64; const int half = rho >> 4, w = rho & 15; const int i = half * 8 + (w & 7); sd = 64 + 2 * i + (w >> 3); }
        return h * 128 + sd; } };
__device__ __forceinline__ void s5_disc(const Args& A, int it, int p, float& are_bar, float& aim_bar, float& cre, float& cim) {
    const float are = A.in[8][(size_t)it * 64 + p], aim = A.in[9][(size_t)it * 64 + p]; const float dt = expf(A.in[10][it]);
    const float zr = are * dt, zi = aim * dt; const float ez = expf(zr), cs = cosf(zi), sn = sinf(zi), sh = sinf(0.5f * zi);
    are_bar = ez * cs; aim_bar = ez * sn;
    const float nr = expm1f(zr) * cs - 2.f * sh * sh, ni = ez * sn;
    const float den = are * are + aim * aim;
    cre = (nr * are + ni * aim) / den; cim = (ni * are - nr * aim) / den;
}
__device__ __forceinline__ void ph_prep(const Args& A, Frame& F) {
    const int tid = F.tid, lane = F.lane, wave = F.wave, G = F.G, bid = F.bid;
    unsigned char* ws = A.ws;
    { float* ca = (float*)F.lds; float* red = ca + NR * 1024; float* MOD = (float*)(ws + WS_MOD);
      for (int i = tid; i < NR * 1024; i += NTHR) { const int r = i >> 10, k = i & 1023; const float c = r < BATCH ? A.in[1][r * 1024 + k] : A.in[3][k]; ca[i] = siluf_(c); }
      __syncthreads();
      for (int it = bid; it < 4 * 96; it += G) { const int l = it / 96, cb = (it % 96) * 64; float acc[NR];
#pragma unroll
          for (int r = 0; r < NR; ++r) acc[r] = 0.f;
          const float* wp = A.in[4] + ((size_t)l * 1024 + wave * 128) * 6144 + cb + lane;
#pragma unroll 8
          for (int k = 0; k < 128; ++k) { const float w = wp[(size_t)k * 6144];
#pragma unroll
              for (int r = 0; r < NR; ++r) acc[r] += ca[r * 1024 + wave * 128 + k] * w; }
#pragma unroll
          for (int r = 0; r < NR; ++r) red[(wave * NR + r) * 64 + lane] = acc[r];
          __syncthreads();
          if (tid < NR * 64) { const int r = tid >> 6, c = tid & 63; float s = A.in[5][l * 6144 + cb + c];
              for (int w = 0; w < 8; ++w) s += red[(w * NR + r) * 64 + c];
              MOD[((size_t)l * NR + r) * 6144 + cb + c] = s; }
          __syncthreads(); } }
    { float* ROPE = (float*)(ws + WS_ROPE);
      for (int i = bid * NTHR + tid; i < 64 * 8; i += G * NTHR) { const int pos = i >> 3, f = i & 7; const float freq = powf(10000.f, -(float)f / 8.f); const float ang = (float)pos * freq;
          ROPE[2 * i] = cosf(ang); ROPE[2 * i + 1] = sinf(ang); } }
    { float* scr = (float*)(F.lds + wave * 16384);
      const int gw = bid * NWAVES + wave, NGW = G * NWAVES;
      bf16_t* WGLU = (bf16_t*)(ws + WS_WGLU); bf16_t* WIN = (bf16_t*)(ws + WS_WIN); bf16_t* WOUT = (bf16_t*)(ws + WS_WOUT); bf16_t* WDOWN = (bf16_t*)(ws + WS_WDOWN);
      bf16_t* WUP = (bf16_t*)(ws + WS_WUP); bf16_t* WO = (bf16_t*)(ws + WS_WO);
      constexpr int I_GLU = 16 * 32, I_IN = 16 * 162, I_OUT = 32 * 32, I_DOWN = 16 * 13, I_UQ = 4 * 48, I_UK = 2 * 32, I_WO = 16 * 32;
      constexpr int NIT = 4 * I_GLU + I_IN + I_OUT + I_DOWN + I_UQ + 2 * I_UK + I_WO;
      for (int it = gw; it < NIT; it += NGW) { int r = it;
          if (r < 4 * I_GLU) { const int which = r / I_GLU, q = r % I_GLU, j = which >> 1, isgate = which & 1;
              const float* W = (isgate ? A.in[16] : A.in[17]) + (size_t)j * 1024 * 1024;
              tr_item(W, 1024, (q / 32) * 64, (q % 32) * 32, WGLU + (size_t)j * 2048 * 1024, 1024, 0, nullptr, RmGlu{isgate * 128}, scr, lane); continue; } r -= 4 * I_GLU;
          if (r < I_IN) { tr_item(A.in[18], SSD_IN, (r / 162) * 64, (r % 162) * 32, WIN, 1024, 0, nullptr, RmId{0}, scr, lane); continue; } r -= I_IN;
          if (r < I_OUT) { tr_item(A.in[25], 1024, (r / 32) * 64, (r % 32) * 32, WOUT, 2048, 0, A.in[24], RmId{0}, scr, lane); continue; } r -= I_OUT;
          if (r < I_DOWN) { tr_item(A.in[26], 416, (r / 13) * 64, (r % 13) * 32, WDOWN, 1024, 0, nullptr, RmId{0}, scr, lane); continue; } r -= I_DOWN;
          if (r < I_UQ) { tr_item(A.in[29], 1536, (r / 48) * 64, (r % 48) * 32, WUP, 384, 0, A.in[27], RmUq{}, scr, lane); continue; } r -= I_UQ;
          if (r < I_UK) { tr_item(A.in[30], 1024, (r / 32) * 64, (r % 32) * 32, WUP, 384, 256, A.in[28], RmId{2048}, scr, lane); continue; } r -= I_UK;
          if (r < I_UK) { tr_item(A.in[31], 1024, (r / 32) * 64, (r % 32) * 32, WUP, 384, 256, A.in[28], RmId{3072}, scr, lane); continue; } r -= I_UK;
          tr_item(A.in[32], 1024, (r / 32) * 64, (r % 32) * 32, WO, 1024, 0, nullptr, RmId{0}, scr, lane); }
      const u32x4 z4 = {0u, 0u, 0u, 0u};
      const long gt = (long)bid * NTHR + tid, GT = (long)G * NTHR;
      for (long i = gt; i < (long)(SSD_IN_PAD - SSD_IN) * 128; i += GT) *(u32x4*)(WIN + (size_t)SSD_IN * 1024 + i * 8) = z4;
      for (long i = gt; i < (long)(512 - 416) * 128; i += GT) *(u32x4*)(WDOWN + (size_t)416 * 1024 + i * 8) = z4;
      for (long i = gt; i < 4096L * 48; i += GT) { const int R = (int)(i / 48), k = (int)(i % 48) * 8;
          const bool zero = R < 2048 ? (k >= 256 || (R & 127) >= 96) : (k < 256);
          if (zero) *(u32x4*)(WUP + (size_t)R * 384 + k) = z4; }
      { unsigned char* UT = ws + WS_UT; unsigned char* VT = ws + WS_VT; float* US = (float*)(ws + WS_US); float* VS = (float*)(ws + WS_VS);
        for (int rw = gw; rw < 2 * 4 * 16384; rw += NGW) { const bool isu = rw < 4 * 16384; const int row = isu ? rw : rw - 4 * 16384;
            const float* src = (isu ? A.in[35] : A.in[36]) + (size_t)row * 1024;
            const f32x4 a = *(const f32x4*)(src + 8 * lane), b = *(const f32x4*)(src + 8 * lane + 4), c = *(const f32x4*)(src + 512 + 8 * lane), d = *(const f32x4*)(src + 512 + 8 * lane + 4);
            float v[16];
#pragma unroll
            for (int e = 0; e < 4; ++e) { v[e] = a[e]; v[4 + e] = b[e]; v[8 + e] = c[e]; v[12 + e] = d[e]; }
            float mx = 0.f;
#pragma unroll
            for (int e = 0; e < 16; ++e) mx = fmaxf(mx, fabsf(v[e]));
            mx = wave_max(mx);
            const float inv = mx > 0.f ? 127.f / mx : 0.f;
            unsigned q[16];
#pragma unroll
            for (int e = 0; e < 16; ++e) q[e] = (unsigned)(int)(rintf(v[e] * inv) + 128.f);
            u32x4 o;
            o.x = q[0] | (q[1] << 8) | (q[2] << 16) | (q[3] << 24); o.y = q[4] | (q[5] << 8) | (q[6] << 16) | (q[7] << 24);
            o.z = q[8] | (q[9] << 8) | (q[10] << 16) | (q[11] << 24); o.w = q[12] | (q[13] << 8) | (q[14] << 16) | (q[15] << 24);
            o.x ^= 0x80808080u; o.y ^= 0x80808080u; o.z ^= 0x80808080u; o.w ^= 0x80808080u;
            *(u32x4*)((isu ? UT : VT) + (size_t)(row >> 14) * 16384 * 1024 + (size_t)(lane >> 3) * 16384 * 128 + (size_t)(row & 16383) * 128 + 16 * (lane & 7)) = o;
            float qs = 0.f;
#pragma unroll
            for (int e = 0; e < 16; ++e) qs += (float)q[e];
            qs = wave_sum(qs);
            if (lane == 0) { if (isu) { US[2 * row] = mx * (1.f / 127.f); US[2 * row + 1] = qs; } else VS[row] = mx * (1.f / 127.f); } } }
      for (int it = gw; it < 2 * 2 * 64; it += NGW) { unsigned char* base = ws + WS_S5C + (size_t)it * S5C_ITEM;
          float ar, ai, cr, ci; s5_disc(A, it, lane, ar, ai, cr, ci);
          ((f32x2*)base)[lane] = (f32x2){ar, ai};
          const int r = lane & 31, h = lane >> 5;
          const float* bre = A.in[11] + (size_t)it * 64 * 16; const float* bim = A.in[12] + (size_t)it * 64 * 16;
          const float* cre = A.in[13] + (size_t)it * 16 * 64; const float* cim = A.in[14] + (size_t)it * 16 * 64;
#pragma unroll
          for (int blk = 0; blk < 4; ++blk) { const int pst = (blk & 1) * 32 + r; float ar2, ai2, kr, ki; s5_disc(A, it, pst, ar2, ai2, kr, ki); float v[8];
#pragma unroll
              for (int j = 0; j < 8; ++j) { const int c = 8 * h + j; const float br = bre[pst * 16 + c], bi = bim[pst * 16 + c]; v[j] = blk < 2 ? (kr * br - ki * bi) : (kr * bi + ki * br); }
              u32x4 o; o.x = pk2(v[0], v[1]); o.y = pk2(v[2], v[3]); o.z = pk2(v[4], v[5]); o.w = pk2(v[6], v[7]);
              ((u32x4*)(base + 512))[blk * 64 + lane] = o; }
#pragma unroll
          for (int ks = 0; ks < 8; ++ks) { float v[8];
#pragma unroll
              for (int j = 0; j < 8; ++j) { const int k = 16 * ks + 8 * h + j, p = k >> 1, comp = k & 1; v[j] = r < 16 ? (comp == 0 ? cre[r * 64 + p] : -cim[r * 64 + p]) : 0.f; }
              u32x4 o; o.x = pk2(v[0], v[1]); o.y = pk2(v[2], v[3]); o.z = pk2(v[4], v[5]); o.w = pk2(v[6], v[7]);
              ((u32x4*)(base + 512 + 4096))[ks * 64 + lane] = o; } }
    }
    __syncthreads();
    { bf16_t* WSC = (bf16_t*)(ws + WS_WSC); const int gw = bid * NWAVES + wave, NGW = G * NWAVES; const int r = lane & 31, hh = lane >> 5;
      for (int it = gw; it < 4 * 16 * 32; it += NGW) { const int l = it >> 9, hj = (it >> 5) & 15, kb = it & 31, k0 = kb * 32;
          const float* wq = A.in[33] + ((size_t)l * 1024 + k0 + r) * 2048 + hj * 128; const float* sk = A.in[34] + ((size_t)l * 16 + hj) * 128 * 128;
          f32x16 acc[4];
#pragma unroll
          for (int ib = 0; ib < 4; ++ib) acc[ib] = f32x16{};
#pragma unroll 2
          for (int t = 0; t < 8; ++t) { const int d0 = 16 * t + 8 * hh;
              const f32x4 a0 = *(const f32x4*)(wq + d0), a1 = *(const f32x4*)(wq + d0 + 4);
              u32x4 ah, al; { float hi_[8], lo_[8];
#pragma unroll
                  for (int e = 0; e < 4; ++e) { hi_[e] = bflo(pk2(a0[e], 0.f)); lo_[e] = a0[e] - hi_[e]; hi_[4 + e] = bflo(pk2(a1[e], 0.f)); lo_[4 + e] = a1[e] - hi_[4 + e]; }
                  ah.x = pk2(hi_[0], hi_[1]); ah.y = pk2(hi_[2], hi_[3]); ah.z = pk2(hi_[4], hi_[5]); ah.w = pk2(hi_[6], hi_[7]);
                  al.x = pk2(lo_[0], lo_[1]); al.y = pk2(lo_[2], lo_[3]); al.z = pk2(lo_[4], lo_[5]); al.w = pk2(lo_[6], lo_[7]); }
              const bf16x8 Ah = __builtin_bit_cast(bf16x8, ah), Al = __builtin_bit_cast(bf16x8, al);
#pragma unroll
              for (int ib = 0; ib < 4; ++ib) { const float* sp = sk + (size_t)(32 * ib + r) * 128 + d0; const f32x4 b0 = *(const f32x4*)sp, b1 = *(const f32x4*)(sp + 4);
                  u32x4 bh, bl; { float hi_[8], lo_[8];
#pragma unroll
                      for (int e = 0; e < 4; ++e) { hi_[e] = bflo(pk2(b0[e], 0.f)); lo_[e] = b0[e] - hi_[e]; hi_[4 + e] = bflo(pk2(b1[e], 0.f)); lo_[4 + e] = b1[e] - hi_[4 + e]; }
                      bh.x = pk2(hi_[0], hi_[1]); bh.y = pk2(hi_[2], hi_[3]); bh.z = pk2(hi_[4], hi_[5]); bh.w = pk2(hi_[6], hi_[7]);
                      bl.x = pk2(lo_[0], lo_[1]); bl.y = pk2(lo_[2], lo_[3]); bl.z = pk2(lo_[4], lo_[5]); bl.w = pk2(lo_[6], lo_[7]); }
                  const bf16x8 Bh = __builtin_bit_cast(bf16x8, bh), Bl = __builtin_bit_cast(bf16x8, bl);
                  acc[ib] = mfma32(Ah, Bh, acc[ib]); acc[ib] = mfma32(Ah, Bl, acc[ib]); acc[ib] = mfma32(Al, Bh, acc[ib]); } }
#pragma unroll
          for (int ib = 0; ib < 4; ++ib) { bf16_t* dst = WSC + ((size_t)l * 2048 + hj * 128 + 32 * ib + r) * 1024 + k0;
#pragma unroll
              for (int g4 = 0; g4 < 4; ++g4) { u32x2 w; w.x = pk2(acc[ib][4 * g4], acc[ib][4 * g4 + 1]); w.y = pk2(acc[ib][4 * g4 + 2], acc[ib][4 * g4 + 3]); *(u32x2*)(dst + 8 * g4 + 4 * hh) = w; } } } }
}

struct Row16 { float v[16]; };
__device__ __forceinline__ Row16 ld_row_f32(const float* p, int lane) { Row16 r; const f32x4 a = *(const f32x4*)(p + 8 * lane), b = *(const f32x4*)(p + 8 * lane + 4), c = *(const f32x4*)(p + 512 + 8 * lane), d = *(const f32x4*)(p + 512 + 8 * lane + 4);
#pragma unroll
    for (int e = 0; e < 4; ++e) { r.v[e] = a[e]; r.v[4 + e] = b[e]; r.v[8 + e] = c[e]; r.v[12 + e] = d[e]; } return r; }
__device__ __forceinline__ void st_row_f32(float* p, int lane, const Row16& r) {
    *(f32x4*)(p + 8 * lane) = (f32x4){r.v[0], r.v[1], r.v[2], r.v[3]}; *(f32x4*)(p + 8 * lane + 4) = (f32x4){r.v[4], r.v[5], r.v[6], r.v[7]};
    *(f32x4*)(p + 512 + 8 * lane) = (f32x4){r.v[8], r.v[9], r.v[10], r.v[11]}; *(f32x4*)(p + 512 + 8 * lane + 4) = (f32x4){r.v[12], r.v[13], r.v[14], r.v[15]}; }
__device__ __forceinline__ Row16 ld_row_bf16(const bf16_t* p, int lane) { Row16 r; const u32x4 a = *(const u32x4*)(p + 8 * lane), b = *(const u32x4*)(p + 512 + 8 * lane);
    r.v[0] = bflo(a.x); r.v[1] = bfhi(a.x); r.v[2] = bflo(a.y); r.v[3] = bfhi(a.y); r.v[4] = bflo(a.z); r.v[5] = bfhi(a.z); r.v[6] = bflo(a.w); r.v[7] = bfhi(a.w);
    r.v[8] = bflo(b.x); r.v[9] = bfhi(b.x); r.v[10] = bflo(b.y); r.v[11] = bfhi(b.y); r.v[12] = bflo(b.z); r.v[13] = bfhi(b.z); r.v[14] = bflo(b.w); r.v[15] = bfhi(b.w); return r; }
__device__ __forceinline__ void st_row_bf16(bf16_t* p, int lane, const Row16& r) {
    u32x4 a, b; a.x = pk2(r.v[0], r.v[1]); a.y = pk2(r.v[2], r.v[3]); a.z = pk2(r.v[4], r.v[5]); a.w = pk2(r.v[6], r.v[7]);
    b.x = pk2(r.v[8], r.v[9]); b.y = pk2(r.v[10], r.v[11]); b.z = pk2(r.v[12], r.v[13]); b.w = pk2(r.v[14], r.v[15]);
    *(u32x4*)(p + 8 * lane) = a; *(u32x4*)(p + 512 + 8 * lane) = b; }
__device__ __forceinline__ Row16 layer_norm_row(const Row16& v, const float* g, const float* b, int lane) {
    float s = 0.f;
#pragma unroll
    for (int e = 0; e < 16; ++e) s += v.v[e];
    const float mean = wave_sum(s) * (1.f / 1024.f); float q = 0.f;
#pragma unroll
    for (int e = 0; e < 16; ++e) { const float d = v.v[e] - mean; q += d * d; }
    const float rstd = 1.0f / sqrtf(wave_sum(q) * (1.f / 1024.f) + 1e-5f);
    const Row16 gg = ld_row_f32(g, lane), bb = ld_row_f32(b, lane); Row16 o;
#pragma unroll
    for (int e = 0; e < 16; ++e) o.v[e] = (v.v[e] - mean) * rstd * gg.v[e] + bb.v[e];
    return o;
}
__device__ __forceinline__ const float* mod_row(const Args& A, int layer, int tok) { const int b = tok / LTOK, p = tok - b * LTOK; return (const float*)(A.ws + WS_MOD) + ((size_t)layer * NR + (p < CTXL ? BATCH : b)) * 6144; }

__device__ __forceinline__ void ph_init(const Args& A, Frame& F) {
    bf16_t* X = (bf16_t*)(A.ws + WS_X); bf16_t* H = (bf16_t*)(A.ws + WS_H);
    for (int tok = F.bid * NWAVES + F.wave; tok < NTOK; tok += F.G * NWAVES) { const int b = tok / LTOK, p = tok - b * LTOK;
        const float* src = p < CTXL ? A.in[2] + ((size_t)b * CTXL + p) * DM : A.in[0] + ((size_t)b * SEQ + (p - CTXL)) * DM;
        const Row16 x = ld_row_f32(src, F.lane); st_row_bf16(X + (size_t)tok * DM, F.lane, x);
        const float* mod = mod_row(A, 0, tok); const Row16 sh = ld_row_f32(mod, F.lane), sc = ld_row_f32(mod + 1024, F.lane); Row16 h;
#pragma unroll
        for (int e = 0; e < 16; ++e) h.v[e] = x.v[e] * (1.f + sc.v[e]) + sh.v[e];
        st_row_bf16(H + (size_t)tok * DM, F.lane, h); }
}
struct LnStat { float mean, rstd; };
__device__ __forceinline__ LnStat ln_stats(const Row16& v) {
    float s = 0.f;
#pragma unroll
    for (int e = 0; e < 16; ++e) s += v.v[e];
    const float mean = wave_sum(s) * (1.f / 1024.f); float q = 0.f;
#pragma unroll
    for (int e = 0; e < 16; ++e) { const float d = v.v[e] - mean; q += d * d; }
    LnStat r; r.mean = mean; r.rstd = 1.0f / sqrtf(wave_sum(q) * (1.f / 1024.f) + 1e-5f); return r;
}
__device__ __forceinline__ void ph_rowop(const Args& A, Frame& F, int layer, bool dry = false) {
    bf16_t* X = (bf16_t*)(A.ws + WS_X); const bf16_t* OUT = (const bf16_t*)(A.ws + WS_OUT); bf16_t* H2 = (bf16_t*)(A.ws + WS_H2);
    const int ntk = layer == 3 ? BATCH * SEQ : NTOK; const int gw = F.bid * NWAVES + F.wave, NGW = F.G * NWAVES;
    const int t_beg = (int)(((long)gw * ntk) / NGW), t_end = (int)(((long)(gw + 1) * ntk) / NGW);
    const Row16 lg = ld_row_f32(A.in[6] + (size_t)(layer * 2) * DM, F.lane), lb = ld_row_f32(A.in[7] + (size_t)(layer * 2) * DM, F.lane);
    Row16 g1, sh, sc; int cls = -1;
    auto tokof = [&](int ti) { return layer == 3 ? (ti / SEQ) * LTOK + CTXL + (ti % SEQ) : ti; };
    auto finish = [&](int tok, const Row16& x, const Row16& o) {
        Row16 v;
#pragma unroll
        for (int e = 0; e < 16; ++e) v.v[e] = DN_ALPHA * x.v[e] + g1.v[e] * o.v[e];
        const LnStat st = ln_stats(v); Row16 x1, h;
#pragma unroll
        for (int e = 0; e < 16; ++e) { x1.v[e] = (v.v[e] - st.mean) * st.rstd * lg.v[e] + lb.v[e]; h.v[e] = x1.v[e] * (1.f + sc.v[e]) + sh.v[e]; }
        if (dry) { if (x1.v[0] == 12345.678f) st_row_bf16(H2 + (size_t)tok * DM, F.lane, x1); return; }
        st_row_bf16(X + (size_t)tok * DM, F.lane, x1); st_row_bf16(H2 + (size_t)tok * DM, F.lane, h); };
    for (int ti = t_beg; ti < t_end; ti += 2) { const int tokA = tokof(ti); const bool two = ti + 1 < t_end; const int tokB = two ? tokof(ti + 1) : tokA;
        const int clsA = (tokA / LTOK) * 2 + ((tokA % LTOK) < CTXL), clsB = (tokB / LTOK) * 2 + ((tokB % LTOK) < CTXL);
        const Row16 xA = ld_row_bf16(X + (size_t)tokA * DM, F.lane), oA = ld_row_bf16(OUT + (size_t)tokA * DM, F.lane);
        const Row16 xB = ld_row_bf16(X + (size_t)tokB * DM, F.lane), oB = ld_row_bf16(OUT + (size_t)tokB * DM, F.lane);
        if (clsA != cls) { const float* mod = mod_row(A, layer, tokA); g1 = ld_row_f32(mod + 2048, F.lane); sh = ld_row_f32(mod + 3072, F.lane); sc = ld_row_f32(mod + 4096, F.lane); cls = clsA; }
        finish(tokA, xA, oA);
        if (two) { if (clsB != cls) { const float* mod = mod_row(A, layer, tokB); g1 = ld_row_f32(mod + 2048, F.lane); sh = ld_row_f32(mod + 3072, F.lane); sc = ld_row_f32(mod + 4096, F.lane); cls = clsB; }
            finish(tokB, xB, oB); } }
}

__device__ __forceinline__ void ph_s5_scan(const Args& A, Frame& F, int j) {
    const int lane = F.lane, wave = F.wave, r = lane & 31, h = lane >> 5;
    constexpr int RS = 272, NSEG = 4, CPS = (LTOK / 32) / NSEG;
    static_assert((LTOK / 32) % NSEG == 0, "segments");
    unsigned char* Sb = F.lds + wave * (32 * RS);
    f32x2* XCH = (f32x2*)(F.lds + 8 * 32 * RS);
    const bf16_t* H = (const bf16_t*)(A.ws + WS_H);
    const int il = wave >> 2, seg = wave & 3;
    for (int it0 = 2 * F.bid; it0 < BATCH * 128; it0 += 2 * F.G) { const int item = it0 + il; const bool act = item < BATCH * 128;
        const int g = item & 63, dir = (item >> 6) & 1, b = item >> 7;
        const unsigned char* cb = A.ws + WS_S5C + (size_t)((j * 2 + dir) * 64 + g) * S5C_ITEM;
        f32x2 ab = {0.f, 0.f}; bf16x8 Bf[4], Cf[8];
        if (act) { ab = ((const f32x2*)cb)[lane];
#pragma unroll
            for (int q = 0; q < 4; ++q) Bf[q] = ((const bf16x8*)(cb + 512))[q * 64 + lane]; }
        const float are = ab.x, aim = ab.y;
        bf16_t* Y = (bf16_t*)(A.ws + (dir ? WS_YB : WS_YF));
        float sre = 0.f, sim = 0.f;
        const int sbeg = seg * CPS * 32;
#define S5_LOADU(s0) (*(const bf16x8*)(H + ((size_t)b * LTOK + seqpos(dir, (s0) + r)) * DM + g * 16 + 8 * h))
#define S5_BU(ua) do { f32x16 a0 = {}, a1 = {}, a2 = {}, a3 = {}; a0 = mfma32(ua, Bf[0], a0); a2 = mfma32(ua, Bf[2], a2); a1 = mfma32(ua, Bf[1], a1); a3 = mfma32(ua, Bf[3], a3); \
            _Pragma("unroll") for (int q = 0; q < 16; ++q) { *(unsigned*)(Sb + crow(q, h) * RS + r * 4) = pk2(a0[q], a2[q]); *(unsigned*)(Sb + crow(q, h) * RS + (32 + r) * 4) = pk2(a1[q], a3[q]); } } while (0)
        if (act && seg < NSEG - 1) {
            const f32x2 abx = ((const f32x2*)cb)[32 + r]; const float ar0 = ((const f32x2*)cb)[r].x, ai0 = ((const f32x2*)cb)[r].y, ar1 = abx.x, ai1 = abx.y;
            float w0r[16], w0i[16], w1r[16], w1i[16];
            { float p0r = 1.f, p0i = 0.f, p1r = 1.f, p1i = 0.f;
#pragma unroll
              for (int q = 0; q < 16; ++q) { w0r[q] = 0.f; w0i[q] = 0.f; w1r[q] = 0.f; w1i[q] = 0.f; }
#pragma unroll
              for (int k = 0; k < 32; ++k) {
#pragma unroll
                  for (int q = 0; q < 16; ++q) { const int k0 = 31 - ((q & 3) + 8 * (q >> 2));
                      if (k0 == k) { w0r[q] = h ? w0r[q] : p0r; w0i[q] = h ? w0i[q] : p0i; w1r[q] = h ? w1r[q] : p1r; w1i[q] = h ? w1i[q] : p1i; }
                      if (k0 - 4 == k) { w0r[q] = h ? p0r : w0r[q]; w0i[q] = h ? p0i : w0i[q]; w1r[q] = h ? p1r : w1r[q]; w1i[q] = h ? p1i : w1i[q]; } }
                  { const float t_ = p0r * ar0 - p0i * ai0; p0i = p0r * ai0 + p0i * ar0; p0r = t_; } { const float t_ = p1r * ar1 - p1i * ai1; p1i = p1r * ai1 + p1i * ar1; p1r = t_; } }
              float s0r = 0.f, s0i = 0.f, s1r = 0.f, s1i = 0.f; bf16x8 un = S5_LOADU(sbeg);
              for (int c = 0; c < CPS; ++c) { const int s0 = sbeg + 32 * c; const bf16x8 ua = un; if (c + 1 < CPS) un = S5_LOADU(s0 + 32);
                  f32x16 a0 = {}, a1 = {}, a2 = {}, a3 = {}; a0 = mfma32(ua, Bf[0], a0); a2 = mfma32(ua, Bf[2], a2); a1 = mfma32(ua, Bf[1], a1); a3 = mfma32(ua, Bf[3], a3);
                  float q0r = 0.f, q0i = 0.f, q1r = 0.f, q1i = 0.f;
#pragma unroll
                  for (int q = 0; q < 16; ++q) { q0r += w0r[q] * a0[q] - w0i[q] * a2[q]; q0i += w0r[q] * a2[q] + w0i[q] * a0[q]; q1r += w1r[q] * a1[q] - w1i[q] * a3[q]; q1i += w1r[q] * a3[q] + w1i[q] * a1[q]; }
                  { const float t_ = p0r * s0r - p0i * s0i + q0r; s0i = p0r * s0i + p0i * s0r + q0i; s0r = t_; } { const float t_ = p1r * s1r - p1i * s1i + q1r; s1i = p1r * s1i + p1i * s1r + q1i; s1r = t_; } }
              s0r += __shfl_xor(s0r, 32); s0i += __shfl_xor(s0i, 32); s1r += __shfl_xor(s1r, 32); s1i += __shfl_xor(s1i, 32);
              XCH[(il * NSEG + seg) * 64 + lane] = h == 0 ? (f32x2){s0r, s0i} : (f32x2){s1r, s1i}; } }
        __syncthreads();
        { float pr = are, pi = aim, ar_ = 1.f, ai_ = 0.f;
          for (int e = CPS * 32; e > 0; e >>= 1) { if (e & 1) { const float t_ = ar_ * pr - ai_ * pi; ai_ = ar_ * pi + ai_ * pr; ar_ = t_; } const float t2 = pr * pr - pi * pi; pi = 2.f * pr * pi; pr = t2; }
          sre = 0.f; sim = 0.f;
          for (int k = 0; k < seg; ++k) { const f32x2 f = XCH[(il * NSEG + k) * 64 + lane]; const float nre = ar_ * sre - ai_ * sim + f.x, nim = ar_ * sim + ai_ * sre + f.y; sre = nre; sim = nim; } }
        if (act) {
            int lane2 = lane;
#ifndef CPU_EMU
            asm volatile("" : "+v"(lane2));
#endif
            const int r = lane2 & 31, h = lane2 >> 5, lane = lane2; (void)lane;
#pragma unroll
            for (int q = 0; q < 8; ++q) Cf[q] = ((const bf16x8*)(cb + 512 + 4096))[q * 64 + lane];
            bf16x8 un = S5_LOADU(sbeg);
            for (int c = 0; c < CPS; ++c) { const int s0 = sbeg + 32 * c; const bf16x8 ua = un; if (c + 1 < CPS) un = S5_LOADU(s0 + 32);
                S5_BU(ua); wave_sync();
#pragma unroll 8
                for (int t = 0; t < 32; ++t) { unsigned* wp = (unsigned*)(Sb + t * RS + lane * 4); const unsigned w = *wp; const float bre = bflo(w), bim = bfhi(w);
                    const float nre = are * sre - aim * sim + bre, nim = are * sim + aim * sre + bim; sre = nre; sim = nim; *wp = pk2(sre, sim); }
                wave_sync();
                f32x16 y = {};
#pragma unroll
                for (int ks = 0; ks < 8; ++ks) { const bf16x8 sa = *(const bf16x8*)(Sb + r * RS + (16 * ks + 8 * h) * 2); y = mfma32(Cf[ks], sa, y); }
                { bf16_t* yp = Y + ((size_t)b * LTOK + seqpos(dir, s0 + r)) * DM + g * 16 + 4 * h;
                  u32x2 w0, w1; w0.x = pk2(y[0], y[1]); w0.y = pk2(y[2], y[3]); w1.x = pk2(y[4], y[5]); w1.y = pk2(y[6], y[7]);
                  *(u32x2*)yp = w0; *(u32x2*)(yp + 8) = w1; }
                wave_sync(); } }
        __syncthreads();
#undef S5_LOADU
#undef S5_BU
    }
}
__device__ __forceinline__ void ph_s5_combine(const Args& A, Frame& F, int j) {
    const bf16_t* H = (const bf16_t*)(A.ws + WS_H); const bf16_t* YF = (const bf16_t*)(A.ws + WS_YF); const bf16_t* YB = (const bf16_t*)(A.ws + WS_YB); bf16_t* Gb = (bf16_t*)(A.ws + WS_G);
    const Row16 d = ld_row_f32(A.in[15] + (size_t)j * DM, F.lane); const int NGW = F.G * NWAVES;
    for (int tok = F.bid * NWAVES + F.wave; tok < NTOK; tok += 2 * NGW) { const int tokB = tok + NGW; const bool two = tokB < NTOK; const size_t oA = (size_t)tok * DM, oB = (size_t)(two ? tokB : tok) * DM;
        const Row16 hA = ld_row_bf16(H + oA, F.lane), fA = ld_row_bf16(YF + oA, F.lane), bA = ld_row_bf16(YB + oA, F.lane);
        const Row16 hB = ld_row_bf16(H + oB, F.lane), fB = ld_row_bf16(YF + oB, F.lane), bB = ld_row_bf16(YB + oB, F.lane); Row16 o;
#pragma unroll
        for (int e = 0; e < 16; ++e) o.v[e] = gelu_tanh(d.v[e] * hA.v[e] + fA.v[e] + bA.v[e]);
        st_row_bf16(Gb + oA, F.lane, o);
        if (two) {
#pragma unroll
            for (int e = 0; e < 16; ++e) o.v[e] = gelu_tanh(d.v[e] * hB.v[e] + fB.v[e] + bB.v[e]);
            st_row_bf16(Gb + oB, F.lane, o); } }
}

__device__ __forceinline__ void ph_ssd_conv(const Args& A, Frame& F) {
    const bf16_t* XBC = (const bf16_t*)(A.ws + WS_XBC); bf16_t* XC = (bf16_t*)(A.ws + WS_XBCC); const float* DT = (const float*)(A.ws + WS_DT); float* DTS = (float*)(A.ws + WS_DTS);
    const float* cw = A.in[19]; const float* cbias = A.in[20]; const float* dtb = A.in[21];
    const long gt = (long)F.bid * NTHR + F.tid, GT = (long)F.G * NTHR;
    for (long i = gt; i < (long)NTOK * 384; i += GT) { const int tok = (int)(i / 384), ch = (int)(i % 384) * 8; const int p = tok % LTOK;
        const bool hp = (p != 0 && p != CTXL), hn = (p != CTXL - 1 && p != LTOK - 1);
        const u32x4 z4 = {0u, 0u, 0u, 0u};
        const u32x4 c0 = *(const u32x4*)(XBC + (size_t)tok * 3072 + ch);
        const u32x4 cm = hp ? *(const u32x4*)(XBC + (size_t)(tok - 1) * 3072 + ch) : z4;
        const u32x4 cp = hn ? *(const u32x4*)(XBC + (size_t)(tok + 1) * 3072 + ch) : z4;
        float o[8];
#pragma unroll
        for (int e = 0; e < 4; ++e) { const unsigned wm = cm[e], w0 = c0[e], wp = cp[e]; const int c = ch + 2 * e;
            o[2 * e] = siluf_(cbias[c] + cw[c] * bflo(wm) + cw[3072 + c] * bflo(w0) + cw[6144 + c] * bflo(wp));
            o[2 * e + 1] = siluf_(cbias[c + 1] + cw[c + 1] * bfhi(wm) + cw[3072 + c + 1] * bfhi(w0) + cw[6144 + c + 1] * bfhi(wp)); }
        u32x4 w; w.x = pk2(o[0], o[1]); w.y = pk2(o[2], o[3]); w.z = pk2(o[4], o[5]); w.w = pk2(o[6], o[7]);
        *(u32x4*)(XC + (size_t)tok * 3072 + ch) = w; }
    { float* ACUM = (float*)(A.ws + WS_ACUM);
      for (long i = gt; i < (long)(NTOK / 64) * 64; i += GT) { const int blk = (int)(i >> 6), j = (int)(i & 63); const int dir = j >> 5; const float Aj = -__expf(A.in[22][j]); const float bj = dtb[j]; float ac = 0.f;
          for (int k = 0; k < 64; ++k) { const size_t tk = (size_t)blk * 64 + (dir ? 63 - k : k); const float x = DT[tk * 64 + j] + bj; const float dt = x > 20.f ? x : log1pf(__expf(x));
              DTS[tk * 64 + j] = dt; ac += dt * Aj; ACUM[tk * 64 + j] = ac; } } }
}
__device__ __forceinline__ int ssd_tokbase(int dir, int c) { return dir == 0 ? 64 * c : (c < CTXL / 64 ? CTXL - 64 * (c + 1) : LTOK + CTXL - 64 * (c + 1)); }
__device__ __forceinline__ bf16x8 tr_frag(const unsigned char* T, int rs, int s0, int c0, int lane) {
    const int i = lane & 15, hh = lane >> 5, rb = 16 * ((lane >> 4) & 1); const unsigned char* p = T + (s0 + 8 * hh + (i >> 2)) * rs + (c0 + rb + 4 * (i & 3)) * 2;
    const s16x4 lo = lds_tr(p), hi = lds_tr(p + 4 * rs); return (bf16x8){lo[0], lo[1], lo[2], lo[3], hi[0], hi[1], hi[2], hi[3]};
}
__device__ __forceinline__ void ph_ssd_scan(const Args& A, Frame& F) {
    const int tid = F.tid, lane = F.lane, wave = F.wave, r = lane & 31, hi = lane >> 5;
    constexpr int RS_BC = 272, RS_X = 144, O_CN = 0, O_BN = 17408, O_XN = 34816, O_XS = 44032, O_ML = 53248, O_SP = 62464, O_VEC = 79872;
    constexpr int O_CN2 = 80896, O_BN2 = 98304, O_XN2 = 115712, O_XS2 = 132096, O_VEC2 = 141312;
    unsigned char* L = F.lds;
    const bf16_t* XC = (const bf16_t*)(A.ws + WS_XBCC); const float* DTS = (const float*)(A.ws + WS_DTS); const float* ACUM = (const float*)(A.ws + WS_ACUM);
    constexpr int NCH = LTOK / 64;
    for (int item = F.bid; item < BATCH * 64; item += F.G) { const int hh = item & 31, dir = (item >> 5) & 1, b = item >> 6, grp = hh >> 3, jj = dir * 32 + hh;
        bf16_t* Y = (bf16_t*)(A.ws + (dir ? WS_YB2 : WS_YF2));
        f32x16 st = {};
        for (int i = tid; i < 64 * 17; i += NTHR) *(u32x4*)(L + O_SP + i * 16) = (u32x4){0u, 0u, 0u, 0u};
        u32x4 rC[2], rB[2], rX; float rdt = 0.f, rac = 0.f, rws = 0.f;
#define SSD_LOAD(c) do { const size_t t0 = (size_t)b * LTOK + ssd_tokbase(dir, (c)); \
            _Pragma("unroll") for (int k = 0; k < 2; ++k) { const int id = tid + 512 * k, row = id >> 4, c8 = (id & 15) * 8; \
                rC[k] = *(const u32x4*)(XC + (t0 + row) * 3072 + 2560 + grp * 128 + c8); rB[k] = *(const u32x4*)(XC + (t0 + row) * 3072 + 2048 + grp * 128 + c8); } \
            { const int row = tid >> 3; rX = *(const u32x4*)(XC + (t0 + row) * 3072 + hh * 64 + (tid & 7) * 8); \
              const float dt_ = DTS[(t0 + row) * 64 + jj], ac_ = ACUM[(t0 + row) * 64 + jj], at_ = ACUM[(t0 + (dir ? 0 : 63)) * 64 + jj]; rws = dt_ * __expf(at_ - ac_); \
              if (tid < 64) { rdt = DTS[(t0 + tid) * 64 + jj]; rac = ACUM[(t0 + tid) * 64 + jj]; } } } while (0)
#define SSD_WRITE(oCN_, oBN_, oXN_, oXS_, oV_) do { float* dtv_ = (float*)(L + (oV_)); float* acv_ = dtv_ + 64; float* eac_ = acv_ + 64; _Pragma("unroll") for (int k = 0; k < 2; ++k) { const int id = tid + 512 * k, row = id >> 4, c8 = (id & 15) * 8; \
                *(u32x4*)(L + (oCN_) + row * RS_BC + c8 * 2) = rC[k]; *(u32x4*)(L + (oBN_) + row * RS_BC + c8 * 2) = rB[k]; } \
            { const int row = tid >> 3, c8 = (tid & 7) * 8; *(u32x4*)(L + (oXN_) + row * RS_X + c8 * 2) = rX; u32x4 xs_; \
              xs_.x = pk2(bflo(rX.x) * rws, bfhi(rX.x) * rws); xs_.y = pk2(bflo(rX.y) * rws, bfhi(rX.y) * rws); xs_.z = pk2(bflo(rX.z) * rws, bfhi(rX.z) * rws); xs_.w = pk2(bflo(rX.w) * rws, bfhi(rX.w) * rws); \
              *(u32x4*)(L + (oXS_) + row * RS_X + c8 * 2) = xs_; } \
            if (tid < 64) { dtv_[tid] = rdt; acv_[tid] = rac; eac_[tid] = __expf(rac); } } while (0)
        SSD_LOAD(0); __syncthreads(); SSD_WRITE(O_CN, O_BN, O_XN, O_XS, O_VEC); __syncthreads();
        for (int c = 0; c < NCH; ++c) { const bool par = (c & 1) != 0;
            const int oCN = par ? O_CN2 : O_CN, oBN = par ? O_BN2 : O_BN, oXN = par ? O_XN2 : O_XN, oXS = par ? O_XS2 : O_XS; const float* dtv = (const float*)(L + (par ? O_VEC2 : O_VEC)); const float* acv = dtv + 64; const float* eac = acv + 64;
            if (c + 1 < NCH) SSD_LOAD(c + 1);
            const size_t t0 = (size_t)b * LTOK + ssd_tokbase(dir, c);
            f32x16 yacc = {};
            int pb = 0, qb = 0;
            if (wave < 4) { pb = wave >> 1; qb = wave & 1;
#pragma unroll
                for (int t = 0; t < 8; ++t) { const bf16x8 af = *(const bf16x8*)(L + O_SP + (32 * pb + r) * RS_BC + (16 * t + 8 * hi) * 2), bfr = *(const bf16x8*)(L + oCN + (32 * qb + r) * RS_BC + (16 * t + 8 * hi) * 2);
                    yacc = mfma32(af, bfr, yacc); }
                const float eq = eac[32 * qb + r];
#pragma unroll
                for (int q = 0; q < 16; ++q) yacc[q] *= eq;
            } else if (wave < 7) { const int ti = wave - 4; const int sb = dir == 0 ? (ti == 2) : (ti >= 1), qb2 = dir == 0 ? (ti >= 1) : (ti == 2);
                f32x16 m = {};
#pragma unroll
                for (int t = 0; t < 8; ++t) { const bf16x8 af = *(const bf16x8*)(L + oBN + (32 * sb + r) * RS_BC + (16 * t + 8 * hi) * 2), bfr = *(const bf16x8*)(L + oCN + (32 * qb2 + r) * RS_BC + (16 * t + 8 * hi) * 2);
                    m = mfma32(af, bfr, m); }
                const int qi = 32 * qb2 + r; const float aq = acv[qi];
#pragma unroll
                for (int g4 = 0; g4 < 4; ++g4) { float v[4];
#pragma unroll
                    for (int e = 0; e < 4; ++e) { const int si = 32 * sb + 8 * g4 + 4 * hi + e; const bool ok = dir == 0 ? (si <= qi) : (si >= qi);
                        v[e] = ok ? m[4 * g4 + e] * dtv[si] * __expf(aq - acv[si]) : 0.f; }
                    u32x2 w; w.x = pk2(v[0], v[1]); w.y = pk2(v[2], v[3]); *(u32x2*)(L + O_ML + qi * RS_X + (32 * sb + 8 * g4 + 4 * hi) * 2) = w; }
            }
            __syncthreads();
            if (wave < 4) {
#pragma unroll
                for (int sb = 0; sb < 2; ++sb) { const bool use = dir == 0 ? (sb <= qb) : (sb >= qb);
                    if (use) {
#pragma unroll
                        for (int kk = 0; kk < 2; ++kk) { const int s0 = 32 * sb + 16 * kk;
                            const bf16x8 af = tr_frag(L + oXN, RS_X, s0, 32 * pb, lane);
                            const bf16x8 bfr = *(const bf16x8*)(L + O_ML + (32 * qb + r) * RS_X + (s0 + 8 * hi) * 2);
                            yacc = mfma32(af, bfr, yacc); } } }
                bf16_t* yp = Y + (t0 + 32 * qb + r) * 2048 + hh * 64 + 32 * pb;
#pragma unroll
                for (int g4 = 0; g4 < 4; ++g4) { u32x2 w; w.x = pk2(yacc[4 * g4], yacc[4 * g4 + 1]); w.y = pk2(yacc[4 * g4 + 2], yacc[4 * g4 + 3]); *(u32x2*)(yp + 8 * g4 + 4 * hi) = w; }
            }
            { const int nb = wave >> 1, pb2 = wave & 1; const float dec = __expf(acv[dir ? 0 : 63]);
#pragma unroll
              for (int q = 0; q < 16; ++q) st[q] *= dec;
#pragma unroll
              for (int t = 0; t < 4; ++t) { const bf16x8 af = tr_frag(L + oBN, RS_BC, 16 * t, 32 * nb, lane), bfr = tr_frag(L + oXS, RS_X, 16 * t, 32 * pb2, lane); st = mfma32(af, bfr, st); }
            }
            { const int nb = wave >> 1, pb2 = wave & 1;
#pragma unroll
              for (int g4 = 0; g4 < 4; ++g4) { u32x2 w; w.x = pk2(st[4 * g4], st[4 * g4 + 1]); w.y = pk2(st[4 * g4 + 2], st[4 * g4 + 3]); *(u32x2*)(L + O_SP + (32 * pb2 + r) * RS_BC + (32 * nb + 8 * g4 + 4 * hi) * 2) = w; } }
            if (c + 1 < NCH) { if (par) SSD_WRITE(O_CN, O_BN, O_XN, O_XS, O_VEC); else SSD_WRITE(O_CN2, O_BN2, O_XN2, O_XS2, O_VEC2); }
            __syncthreads();
        }
#undef SSD_LOAD
#undef SSD_WRITE
    }
}
__device__ __forceinline__ void ph_ssd_gate(const Args& A, Frame& F) {
    const bf16_t* YF = (const bf16_t*)(A.ws + WS_YF2); const bf16_t* YB = (const bf16_t*)(A.ws + WS_YB2); const bf16_t* XC = (const bf16_t*)(A.ws + WS_XBCC); const bf16_t* Z = (const bf16_t*)(A.ws + WS_Z);
    bf16_t* G2 = (bf16_t*)(A.ws + WS_G2); const float* Dh = A.in[23]; const int NGW = F.G * NWAVES;
    float dh[4];
#pragma unroll
    for (int j = 0; j < 4; ++j) dh[j] = Dh[(512 * j + 8 * F.lane) >> 6];
    for (int tok = F.bid * NWAVES + F.wave; tok < NTOK; tok += 2 * NGW) { const int tokB = tok + NGW; const bool two = tokB < NTOK; const int tk[2] = {tok, two ? tokB : tok};
        u32x4 a[2][4], bq[2][4], x[2][4], z[2][4];
#pragma unroll
        for (int t = 0; t < 2; ++t)
#pragma unroll
            for (int j = 0; j < 4; ++j) { const int d0 = 512 * j + 8 * F.lane;
                a[t][j] = *(const u32x4*)(YF + (size_t)tk[t] * 2048 + d0); bq[t][j] = *(const u32x4*)(YB + (size_t)tk[t] * 2048 + d0); x[t][j] = *(const u32x4*)(XC + (size_t)tk[t] * 3072 + d0); z[t][j] = *(const u32x4*)(Z + (size_t)tk[t] * 2048 + d0); }
#pragma unroll
        for (int t = 0; t < 2; ++t) { if (t == 1 && !two) break; float v[32]; float ss = 0.f;
#pragma unroll
            for (int j = 0; j < 4; ++j)
#pragma unroll
                for (int e = 0; e < 4; ++e) { const float v0 = (bflo(a[t][j][e]) + bflo(bq[t][j][e]) + dh[j] * bflo(x[t][j][e])) * siluf_(bflo(z[t][j][e])), v1 = (bfhi(a[t][j][e]) + bfhi(bq[t][j][e]) + dh[j] * bfhi(x[t][j][e])) * siluf_(bfhi(z[t][j][e]));
                    v[8 * j + 2 * e] = v0; v[8 * j + 2 * e + 1] = v1; ss += v0 * v0 + v1 * v1; }
            const float rn = 1.0f / sqrtf(wave_sum(ss) * (1.f / 2048.f) + 1e-6f);
#pragma unroll
            for (int j = 0; j < 4; ++j) { u32x4 w; w.x = pk2(v[8 * j] * rn, v[8 * j + 1] * rn); w.y = pk2(v[8 * j + 2] * rn, v[8 * j + 3] * rn); w.z = pk2(v[8 * j + 4] * rn, v[8 * j + 5] * rn); w.w = pk2(v[8 * j + 6] * rn, v[8 * j + 7] * rn);
                *(u32x4*)(G2 + (size_t)tk[t] * 2048 + 512 * j + 8 * F.lane) = w; } } }
}

__device__ __forceinline__ void mla_kr(const Args& A, Frame& F) {
    const bf16_t* C = (const bf16_t*)(A.ws + WS_CQKV); bf16_t* Kb = (bf16_t*)(A.ws + WS_K); const float* ROPE = (const float*)(A.ws + WS_ROPE);
    const long gt = (long)F.bid * NTHR + F.tid, GT = (long)F.G * NTHR;
    for (long idx = gt; idx < (long)NTOK * 16; idx += GT) { const int tok = (int)(idx >> 4), i = (int)(idx & 15); const int b = tok / LTOK, p = tok - b * LTOK;
        const int o1 = (i < 8) ? i : 16 + (i - 8); float x1 = bf2f(C[(size_t)tok * 512 + 384 + o1]), x2 = bf2f(C[(size_t)tok * 512 + 384 + o1 + 8]);
        if (p >= CTXL) { const int t = p - CTXL; const int pos = (i < 8) ? (t >> 6) : (t & 63); const float c = ROPE[(pos * 8 + (i & 7)) * 2], s = ROPE[(pos * 8 + (i & 7)) * 2 + 1];
            const float y1 = x1 * c - x2 * s, y2 = x2 * c + x1 * s; x1 = y1; x2 = y2; }
        const unsigned w = pk2(x1, x2);
#pragma unroll 4
        for (int hd = 0; hd < 16; ++hd) *(unsigned*)(Kb + ((size_t)(b * 16 + hd) * LTOK + p) * 128 + 64 + 2 * i) = w; }
}
__device__ __forceinline__ void ph_attn(const Args& A, Frame& F) {
    const bf16_t* Q = (const bf16_t*)(A.ws + WS_Q); const bf16_t* Kb = (const bf16_t*)(A.ws + WS_K); const bf16_t* Vb = (const bf16_t*)(A.ws + WS_V); bf16_t* O = (bf16_t*)(A.ws + WS_O);
    constexpr int NLQ = SEQ / 256, NCQ = CTXL / 256, NLU = BATCH * 16 * NLQ, NU = NLU + BATCH * 16 * NCQ;
    const int vb = (F.G % 8 == 0) ? (F.bid % 8) * (F.G / 8) + F.bid / 8 : F.bid;
    for (int u = vb; u < NU; u += F.G) { int bh, p0, seq;
        if (u < NLU) { bh = u / NLQ; p0 = CTXL + (u % NLQ) * 256; seq = LTOK; } else { const int v = u - NLU; bh = v / NCQ; p0 = (v % NCQ) * 256; seq = CTXL; }
        const int b = bh >> 4, hd = bh & 15;
        att::attn_body(Q + ((size_t)bh * LTOK + p0) * 128, Kb + (size_t)bh * LTOK * 128, Vb + (size_t)bh * LTOK * 64, O + ((size_t)b * LTOK + p0) * DM + hd * 64, seq,
#ifdef CPU_EMU
                       F.lds,
#else
                       (char*)F.lds,
#endif
                       p0 >= CTXL ? p0 - CTXL : -1, (const float*)(A.ws + WS_ROPE), F.wave); }
}

__device__ __forceinline__ float ub0(unsigned w) { return (float)(w & 0xffu); }
__device__ __forceinline__ float ub1(unsigned w) { return (float)((w >> 8) & 0xffu); }
__device__ __forceinline__ float ub2(unsigned w) { return (float)((w >> 16) & 0xffu); }
__device__ __forceinline__ float ub3(unsigned w) { return (float)(w >> 24); }
#ifdef CPU_EMU
__device__ __forceinline__ unsigned udot4(unsigned a, unsigned b, unsigned c) { for (int i = 0; i < 4; ++i) c += ((a >> (8 * i)) & 255u) * ((b >> (8 * i)) & 255u); return c; }
#else
__device__ __forceinline__ unsigned udot4(unsigned a, unsigned b, unsigned c) { return __builtin_amdgcn_udot4(a, b, c, false); }
#endif
#ifdef CPU_EMU
__device__ __forceinline__ unsigned med3u(unsigned a, unsigned b, unsigned c) { const unsigned mn = a < b ? a : b, mx = a < b ? b : a; const unsigned t = mx < c ? mx : c; return mn > t ? mn : t; }
__device__ __forceinline__ unsigned lane_xor1(unsigned x) { return __shfl_xor(x, 1); }
#else
__device__ __forceinline__ unsigned med3u(unsigned a, unsigned b, unsigned c) { unsigned r; asm("v_med3_u32 %0, %1, %2, %3" : "=v"(r) : "v"(a), "v"(b), "v"(c)); return r; }
__device__ __forceinline__ unsigned lane_xor1(unsigned x) { return (unsigned)__builtin_amdgcn_update_dpp(0, (int)x, 0xB1, 0xF, 0xF, true); }
#endif
#define TOP16_INSERT(t, x) do { _Pragma("unroll") for (int k_ = 15; k_ >= 1; --k_) t[k_] = med3u(t[k_ - 1], t[k_], (x)); t[0] = t[0] > (x) ? t[0] : (x); } while (0)
__device__ __forceinline__ int peer_tok(int layer, int ti) { return layer == 3 ? (ti / SEQ) * LTOK + CTXL + (ti % SEQ) : ti; }
#ifdef CPU_EMU
__device__ __forceinline__ int ror8_i(int v) { return __shfl_xor(v, 8); }
__device__ __forceinline__ void lane_pair16(int x, int& lo, int& hi) { const int o = __shfl_xor(x, 16); const bool up = (threadIdx.x >> 4) & 1; lo = up ? o : x; hi = up ? x : o; }
__device__ __forceinline__ void lane_pair32(int x, int& lo, int& hi) { const int o = __shfl_xor(x, 32); const bool up = (threadIdx.x >> 5) & 1; lo = up ? o : x; hi = up ? x : o; }
#else
__device__ __forceinline__ int ror8_i(int v) { return __builtin_amdgcn_update_dpp(0, v, 0x128, 0xF, 0xF, true); }
__device__ __forceinline__ void lane_pair16(int x, int& lo, int& hi) { auto rr = __builtin_amdgcn_permlane16_swap((unsigned)x, (unsigned)x, false, false); lo = (int)rr[0]; hi = (int)rr[1]; }
__device__ __forceinline__ void lane_pair32(int x, int& lo, int& hi) { auto rr = __builtin_amdgcn_permlane32_swap((unsigned)x, (unsigned)x, false, false); lo = (int)rr[0]; hi = (int)rr[1]; }
#endif
#ifdef CPU_EMU
__device__ __forceinline__ unsigned bperm(unsigned s0, unsigned s1, unsigned sel) { const unsigned long long v = ((unsigned long long)s0 << 32) | s1; unsigned r = 0; for (int i = 0; i < 4; ++i) { const unsigned k = (sel >> (8 * i)) & 255u; const unsigned byte = k < 8u ? (unsigned)((v >> (8 * k)) & 255ull) : (k == 12u ? 0u : 255u); r |= byte << (8 * i); } return r; }
#else
__device__ __forceinline__ unsigned bperm(unsigned s0, unsigned s1, unsigned sel) { return __builtin_amdgcn_perm(s0, s1, sel); }
#endif
#ifdef CPU_EMU
__device__ __forceinline__ int sdot4(unsigned a, unsigned b, int c) { for (int i = 0; i < 4; ++i) c += (int)(signed char)(a >> (8 * i)) * (int)(signed char)(b >> (8 * i)); return c; }
__device__ __forceinline__ float sum_bits012(float v) { v += __shfl_xor(v, 1); v += __shfl_xor(v, 2); v += __shfl_xor(v, 4); return v; }
#else
__device__ __forceinline__ int sdot4(unsigned a, unsigned b, int c) { return __builtin_amdgcn_sdot4((int)a, (int)b, c, false); }
__device__ __forceinline__ float sum_bits012(float v) { v += dpp_f<0xB1>(v); v += dpp_f<0x4E>(v); v += dpp_f<0x141>(v); return v; }
#endif
#ifdef CPU_EMU
__device__ __forceinline__ float sum_bits345(float v) { v += __shfl_xor(v, 8); v += __shfl_xor(v, 16); v += __shfl_xor(v, 32); return v; }
#else
__device__ __forceinline__ float sum_bits345(float v) {
    v += dpp_f<0x128>(v);
    { auto rr = __builtin_amdgcn_permlane16_swap(__float_as_uint(v), __float_as_uint(v), false, false); v = __uint_as_float(rr[0]) + __uint_as_float(rr[1]); }
    { auto rr = __builtin_amdgcn_permlane32_swap(__float_as_uint(v), __float_as_uint(v), false, false); v = __uint_as_float(rr[0]) + __uint_as_float(rr[1]); }
    return v;
}
#endif
#ifdef CPU_EMU
__device__ __forceinline__ float merge_bit3(float a, float b) { const bool hi = (threadIdx.x >> 3) & 1; const float k = hi ? b : a, t = hi ? a : b; return k + __shfl_xor(t, 8); }
__device__ __forceinline__ float merge_bit4(float a, float b) { const bool hi = (threadIdx.x >> 4) & 1; const float k = hi ? b : a, t = hi ? a : b; return k + __shfl_xor(t, 16); }
__device__ __forceinline__ float merge_bit5(float a, float b) { const bool hi = (threadIdx.x >> 5) & 1; const float k = hi ? b : a, t = hi ? a : b; return k + __shfl_xor(t, 32); }
#else
__device__ __forceinline__ float merge_bit3(float a, float b) {
    const int x = __builtin_amdgcn_update_dpp(__builtin_bit_cast(int, b), __builtin_bit_cast(int, a), 0x128, 0xF, 0x3, false);
    const int y = __builtin_amdgcn_update_dpp(__builtin_bit_cast(int, a), __builtin_bit_cast(int, b), 0x128, 0xF, 0xC, false);
    return __builtin_bit_cast(float, x) + __builtin_bit_cast(float, y); }
__device__ __forceinline__ float merge_bit4(float a, float b) { auto rr = __builtin_amdgcn_permlane16_swap(__float_as_uint(a), __float_as_uint(b), false, false); return __uint_as_float(rr[0]) + __uint_as_float(rr[1]); }
__device__ __forceinline__ float merge_bit5(float a, float b) { auto rr = __builtin_amdgcn_permlane32_swap(__float_as_uint(a), __float_as_uint(b), false, false); return __uint_as_float(rr[0]) + __uint_as_float(rr[1]); }
#endif
#ifdef CPU_EMU
template <int K> __device__ __forceinline__ unsigned quad_bcast(unsigned v) { return __shfl(v, (int)((threadIdx.x & 63 & ~3) | K)); }
#else
template <int K> __device__ __forceinline__ unsigned quad_bcast(unsigned v) { return (unsigned)__builtin_amdgcn_update_dpp(0, (int)v, K * 0x55, 0xF, 0xF, true); }
#endif
#define EL_LOAD(ELQ, TOK) do { ELQ = *(const u32x4*)(PL + (size_t)(TOK) * 512 + 16 * e8 + 4 * (lane & 3)); } while (0)
#define EL_GET(ELQ, i) ((i) >> 2) == 0 ? quad_bcast<0>(ELQ[(i) & 3]) : ((i) >> 2) == 1 ? quad_bcast<1>(ELQ[(i) & 3]) : ((i) >> 2) == 2 ? quad_bcast<2>(ELQ[(i) & 3]) : quad_bcast<3>(ELQ[(i) & 3])
#ifdef CPU_EMU
__device__ __forceinline__ float fmerge_bit2(float a, float b) { const bool hi = (threadIdx.x >> 2) & 1; const float k = hi ? b : a, t = hi ? a : b; return k + __shfl_xor(t, 7); }
__device__ __forceinline__ float fmerge_bit1(float a, float b, int lane) { const bool hi = (lane >> 1) & 1; const float k = hi ? b : a, t = hi ? a : b; return k + __shfl_xor(t, 2); }
__device__ __forceinline__ float fmerge_bit0(float a, float b, int lane) { const bool hi = lane & 1; const float k = hi ? b : a, t = hi ? a : b; return k + __shfl_xor(t, 1); }
#else
__device__ __forceinline__ float fmerge_bit2(float a, float b) {
    const int x = __builtin_amdgcn_update_dpp(__builtin_bit_cast(int, b), __builtin_bit_cast(int, a), 0x141, 0xF, 0x5, false), y = __builtin_amdgcn_update_dpp(__builtin_bit_cast(int, a), __builtin_bit_cast(int, b), 0x141, 0xF, 0xA, false);
    return __builtin_bit_cast(float, x) + __builtin_bit_cast(float, y); }
__device__ __forceinline__ float fmerge_bit1(float a, float b, int lane) { const bool hi = (lane >> 1) & 1; const float k = hi ? b : a, t = hi ? a : b; return k + dpp_f<0x4E>(t); }
__device__ __forceinline__ float fmerge_bit0(float a, float b, int lane) { const bool hi = lane & 1; const float k = hi ? b : a, t = hi ? a : b; return k + dpp_f<0xB1>(t); }
#endif
#ifdef CPU_EMU
__device__ __forceinline__ int imerge_bit2(int a, int b) { const bool hi = (threadIdx.x >> 2) & 1; const int k = hi ? b : a, t = hi ? a : b; return k + __shfl_xor(t, 7); }
__device__ __forceinline__ int imerge_bit1(int a, int b, int lane) { const bool hi = (lane >> 1) & 1; const int k = hi ? b : a, t = hi ? a : b; return k + __shfl_xor(t, 2); }
__device__ __forceinline__ int imerge_bit0(int a, int b, int lane) { const bool hi = lane & 1; const int k = hi ? b : a, t = hi ? a : b; return k + __shfl_xor(t, 1); }
#else
__device__ __forceinline__ int imerge_bit2(int a, int b) {
    const int x = __builtin_amdgcn_update_dpp(b, a, 0x141, 0xF, 0x5, false), y = __builtin_amdgcn_update_dpp(a, b, 0x141, 0xF, 0xA, false); return x + y; }
__device__ __forceinline__ int imerge_bit1(int a, int b, int lane) { const bool hi = (lane >> 1) & 1; const int k = hi ? b : a, t = hi ? a : b; return k + __builtin_amdgcn_update_dpp(0, t, 0x4E, 0xF, 0xF, true); }
__device__ __forceinline__ int imerge_bit0(int a, int b, int lane) { const bool hi = lane & 1; const int k = hi ? b : a, t = hi ? a : b; return k + __builtin_amdgcn_update_dpp(0, t, 0xB1, 0xF, 0xF, true); }
#endif
__device__ __forceinline__ void ph_peer_a(const Args& A, Frame& F, int layer) {
    const int lane = F.lane;
    float* wsc = (float*)(F.lds + F.wave * 10240);
    const unsigned short* SC = (const unsigned short*)(A.ws + WS_SC); const bf16_t* H2 = (const bf16_t*)(A.ws + WS_H2);
    const float* US = (const float*)(A.ws + WS_US) + (size_t)layer * 16384 * 2; const float* VS = (const float*)(A.ws + WS_VS) + (size_t)layer * 16384;
    unsigned* PL = (unsigned*)(A.ws + WS_PL); unsigned char* PH = A.ws + WS_PH;
    const int ntk = layer == 3 ? BATCH * SEQ : NTOK; const int gw = F.bid * NWAVES + F.wave, NGW = F.G * NWAVES;
    const int t_beg = (int)(((long)gw * ntk) / NGW), t_end = (int)(((long)(gw + 1) * ntk) / NGW);
    for (int tg = t_beg; tg < t_end; tg += 4) {
        { const int tq = lane >> 4, li = lane & 15; const int ti = (tg + tq < t_end) ? tg + tq : t_end - 1;
          const int tokL = peer_tok(layer, ti);
          const unsigned short* src = SC + (size_t)tokL * 2048 + li * 128;
          unsigned t1[16];
#pragma unroll
          for (int k = 0; k < 16; ++k) t1[k] = 0u;
#pragma unroll 1
          for (int i = 0; i < 128; i += 8) { const u32x4 v = *(const u32x4*)(src + i);
#pragma unroll
              for (int e = 0; e < 8; ++e) { const float sv_ = (e & 1) ? hhi(v[e >> 1]) : hlo(v[e >> 1]); const float fv = fminf(fmaxf(sv_, -63.99f), 63.99f); const unsigned key = ((unsigned)((fv + 64.f) * 262144.f) << 7) | (unsigned)(i + e); TOP16_INSERT(t1, key); } }
          float v1[16], v2[16]; unsigned i1[16], i2[16];
#pragma unroll
          for (int k = 0; k < 16; ++k) { const unsigned p = lane_xor1(t1[k]); v1[k] = (float)(t1[k] >> 7) * (1.f / 262144.f) - 64.f; i1[k] = (t1[k] & 127u) << 7; v2[k] = (float)(p >> 7) * (1.f / 262144.f) - 64.f; i2[k] = p & 127u; }
          unsigned c[16];
#pragma unroll
          for (int k = 0; k < 16; ++k) c[k] = 0u;
#pragma unroll
          for (int ia = 0; ia < 16; ++ia)
#pragma unroll
              for (int ib = 0; ib < 16 / (ia + 1); ++ib) { const float sm = fminf(fmaxf(v1[ia] + v2[ib], -127.9f), 127.9f); const unsigned key = ((unsigned)((sm + 128.f) * 1024.f) << 14) | i1[ia] | i2[ib]; TOP16_INSERT(c, key); }
          if ((li & 1) == 0 && tg + tq < t_end) { float* Lb = wsc + tq * 640; int* EL = (int*)Lb; float* GL = Lb + 128; float* SUL = Lb + 256; const int hd = li >> 1;
              const float mx = (float)(c[0] >> 14) * (1.f / 1024.f); float ex[16]; float sum = 0.f;
#pragma unroll
              for (int k = 0; k < 16; ++k) { ex[k] = __expf((float)(c[k] >> 14) * (1.f / 1024.f) - mx); sum += ex[k]; }
              const float inv = 1.f / sum;
#pragma unroll
              for (int k = 0; k < 16; ++k) { const int e = (int)(c[k] & 16383u); EL[hd * 16 + k] = e * 128; GL[hd * 16 + k] = ex[k] * inv * VS[e]; SUL[hd * 16 + k] = US[2 * e]; } }
          wave_sync(); }
        for (int tq = 0; tq < 4 && tg + tq < t_end; ++tq) { const int tok = peer_tok(layer, tg + tq); const unsigned* Lb = (const unsigned*)(wsc + tq * 640);
            const Row16 hv = ld_row_bf16(H2 + (size_t)tok * DM, lane);
#pragma unroll
            for (int a = 0; a < 3; ++a)
#pragma unroll
                for (int r = 0; r < 2; ++r) { const int p = 64 * r + lane; PL[(size_t)tok * 512 + a * 128 + p] = Lb[a * 128 + (p & 7) * 16 + (p >> 3)]; }
            float amax = 0.f;
#pragma unroll
            for (int e = 0; e < 16; ++e) amax = fmaxf(amax, fabsf(hv.v[e]));
            const float shc = amax * (1.f / 127.f), inv1 = amax > 0.f ? 127.f / amax : 0.f;
            u32x4 h1w;
#pragma unroll
            for (int k = 0; k < 4; ++k) { unsigned w1 = 0u;
#pragma unroll
                for (int e = 0; e < 4; ++e) w1 |= ((unsigned)(int)rintf(hv.v[4 * k + e] * inv1) & 255u) << (8 * e);
                h1w[k] = w1; }
            *(u32x4*)(PH + (size_t)tok * 2048 + 16 * lane) = h1w; *(float*)(PH + (size_t)tok * 2048 + 1024 + 4 * lane) = shc; }
        wave_sync();
    }
}
struct PeerSlice { int s0, sstep, t_beg, t_end; };
__device__ __forceinline__ PeerSlice peer_slice(const Args& A, const Frame& F, int layer) {
    int m = F.G < 8 ? F.G : 8, r = F.bid % m, rank = F.bid / m, nrank = (F.G - 1 - r) / m + 1;
#ifndef CPU_EMU
    if (A.ph_hi - A.ph_lo > 1) { const unsigned* bar = (const unsigned*)(A.ws + WS_CTL) + 1024; bool ok = true; unsigned tot = 0u;
#pragma unroll
        for (int j = 0; j < 16; ++j) { const unsigned cj = __hip_atomic_load(&bar[256 + 64 * j], __ATOMIC_RELAXED, __HIP_MEMORY_SCOPE_AGENT); tot += cj; ok = ok && ((j < 8) == (cj > 0u)); }
        const volatile __attribute__((address_space(3))) unsigned* st = (const volatile __attribute__((address_space(3))) unsigned*)((__attribute__((address_space(3))) unsigned char*)F.lds + 131072) + 8;
        if (ok && tot == (unsigned)F.G) { const int x = rfl((int)st[3]); m = 8; r = x; rank = rfl((int)st[2]); nrank = rfl((int)__hip_atomic_load(&bar[256 + 64 * x], __ATOMIC_RELAXED, __HIP_MEMORY_SCOPE_AGENT)); } }
#endif
    const int ntk = layer == 3 ? BATCH * SEQ : NTOK, wi = rank * NWAVES + F.wave, nws = nrank * NWAVES;
    PeerSlice P; P.s0 = r; P.sstep = m; P.t_beg = (int)(((long)wi * ntk) / nws); P.t_end = (int)(((long)(wi + 1) * ntk) / nws); return P;
}
__device__ __forceinline__ void ph_peer_u(const Args& A, Frame& F, int layer) {
    const int lane = F.lane, e8 = lane >> 3, c = lane & 7; const PeerSlice P = peer_slice(A, F, layer);
    const unsigned* PL = (const unsigned*)(A.ws + WS_PL); const unsigned char* PH = A.ws + WS_PH; float* PD = (float*)(A.ws + WS_PD);
    const int kx = (lane & 1) * 4 + ((lane >> 1) & 1) * 2 + ((lane >> 2) & 1);
#define PU_LISTS(EL, H1, HS, TOK) do { H1 = *(const u32x4*)(PH + (size_t)(TOK) * 2048 + hoff); HS = *(const float*)(PH + (size_t)(TOK) * 2048 + 1024 + soff); \
        EL_LOAD(EL, TOK); } while (0)
#define PU_ROWS(Q, EL) do { _Pragma("unroll") for (int i = 0; i < 16; ++i) { const unsigned e_ = EL_GET(EL, i); Q[i] = *(const u32x4*)(UTs + (e_ + c16)); } } while (0)
#define PU_COMP(Q, C1, HS, TOK) do { float d[16]; \
        _Pragma("unroll") for (int i = 0; i < 16; ++i) { int d1 = 0; \
            _Pragma("unroll") for (int j = 0; j < 4; ++j) d1 = sdot4(Q[i][j], C1[j], d1); \
            d[i] = (float)d1 * HS; } \
        float m_[8], n_[4]; \
        _Pragma("unroll") for (int j = 0; j < 8; ++j) m_[j] = fmerge_bit2(d[2 * j], d[2 * j + 1]); \
        _Pragma("unroll") for (int j = 0; j < 4; ++j) n_[j] = fmerge_bit1(m_[2 * j], m_[2 * j + 1], lane); \
        const float p0_ = fmerge_bit0(n_[0], n_[1], lane), p1_ = fmerge_bit0(n_[2], n_[3], lane); \
        *(h16x2*)((_Float16*)PD + ((size_t)(TOK) * 8 + s) * 128 + 16 * e8 + 2 * kx) = pk_h2(p0_ * (1.f / 64.f), p1_ * (1.f / 64.f)); } while (0)
    for (int s = P.s0; s < 8; s += P.sstep) {
        const unsigned char* UTs = A.ws + WS_UT + (size_t)layer * 16384 * 1024 + (size_t)s * 16384 * 128; const unsigned c16 = 16u * (unsigned)c;
        const unsigned hoff = (unsigned)(128 * s + 16 * c), soff = (unsigned)(4 * (8 * s + c));
        if (P.t_beg >= P.t_end) continue;
        u32x4 ela, elb, ha1, hb1, qa[16], qb[16]; float ha2 = 0.f, hb2 = 0.f;
        int toka = peer_tok(layer, P.t_beg), tokb = toka;
        PU_LISTS(ela, ha1, ha2, toka); PU_ROWS(qa, ela);
        if (P.t_beg + 1 < P.t_end) { tokb = peer_tok(layer, P.t_beg + 1); PU_LISTS(elb, hb1, hb2, tokb); }
#pragma unroll 1
        for (int ti = P.t_beg; ti < P.t_end; ti += 2) {
            { if (ti + 1 < P.t_end) PU_ROWS(qb, elb);
              const int tc = toka; const u32x4 c1 = ha1; const float c2 = ha2;
              if (ti + 2 < P.t_end) { toka = peer_tok(layer, ti + 2); PU_LISTS(ela, ha1, ha2, toka); }
              PU_COMP(qa, c1, c2, tc); }
            if (ti + 1 >= P.t_end) break;
            { if (ti + 2 < P.t_end) PU_ROWS(qa, ela);
              const int tc = tokb; const u32x4 c1 = hb1; const float c2 = hb2;
              if (ti + 3 < P.t_end) { tokb = peer_tok(layer, ti + 3); PU_LISTS(elb, hb1, hb2, tokb); }
              PU_COMP(qb, c1, c2, tc); }
        }
    }
#undef PU_LISTS
#undef PU_ROWS
#undef PU_COMP
}
__device__ __forceinline__ void ph_peer_w(const Args& A, Frame& F, int layer) {
    const int lane = F.lane; const unsigned* PL = (const unsigned*)(A.ws + WS_PL); const float* PD = (const float*)(A.ws + WS_PD);
    unsigned char* PWB = A.ws + WS_PW; float* PWS = (float*)(A.ws + WS_PWS);
    const int ntk = layer == 3 ? BATCH * SEQ : NTOK; const int gw = F.bid * NWAVES + F.wave, NGW = F.G * NWAVES;
    const int t_beg = (int)(((long)gw * ntk) / NGW), t_end = (int)(((long)(gw + 1) * ntk) / NGW);
#pragma unroll 2
    for (int ti = t_beg; ti < t_end; ++ti) { const int tok = peer_tok(layer, ti); const int p0 = 16 * (lane >> 3) + (lane & 7);
        const _Float16* pd = (const _Float16*)PD + (size_t)tok * 1024 + 16 * (lane >> 3) + 2 * (lane & 7); const float* pl = (const float*)(PL + (size_t)tok * 512) + p0;
        float d0 = 0.f, d1 = 0.f;
#pragma unroll
        for (int s = 0; s < 8; ++s) { const unsigned w2 = *(const unsigned*)(pd + s * 128); d0 += hlo(w2); d1 += hhi(w2); }
        d0 *= 64.f; d1 *= 64.f;
        const float w0 = pl[128] * gelu_tanh(d0 * pl[256]), w1 = pl[128 + 8] * gelu_tanh(d1 * pl[256 + 8]);
        const float wmax = wave_max(fmaxf(fabsf(w0), fabsf(w1))); const float wsc = wmax * (1.f / 16256.f), winv = wmax > 0.f ? 16256.f / wmax : 0.f;
        const int q0 = (int)rintf(w0 * winv), q1 = (int)rintf(w1 * winv); const int h0 = q0 >> 7, h1 = q1 >> 7;
        unsigned char* pw = PWB + (size_t)tok * 256 + p0;
        pw[0] = (unsigned char)(h0 & 255); pw[8] = (unsigned char)(h1 & 255); pw[128] = (unsigned char)(q0 - h0 * 128); pw[136] = (unsigned char)(q1 - h1 * 128);
        if (lane == 0) PWS[tok] = wsc; }
}
__device__ __forceinline__ void ph_peer_v(const Args& A, Frame& F, int layer) {
    const int lane = F.lane, e8 = lane >> 3, c = lane & 7; const PeerSlice P = peer_slice(A, F, layer);
    const unsigned* PL = (const unsigned*)(A.ws + WS_PL); const unsigned char* PWB = A.ws + WS_PW; const float* PWS = (const float*)(A.ws + WS_PWS); _Float16* PO = (_Float16*)(A.ws + WS_PO);
    const unsigned c16 = 16u * (unsigned)c;
    const int am = lane & 15, aterm = am & 1, acb = ((am >> 1) & 1) + 2 * (am >> 3), apar = (am >> 2) & 1;
    const unsigned aoff = (unsigned)(aterm * 128 + 16 * (2 * (lane >> 4) + apar));
    unsigned asel[4];
#pragma unroll
    for (int sl = 0; sl < 4; ++sl) asel[sl] = 0x0C0C0C0Cu ^ ((0x0Cu ^ (unsigned)sl) << (8 * acb));
    for (int s = P.s0; s < 8; s += P.sstep) {
        const unsigned char* VTs = A.ws + WS_VT + (size_t)layer * 16384 * 1024 + (size_t)s * 16384 * 128;
        if (P.t_beg >= P.t_end) continue;
        int tok = peer_tok(layer, P.t_beg);
        u32x4 el; EL_LOAD(el, tok);
        u32x4 wa = *(const u32x4*)(PWB + (size_t)tok * 256 + aoff); float wsc = PWS[tok];
#pragma unroll 1
        for (int ti = P.t_beg; ti < P.t_end; ++ti) {
            u32x4 q[16];
#pragma unroll
            for (int i = 0; i < 16; ++i) { const unsigned e_ = EL_GET(el, i); q[i] = *(const u32x4*)(VTs + (e_ + c16)); }
            const int tokc = tok; const u32x4 wc = wa; const float wsc_c = wsc;
            if (ti + 1 < P.t_end) { tok = peer_tok(layer, ti + 1); EL_LOAD(el, tok);
                wa = *(const u32x4*)(PWB + (size_t)tok * 256 + aoff); wsc = PWS[tok]; }
            i32x4 acc[4];
#pragma unroll
            for (int d = 0; d < 4; ++d) acc[d] = (i32x4){0, 0, 0, 0};
#pragma unroll
            for (int j = 0; j < 4; ++j) { i32x4 aj;
#pragma unroll
                for (int sl = 0; sl < 4; ++sl) aj[sl] = (int)bperm(0u, wc[j], asel[sl]);
#pragma unroll
                for (int d = 0; d < 4; ++d) { const i32x4 bj = {(int)q[4 * j][d], (int)q[4 * j + 1][d], (int)q[4 * j + 2][d], (int)q[4 * j + 3][d]}; acc[d] = mfma_i8(aj, bj, acc[d]); } }
            int o[8];
#pragma unroll
            for (int d = 0; d < 4; ++d)
#pragma unroll
                for (int cl = 0; cl < 2; ++cl) { const int w_ = acc[d][2 * cl] * 128 + acc[d][2 * cl + 1]; int x0, x1; lane_pair16(w_, x0, x1); o[2 * d + cl] = x0 + ror8_i(x1); }
            if ((lane & 0x18) == 0) { _Float16* dst = PO + (size_t)tokc * 1024 + 128 * s + 16 * c + 2 * (lane >> 5);
#pragma unroll
                for (int d = 0; d < 4; ++d) *(h16x2*)(dst + 4 * d) = pk_h2((float)o[2 * d] * wsc_c, (float)o[2 * d + 1] * wsc_c); }
        }
    }
}
__device__ __forceinline__ void ph_peer_e(const Args& A, Frame& F, int layer, bool dry = false) {
    const int lane = F.lane; bf16_t* X = (bf16_t*)(A.ws + WS_X); bf16_t* H = (bf16_t*)(A.ws + WS_H); const float* PO = (const float*)(A.ws + WS_PO); const float* PWS = (const float*)(A.ws + WS_PWS);
    const int ntk = layer == 3 ? BATCH * SEQ : NTOK; const int gw = F.bid * NWAVES + F.wave, NGW = F.G * NWAVES;
    const int t_beg = (int)(((long)gw * ntk) / NGW), t_end = (int)(((long)(gw + 1) * ntk) / NGW);
    const Row16 lg = ld_row_f32(A.in[6] + (size_t)(layer * 2 + 1) * DM, lane), lb = ld_row_f32(A.in[7] + (size_t)(layer * 2 + 1) * DM, lane);
    Row16 g2, sh, scl; int cls = -1;
    auto setcls = [&](int tok) { const int c_ = (tok / LTOK) * 2 + ((tok % LTOK) < CTXL); if (c_ != cls) { cls = c_; g2 = ld_row_f32(mod_row(A, layer, tok) + 5120, lane);
            if (layer < 3) { const float* modn = mod_row(A, layer + 1, tok); sh = ld_row_f32(modn, lane); scl = ld_row_f32(modn + 1024, lane); } } };
    auto ldpo = [&](int tok) { const _Float16* po = (const _Float16*)PO + (size_t)tok * 1024 + 16 * lane; const u32x4 o0 = *(const u32x4*)po, o1 = *(const u32x4*)(po + 8); Row16 out;
#pragma unroll
        for (int e = 0; e < 4; ++e) { out.v[2 * e] = hlo(o0[e]); out.v[2 * e + 1] = hhi(o0[e]); out.v[8 + 2 * e] = hlo(o1[e]); out.v[8 + 2 * e + 1] = hhi(o1[e]); }
        return out; };
    auto finish = [&](int tok, const Row16& x1, const Row16& out) { const int b = tok / LTOK, p = tok - b * LTOK; Row16 v;
#pragma unroll
        for (int e = 0; e < 16; ++e) v.v[e] = DN_ALPHA * x1.v[e] + g2.v[e] * out.v[e];
        const LnStat st = ln_stats(v); Row16 x2;
#pragma unroll
        for (int e = 0; e < 16; ++e) x2.v[e] = (v.v[e] - st.mean) * st.rstd * lg.v[e] + lb.v[e];
        if (dry) { if (x2.v[0] == 12345.678f) st_row_f32((float*)(A.ws + WS_OUT) + (size_t)tok * DM, lane, x2); return; }
        if (layer < 3) { st_row_bf16(X + (size_t)tok * DM, lane, x2); Row16 hn;
#pragma unroll
            for (int e = 0; e < 16; ++e) hn.v[e] = x2.v[e] * (1.f + scl.v[e]) + sh.v[e];
            st_row_bf16(H + (size_t)tok * DM, lane, hn);
        } else { st_row_f32(A.out + ((size_t)b * SEQ + (p - CTXL)) * DM, lane, x2); } };
    for (int ti = t_beg; ti < t_end; ti += 2) { const int tokA = peer_tok(layer, ti); const bool two = ti + 1 < t_end; const int tokB = two ? peer_tok(layer, ti + 1) : tokA;
        const Row16 oA = ldpo(tokA), xA = ld_row_bf16(X + (size_t)tokA * DM, lane), oB = ldpo(tokB), xB = ld_row_bf16(X + (size_t)tokB * DM, lane);
        setcls(tokA); finish(tokA, xA, oA);
        if (two) { setcls(tokB); finish(tokB, xB, oB); } }
}

constexpr int NPHASE = 45;
constexpr int PH_ORDER[NPHASE] = {0, 1, 2, 3, 4, 5, 6, 29, 30, 31, 32, 7, 8, 9, 10, 11, 12, 13, 14, 33, 34, 35, 36, 15, 16, 17, 18, 19, 20, 21, 37, 38, 39, 40, 22, 23, 24, 25, 26, 27, 41, 42, 43, 44, 28};
__device__ __forceinline__ void gemm_f32(const Args& A, Frame& F, const bf16_t* Am, int lda, const bf16_t* Bt, int ldb, int N, int K, float* O, int ldc, bool lat = false) {
    pg8::Gemm g{Am, Bt, NTOK, N, K, lda, ldb}; pg8::StaticOrder S; S.init(NTOK, N, F.G, F.bid, lat); EpiF32 E{O, ldc};
    pg8::gemm_phase<EpiF32, pg8::StaticOrder, PG8_ALIGN, PG8_SP2>(GEMM_LDS(F), g, S, E, F.wave);
}
__device__ __forceinline__ void gemm_b16(const Args& A, Frame& F, const bf16_t* Am, int lda, const bf16_t* Bt, int ldb, int N, int K, bf16_t* O, int ldc) {
    pg8::Gemm g{Am, Bt, NTOK, N, K, lda, ldb}; pg8::StaticOrder S; S.init(NTOK, N, F.G, F.bid); EpiB16 E{O, ldc};
    pg8::gemm_phase<EpiB16, pg8::StaticOrder, PG8_ALIGN, PG8_SP2>(GEMM_LDS(F), g, S, E, F.wave);
}
__device__ __forceinline__ void run_phase(const Args& A, Frame& F, int ph, bool dry = false) {
    unsigned char* ws = A.ws;
    switch (ph) {
    case 0: ph_prep(A, F); break;
    case 1: ph_init(A, F); break;
    case 2: case 23: ph_s5_scan(A, F, ph == 2 ? 0 : 1); break;
    case 3: case 24: ph_s5_combine(A, F, ph == 3 ? 0 : 1); break;
    case 4: case 25: { const int j = ph == 4 ? 0 : 1;
        pg8::Gemm g{(const bf16_t*)(ws + WS_G), (const bf16_t*)(ws + WS_WGLU) + (size_t)j * 2048 * 1024, NTOK, 2048, 1024, 1024, 1024}; pg8::StaticOrder S; S.init(NTOK, 2048, F.G, F.bid, j == 1); EpiGlu E{(bf16_t*)(ws + WS_OUT)};
        pg8::gemm_phase<EpiGlu, pg8::StaticOrder, PG8_ALIGN, PG8_SP2>(GEMM_LDS(F), g, S, E, F.wave); } break;
    case 5: ph_rowop(A, F, 0, dry); break;
    case 13: ph_rowop(A, F, 1, dry); break;
    case 20: ph_rowop(A, F, 2, dry); break;
    case 26: ph_rowop(A, F, 3, dry); break;
    case 6: case 14: case 21: case 27: { const int layer = ph == 6 ? 0 : ph == 14 ? 1 : ph == 21 ? 2 : 3;
        pg8::Gemm g{(const bf16_t*)(ws + WS_H2), (const bf16_t*)(ws + WS_WSC) + (size_t)layer * 2048 * 1024, NTOK, 2048, 1024, 1024, 1024}; pg8::StaticOrder S; S.init(NTOK, 2048, F.G, F.bid, layer == 3);
        EpiH16 E{(unsigned short*)(ws + WS_SC), 2048};
        pg8::gemm_phase<EpiH16, pg8::StaticOrder, PG8_ALIGN, PG8_SP2>(GEMM_LDS(F), g, S, E, F.wave); } break;
    case 7: ph_peer_e(A, F, 0, dry); break;
    case 15: ph_peer_e(A, F, 1, dry); break;
    case 22: ph_peer_e(A, F, 2, dry); break;
    case 28: ph_peer_e(A, F, 3, dry); break;
    case 29: case 33: case 37: case 41: ph_peer_a(A, F, (ph - 29) >> 2); break;
    case 30: case 34: case 38: case 42: ph_peer_u(A, F, (ph - 29) >> 2); break;
    case 31: case 35: case 39: case 43: ph_peer_w(A, F, (ph - 29) >> 2); break;
    case 32: case 36: case 40: case 44: ph_peer_v(A, F, (ph - 29) >> 2); break;
    case 8: { pg8::Gemm g{(const bf16_t*)(ws + WS_H), (const bf16_t*)(ws + WS_WIN), NTOK, SSD_IN_PAD, 1024, 1024, 1024}; pg8::StaticOrder S; S.init(NTOK, SSD_IN_PAD, F.G, F.bid);
        EpiSsdIn E{(bf16_t*)(ws + WS_Z), (bf16_t*)(ws + WS_XBC), (float*)(ws + WS_DT)};
        pg8::gemm_phase<EpiSsdIn, pg8::StaticOrder, PG8_ALIGN, PG8_SP2>(GEMM_LDS(F), g, S, E, F.wave); } break;
    case 9: ph_ssd_conv(A, F); break;
    case 10: ph_ssd_scan(A, F); break;
    case 11: ph_ssd_gate(A, F); break;
    case 12: gemm_b16(A, F, (const bf16_t*)(ws + WS_G2), 2048, (const bf16_t*)(ws + WS_WOUT), 2048, 1024, 2048, (bf16_t*)(ws + WS_OUT), 1024); break;
    case 16: { pg8::Gemm g{(const bf16_t*)(ws + WS_H), (const bf16_t*)(ws + WS_WDOWN), NTOK, 512, 1024, 1024, 1024}; pg8::StaticOrder S; S.init(NTOK, 512, F.G, F.bid);
        EpiMlaDown E{(bf16_t*)(ws + WS_CQKV), (float*)(ws + WS_RS)};
        pg8::gemm_phase<EpiMlaDown, pg8::StaticOrder, PG8_ALIGN, PG8_SP2>(GEMM_LDS(F), g, S, E, F.wave); } break;
    case 17: { mla_kr(A, F); __syncthreads();
        pg8::Gemm g{(const bf16_t*)(ws + WS_CQKV), (const bf16_t*)(ws + WS_WUP), NTOK, 4096, 384, 512, 384}; pg8::StaticOrder S; S.init(NTOK, 4096, F.G, F.bid);
        EpiMlaUp E{(bf16_t*)(ws + WS_Q), (bf16_t*)(ws + WS_K), (bf16_t*)(ws + WS_V), (const float*)(ws + WS_RS)};
        pg8::gemm_phase<EpiMlaUp, pg8::StaticOrder, PG8_ALIGN, PG8_SP2>(GEMM_LDS(F), g, S, E, F.wave); } break;
    case 18: ph_attn(A, F); break;
    case 19: gemm_b16(A, F, (const bf16_t*)(ws + WS_O), 1024, (const bf16_t*)(ws + WS_WO), 1024, 1024, 1024, (bf16_t*)(ws + WS_OUT), 1024); break;
    default: break;
    }
}

#ifndef CPU_EMU
#define LAS __attribute__((address_space(3)))
#define XB_TMO      128
#define XB_XCNT(j)  (256  + 64 * (j))
#define XB_XSUB(j)  (1280 + 64 * (j))
#define XB_XGEN(j)  (2304 + 64 * (j))
#define XB_TOP      3328
#define XB_TOPGEN   3392
#define XCD_BAR_WORDS 3456
#define XB_SPIN_CAP (1u << 22)
__device__ __forceinline__ unsigned xb_ld(unsigned* p)              { return __hip_atomic_load(p, __ATOMIC_RELAXED, __HIP_MEMORY_SCOPE_AGENT); }
__device__ __forceinline__ unsigned xb_add(unsigned* p, unsigned v) { return __hip_atomic_fetch_add(p, v, __ATOMIC_RELAXED, __HIP_MEMORY_SCOPE_AGENT); }
__device__ __forceinline__ unsigned xb_xcc_id() { return (unsigned)__builtin_amdgcn_s_getreg((3 << 11) | 20) & 0xFu; }
#define XB_SPIN(cond, bar) do { unsigned _sp = 0; while (cond) { __builtin_amdgcn_s_sleep(1); \
    if ((++_sp & 255u) == 0u) { if (xb_ld(&(bar)[XB_TMO])) break; if (_sp > XB_SPIN_CAP) { atomicAdd(&(bar)[XB_TMO], 1u); break; } } } } while (0)
struct XcdBarrier { unsigned* bar; unsigned x; volatile LAS unsigned* st; };
__device__ __forceinline__ XcdBarrier xcd_barrier_post(unsigned* bar, volatile LAS unsigned* st) {
    XcdBarrier b; b.bar = bar; b.x = xb_xcc_id(); b.st = st;
    if (threadIdx.x == 0) { st[2] = xb_add(&bar[XB_XCNT(b.x)], 1u); st[3] = b.x; }
    return b;
}
__device__ __forceinline__ void xcd_barrier_complete(unsigned* bar, unsigned x, unsigned& nloc, unsigned& nx) {
    const unsigned G = gridDim.x * gridDim.y * gridDim.z;
    unsigned sum, cnt, mine, sp = 0u;
    for (;;) {
        sum = 0u; cnt = 0u; mine = 0u;
#pragma unroll
        for (unsigned j = 0; j < 16; ++j) { const unsigned c = xb_ld(&bar[XB_XCNT(j)]); sum += c; cnt += (c > 0u) ? 1u : 0u; mine = (j == x) ? c : mine; }
        if (sum == G) break;
        __builtin_amdgcn_s_sleep(1);
        if ((++sp & 255u) == 0u) { if (xb_ld(&bar[XB_TMO])) break; if (sp > XB_SPIN_CAP) { atomicAdd(&bar[XB_TMO], 1u); break; } }
    }
    nloc = mine > 0u ? mine : 1u; nx = cnt > 0u ? cnt : 1u;
}
__device__ __forceinline__ void xcd_barrier(const XcdBarrier& b, int wave_s) {
    asm volatile("s_waitcnt vmcnt(0)" ::: "memory");
    __syncthreads();
    if (wave_s == 0 && hw_lane() == 0) {
        unsigned* bar = b.bar;
        __builtin_amdgcn_s_waitcnt(0);
        unsigned nloc = b.st[0], nx = b.st[1];
        if (nloc == 0u) { xcd_barrier_complete(bar, b.x, nloc, nx); b.st[0] = nloc; b.st[1] = nx; }
        const unsigned old = xb_add(&bar[XB_XSUB(b.x)], 1u);
        const unsigned gen = old / nloc;
        if (old + 1u == (gen + 1u) * nloc) {
            __builtin_amdgcn_fence(__ATOMIC_RELEASE, "agent");
            asm volatile("s_waitcnt vmcnt(0)" ::: "memory");
            const unsigned og = xb_add(&bar[XB_TOP], 1u);
            const unsigned tg = og / nx;
            if (og + 1u == (tg + 1u) * nx) xb_add(&bar[XB_TOPGEN], 1u);
            else XB_SPIN(xb_ld(&bar[XB_TOPGEN]) == tg, bar);
            __builtin_amdgcn_fence(__ATOMIC_ACQUIRE, "agent");
            xb_add(&bar[XB_XGEN(b.x)], 1u);
            asm volatile("s_waitcnt vmcnt(0)" ::: "memory");
        } else {
            XB_SPIN(xb_ld(&bar[XB_XGEN(b.x)]) == gen, bar);
            __builtin_amdgcn_fence(__ATOMIC_ACQUIRE, "agent");
            asm volatile("s_waitcnt vmcnt(0)" ::: "memory");
        }
    }
    __syncthreads();
}

constexpr int LDS_BYTES = 147456;
constexpr int LDSCTL_OFF = 131072;
__device__ __forceinline__ Frame mk_frame(unsigned char* lds, int wave_s) {
    int l = hw_lane(); asm volatile("" : "+v"(l));
    Frame F; F.lds = lds; F.lane = l; F.wave = wave_s; F.tid = wave_s * 64 + l; F.G = gridDim.x; F.bid = blockIdx.x; return F;
}
__device__ __forceinline__ void grid_bar(unsigned char* ws, unsigned char* lds, int wave_s) {
    XcdBarrier bar; bar.bar = (unsigned*)(ws + WS_CTL) + 1024; bar.x = xb_xcc_id(); bar.st = (volatile LAS unsigned*)((LAS unsigned char*)lds + LDSCTL_OFF) + 8;
    xcd_barrier(bar, wave_s);
}
__global__ void __launch_bounds__(NTHR, 2) hybrid_fwd(Args args) {
    extern __shared__ __attribute__((aligned(16))) unsigned char lds[];
    const int wave_s = __builtin_amdgcn_readfirstlane((int)threadIdx.x >> 6);
    { volatile LAS unsigned* MISC = (volatile LAS unsigned*)((LAS unsigned char*)lds + LDSCTL_OFF);
      if (wave_s == 0) MISC[hw_lane()] = 0u;
      __syncthreads();
      if (args.ph_hi - args.ph_lo > 1) (void)xcd_barrier_post((unsigned*)(args.ws + WS_CTL) + 1024, MISC + 8); }
    const int lo = args.ph_lo, hi = args.ph_hi;
    if (PROBE && blockIdx.x == 0 && wave_s == 0 && hw_lane() == 0) { ((unsigned long long*)(args.ws + WS_TS))[0] = __builtin_amdgcn_s_memrealtime(); ((unsigned long long*)(args.ws + WS_TS))[40] = 0ull; ((unsigned long long*)(args.ws + WS_TS))[41] = 0ull; }
#define PHASE(k, id) if (lo <= (k) && (k) < hi) { if ((DUPMASK >> (k)) & 1ull) { Frame F = mk_frame(lds, wave_s); run_phase(args, F, (id), true); grid_bar(args.ws, lds, wave_s); } { Frame F = mk_frame(lds, wave_s); run_phase(args, F, (id)); } if ((k) + 1 < hi) { if (USE_CG && (k) == 0) cg::this_grid().sync(); grid_bar(args.ws, lds, wave_s); } }
    PHASE(0, 0) PHASE(1, 1) PHASE(2, 2) PHASE(3, 3) PHASE(4, 4) PHASE(5, 5) PHASE(6, 6) PHASE(7, 29) PHASE(8, 30) PHASE(9, 31) PHASE(10, 32) PHASE(11, 7)
    PHASE(12, 8) PHASE(13, 9) PHASE(14, 10) PHASE(15, 11) PHASE(16, 12) PHASE(17, 13) PHASE(18, 14) PHASE(19, 33) PHASE(20, 34) PHASE(21, 35) PHASE(22, 36) PHASE(23, 15)
    PHASE(24, 16) PHASE(25, 17) PHASE(26, 18) PHASE(27, 19) PHASE(28, 20) PHASE(29, 21) PHASE(30, 37) PHASE(31, 38) PHASE(32, 39) PHASE(33, 40) PHASE(34, 22)
    PHASE(35, 23) PHASE(36, 24) PHASE(37, 25) PHASE(38, 26) PHASE(39, 27) PHASE(40, 41) PHASE(41, 42) PHASE(42, 43) PHASE(43, 44) PHASE(44, 28)
#undef PHASE
}

extern "C" void kernel_launch(void* const* d_in, const int* in_sizes, int n_in, void* d_out, int out_size, void* d_ws, size_t ws_size, hipStream_t stream) {
    static int grid = 0;
    if (grid == 0) {
        if (n_in != 37 || ws_size < WS_END) { fprintf(stderr, "kernel_launch: unexpected n_in %d / ws %zu\n", n_in, ws_size); grid = -1; return; }
        int dev = 0, cus = 0, per_cu = 0;
        hipGetDevice(&dev); hipDeviceGetAttribute(&cus, hipDeviceAttributeMultiprocessorCount, dev);
        hipFuncSetAttribute((const void*)hybrid_fwd, hipFuncAttributeMaxDynamicSharedMemorySize, LDS_BYTES);
        hipOccupancyMaxActiveBlocksPerMultiprocessor(&per_cu, (const void*)hybrid_fwd, NTHR, LDS_BYTES);
        (void)hipGetLastError();
        if (per_cu < 1) { fprintf(stderr, "kernel_launch: occupancy query says %d blocks/CU\n", per_cu); per_cu = 1; }
        grid = cus;
    }
    if (grid < 0) return;
    hipMemsetAsync((char*)d_ws + WS_CTL, 0, CTL_ZERO_BYTES, stream);
    Args a{};
    for (int i = 0; i < 37; ++i) a.in[i] = (const float*)d_in[i];
    a.out = (float*)d_out; a.ws = (unsigned char*)d_ws; a.ph_lo = 0; a.ph_hi = NPHASE;
#if USE_CG
    void* kargs[] = {&a};
    hipError_t e = hipLaunchCooperativeKernel((const void*)hybrid_fwd, dim3(grid), dim3(NTHR), kargs, LDS_BYTES, stream);
    if (e != hipSuccess) fprintf(stderr, "cooperative launch failed: %s (grid %d)\n", hipGetErrorString(e), grid);
#else
    hipLaunchKernelGGL(hybrid_fwd, dim3(grid), dim3(NTHR), LDS_BYTES, stream, a);
    const hipError_t e = hipPeekAtLastError();
    if (e != hipSuccess) fprintf(stderr, "launch failed: %s (grid %d)\n", hipGetErrorString(e), grid);
#endif
}
#endif
```
